# Optimizing an MI355X kernel written in HIP

```python
import math
import jax, jax.numpy as jnp
from jax import lax
import numpy as np

D_MODEL = 1024
BATCH = 8
SEQ = 2048
DEPTH = 2

HEAD_DIM = 64
ROPE_THETA = 10000.0
RNN_WIDTH = 1024
RNN_BLOCKS = 16
RNN_BLOCK_W = RNN_WIDTH // RNN_BLOCKS
CONV_W = 4
LRU_C = 8.0
DIFF_HEADS = 4
DIFF_QK = DIFF_HEADS * 2 * HEAD_DIM
DIFF_V = DIFF_HEADS * 2 * HEAD_DIM
MOBA_HEADS = 8
MOBA_W = MOBA_HEADS * HEAD_DIM
MOBA_BLOCK = 256
MOBA_TOPK = 3
MOBA_Q_CHUNK = 16
ATTN_Q_BLOCK = 128
N_BRANCH = 3
IN_SPLITS = (RNN_WIDTH, RNN_WIDTH, DIFF_QK, DIFF_QK, DIFF_V, MOBA_W, MOBA_W, MOBA_W, N_BRANCH * D_MODEL)
IN_COLS = sum(IN_SPLITS)
D_FF = 2816
N_EXPERTS = 8
TOP_K = 2
N_DENSE = (DEPTH + 1) // 2
N_MOE = DEPTH // 2
EPS = 1e-6
NEG = -1e30

kernel_name = "hybrid_gated_rglru_diffattn_moba_moe_block"


def rms_norm(x, g):
    xf = x.astype(jnp.float32)
    y = xf * lax.rsqrt(jnp.mean(xf * xf, axis=-1, keepdims=True) + EPS)
    return (y * g.astype(jnp.float32)).astype(x.dtype)


def rope_tables(positions):
    inv = 1.0 / (ROPE_THETA ** (jnp.arange(0, HEAD_DIM, 2, dtype=jnp.float32) / HEAD_DIM))
    ang = positions.astype(jnp.float32)[..., None] * inv
    return jnp.cos(ang), jnp.sin(ang)


def apply_rope(x, cos, sin):
    xf = x.astype(jnp.float32)
    x1, x2 = jnp.split(xf, 2, axis=-1)
    c = cos[:, :, None, :]
    s = sin[:, :, None, :]
    return jnp.concatenate([x1 * c - x2 * s, x2 * c + x1 * s], axis=-1).astype(x.dtype)


def causal_depthwise_conv(x, w, b):
    C = x.shape[-1]
    y = lax.conv_general_dilated(
        x, w[:, None, :].astype(x.dtype), window_strides=(1,), padding=[(CONV_W - 1, 0)],
        dimension_numbers=("NWC", "WIO", "NWC"), feature_group_count=C)
    return y + b


def rg_lru(x, w_a, b_a, w_x, b_x, lam):
    B, S, _ = x.shape
    xb = x.reshape(B, S, RNN_BLOCKS, RNN_BLOCK_W)
    r = jax.nn.sigmoid(jnp.einsum("bsnd,nde->bsne", xb, w_a).reshape(B, S, RNN_WIDTH) + b_a).astype(jnp.float32)
    i = jax.nn.sigmoid(jnp.einsum("bsnd,nde->bsne", xb, w_x).reshape(B, S, RNN_WIDTH) + b_x).astype(jnp.float32)
    log_a = -LRU_C * r * jax.nn.softplus(-lam.astype(jnp.float32))
    a = jnp.exp(log_a)
    mult = jnp.sqrt(-jnp.expm1(2.0 * log_a))
    u = mult * i * x.astype(jnp.float32)

    def combine(left, right):
        a1, u1 = left
        a2, u2 = right
        return a1 * a2, a2 * u1 + u2

    _, h = lax.associative_scan(combine, (a, u), axis=1)
    return h.astype(x.dtype)


def diff_attention(q, k, v, lam, lam_init, subln_g):
    B, H, _, S, Dh = q.shape
    nq = S // ATTN_Q_BLOCK
    scale = 1.0 / math.sqrt(Dh)
    kf = k.astype(jnp.float32)
    vf = v.astype(jnp.float32)
    qb = jnp.moveaxis(q.reshape(B, H, 2, nq, ATTN_Q_BLOCK, Dh), 3, 0)
    k_pos = jnp.arange(S)

    def block(args):
        qi, i = args
        s = jnp.einsum("bhjqd,bhjkd->bhjqk", qi.astype(jnp.float32), kf) * scale
        q_pos = i * ATTN_Q_BLOCK + jnp.arange(ATTN_Q_BLOCK)
        s = jnp.where(k_pos[None, :] <= q_pos[:, None], s, NEG)
        p = jax.nn.softmax(s, axis=-1)
        a = p[:, :, 0] - lam * p[:, :, 1]
        return jnp.einsum("bhqk,bhkd->bhqd", a, vf)

    o = lax.map(block, (qb, jnp.arange(nq)))
    o = jnp.moveaxis(o, 0, 2).reshape(B, H, S, 2 * Dh)
    o = rms_norm(o, subln_g) * (1.0 - lam_init)
    return o.transpose(0, 2, 1, 3).reshape(B, S, H * 2 * Dh).astype(v.dtype)


def moba_attention(q, k, v):
    B, H, S, Dh = q.shape
    scale = 1.0 / math.sqrt(Dh)
    nb = -(-S // MOBA_BLOCK)
    pad = nb * MOBA_BLOCK - S
    kf = jnp.pad(k.astype(jnp.float32), ((0, 0), (0, 0), (0, pad), (0, 0)))
    vf = jnp.pad(v.astype(jnp.float32), ((0, 0), (0, 0), (0, pad), (0, 0)))
    k_blk = kf.reshape(B, H, nb, MOBA_BLOCK, Dh)
    v_blk = vf.reshape(B, H, nb, MOBA_BLOCK, Dh)
    k_mean = jnp.mean(k_blk, axis=3)
    n_sel = min(MOBA_TOPK, nb - 1)
    nq = S // MOBA_Q_CHUNK
    qc = jnp.moveaxis(q.reshape(B, H, nq, MOBA_Q_CHUNK, Dh), 2, 0)
    bi = jnp.arange(B)[:, None, None, None]
    hi = jnp.arange(H)[None, :, None, None]
    blk_ids = jnp.arange(nb)

    def chunk(args):
        qi, i = args
        qi = qi.astype(jnp.float32)
        q_pos = i * MOBA_Q_CHUNK + jnp.arange(MOBA_Q_CHUNK)
        cur = (i * MOBA_Q_CHUNK) // MOBA_BLOCK
        k_own = lax.dynamic_index_in_dim(k_blk, cur, axis=2, keepdims=False)
        v_own = lax.dynamic_index_in_dim(v_blk, cur, axis=2, keepdims=False)
        own_pos = cur * MOBA_BLOCK + jnp.arange(MOBA_BLOCK)
        s_own = jnp.einsum("bhqd,bhkd->bhqk", qi, k_own) * scale
        s_own = jnp.where(own_pos[None, :] <= q_pos[:, None], s_own, NEG)
        if n_sel == 0:
            p_own = jax.nn.softmax(s_own, axis=-1)
            return jnp.einsum("bhqk,bhkd->bhqd", p_own, v_own)
        gate = jnp.einsum("bhqd,bhnd->bhqn", qi, k_mean)
        gate = jnp.where(blk_ids < cur, gate, NEG)
        _, idx = lax.top_k(gate, n_sel)
        valid = idx < cur
        kg = k_blk[bi, hi, idx]
        vg = v_blk[bi, hi, idx]
        s_sel = jnp.einsum("bhqd,bhqnkd->bhqnk", qi, kg) * scale
        s_sel = jnp.where(valid[..., None], s_sel, NEG).reshape(B, H, MOBA_Q_CHUNK, n_sel * MOBA_BLOCK)
        p = jax.nn.softmax(jnp.concatenate([s_sel, s_own], axis=-1), axis=-1)
        p_sel = p[..., : n_sel * MOBA_BLOCK].reshape(B, H, MOBA_Q_CHUNK, n_sel, MOBA_BLOCK)
        p_own = p[..., n_sel * MOBA_BLOCK:]
        return (jnp.einsum("bhqnk,bhqnkd->bhqd", p_sel, vg)
                + jnp.einsum("bhqk,bhkd->bhqd", p_own, v_own))

    o = lax.map(chunk, (qc, jnp.arange(nq)))
    o = jnp.moveaxis(o, 0, 2).reshape(B, H, S, Dh)
    return o.transpose(0, 2, 1, 3).reshape(B, S, H * Dh).astype(v.dtype)


def token_mixers(h, cos, sin, lam_init, w_in, gate_b, conv_w, conv_b, lru_wa, lru_ba, lru_wx, lru_bx,
                 lru_lambda, diff_qn, diff_kn, diff_lq1, diff_lk1, diff_lq2, diff_lk2, diff_subln,
                 moba_qn, moba_kn, w_br_a, w_br_b, w_br_c, w_out):
    B, S, _ = h.shape
    offsets = [sum(IN_SPLITS[:n]) for n in range(1, len(IN_SPLITS))]
    proj = h @ w_in
    x_rnn, g_rnn, dq, dk, dv, mq, mk, mv, g_br = jnp.split(proj, offsets, axis=-1)

    xc = causal_depthwise_conv(x_rnn, conv_w, conv_b)
    y_a = jax.nn.gelu(g_rnn) * rg_lru(xc, lru_wa, lru_ba, lru_wx, lru_bx, lru_lambda)

    dq = apply_rope(rms_norm(dq.reshape(B, S, 2 * DIFF_HEADS, HEAD_DIM), diff_qn), cos, sin)
    dk = apply_rope(rms_norm(dk.reshape(B, S, 2 * DIFF_HEADS, HEAD_DIM), diff_kn), cos, sin)
    dq = dq.reshape(B, S, DIFF_HEADS, 2, HEAD_DIM).transpose(0, 2, 3, 1, 4)
    dk = dk.reshape(B, S, DIFF_HEADS, 2, HEAD_DIM).transpose(0, 2, 3, 1, 4)
    dv = dv.reshape(B, S, DIFF_HEADS, 2 * HEAD_DIM).transpose(0, 2, 1, 3)
    lam = (jnp.exp(jnp.sum(diff_lq1.astype(jnp.float32) * diff_lk1.astype(jnp.float32)))
           - jnp.exp(jnp.sum(diff_lq2.astype(jnp.float32) * diff_lk2.astype(jnp.float32))) + lam_init)
    y_b = diff_attention(dq, dk, dv, lam, lam_init, diff_subln)

    mq = apply_rope(rms_norm(mq.reshape(B, S, MOBA_HEADS, HEAD_DIM), moba_qn), cos, sin).transpose(0, 2, 1, 3)
    mk = apply_rope(rms_norm(mk.reshape(B, S, MOBA_HEADS, HEAD_DIM), moba_kn), cos, sin).transpose(0, 2, 1, 3)
    mv = mv.reshape(B, S, MOBA_HEADS, HEAD_DIM).transpose(0, 2, 1, 3)
    y_c = moba_attention(mq, mk, mv)

    gates = jax.nn.sigmoid(g_br.reshape(B, S, N_BRANCH, D_MODEL) + gate_b)
    merged = (gates[:, :, 0] * (y_a @ w_br_a) + gates[:, :, 1] * (y_b @ w_br_b)
              + gates[:, :, 2] * (y_c @ w_br_c))
    return merged @ w_out


def swiglu(h, w1, w3, w2):
    return (jax.nn.silu(h @ w1) * (h @ w3)) @ w2


def moe_ffn(h, router_w, router_b, w1, w3, w2):
    logits = (h @ router_w).astype(jnp.float32) + router_b.astype(jnp.float32)
    top_v, top_i = lax.top_k(logits, TOP_K)
    top_w = jax.nn.softmax(top_v, axis=-1)
    combine = jnp.sum(jax.nn.one_hot(top_i, N_EXPERTS, dtype=jnp.float32) * top_w[..., None], axis=-2)
    combine = combine.astype(h.dtype)
    y = jnp.zeros_like(h)
    for e in range(N_EXPERTS):
        y = y + combine[..., e:e + 1] * swiglu(h, w1[e], w3[e], w2[e])
    return y


def setup_inputs(seed: int = 0) -> dict:
    key = jax.random.key(seed)
    counter = [0]

    def nrm(shape, scale):
        counter[0] += 1
        return scale * jax.random.normal(jax.random.fold_in(key, counter[0]), shape, jnp.float32)

    L, D = DEPTH, D_MODEL
    x = nrm((BATCH, SEQ, D), 1.0)
    c = nrm((BATCH, D), 1.0)
    offs = jax.random.randint(jax.random.fold_in(key, 1000), (BATCH, 1), 0, 4096, dtype=jnp.int32)
    positions = offs + jnp.arange(SEQ, dtype=jnp.int32)[None, :]
    u = jax.random.uniform(jax.random.fold_in(key, 1001), (L, RNN_WIDTH), jnp.float32, 0.9, 0.999)
    a0 = u ** (1.0 / LRU_C)
    lru_lambda = jnp.log(a0) - jnp.log1p(-a0)
    return {
        "x": x,
        "c": c,
        "positions": positions,
        "ada_w": nrm((L, D, 6 * D), 0.2 * D ** -0.5),
        "ada_b": nrm((L, 6 * D), 0.02),
        "norm1_g": 1.0 + nrm((L, D), 0.02),
        "norm2_g": 1.0 + nrm((L, D), 0.02),
        "w_in": nrm((L, D, IN_COLS), D ** -0.5),
        "gate_b": nrm((L, N_BRANCH, D), 0.1),
        "conv_w": nrm((L, CONV_W, RNN_WIDTH), CONV_W ** -0.5),
        "conv_b": nrm((L, RNN_WIDTH), 0.02),
        "lru_wa": nrm((L, RNN_BLOCKS, RNN_BLOCK_W, RNN_BLOCK_W), RNN_BLOCK_W ** -0.5),
        "lru_ba": nrm((L, RNN_WIDTH), 0.1),
        "lru_wx": nrm((L, RNN_BLOCKS, RNN_BLOCK_W, RNN_BLOCK_W), RNN_BLOCK_W ** -0.5),
        "lru_bx": nrm((L, RNN_WIDTH), 0.1),
        "lru_lambda": lru_lambda,
        "diff_qn": 1.0 + nrm((L, HEAD_DIM), 0.02),
        "diff_kn": 1.0 + nrm((L, HEAD_DIM), 0.02),
        "diff_lq1": nrm((L, HEAD_DIM), 0.1),
        "diff_lk1": nrm((L, HEAD_DIM), 0.1),
        "diff_lq2": nrm((L, HEAD_DIM), 0.1),
        "diff_lk2": nrm((L, HEAD_DIM), 0.1),
        "diff_subln": 1.0 + nrm((L, 2 * HEAD_DIM), 0.02),
        "moba_qn": 1.0 + nrm((L, HEAD_DIM), 0.02),
        "moba_kn": 1.0 + nrm((L, HEAD_DIM), 0.02),
        "w_br_a": nrm((L, RNN_WIDTH, D), RNN_WIDTH ** -0.5),
        "w_br_b": nrm((L, DIFF_V, D), DIFF_V ** -0.5),
        "w_br_c": nrm((L, MOBA_W, D), MOBA_W ** -0.5),
        "w_out": nrm((L, D, D), D ** -0.5),
        "ffn_w1": nrm((N_DENSE, D, D_FF), D ** -0.5),
        "ffn_w3": nrm((N_DENSE, D, D_FF), D ** -0.5),
        "ffn_w2": nrm((N_DENSE, D_FF, D), D_FF ** -0.5),
        "router_w": nrm((N_MOE, D, N_EXPERTS), D ** -0.5),
        "router_b": nrm((N_MOE, N_EXPERTS), 0.01),
        "moe_w1": nrm((N_MOE, N_EXPERTS, D, D_FF), D ** -0.5),
        "moe_w3": nrm((N_MOE, N_EXPERTS, D, D_FF), D ** -0.5),
        "moe_w2": nrm((N_MOE, N_EXPERTS, D_FF, D), D_FF ** -0.5),
    }


def reference(x, c, positions, ada_w, ada_b, norm1_g, norm2_g, w_in, gate_b, conv_w, conv_b,
              lru_wa, lru_ba, lru_wx, lru_bx, lru_lambda, diff_qn, diff_kn, diff_lq1, diff_lk1,
              diff_lq2, diff_lk2, diff_subln, moba_qn, moba_kn, w_br_a, w_br_b, w_br_c, w_out,
              ffn_w1, ffn_w3, ffn_w2, router_w, router_b, moe_w1, moe_w3, moe_w2):
    cos, sin = rope_tables(positions)
    for l in range(DEPTH):
        mod = (c @ ada_w[l] + ada_b[l])[:, None, :]
        shift1, scale1, gate1, shift2, scale2, gate2 = jnp.split(mod, 6, axis=-1)
        lam_init = 0.8 - 0.6 * math.exp(-0.3 * l)
        h = rms_norm(x, norm1_g[l]) * (1.0 + scale1) + shift1
        mix = token_mixers(h, cos, sin, lam_init, w_in[l], gate_b[l], conv_w[l], conv_b[l],
                           lru_wa[l], lru_ba[l], lru_wx[l], lru_bx[l], lru_lambda[l],
                           diff_qn[l], diff_kn[l], diff_lq1[l], diff_lk1[l], diff_lq2[l], diff_lk2[l],
                           diff_subln[l], moba_qn[l], moba_kn[l], w_br_a[l], w_br_b[l], w_br_c[l], w_out[l])
        x = x + gate1 * mix
        h = rms_norm(x, norm2_g[l]) * (1.0 + scale2) + shift2
        if l % 2 == 0:
            y = swiglu(h, ffn_w1[l // 2], ffn_w3[l // 2], ffn_w2[l // 2])
        else:
            y = moe_ffn(h, router_w[l // 2], router_b[l // 2], moe_w1[l // 2], moe_w3[l // 2], moe_w2[l // 2])
        x = x + gate2 * y
    return x
```

```cpp
#include <hip/hip_runtime.h>
#include <stdint.h>
#include <stdio.h>

#define LAS __attribute__((address_space(3)))
typedef unsigned short bf16_t;
typedef short bf16x8 __attribute__((ext_vector_type(8)));
typedef short s16x4 __attribute__((ext_vector_type(4)));
typedef float f32x2 __attribute__((ext_vector_type(2)));
typedef float f32x4 __attribute__((ext_vector_type(4)));
typedef float f32x16 __attribute__((ext_vector_type(16)));
typedef unsigned u32x2 __attribute__((ext_vector_type(2)));
typedef unsigned u32x4 __attribute__((ext_vector_type(4)));

constexpr int D = 1024, NB = 8, SEQ = 2048, M = NB * SEQ, INC = 8192, DFF = 2816, NE = 8, DFF2 = 2 * DFF;
constexpr int C_XR = 0, C_GR = 1024, C_DQ = 2048, C_DK = 2560, C_DV = 3072, C_MQ = 3584, C_MK = 4096, C_MV = 4608, C_GB = 5120;
constexpr int YW = 2048, Y_A = 0, Y_B = 1024, Y_C = 1536;
constexpr float EPS = 1e-6f;
constexpr float QSCALE = 0.125f * 1.4426950408889634f;
constexpr int MOE_MAXROWS = 34816, MOE_MAXTILES = MOE_MAXROWS / 256;

__device__ __forceinline__ float bf2f(unsigned v) { return __uint_as_float(v << 16); }
__device__ __forceinline__ unsigned f2bf(float f) { unsigned u = __float_as_uint(f); return (u + 0x7fffu + ((u >> 16) & 1u)) >> 16; }
__device__ __forceinline__ unsigned pk2(float lo, float hi) { unsigned r; asm volatile("v_cvt_pk_bf16_f32 %0, %1, %2" : "=v"(r) : "v"(lo), "v"(hi)); return r; }
__device__ __forceinline__ float fexp2(float x) { return __builtin_amdgcn_exp2f(x); }
__device__ __forceinline__ float frcp(float x) { return __builtin_amdgcn_rcpf(x); }
__device__ __forceinline__ float sigmoid_f(float x) { return frcp(1.0f + fexp2(-1.4426950408889634f * x)); }
__device__ __forceinline__ float gelu_tanh_f(float x) { return x * sigmoid_f(1.5957691216057308f * (x + 0.044715f * x * x * x)); }
__device__ __forceinline__ float silu_f(float x) { return x * sigmoid_f(x); }
__device__ __forceinline__ float wave_sum(float v) {
#pragma unroll
    for (int o = 1; o < 64; o <<= 1) v += __shfl_xor(v, o);
    return v;
}
namespace pg8 {
constexpr int BM = 256, BK = 64, HALF = 128, HTB = HALF * BK * 2  , STAGE_BYTES = 8 * HTB, NXCD = 8, WGM = 8;

__host__ __device__ __forceinline__ int lds_byte(int r, int c) { const int st = (r >> 4) * 2 + (c >> 5), rr = r & 15, cc = c & 31, ob = rr * 64 + cc * 2; return st * 1024 + (ob ^ (((ob >> 9) & 1) << 5)); }
__host__ __device__ __forceinline__ void stage_rc(int b, int& R, int& C) { const int st = b / 1024, sb = b % 1024, swz = sb ^ (((sb >> 9) & 1) << 5); R = (st >> 1) * 16 + swz / 64; C = (st & 1) * 32 + (swz % 64) / 2; }
__host__ __device__ __forceinline__ int perm32(int rho) { const int n = rho >> 4, i = rho & 15; return 8 * (i >> 2) + 4 * n + (i & 3); }

struct Unit { int pm, pn, e, aux; };

struct StaticOrder {
    int nM, nN, nwg, G, c;
    __host__ __device__ void init(int M, int N, int G_, int c_) { nM = M / BM; nN = N / BM; nwg = nM * nN; G = G_; c = c_; }
    __device__ __forceinline__ bool next(int i, Unit& u) const {
        const long L = (long)i * G + c; if (L >= nwg) return false;
        int wgid = (int)L; { const int q = nwg / NXCD, r = nwg % NXCD, xcd = wgid % NXCD, off = wgid / NXCD; wgid = (xcd < r ? xcd * (q + 1) : r * (q + 1) + (xcd - r) * q) + off; }
        const int nig = WGM * nN, gid = wgid / nig, fm = gid * WGM, gsz = (nM - fm) < WGM ? (nM - fm) : WGM;
        u.pm = fm + ((wgid % nig) % gsz); u.pn = (wgid % nig) / gsz; u.e = 0; u.aux = 0; return true;
    }
};

struct DenseProb {
    static constexpr bool GATHER = false;
    const bf16_t* A; const bf16_t* Bt; int K, lda, ldb, pad;
    __device__ __forceinline__ const char* a_base(const Unit& u) const { return (const char*)A + (size_t)u.pm * BM * lda * 2; }
    __device__ __forceinline__ const char* b_base(const Unit& u) const { return (const char*)Bt + (size_t)u.pn * BM * ldb * 2; }
    __device__ __forceinline__ unsigned a_off(const Unit&, int row, int col) const { return (unsigned)(row * lda + col) * 2u; }
};

template <class Prob, class Epi, class Sched, bool ALIGN_EPI = true>
__device__ __forceinline__ void gemm_phase(LAS unsigned char* lds, const Prob& g, const Sched& S, const Epi& E) {
    const int tid = threadIdx.x, wid = __builtin_amdgcn_readfirstlane(tid >> 6), lane = tid & 63, wr = wid >> 2, wc = wid & 3, fr = lane & 15, fq = lane >> 4;
    const int K = g.K, nt = K / BK;
    int sR[2], sC[2]; unsigned voffB[2];
#pragma unroll
    for (int i = 0; i < 2; ++i) { int R, C; stage_rc(tid * 16 + i * 8192, R, C); sR[i] = R; sC[i] = C; const int Rb = Epi::PERM ? ((R & ~31) + perm32(R & 31)) : R; voffB[i] = (unsigned)(Rb * g.ldb + C) * 2u; }
    const size_t kstep = (size_t)(BK * 2);
    const size_t hstepB = (size_t)HALF * g.ldb * 2;
    const unsigned ldsw = (unsigned)wid * 1024u;
    const int aoff = lds_byte(wr * 64 + fr, fq * 8), boff = lds_byte(wc * 32 + fr, fq * 8);
#define PG8_SA(b, h) (((b) * 2 + (h)) * HTB)
#define PG8_SB(b, h) ((4 + (b) * 2 + (h)) * HTB)
#define PG8_STAGE(bufoff, gbase, voff) do { _Pragma("unroll") for (int _i = 0; _i < 2; ++_i) \
        __builtin_amdgcn_global_load_lds((const unsigned*)((const char*)(gbase) + (voff)[_i]), (LAS unsigned*)(lds + (bufoff) + ldsw + _i * 8192), 16, 0, 0); } while (0)
#define PG8_LDA(dst, b, h) do { _Pragma("unroll") for (int m = 0; m < 4; ++m) _Pragma("unroll") for (int k = 0; k < 2; ++k) dst[m][k] = *(const LAS bf16x8*)(lds + PG8_SA(b, h) + aoff + m * 2048 + k * 1024); } while (0)
#define PG8_LDB(dst, b, h) do { _Pragma("unroll") for (int n = 0; n < 2; ++n) _Pragma("unroll") for (int k = 0; k < 2; ++k) dst[n][k] = *(const LAS bf16x8*)(lds + PG8_SB(b, h) + boff + n * 2048 + k * 1024); } while (0)
#define PG8_MMA(ai, bj, At, Bt) do { __builtin_amdgcn_s_setprio(1); _Pragma("unroll") for (int m = 0; m < 4; ++m) _Pragma("unroll") for (int n = 0; n < 2; ++n) _Pragma("unroll") for (int k = 0; k < 2; ++k) \
        acc[ai][bj][m][n] = __builtin_amdgcn_mfma_f32_16x16x32_bf16(Bt[n][k], At[m][k], acc[ai][bj][m][n], 0, 0, 0); __builtin_amdgcn_s_setprio(0); } while (0)
#define PG8_WAIT_V(n) asm volatile("s_waitcnt vmcnt(" #n ")" ::: "memory")
#define PG8_WAIT_L(n) asm volatile("s_waitcnt lgkmcnt(" #n ")" ::: "memory")
#define PG8_BAR __builtin_amdgcn_s_barrier()
#define PG8_SCHED __builtin_amdgcn_sched_barrier(0)
    Unit cur, nxt; int ui = 0;
    if (!S.next(0, cur)) return;
    f32x4 acc[2][2][4][2];
#pragma unroll
    for (int a = 0; a < 2; ++a)
#pragma unroll
        for (int b = 0; b < 2; ++b)
#pragma unroll
            for (int m = 0; m < 4; ++m)
#pragma unroll
                for (int n = 0; n < 2; ++n) acc[a][b][m][n] = (f32x4){0.f, 0.f, 0.f, 0.f};
    bf16x8 At[4][2], B0[2][2], B1[2][2];
    unsigned vA[2][2], vN[2][2];
#pragma unroll
    for (int h = 0; h < 2; ++h)
#pragma unroll
        for (int i = 0; i < 2; ++i) { vA[h][i] = g.a_off(cur, h * HALF + sR[i], sC[i]); vN[h][i] = vA[h][i]; }
    const char* cA = g.a_base(cur); const char* cB = g.b_base(cur);
    PG8_STAGE(PG8_SB(0, 0), cB, voffB); PG8_STAGE(PG8_SB(0, 1), cB + hstepB, voffB); PG8_STAGE(PG8_SA(0, 0), cA, vA[0]); PG8_STAGE(PG8_SA(0, 1), cA, vA[1]);
    if (wr == 1) PG8_BAR;
    PG8_WAIT_V(2); PG8_BAR;
    PG8_STAGE(PG8_SB(1, 0), cB + kstep, voffB); PG8_STAGE(PG8_SA(1, 0), cA + kstep, vA[0]); PG8_STAGE(PG8_SB(1, 1), cB + hstepB + kstep, voffB);
    PG8_WAIT_V(6); PG8_BAR;
    for (;;) {
        const bool has_next = S.next(ui + 1, nxt);
        const char* nA = has_next ? g.a_base(nxt) : cA; const char* nB = has_next ? g.b_base(nxt) : cB;
        if (Prob::GATHER) {
#pragma unroll
            for (int h = 0; h < 2; ++h)
#pragma unroll
                for (int i = 0; i < 2; ++i) vN[h][i] = has_next ? g.a_off(nxt, h * HALF + sR[i], sC[i]) : vA[h][i];
        }
        for (int t = 0; t < nt; t += 2) {
            const bool last = (t == nt - 2);
            const char* a1 = cA + (size_t)(t + 1) * kstep;
            const char* a2 = last ? nA : cA + (size_t)(t + 2) * kstep; const char* b2 = last ? nB : cB + (size_t)(t + 2) * kstep;
            const char* a3 = a2 + kstep; const char* b3 = b2 + kstep;
            unsigned v2[2][2];
#pragma unroll
            for (int h = 0; h < 2; ++h)
#pragma unroll
                for (int i = 0; i < 2; ++i) v2[h][i] = (Prob::GATHER && last) ? vN[h][i] : vA[h][i];
            PG8_LDB(B0, 0, 0); PG8_LDB(B1, 0, 1); PG8_SCHED; PG8_LDA(At, 0, 0); PG8_STAGE(PG8_SA(1, 1), a1, vA[1]);
            PG8_WAIT_V(8); PG8_WAIT_L(0); PG8_BAR; PG8_MMA(0, 0, At, B0); PG8_MMA(0, 1, At, B1); PG8_BAR; PG8_SCHED;
            PG8_LDA(At, 0, 1); PG8_STAGE(PG8_SB(0, 0), b2, voffB); PG8_STAGE(PG8_SB(0, 1), b2 + hstepB, voffB); PG8_STAGE(PG8_SA(0, 0), a2, v2[0]);
            PG8_WAIT_V(8); PG8_WAIT_L(0); PG8_BAR; PG8_MMA(1, 0, At, B0); PG8_MMA(1, 1, At, B1); PG8_BAR; PG8_SCHED;
            PG8_LDB(B0, 1, 0); PG8_LDB(B1, 1, 1); PG8_SCHED; PG8_LDA(At, 1, 0); PG8_STAGE(PG8_SA(0, 1), a2, v2[1]);
            PG8_WAIT_V(8); PG8_WAIT_L(0); PG8_BAR; PG8_MMA(0, 0, At, B0); PG8_MMA(0, 1, At, B1); PG8_BAR; PG8_SCHED;
            PG8_LDA(At, 1, 1); PG8_STAGE(PG8_SB(1, 0), b3, voffB); PG8_STAGE(PG8_SB(1, 1), b3 + hstepB, voffB); PG8_STAGE(PG8_SA(1, 0), a3, v2[0]);
            PG8_WAIT_V(8); PG8_WAIT_L(0); PG8_BAR; PG8_MMA(1, 0, At, B0); PG8_MMA(1, 1, At, B1); PG8_BAR; PG8_SCHED;
        }
        if constexpr (ALIGN_EPI) { if (wr == 0) PG8_BAR; }
        E(acc, cur, wr, wc, fr, fq);
        if (!has_next) break;
#pragma unroll
        for (int a = 0; a < 2; ++a)
#pragma unroll
            for (int b = 0; b < 2; ++b)
#pragma unroll
                for (int m = 0; m < 4; ++m)
#pragma unroll
                    for (int n = 0; n < 2; ++n) acc[a][b][m][n] = (f32x4){0.f, 0.f, 0.f, 0.f};
        cur = nxt; cA = nA; cB = nB; ++ui;
        if (Prob::GATHER) {
#pragma unroll
            for (int h = 0; h < 2; ++h)
#pragma unroll
                for (int i = 0; i < 2; ++i) vA[h][i] = vN[h][i];
        }
        if constexpr (ALIGN_EPI) { if (wr == 1) PG8_BAR; }
    }
    PG8_WAIT_V(0);
    if constexpr (!ALIGN_EPI) { if (wr == 0) PG8_BAR; }
    PG8_BAR;
#undef PG8_SA
#undef PG8_SB
#undef PG8_STAGE
#undef PG8_LDA
#undef PG8_LDB
#undef PG8_MMA
#undef PG8_WAIT_V
#undef PG8_WAIT_L
#undef PG8_BAR
#undef PG8_SCHED
}
}
namespace epi {
using pg8::Unit; using pg8::BM; using pg8::HALF;
typedef const f32x4 (&AccRef)[2][2][4][2];

struct Proj {
    static constexpr bool PERM = true;
    bf16_t* O; const float* gate_b;
    __device__ __forceinline__ void operator()(AccRef acc, const Unit& u, int wr, int wc, int fr, int fq) const {
        const int row0 = u.pm * BM + wr * 64 + fr, col0 = u.pn * BM + wc * 32 + 8 * fq;
        const int mode = (u.pn >= 20) ? 2 : ((u.pn >= 4 && u.pn < 8) ? 1 : 0);
        f32x4 bv[2][2];
#pragma unroll
        for (int bj = 0; bj < 2; ++bj)
#pragma unroll
            for (int n = 0; n < 2; ++n) bv[bj][n] = (mode == 2) ? *(const f32x4*)(gate_b + (col0 - C_GB) + bj * HALF + 4 * n) : (f32x4){0.f, 0.f, 0.f, 0.f};
#pragma unroll
        for (int ai = 0; ai < 2; ++ai)
#pragma unroll
            for (int m = 0; m < 4; ++m) { bf16_t* rowp = O + (size_t)(row0 + ai * HALF + m * 16) * INC + col0;
#pragma unroll
                for (int bj = 0; bj < 2; ++bj) { f32x4 v0 = acc[ai][bj][m][0] + bv[bj][0], v1 = acc[ai][bj][m][1] + bv[bj][1];
                    if (mode == 1) {
#pragma unroll
                        for (int j = 0; j < 4; ++j) { v0[j] = gelu_tanh_f(v0[j]); v1[j] = gelu_tanh_f(v1[j]); } }
                    if (mode == 2) {
#pragma unroll
                        for (int j = 0; j < 4; ++j) { v0[j] = sigmoid_f(v0[j]); v1[j] = sigmoid_f(v1[j]); } }
                    u32x4 w; w.x = pk2(v0[0], v0[1]); w.y = pk2(v0[2], v0[3]); w.z = pk2(v1[0], v1[1]); w.w = pk2(v1[2], v1[3]);
                    *(u32x4*)(rowp + bj * HALF) = w; } }
    }
};

template <int STEP> struct Branch {
    static constexpr bool PERM = false;
    const bf16_t* proj; float* P; bf16_t* merged;
    __device__ __forceinline__ void operator()(AccRef acc, const Unit& u, int wr, int wc, int fr, int fq) const {
        const int row0 = u.pm * BM + wr * 64 + fr, col0 = u.pn * BM + wc * 32 + 4 * fq;
#pragma unroll
        for (int ai = 0; ai < 2; ++ai)
#pragma unroll
            for (int m = 0; m < 4; ++m) { const size_t row = (size_t)(row0 + ai * HALF + m * 16);
#pragma unroll
                for (int bj = 0; bj < 2; ++bj)
#pragma unroll
                    for (int n = 0; n < 2; ++n) { const int col = col0 + bj * HALF + n * 16;
                        const u32x2 gw = *(const u32x2*)(proj + row * INC + C_GB + STEP * 1024 + col);
                        const f32x4 gv = {bf2f(gw.x & 0xffffu), bf2f(gw.x >> 16), bf2f(gw.y & 0xffffu), bf2f(gw.y >> 16)};
                        f32x4 v = acc[ai][bj][m][n] * gv;
                        float* pp = P + row * D + col;
                        if (STEP >= 1) v += *(const f32x4*)pp;
                        if (STEP <= 1) *(f32x4*)pp = v;
                        else { u32x2 w; w.x = pk2(v[0], v[1]); w.y = pk2(v[2], v[3]); *(u32x2*)(merged + row * D + col) = w; } } }
    }
};

struct Resid {
    static constexpr bool PERM = false;
    const float* base; float* out; const float* gate;
    __device__ __forceinline__ void operator()(AccRef acc, const Unit& u, int wr, int wc, int fr, int fq) const {
        const int row0 = u.pm * BM + wr * 64 + fr, col0 = u.pn * BM + wc * 32 + 4 * fq;
        const float* gp = gate + (size_t)((u.pm * BM) / SEQ) * (6 * D) + col0;
        f32x4 gv[2][2];
#pragma unroll
        for (int bj = 0; bj < 2; ++bj)
#pragma unroll
            for (int n = 0; n < 2; ++n) gv[bj][n] = *(const f32x4*)(gp + bj * HALF + n * 16);
#pragma unroll
        for (int ai = 0; ai < 2; ++ai)
#pragma unroll
            for (int m = 0; m < 4; ++m) { const size_t off = (size_t)(row0 + ai * HALF + m * 16) * D + col0;
#pragma unroll
                for (int bj = 0; bj < 2; ++bj)
#pragma unroll
                    for (int n = 0; n < 2; ++n) { const f32x4 bs = *(const f32x4*)(base + off + bj * HALF + n * 16);
                        *(f32x4*)(out + off + bj * HALF + n * 16) = bs + gv[bj][n] * acc[ai][bj][m][n]; } }
    }
};

struct SwiGLU {
    static constexpr bool PERM = true;
    bf16_t* O;
    __device__ __forceinline__ void operator()(AccRef acc, const Unit& u, int wr, int wc, int fr, int fq) const {
        const int row0 = u.pm * BM + wr * 64 + fr, col0 = u.pn * HALF + wc * 32 + 8 * fq;
#pragma unroll
        for (int ai = 0; ai < 2; ++ai)
#pragma unroll
            for (int m = 0; m < 4; ++m) { bf16_t* rowp = O + (size_t)(row0 + ai * HALF + m * 16) * DFF + col0;
                f32x4 v0, v1;
#pragma unroll
                for (int j = 0; j < 4; ++j) { v0[j] = silu_f(acc[ai][0][m][0][j]) * acc[ai][1][m][0][j]; v1[j] = silu_f(acc[ai][0][m][1][j]) * acc[ai][1][m][1][j]; }
                u32x4 w; w.x = pk2(v0[0], v0[1]); w.y = pk2(v0[2], v0[3]); w.z = pk2(v1[0], v1[1]); w.w = pk2(v1[2], v1[3]);
                *(u32x4*)rowp = w; }
    }
};

struct MoeDown {
    static constexpr bool PERM = false;
    const int* rowdst; const float* roww; bf16_t* yslot;
    __device__ __forceinline__ void operator()(AccRef acc, const Unit& u, int wr, int wc, int fr, int fq) const {
        const int row0 = u.pm * BM + wr * 64 + fr, col0 = u.pn * BM + wc * 32 + 4 * fq;
#pragma unroll
        for (int ai = 0; ai < 2; ++ai)
#pragma unroll
            for (int m = 0; m < 4; ++m) { const int p = row0 + ai * HALF + m * 16; const int dst = rowdst[p]; const float w = roww[p];
                if (dst >= 0) { bf16_t* rowp = yslot + (size_t)dst * D + col0;
#pragma unroll
                    for (int bj = 0; bj < 2; ++bj)
#pragma unroll
                        for (int n = 0; n < 2; ++n) { const f32x4 v = acc[ai][bj][m][n] * w; u32x2 o; o.x = pk2(v[0], v[1]); o.y = pk2(v[2], v[3]); *(u32x2*)(rowp + bj * HALF + n * 16) = o; } } }
    }
};
}
namespace attn {
constexpr int KSTR = 144;
constexpr int VSTR128 = 320, VSTR64 = 192;
constexpr int LDS_K = 0, LDS_V = 64 * KSTR, LDS_BYTES = LDS_V + 64 * VSTR128;
constexpr float NEGF = -1e30f;
__device__ __forceinline__ int crow(int r, int hi) { return (r & 3) + 8 * (r >> 2) + 4 * hi; }
__device__ __forceinline__ float swapmax(float m) { auto rr = __builtin_amdgcn_permlane32_swap(__float_as_uint(m), __float_as_uint(m), false, false); return fmaxf(__uint_as_float(rr[0]), __uint_as_float(rr[1])); }
__device__ __forceinline__ float swapsum(float m) { auto rr = __builtin_amdgcn_permlane32_swap(__float_as_uint(m), __float_as_uint(m), false, false); return __uint_as_float(rr[0]) + __uint_as_float(rr[1]); }
typedef short v4i16_t __attribute__((ext_vector_type(4)));
__device__ __forceinline__ s16x4 vtr(const LAS char* p) { return __builtin_bit_cast(s16x4, __builtin_amdgcn_ds_read_tr16_b64_v4i16((LAS v4i16_t*)p)); }

__device__ __forceinline__ void qk_tile(f32x16& sA, f32x16& sB, const LAS char* Kt, const bf16x8 (&qf)[4], int r, int h) {
    const LAS char* kb = Kt + r * KSTR + h * 16;
#pragma unroll
    for (int j = 0; j < 16; ++j) { sA[j] = 0.f; sB[j] = 0.f; }
#pragma unroll
    for (int ks = 0; ks < 4; ++ks) {
        const bf16x8 a0 = *(const LAS bf16x8*)(kb + ks * 32);
        const bf16x8 a1 = *(const LAS bf16x8*)(kb + 32 * KSTR + ks * 32);
        sA = __builtin_amdgcn_mfma_f32_32x32x16_bf16(a0, qf[ks], sA, 0, 0, 0);
        sB = __builtin_amdgcn_mfma_f32_32x32x16_bf16(a1, qf[ks], sB, 0, 0, 0);
    }
}
template <int NDB, int VSTR>
__device__ __forceinline__ void pv_tile(f32x16 (&o)[NDB], const LAS char* Vt, const bf16x8 (&pf)[4], int lane) {
    const int h = lane >> 5, q = (lane & 15) >> 2, p = lane & 3, g1 = (lane >> 4) & 1;
    const LAS char* vb = Vt + (4 * h + q) * VSTR + (16 * g1 + 4 * p) * 2;
#pragma unroll
    for (int db = 0; db < NDB; ++db)
#pragma unroll
        for (int kb = 0; kb < 2; ++kb)
#pragma unroll
            for (int s = 0; s < 2; ++s) {
                const int r0 = kb * 32 + 16 * s;
                const s16x4 lo = vtr(vb + r0 * VSTR + db * 64), hi = vtr(vb + (r0 + 8) * VSTR + db * 64);
                const bf16x8 vf = {lo[0], lo[1], lo[2], lo[3], hi[0], hi[1], hi[2], hi[3]};
                o[db] = __builtin_amdgcn_mfma_f32_32x32x16_bf16(pf[kb * 2 + s], vf, o[db], 0, 0, 0);
            }
}
template <int NDB, int VSTR>
__device__ __forceinline__ void softmax_pv(f32x16& sA, f32x16& sB, f32x16 (&o)[NDB], float& mrow, float& lrow, const LAS char* Vt, int lane) {
    const int h = lane >> 5;
    float mx = fmaxf(sA[0], sB[0]);
#pragma unroll
    for (int j = 1; j < 16; ++j) mx = fmaxf(mx, fmaxf(sA[j], sB[j]));
    mx = swapmax(mx);
    const float mnew = fmaxf(mrow, mx), alpha = fexp2(mrow - mnew);
    mrow = mnew;
    float rs = 0.f;
#pragma unroll
    for (int j = 0; j < 16; ++j) { sA[j] = fexp2(sA[j] - mnew); sB[j] = fexp2(sB[j] - mnew); rs += sA[j] + sB[j]; }
    rs = swapsum(rs);
    lrow = lrow * alpha + rs;
    if (__any(alpha != 1.0f)) {
#pragma unroll
        for (int j = 0; j < 16; ++j) { const float a = __shfl(alpha, crow(j, h));
#pragma unroll
            for (int db = 0; db < NDB; ++db) o[db][j] *= a; }
    }
    bf16x8 pf[4];
    { u32x4 w;
      w.x = pk2(sA[0], sA[1]); w.y = pk2(sA[2], sA[3]); w.z = pk2(sA[4], sA[5]); w.w = pk2(sA[6], sA[7]); pf[0] = __builtin_bit_cast(bf16x8, w);
      w.x = pk2(sA[8], sA[9]); w.y = pk2(sA[10], sA[11]); w.z = pk2(sA[12], sA[13]); w.w = pk2(sA[14], sA[15]); pf[1] = __builtin_bit_cast(bf16x8, w);
      w.x = pk2(sB[0], sB[1]); w.y = pk2(sB[2], sB[3]); w.z = pk2(sB[4], sB[5]); w.w = pk2(sB[6], sB[7]); pf[2] = __builtin_bit_cast(bf16x8, w);
      w.x = pk2(sB[8], sB[9]); w.y = pk2(sB[10], sB[11]); w.z = pk2(sB[12], sB[13]); w.w = pk2(sB[14], sB[15]); pf[3] = __builtin_bit_cast(bf16x8, w); }
    pv_tile<NDB, VSTR>(o, Vt, pf, lane);
}

template <int DV> struct TileRegs { u32x4 k; u32x4 v[DV / 64]; };
template <int DV>
__device__ __forceinline__ void tile_load(TileRegs<DV>& t, const bf16_t* Kg, const bf16_t* Vg, int key0, int tid) {
    t.k = *(const u32x4*)(Kg + (size_t)(key0 + (tid >> 3)) * INC + (tid & 7) * 8);
    if (DV == 64) t.v[0] = *(const u32x4*)(Vg + (size_t)(key0 + (tid >> 3)) * INC + (tid & 7) * 8);
    else {
#pragma unroll
        for (int i = 0; i < DV / 64; ++i) t.v[i] = *(const u32x4*)(Vg + (size_t)(key0 + (tid >> 4) + 32 * i) * INC + (tid & 15) * 8);
    }
}
template <int DV, int VSTR>
__device__ __forceinline__ void tile_store(const TileRegs<DV>& t, LAS char* lds, int tid) {
    *(LAS u32x4*)(lds + LDS_K + (tid >> 3) * KSTR + (tid & 7) * 16) = t.k;
    if (DV == 64) *(LAS u32x4*)(lds + LDS_V + (tid >> 3) * VSTR + (tid & 7) * 16) = t.v[0];
    else {
#pragma unroll
        for (int i = 0; i < DV / 64; ++i) *(LAS u32x4*)(lds + LDS_V + ((tid >> 4) + 32 * i) * VSTR + (tid & 15) * 16) = t.v[i];
    }
}

template <int DV, int VSTR>
__device__ __forceinline__ void causal_pass(f32x16 (&o)[DV / 32], float& mrow, float& lrow, const bf16x8 (&qf)[4], const bf16_t* Kg, const bf16_t* Vg,
                                            int ntiles, int qw0, LAS char* lds, int tid) {
    const int lane = tid & 63, r = lane & 31, h = lane >> 5;
    TileRegs<DV> tr;
    tile_load<DV>(tr, Kg, Vg, 0, tid);
    for (int t = 0; t < ntiles; ++t) {
        __syncthreads();
        tile_store<DV, VSTR>(tr, lds, tid);
        __syncthreads();
        if (t + 1 < ntiles) tile_load<DV>(tr, Kg, Vg, (t + 1) * 64, tid);
        const int key0 = t * 64;
        if (key0 <= qw0 + 31) {
            f32x16 sA, sB;
            qk_tile(sA, sB, lds + LDS_K, qf, r, h);
            if (key0 + 63 > qw0) {
                const int qpos = qw0 + r;
#pragma unroll
                for (int j = 0; j < 16; ++j) { const int kp = key0 + crow(j, h); if (kp > qpos) sA[j] = NEGF; if (kp + 32 > qpos) sB[j] = NEGF; }
            }
            softmax_pv<DV / 32, VSTR>(sA, sB, o, mrow, lrow, lds + LDS_V, lane);
        }
    }
}

__device__ __forceinline__ void diff_unit(int b, int hd, int qt, const bf16_t* proj, bf16_t* yabc, const float* subln, float lam, float one_m_laminit, LAS char* lds) {
    const int tid = threadIdx.x, lane = tid & 63, wid = tid >> 6, r = lane & 31, h = lane >> 5;
    const int qw0 = qt * 256 + wid * 32;
    const size_t rowb = (size_t)b * SEQ;
    const int ntiles = 4 * (qt + 1);
    unsigned o0p[4][8];
#pragma unroll
    for (int j = 0; j < 2; ++j) {
        const bf16_t* qp = proj + (rowb + qw0 + r) * INC + C_DQ + (hd * 2 + j) * 64 + h * 8;
        bf16x8 qf[4];
#pragma unroll
        for (int ks = 0; ks < 4; ++ks) qf[ks] = *(const bf16x8*)(qp + ks * 16);
        f32x16 o[4];
#pragma unroll
        for (int db = 0; db < 4; ++db)
#pragma unroll
            for (int i = 0; i < 16; ++i) o[db][i] = 0.f;
        float mrow = NEGF, lrow = 0.f;
        causal_pass<128, VSTR128>(o, mrow, lrow, qf, proj + rowb * INC + C_DK + (hd * 2 + j) * 64, proj + rowb * INC + C_DV + hd * 128, ntiles, qw0, lds, tid);
        const float il = frcp(lrow);
        if (j == 0) {
#pragma unroll
            for (int i = 0; i < 16; i += 2) { const float a0 = __shfl(il, crow(i, h)), a1 = __shfl(il, crow(i + 1, h));
#pragma unroll
                for (int db = 0; db < 4; ++db) o0p[db][i >> 1] = pk2(o[db][i] * a0, o[db][i + 1] * a1); }
        } else {
#pragma unroll
            for (int i = 0; i < 16; ++i) { const float a = __shfl(il, crow(i, h)) * lam;
                float ss = 0.f; float cv[4];
#pragma unroll
                for (int db = 0; db < 4; ++db) { const unsigned w = o0p[db][i >> 1]; const float x0 = (i & 1) ? bf2f(w >> 16) : bf2f(w & 0xffffu); const float c = x0 - o[db][i] * a; cv[db] = c; ss += c * c; }
                ss += __shfl_xor(ss, 1); ss += __shfl_xor(ss, 2); ss += __shfl_xor(ss, 4); ss += __shfl_xor(ss, 8); ss += __shfl_xor(ss, 16);
                const float rn = rsqrtf(ss * (1.0f / 128.0f) + EPS) * one_m_laminit;
                bf16_t* yp = yabc + (rowb + qw0 + crow(i, h)) * YW + Y_B + hd * 128 + r;
#pragma unroll
                for (int db = 0; db < 4; ++db) yp[db * 32] = (bf16_t)f2bf(cv[db] * rn * subln[db * 32 + r]);
            }
        }
    }
}

__device__ __forceinline__ void moba_unit(int b, int hd, int cur, const bf16_t* proj, bf16_t* yabc, const float* kmean, LAS char* lds) {
    const int tid = threadIdx.x, lane = tid & 63, wid = tid >> 6, r = lane & 31, h = lane >> 5;
    const int qw0 = cur * 256 + wid * 32;
    const size_t rowb = (size_t)b * SEQ;
    const bf16_t* qp = proj + (rowb + qw0 + r) * INC + C_MQ + hd * 64 + h * 8;
    bf16x8 qf[4];
#pragma unroll
    for (int ks = 0; ks < 4; ++ks) qf[ks] = *(const bf16x8*)(qp + ks * 16);
    unsigned selmask = 0u;
    if (cur > 0) {
        float gate[8];
#pragma unroll
        for (int n = 0; n < 8; ++n) {
            float g = 0.f;
            if (n < cur) {
                const float* km = kmean + ((size_t)((b * 8 + hd) * 8 + n)) * 64 + h * 8;
#pragma unroll
                for (int ks = 0; ks < 4; ++ks)
#pragma unroll
                    for (int j = 0; j < 8; ++j) g += bf2f((unsigned)(unsigned short)qf[ks][j]) * km[ks * 16 + j];
                g = swapsum(g);
            } else g = -3.0e38f;
            gate[n] = g;
        }
        const int nsel = cur < 3 ? cur : 3;
        for (int s = 0; s < nsel; ++s) {
            float best = -3.0e38f; int bi = 0;
#pragma unroll
            for (int n = 0; n < 8; ++n) { const bool tk = (n < cur) && !((selmask >> n) & 1u) && (gate[n] > best); if (tk) { best = gate[n]; bi = n; } }
            selmask |= 1u << bi;
        }
    }
    f32x16 o[2];
#pragma unroll
    for (int db = 0; db < 2; ++db)
#pragma unroll
        for (int i = 0; i < 16; ++i) o[db][i] = 0.f;
    float mrow = NEGF, lrow = 0.f;
    const bf16_t* Kg = proj + rowb * INC + C_MK + hd * 64; const bf16_t* Vg = proj + rowb * INC + C_MV + hd * 64;
    const int ntiles = 4 * (cur + 1);
    TileRegs<64> tr;
    tile_load<64>(tr, Kg, Vg, cur * 256, tid);
    for (int t = 0; t < ntiles; ++t) {
        __syncthreads();
        tile_store<64, VSTR64>(tr, lds, tid);
        __syncthreads();
        const int blk = (t < 4) ? cur : (t >> 2) - 1;
        if (t + 1 < ntiles) { const int t1 = t + 1; const int blk1 = (t1 < 4) ? cur : (t1 >> 2) - 1; tile_load<64>(tr, Kg, Vg, blk1 * 256 + (t1 & 3) * 64, tid); }
        const int key0 = blk * 256 + (t & 3) * 64;
        const bool own = (t < 4);
        const bool lane_on = own ? true : (((selmask >> blk) & 1u) != 0u);
        const bool wave_on = own ? (key0 <= qw0 + 31) : (__any(lane_on) != 0);
        if (wave_on) {
            f32x16 sA, sB;
            qk_tile(sA, sB, lds + LDS_K, qf, r, h);
            if (own) {
                if (key0 + 63 > qw0) {
                    const int qpos = qw0 + r;
#pragma unroll
                    for (int j = 0; j < 16; ++j) { const int kp = key0 + crow(j, h); if (kp > qpos) sA[j] = NEGF; if (kp + 32 > qpos) sB[j] = NEGF; }
                }
            } else if (!lane_on) {
#pragma unroll
                for (int j = 0; j < 16; ++j) { sA[j] = NEGF; sB[j] = NEGF; }
            }
            softmax_pv<2, VSTR64>(sA, sB, o, mrow, lrow, lds + LDS_V, lane);
        }
    }
    const float il = frcp(lrow);
#pragma unroll
    for (int i = 0; i < 16; ++i) { const float a = __shfl(il, crow(i, h));
        bf16_t* yp = yabc + (rowb + qw0 + crow(i, h)) * YW + Y_C + hd * 64 + r;
#pragma unroll
        for (int db = 0; db < 2; ++db) yp[db * 32] = (bf16_t)f2bf(o[db][i] * a); }
}
}
namespace thin {
__device__ __forceinline__ void transpose_item(const float* W, int K, int N, bf16_t* WT, int row_off, int mode, LAS float* scr, int item, int lane) {
    const int nblk = N / 32, kb = item / nblk, nb = item % nblk, k0 = 64 * kb, n0 = 32 * nb;
#pragma unroll 8
    for (int i = 0; i < 32; ++i) { const int kk = 2 * i + (lane >> 5); scr[kk * 33 + (lane & 31)] = W[(size_t)(k0 + kk) * N + n0 + (lane & 31)]; }
    asm volatile("s_waitcnt lgkmcnt(0)" ::: "memory");
    const int c = lane & 7;
#pragma unroll
    for (int j = 0; j < 4; ++j) { const int n = (lane >> 3) + 8 * j; const LAS float* s = scr + (8 * c) * 33 + n;
        u32x4 o; o.x = pk2(s[0 * 33], s[1 * 33]); o.y = pk2(s[2 * 33], s[3 * 33]); o.z = pk2(s[4 * 33], s[5 * 33]); o.w = pk2(s[6 * 33], s[7 * 33]);
        const int nn = n0 + n; const int row = row_off + (mode == 0 ? nn : ((nn >> 7) * 256 + (mode == 2 ? 128 : 0) + (nn & 127)));
        *(u32x4*)(WT + (size_t)row * K + k0 + 8 * c) = o; }
    asm volatile("s_waitcnt lgkmcnt(0)" ::: "memory");
}
__device__ __forceinline__ void transpose_matrix(const float* W, int K, int N, bf16_t* WT, int row_off, int mode, LAS float* scr, int gw, int ngw, int lane) {
    const int nitems = (K / 64) * (N / 32);
    for (int it = gw; it < nitems; it += ngw) transpose_item(W, K, N, WT, row_off, mode, scr, it, lane);
}

__device__ __forceinline__ void mod_body(const float* c, const float* ada_w, const float* ada_b, float* mod, int gtid, int ngt) {
    for (int idx = gtid; idx < 2 * 6 * D; idx += ngt) {
        const int l = idx / (6 * D), j = idx % (6 * D);
        float acc[NB];
#pragma unroll
        for (int b = 0; b < NB; ++b) acc[b] = 0.f;
        const float* w = ada_w + (size_t)l * D * 6 * D + j;
        for (int k = 0; k < D; ++k) { const float wv = w[(size_t)k * 6 * D];
#pragma unroll
            for (int b = 0; b < NB; ++b) acc[b] += c[b * D + k] * wv; }
#pragma unroll
        for (int b = 0; b < NB; ++b) mod[((size_t)l * NB + b) * 6 * D + j] = acc[b] + ada_b[l * 6 * D + j];
    }
}
__device__ __forceinline__ void rope_body(const int* positions, f32x2* cs, int gtid, int ngt) {
    for (int idx = gtid; idx < M * 32; idx += ngt) {
        const int tok = idx >> 5, i = idx & 31;
        const float inv = 1.0f / powf(10000.0f, (float)(2 * i) / 64.0f);
        const float ang = (float)positions[tok] * inv;
        float s, c; sincosf(ang, &s, &c);
        cs[idx] = (f32x2){c, s};
    }
}
__device__ __forceinline__ void norm_row(const float* xrow, const float* g, const float* shift, const float* scale, bf16_t* orow, int lane, f32x4 (&y)[4]) {
    const f32x4* xr = (const f32x4*)xrow + lane;
    f32x4 v[4]; float ss = 0.f;
#pragma unroll
    for (int j = 0; j < 4; ++j) { v[j] = xr[64 * j]; ss += (v[j].x * v[j].x + v[j].y * v[j].y) + (v[j].z * v[j].z + v[j].w * v[j].w); }
    const float rn = rsqrtf(wave_sum(ss) * (1.0f / D) + EPS);
    u32x2* o8 = (u32x2*)orow + lane;
#pragma unroll
    for (int j = 0; j < 4; ++j) { const int col = 4 * lane + 256 * j;
        const f32x4 gg = *(const f32x4*)(g + col), sc = *(const f32x4*)(scale + col), sh = *(const f32x4*)(shift + col);
        y[j] = v[j] * rn * gg * (sc + 1.0f) + sh;
        u32x2 w; w.x = pk2(y[j].x, y[j].y); w.y = pk2(y[j].z, y[j].w); o8[64 * j] = w; }
}
__device__ __forceinline__ void norm_body(const float* x, const float* g, const float* shift, const float* scale, bf16_t* out, int gw, int ngw, int lane) {
    for (int m = gw; m < M; m += ngw) { const int b = m / SEQ; f32x4 y[4]; norm_row(x + (size_t)m * D, g, shift + b * 6 * D, scale + b * 6 * D, out + (size_t)m * D, lane, y); }
}
__device__ __forceinline__ void norm_router_body(const float* x, const float* g, const float* shift, const float* scale, bf16_t* out,
                                                 const float* rw, const float* rb, int* topi, float* topw, int gw, int ngw, int lane) {
    for (int m = gw; m < M; m += ngw) { const int b = m / SEQ; f32x4 y[4];
        norm_row(x + (size_t)m * D, g, shift + b * 6 * D, scale + b * 6 * D, out + (size_t)m * D, lane, y);
        float lg[NE];
#pragma unroll
        for (int e = 0; e < NE; ++e) lg[e] = 0.f;
#pragma unroll
        for (int j = 0; j < 4; ++j)
#pragma unroll
            for (int q = 0; q < 4; ++q) { const int col = 4 * lane + 256 * j + q; const f32x4 w0 = *(const f32x4*)(rw + col * NE), w1 = *(const f32x4*)(rw + col * NE + 4); const float hv = y[j][q];
                lg[0] += hv * w0.x; lg[1] += hv * w0.y; lg[2] += hv * w0.z; lg[3] += hv * w0.w; lg[4] += hv * w1.x; lg[5] += hv * w1.y; lg[6] += hv * w1.z; lg[7] += hv * w1.w; }
#pragma unroll
        for (int e = 0; e < NE; ++e) lg[e] = wave_sum(lg[e]) + rb[e];
        int i0 = 0; float v0 = lg[0];
#pragma unroll
        for (int e = 1; e < NE; ++e) if (lg[e] > v0) { v0 = lg[e]; i0 = e; }
        int i1 = -1; float v1 = -3.0e38f;
#pragma unroll
        for (int e = 0; e < NE; ++e) if (e != i0 && lg[e] > v1) { v1 = lg[e]; i1 = e; }
        const float w1v = 1.0f / (1.0f + expf(v0 - v1)), w0v = 1.0f - w1v;
        if (lane == 0) { topi[2 * m] = i0; topi[2 * m + 1] = i1; topw[2 * m] = w0v; topw[2 * m + 1] = w1v; }
    }
}
__device__ __forceinline__ void qknorm_body(bf16_t* proj, const f32x2* cs, const float* dqn, const float* dkn, const float* mqn, const float* mkn, int gtid, int ngt) {
    for (long idx = gtid; idx < (long)M * 32 * 32; idx += ngt) {
        const int i = (int)(idx & 31); const long pair = idx >> 5; const int hh = (int)(pair & 31); const int tok = (int)(pair >> 5);
        const int grp = hh >> 3, hi = hh & 7;
        const int cb = (grp == 0 ? C_DQ : grp == 1 ? C_DK : grp == 2 ? C_MQ : C_MK) + hi * 64;
        const float* gn = grp == 0 ? dqn : grp == 1 ? dkn : grp == 2 ? mqn : mkn;
        bf16_t* p = proj + (size_t)tok * INC + cb;
        const float x1 = bf2f(p[i]), x2 = bf2f(p[i + 32]);
        float ss = x1 * x1 + x2 * x2;
        ss += __shfl_xor(ss, 1); ss += __shfl_xor(ss, 2); ss += __shfl_xor(ss, 4); ss += __shfl_xor(ss, 8); ss += __shfl_xor(ss, 16);
        const float rn = rsqrtf(ss * (1.0f / 64.0f) + EPS);
        const float y1 = x1 * rn * gn[i], y2 = x2 * rn * gn[i + 32];
        const f32x2 c = cs[(size_t)tok * 32 + i];
        float o1 = y1 * c.x - y2 * c.y, o2 = y2 * c.x + y1 * c.y;
        if ((grp & 1) == 0) { o1 *= QSCALE; o2 *= QSCALE; }
        p[i] = (bf16_t)f2bf(o1); p[i + 32] = (bf16_t)f2bf(o2);
    }
}
__device__ __forceinline__ void kmean_body(const bf16_t* proj, float* kmean, int gw, int ngw, int lane) {
    for (int it = gw; it < NB * 8 * 8; it += ngw) { const int blk = it & 7, hd = (it >> 3) & 7, b = it >> 6;
        const bf16_t* p = proj + ((size_t)b * SEQ + blk * 256) * INC + C_MK + hd * 64 + lane;
        float s = 0.f;
        for (int t = 0; t < 256; ++t) s += bf2f(p[(size_t)t * INC]);
        kmean[(size_t)it * 64 + lane] = s * (1.0f / 256.0f); }
}
__device__ __forceinline__ void moe_combine_body(const float* x1, const bf16_t* yslot, const float* gate, float* out, int gtid, int ngt) {
    for (long idx = gtid; idx < (long)M * D / 4; idx += ngt) { const int m = (int)(idx >> 8), c4 = (int)(idx & 255) * 4; const int b = m / SEQ;
        const f32x4 xv = *(const f32x4*)(x1 + (size_t)m * D + c4), gv = *(const f32x4*)(gate + b * 6 * D + c4);
        const u32x2 a = *(const u32x2*)(yslot + (size_t)m * D + c4), c = *(const u32x2*)(yslot + ((size_t)M + m) * D + c4);
        f32x4 y = {bf2f(a.x & 0xffffu) + bf2f(c.x & 0xffffu), bf2f(a.x >> 16) + bf2f(c.x >> 16), bf2f(a.y & 0xffffu) + bf2f(c.y & 0xffffu), bf2f(a.y >> 16) + bf2f(c.y >> 16)};
        *(f32x4*)(out + (size_t)m * D + c4) = xv + gv * y; }
}
}
namespace rglru {
constexpr int TT = 32;
constexpr int LDS_WA = 0, LDS_WX = 16384, LDS_XC = 32768, LDS_A = LDS_XC + TT * 65 * 4, LDS_U = LDS_A + TT * 64 * 4, LDS_BYTES = LDS_U + TT * 64 * 4;
__device__ __forceinline__ void unit(int b, int n, const bf16_t* proj, bf16_t* yabc, const float* conv_w, const float* conv_b, const float* wa, const float* ba,
                                     const float* wx, const float* bx, const float* lam, LAS char* lds) {
    const int tid = threadIdx.x;
    LAS float* Wa = (LAS float*)(lds + LDS_WA); LAS float* Wx = (LAS float*)(lds + LDS_WX); LAS float* XC = (LAS float*)(lds + LDS_XC);
    LAS float* AV = (LAS float*)(lds + LDS_A); LAS float* UV = (LAS float*)(lds + LDS_U);
    __syncthreads();
    for (int i = tid; i < 4096; i += 512) { Wa[i] = wa[(size_t)n * 4096 + i]; Wx[i] = wx[(size_t)n * 4096 + i]; }
    const int cc = tid & 63, ct = tid >> 6;
    const int ch = n * 64 + cc;
    const float cw0 = conv_w[0 * D + ch], cw1 = conv_w[1 * D + ch], cw2 = conv_w[2 * D + ch], cw3 = conv_w[3 * D + ch], cb = conv_b[ch];
    const int gt = tid >> 4, eq = tid & 15;
    float gba[4], gbx[4], gsp[4];
#pragma unroll
    for (int j = 0; j < 4; ++j) { const int e = n * 64 + eq * 4 + j; gba[j] = ba[e]; gbx[j] = bx[e]; const float x = -lam[e]; gsp[j] = fmaxf(x, 0.f) + log1pf(expf(-fabsf(x))); }
    float hstate = 0.f;
    const size_t rowb = (size_t)b * SEQ;
    __syncthreads();
    for (int t0 = 0; t0 < SEQ; t0 += TT) {
#pragma unroll
        for (int i = 0; i < 4; ++i) { const int tt = ct + 8 * i, t = t0 + tt;
            const bf16_t* p = proj + (rowb + t) * INC + C_XR + ch;
            float acc = cb + cw3 * bf2f(p[0]);
            if (t >= 1) acc += cw2 * bf2f(*(p - INC));
            if (t >= 2) acc += cw1 * bf2f(*(p - 2 * INC));
            if (t >= 3) acc += cw0 * bf2f(*(p - 3 * INC));
            XC[tt * 65 + cc] = acc; }
        __syncthreads();
        { f32x4 ar = {0.f, 0.f, 0.f, 0.f}, ai = {0.f, 0.f, 0.f, 0.f};
#pragma unroll 8
          for (int d = 0; d < 64; ++d) { const float xv = XC[gt * 65 + d]; ar += *(const LAS f32x4*)(Wa + d * 64 + eq * 4) * xv; ai += *(const LAS f32x4*)(Wx + d * 64 + eq * 4) * xv; }
#pragma unroll
          for (int j = 0; j < 4; ++j) { const int e = eq * 4 + j;
              const float rg = 1.0f / (1.0f + expf(-(ar[j] + gba[j]))), ig = 1.0f / (1.0f + expf(-(ai[j] + gbx[j])));
              const float log_a = -8.0f * rg * gsp[j]; const float a = expf(log_a); const float mult = sqrtf(-expm1f(2.0f * log_a));
              AV[gt * 64 + e] = a; UV[gt * 64 + e] = mult * ig * XC[gt * 65 + e]; } }
        __syncthreads();
        if (tid < 64) {
            for (int tt = 0; tt < TT; ++tt) { hstate = AV[tt * 64 + tid] * hstate + UV[tt * 64 + tid];
                const size_t row = rowb + t0 + tt;
                const float g = bf2f(proj[row * INC + C_GR + n * 64 + tid]);
                yabc[row * YW + Y_A + n * 64 + tid] = (bf16_t)f2bf(g * hstate); }
        }
        __syncthreads();
    }
}
}

namespace moe {
__device__ __forceinline__ void assign(const int* topi, const float* topw, int* rowtok, int* rowdst, float* roww, int* tile_e, int* ntiles, LAS int* sm) {
    const int tid = threadIdx.x, nthr = blockDim.x, per = M / nthr, t0 = tid * per;
    int cnt[NE];
#pragma unroll
    for (int e = 0; e < NE; ++e) cnt[e] = 0;
    for (int t = t0; t < t0 + per; ++t) { const int e0 = topi[2 * t], e1 = topi[2 * t + 1];
#pragma unroll
        for (int e = 0; e < NE; ++e) cnt[e] += (e0 == e) + (e1 == e); }
#pragma unroll
    for (int e = 0; e < NE; ++e) sm[e * nthr + tid] = cnt[e];
    __syncthreads();
    if (tid < NE) { int run = 0; for (int i = 0; i < nthr; ++i) { const int v = sm[tid * nthr + i]; sm[tid * nthr + i] = run; run += v; } sm[NE * nthr + tid] = run; }
    __syncthreads();
    if (tid == 0) { int p = 0, nt = 0;
        for (int e = 0; e < NE; ++e) { const int tot = sm[NE * nthr + e]; sm[NE * nthr + 8 + e] = p; const int nte = (tot + 255) >> 8; for (int i = 0; i < nte; ++i) tile_e[nt++] = e; p += nte * 256; }
        *ntiles = nt; }
    __syncthreads();
    for (int e = 0; e < NE; ++e) { const int tot = sm[NE * nthr + e], base = sm[NE * nthr + 8 + e], padded = ((tot + 255) >> 8) << 8;
        for (int i = tot + tid; i < padded; i += nthr) { rowtok[base + i] = 0; rowdst[base + i] = -1; roww[base + i] = 0.f; } }
    int pos[NE];
#pragma unroll
    for (int e = 0; e < NE; ++e) pos[e] = sm[NE * nthr + 8 + e] + sm[e * nthr + tid];
    for (int t = t0; t < t0 + per; ++t) {
#pragma unroll
        for (int k = 0; k < 2; ++k) { const int ek = topi[2 * t + k]; int p = 0;
#pragma unroll
            for (int e = 0; e < NE; ++e) { if (ek == e) { p = pos[e]; pos[e] = p + 1; } }
            rowtok[p] = t; rowdst[p] = k * M + t; roww[p] = topw[2 * t + k]; } }
}
struct Order {
    const int* tile_e; const int* ntiles_p; int nN, G, c, ntiles;
    __device__ __forceinline__ void dev_init(int G_, int c_) { G = G_; c = c_; ntiles = *ntiles_p; }
    __device__ __forceinline__ bool next(int i, pg8::Unit& u) const { const int L = i * G + c; if (L >= ntiles * nN) return false; u.pm = L / nN; u.pn = L % nN; u.e = tile_e[u.pm]; u.aux = 0; return true; }
};
struct ProbUp {
    static constexpr bool GATHER = true;
    const bf16_t* A; const bf16_t* Bt; const int* rowtok; int K, lda, ldb, pad;
    __device__ __forceinline__ const char* a_base(const pg8::Unit&) const { return (const char*)A; }
    __device__ __forceinline__ const char* b_base(const pg8::Unit& u) const { return (const char*)Bt + ((size_t)u.e * DFF2 + (size_t)u.pn * 256) * ldb * 2; }
    __device__ __forceinline__ unsigned a_off(const pg8::Unit& u, int row, int col) const { return (unsigned)(rowtok[u.pm * 256 + row] * lda + col) * 2u; }
};
struct ProbDown {
    static constexpr bool GATHER = false;
    const bf16_t* A; const bf16_t* Bt; int K, lda, ldb, pad;
    __device__ __forceinline__ const char* a_base(const pg8::Unit& u) const { return (const char*)A + (size_t)u.pm * 256 * lda * 2; }
    __device__ __forceinline__ const char* b_base(const pg8::Unit& u) const { return (const char*)Bt + ((size_t)u.e * D + (size_t)u.pn * 256) * ldb * 2; }
    __device__ __forceinline__ unsigned a_off(const pg8::Unit&, int row, int col) const { return (unsigned)(row * lda + col) * 2u; }
};
}
constexpr size_t MiB = 1u << 20;
constexpr size_t WS_CTL = 0, WS_ROWTOK = 256 * 1024, WS_ROWDST = 400 * 1024, WS_ROWW = 544 * 1024, WS_TILEE = 700 * 1024, WS_NTILES = 702 * 1024;
constexpr size_t WS_MOD = 1 * MiB, WS_CS = 1 * MiB + 512 * 1024, WS_KMEAN = 5 * MiB + 512 * 1024, WS_TOPI = 5 * MiB + 640 * 1024, WS_TOPW = 5 * MiB + 768 * 1024;
constexpr size_t WS_L1W = 6 * MiB, WS_H = 28 * MiB, WS_YABC = 60 * MiB, WS_PROJ = 124 * MiB, WS_XA = 380 * MiB, WS_END = 444 * MiB;
constexpr size_t WS_MOEW13 = 6 * MiB, WS_MOEW2 = 94 * MiB, WS_HMID_MOE = 138 * MiB, WS_YSLOT = 325 * MiB, WS_H2L1 = 412 * MiB;
constexpr size_t LW_IN = 0, LW_BRA = 16 * MiB, LW_BRB = 18 * MiB, LW_BRC = 19 * MiB, LW_OUT = 20 * MiB, LW_W13 = 22 * MiB, LW_W2 = 33 * MiB;

struct CvtDesc { const float* W; bf16_t* WT; int K, N, row_off, mode; };
struct CvtArgs { CvtDesc d[24]; int n; int pad; };
__global__ __launch_bounds__(256) void k_convert(CvtArgs a) {
    __shared__ float scr[4][64 * 33];
    const int wid = threadIdx.x >> 6, lane = threadIdx.x & 63, gw = blockIdx.x * 4 + wid, ngw = gridDim.x * 4;
    for (int i = 0; i < a.n; ++i) thin::transpose_matrix(a.d[i].W, a.d[i].K, a.d[i].N, a.d[i].WT, a.d[i].row_off, a.d[i].mode, (LAS float*)scr[wid], gw, ngw, lane);
}
__global__ void k_mod(const float* c, const float* ada_w, const float* ada_b, float* mod) { thin::mod_body(c, ada_w, ada_b, mod, blockIdx.x * blockDim.x + threadIdx.x, gridDim.x * blockDim.x); }
__global__ void k_rope(const int* pos, f32x2* cs) { thin::rope_body(pos, cs, blockIdx.x * blockDim.x + threadIdx.x, gridDim.x * blockDim.x); }
__global__ __launch_bounds__(512, 2) void k_norm(const float* x, const float* g, const float* shift, const float* scale, bf16_t* out) {
    thin::norm_body(x, g, shift, scale, out, blockIdx.x * 8 + (threadIdx.x >> 6), gridDim.x * 8, threadIdx.x & 63); }
__global__ __launch_bounds__(512, 2) void k_norm_router(const float* x, const float* g, const float* shift, const float* scale, bf16_t* out, const float* rw, const float* rb, int* topi, float* topw) {
    thin::norm_router_body(x, g, shift, scale, out, rw, rb, topi, topw, blockIdx.x * 8 + (threadIdx.x >> 6), gridDim.x * 8, threadIdx.x & 63); }
__global__ __launch_bounds__(512, 2) void k_qknorm(bf16_t* proj, const f32x2* cs, const float* dqn, const float* dkn, const float* mqn, const float* mkn) {
    thin::qknorm_body(proj, cs, dqn, dkn, mqn, mkn, blockIdx.x * blockDim.x + threadIdx.x, gridDim.x * blockDim.x); }
__global__ __launch_bounds__(512, 2) void k_kmean(const bf16_t* proj, float* kmean) { thin::kmean_body(proj, kmean, blockIdx.x * 8 + (threadIdx.x >> 6), gridDim.x * 8, threadIdx.x & 63); }
__global__ __launch_bounds__(512, 2) void k_rglru(const bf16_t* proj, bf16_t* yabc, const float* conv_w, const float* conv_b, const float* wa, const float* ba, const float* wx, const float* bx, const float* lam) {
    __shared__ __attribute__((aligned(16))) char lds[rglru::LDS_BYTES];
    rglru::unit(blockIdx.x >> 4, blockIdx.x & 15, proj, yabc, conv_w, conv_b, wa, ba, wx, bx, lam, (LAS char*)lds); }
__device__ __forceinline__ float diff_lambda(const float* lq1, const float* lk1, const float* lq2, const float* lk2, float lam_init) {
    float s1 = 0.f, s2 = 0.f; for (int i = 0; i < 64; ++i) { s1 += lq1[i] * lk1[i]; s2 += lq2[i] * lk2[i]; } return expf(s1) - expf(s2) + lam_init; }
__global__ __launch_bounds__(512, 2) void k_diff(const bf16_t* proj, bf16_t* yabc, const float* subln, const float* lq1, const float* lk1, const float* lq2, const float* lk2, float lam_init) {
    __shared__ __attribute__((aligned(16))) char lds[attn::LDS_BYTES];
    const float lam = diff_lambda(lq1, lk1, lq2, lk2, lam_init);
    const int u = blockIdx.x; const int qt = 7 - (u >> 5), bh = u & 31;
    attn::diff_unit(bh >> 2, bh & 3, qt, proj, yabc, subln, lam, 1.0f - lam_init, (LAS char*)lds); }
__global__ __launch_bounds__(512, 2) void k_moba(const bf16_t* proj, bf16_t* yabc, const float* kmean) {
    __shared__ __attribute__((aligned(16))) char lds[attn::LDS_BYTES];
    const int u = blockIdx.x; const int cur = 7 - (u >> 6), bh = u & 63;
    attn::moba_unit(bh >> 3, bh & 7, cur, proj, yabc, kmean, (LAS char*)lds); }
__global__ __launch_bounds__(512, 2) void k_moe_assign(const int* topi, const float* topw, int* rowtok, int* rowdst, float* roww, int* tile_e, int* ntiles) {
    __shared__ int sm[8 * 512 + 16];
    moe::assign(topi, topw, rowtok, rowdst, roww, tile_e, ntiles, (LAS int*)sm); }
__global__ __launch_bounds__(512, 2) void k_moe_combine(const float* x1, const bf16_t* yslot, const float* gate, float* out) {
    thin::moe_combine_body(x1, yslot, gate, out, blockIdx.x * blockDim.x + threadIdx.x, gridDim.x * blockDim.x); }

template <class Epi> __global__ __launch_bounds__(512, 2) void k_gemm_dense(pg8::DenseProb g, Epi E, int Mrows, int N) {
    extern __shared__ __attribute__((aligned(16))) unsigned char shm[];
    pg8::StaticOrder S; S.init(Mrows, N, (int)gridDim.x, (int)blockIdx.x);
    pg8::gemm_phase<pg8::DenseProb, Epi, pg8::StaticOrder, true>((LAS unsigned char*)shm, g, S, E);
}
template <class Prob, class Epi> __global__ __launch_bounds__(512, 2) void k_gemm_moe(Prob g, Epi E, moe::Order S0) {
    extern __shared__ __attribute__((aligned(16))) unsigned char shm[];
    moe::Order S = S0; S.dev_init((int)gridDim.x, (int)blockIdx.x);
    pg8::gemm_phase<Prob, Epi, moe::Order, true>((LAS unsigned char*)shm, g, S, E);
}
template <class Epi> static void launch_dense(hipStream_t st, int grid, const bf16_t* A, int lda, const bf16_t* Bt, int ldb, int K, int Mrows, int N, Epi E) {
    static bool once = false;
    if (!once) { (void)hipFuncSetAttribute((const void*)k_gemm_dense<Epi>, hipFuncAttributeMaxDynamicSharedMemorySize, pg8::STAGE_BYTES); once = true; }
    pg8::DenseProb g{A, Bt, K, lda, ldb, 0};
    hipLaunchKernelGGL(k_gemm_dense<Epi>, dim3(grid), dim3(512), pg8::STAGE_BYTES, st, g, E, Mrows, N);
}
template <class Prob, class Epi> static void launch_moe(hipStream_t st, int grid, Prob g, Epi E, moe::Order S) {
    static bool once = false;
    if (!once) { (void)hipFuncSetAttribute((const void*)k_gemm_moe<Prob, Epi>, hipFuncAttributeMaxDynamicSharedMemorySize, pg8::STAGE_BYTES); once = true; }
    hipLaunchKernelGGL((k_gemm_moe<Prob, Epi>), dim3(grid), dim3(512), pg8::STAGE_BYTES, st, g, E, S);
}

extern "C" void kernel_launch(void* const* d_in, const int* in_sizes, int n_in, void* d_out, int out_size, void* d_ws, size_t ws_size, hipStream_t stream) {
    if (n_in != 37 || ws_size < WS_END) { fprintf(stderr, "kernel_launch: unexpected n_in %d / ws_size %zu\n", n_in, ws_size); return; }
    const int grid = 256;
    auto F = [&](int i) { return (const float*)d_in[i]; };
    char* ws = (char*)d_ws; char* outb = (char*)d_out;
    const float* x = F(0); const float* c = F(1); const int* positions = (const int*)d_in[2];
    float* mod = (float*)(ws + WS_MOD); f32x2* cs = (f32x2*)(ws + WS_CS); float* kmean = (float*)(ws + WS_KMEAN);
    int* topi = (int*)(ws + WS_TOPI); float* topw = (float*)(ws + WS_TOPW);
    int* rowtok = (int*)(ws + WS_ROWTOK); int* rowdst = (int*)(ws + WS_ROWDST); float* roww = (float*)(ws + WS_ROWW); int* tile_e = (int*)(ws + WS_TILEE); int* ntiles = (int*)(ws + WS_NTILES);
    bf16_t* H = (bf16_t*)(ws + WS_H); bf16_t* YABC = (bf16_t*)(ws + WS_YABC); bf16_t* PROJ = (bf16_t*)(ws + WS_PROJ); float* XA = (float*)(ws + WS_XA);
    char* lw[2] = {outb, ws + WS_L1W};
    { CvtArgs a{}; int n = 0;
      for (int l = 0; l < 2; ++l) {
        a.d[n++] = {F(7) + (size_t)l * D * INC, (bf16_t*)(lw[l] + LW_IN), D, INC, 0, 0};
        a.d[n++] = {F(25) + (size_t)l * D * D, (bf16_t*)(lw[l] + LW_BRA), D, D, 0, 0};
        a.d[n++] = {F(26) + (size_t)l * 512 * D, (bf16_t*)(lw[l] + LW_BRB), 512, D, 0, 0};
        a.d[n++] = {F(27) + (size_t)l * 512 * D, (bf16_t*)(lw[l] + LW_BRC), 512, D, 0, 0};
        a.d[n++] = {F(28) + (size_t)l * D * D, (bf16_t*)(lw[l] + LW_OUT), D, D, 0, 0}; }
      a.d[n++] = {F(29), (bf16_t*)(lw[0] + LW_W13), D, DFF, 0, 1};
      a.d[n++] = {F(30), (bf16_t*)(lw[0] + LW_W13), D, DFF, 0, 2};
      a.d[n++] = {F(31), (bf16_t*)(lw[0] + LW_W2), DFF, D, 0, 0};
      a.n = n;
      hipLaunchKernelGGL(k_convert, dim3(1024), dim3(256), 0, stream, a); }
    hipLaunchKernelGGL(k_mod, dim3(48), dim3(256), 0, stream, c, F(3), F(4), mod);
    hipLaunchKernelGGL(k_rope, dim3(512), dim3(256), 0, stream, positions, cs);
    for (int l = 0; l < 2; ++l) {
        const float* xin = (l == 0) ? x : (const float*)XA;
        float* x1 = (l == 0) ? XA : (float*)d_out;
        float* Ptmp = (l == 0) ? XA : (float*)d_out;
        const float* modl = mod + (size_t)l * NB * 6 * D;
        const float lam_init = 0.8f - 0.6f * expf(-0.3f * (float)l);
        hipLaunchKernelGGL(k_norm, dim3(grid), dim3(512), 0, stream, xin, F(5) + l * D, modl + 0 * D, modl + 1 * D, H);
        launch_dense(stream, grid, H, D, (const bf16_t*)(lw[l] + LW_IN), D, D, M, INC, epi::Proj{PROJ, F(8) + l * 3 * D});
        hipLaunchKernelGGL(k_qknorm, dim3(2048), dim3(512), 0, stream, PROJ, (const f32x2*)cs, F(16) + l * 64, F(17) + l * 64, F(23) + l * 64, F(24) + l * 64);
        hipLaunchKernelGGL(k_kmean, dim3(64), dim3(512), 0, stream, (const bf16_t*)PROJ, kmean);
        hipLaunchKernelGGL(k_rglru, dim3(128), dim3(512), 0, stream, (const bf16_t*)PROJ, YABC, F(9) + l * 4 * D, F(10) + l * D, F(11) + (size_t)l * 16 * 4096, F(12) + l * D, F(13) + (size_t)l * 16 * 4096, F(14) + l * D, F(15) + l * D);
        hipLaunchKernelGGL(k_diff, dim3(256), dim3(512), 0, stream, (const bf16_t*)PROJ, YABC, F(22) + l * 128, F(18) + l * 64, F(19) + l * 64, F(20) + l * 64, F(21) + l * 64, lam_init);
        hipLaunchKernelGGL(k_moba, dim3(512), dim3(512), 0, stream, (const bf16_t*)PROJ, YABC, (const float*)kmean);
        launch_dense(stream, grid, YABC + Y_A, YW, (const bf16_t*)(lw[l] + LW_BRA), D, D, M, D, epi::Branch<0>{PROJ, Ptmp, H});
        launch_dense(stream, grid, YABC + Y_B, YW, (const bf16_t*)(lw[l] + LW_BRB), 512, 512, M, D, epi::Branch<1>{PROJ, Ptmp, H});
        launch_dense(stream, grid, YABC + Y_C, YW, (const bf16_t*)(lw[l] + LW_BRC), 512, 512, M, D, epi::Branch<2>{PROJ, Ptmp, H});
        launch_dense(stream, grid, H, D, (const bf16_t*)(lw[l] + LW_OUT), D, D, M, D, epi::Resid{xin, x1, modl + 2 * D});
        if (l == 0) {
            hipLaunchKernelGGL(k_norm, dim3(grid), dim3(512), 0, stream, (const float*)x1, F(6) + l * D, modl + 3 * D, modl + 4 * D, H);
            bf16_t* hmid = PROJ;
            launch_dense(stream, grid, H, D, (const bf16_t*)(lw[0] + LW_W13), D, D, M, DFF2, epi::SwiGLU{hmid});
            launch_dense(stream, grid, hmid, DFF, (const bf16_t*)(lw[0] + LW_W2), DFF, DFF, M, D, epi::Resid{x1, x1, modl + 5 * D});
        } else {
            bf16_t* W13 = (bf16_t*)(ws + WS_MOEW13); bf16_t* W2 = (bf16_t*)(ws + WS_MOEW2); bf16_t* h2 = (bf16_t*)(ws + WS_H2L1);
            bf16_t* hmid = (bf16_t*)(ws + WS_HMID_MOE); bf16_t* yslot = (bf16_t*)(ws + WS_YSLOT);
            { CvtArgs a{}; int n = 0;
              for (int e = 0; e < NE; ++e) {
                a.d[n++] = {F(34) + (size_t)e * D * DFF, W13, D, DFF, e * DFF2, 1};
                a.d[n++] = {F(35) + (size_t)e * D * DFF, W13, D, DFF, e * DFF2, 2};
                a.d[n++] = {F(36) + (size_t)e * DFF * D, W2, DFF, D, e * D, 0}; }
              a.n = n;
              hipLaunchKernelGGL(k_convert, dim3(1024), dim3(256), 0, stream, a); }
            hipLaunchKernelGGL(k_norm_router, dim3(grid), dim3(512), 0, stream, (const float*)x1, F(6) + l * D, modl + 3 * D, modl + 4 * D, h2, F(32), F(33), topi, topw);
            hipLaunchKernelGGL(k_moe_assign, dim3(1), dim3(512), 0, stream, (const int*)topi, (const float*)topw, rowtok, rowdst, roww, tile_e, ntiles);
            launch_moe(stream, grid, moe::ProbUp{h2, W13, rowtok, D, D, D, 0}, epi::SwiGLU{hmid}, moe::Order{tile_e, ntiles, DFF2 / 256, 0, 0, 0});
            launch_moe(stream, grid, moe::ProbDown{hmid, W2, DFF, DFF, DFF, 0}, epi::MoeDown{rowdst, roww, yslot}, moe::Order{tile_e, ntiles, D / 256, 0, 0, 0});
            hipLaunchKernelGGL(k_moe_combine, dim3(1024), dim3(512), 0, stream, (const float*)x1, (const bf16_t*)yslot, modl + 5 * D, (float*)d_out);
        }
    }
}
```

```cpp
#include <hip/hip_runtime.h>
#include <stdint.h>
#include <stdio.h>

#define LAS __attribute__((address_space(3)))
typedef unsigned short bf16_t;
typedef short bf16x8 __attribute__((ext_vector_type(8)));
typedef short s16x4 __attribute__((ext_vector_type(4)));
typedef float f32x2 __attribute__((ext_vector_type(2)));
typedef float f32x4 __attribute__((ext_vector_type(4)));
typedef float f32x16 __attribute__((ext_vector_type(16)));
typedef unsigned u32x2 __attribute__((ext_vector_type(2)));
typedef unsigned u32x4 __attribute__((ext_vector_type(4)));

constexpr int D = 1024, NB = 8, SEQ = 2048, M = NB * SEQ, INC = 8192, DFF = 2816, NE = 8, DFF2 = 2 * DFF;
constexpr int C_XR = 0, C_GR = 1024, C_DQ = 2048, C_DK = 2560, C_DV = 3072, C_MQ = 3584, C_MK = 4096, C_MV = 4608, C_GB = 5120;
constexpr int YW = 2048, Y_A = 0, Y_B = 1024, Y_C = 1536;
constexpr float EPS = 1e-6f;
constexpr float QSCALE = 0.125f * 1.4426950408889634f;
constexpr int MOE_MAXROWS = 34816, MOE_MAXTILES = MOE_MAXROWS / 256;

__device__ __forceinline__ float bf2f(unsigned v) { return __uint_as_float(v << 16); }
__device__ __forceinline__ unsigned f2bf(float f) { unsigned u = __float_as_uint(f); return (u + 0x7fffu + ((u >> 16) & 1u)) >> 16; }
__device__ __forceinline__ unsigned pk2(float lo, float hi) { unsigned r; asm volatile("v_cvt_pk_bf16_f32 %0, %1, %2" : "=v"(r) : "v"(lo), "v"(hi)); return r; }
__device__ __forceinline__ float fexp2(float x) { return __builtin_amdgcn_exp2f(x); }
__device__ __forceinline__ float frcp(float x) { return __builtin_amdgcn_rcpf(x); }
__device__ __forceinline__ float sigmoid_f(float x) { return frcp(1.0f + fexp2(-1.4426950408889634f * x)); }
__device__ __forceinline__ float gelu_tanh_f(float x) { return x * sigmoid_f(1.5957691216057308f * (x + 0.044715f * x * x * x)); }
__device__ __forceinline__ float silu_f(float x) { return x * sigmoid_f(x); }
__device__ __forceinline__ float wave_sum(float v) {
#pragma unroll
    for (int o = 1; o < 64; o <<= 1) v += __shfl_xor(v, o);
    return v;
}
namespace pg8 {
constexpr int BM = 256, BK = 64, HALF = 128, HTB = HALF * BK * 2  , STAGE_BYTES = 8 * HTB, NXCD = 8, WGM = 8;

__host__ __device__ __forceinline__ int lds_byte(int r, int c) { const int st = (r >> 4) * 2 + (c >> 5), rr = r & 15, cc = c & 31, ob = rr * 64 + cc * 2; return st * 1024 + (ob ^ (((ob >> 9) & 1) << 5)); }
__host__ __device__ __forceinline__ void stage_rc(int b, int& R, int& C) { const int st = b / 1024, sb = b % 1024, swz = sb ^ (((sb >> 9) & 1) << 5); R = (st >> 1) * 16 + swz / 64; C = (st & 1) * 32 + (swz % 64) / 2; }
__host__ __device__ __forceinline__ int perm32(int rho) { const int n = rho >> 4, i = rho & 15; return 8 * (i >> 2) + 4 * n + (i & 3); }

struct Unit { int pm, pn, e, aux; };

struct StaticOrder {
    int nM, nN, nwg, G, c;
    __host__ __device__ void init(int M, int N, int G_, int c_) { nM = M / BM; nN = N / BM; nwg = nM * nN; G = G_; c = c_; }
    __device__ __forceinline__ bool next(int i, Unit& u) const {
        const long L = (long)i * G + c; if (L >= nwg) return false;
        int wgid = (int)L; { const int q = nwg / NXCD, r = nwg % NXCD, xcd = wgid % NXCD, off = wgid / NXCD; wgid = (xcd < r ? xcd * (q + 1) : r * (q + 1) + (xcd - r) * q) + off; }
        const int nig = WGM * nN, gid = wgid / nig, fm = gid * WGM, gsz = (nM - fm) < WGM ? (nM - fm) : WGM;
        u.pm = fm + ((wgid % nig) % gsz); u.pn = (wgid % nig) / gsz; u.e = 0; u.aux = 0; return true;
    }
};

struct DenseProb {
    static constexpr bool GATHER = false;
    const bf16_t* A; const bf16_t* Bt; int K, lda, ldb, pad;
    __device__ __forceinline__ const char* a_base(const Unit& u) const { return (const char*)A + (size_t)u.pm * BM * lda * 2; }
    __device__ __forceinline__ const char* b_base(const Unit& u) const { return (const char*)Bt + (size_t)u.pn * BM * ldb * 2; }
    __device__ __forceinline__ unsigned a_off(const Unit&, int row, int col) const { return (unsigned)(row * lda + col) * 2u; }
};

template <class Prob, class Epi, class Sched, bool ALIGN_EPI = true>
__device__ __forceinline__ void gemm_phase(LAS unsigned char* lds, const Prob& g, const Sched& S, const Epi& E) {
    int tid_l = threadIdx.x; asm volatile("" : "+v"(tid_l));
    const int tid = tid_l, wid = __builtin_amdgcn_readfirstlane(tid >> 6), lane = tid & 63, wr = wid >> 2, wc = wid & 3, fr = lane & 15, fq = lane >> 4;
    const int K = g.K, nt = K / BK;
    int sR[2], sC[2]; unsigned voffB[2];
#pragma unroll
    for (int i = 0; i < 2; ++i) { int R, C; stage_rc(tid * 16 + i * 8192, R, C); sR[i] = R; sC[i] = C; const int Rb = Epi::PERM ? ((R & ~31) + perm32(R & 31)) : R; voffB[i] = (unsigned)(Rb * g.ldb + C) * 2u; }
    const size_t kstep = (size_t)(BK * 2);
    const size_t hstepB = (size_t)HALF * g.ldb * 2;
    const unsigned ldsw = (unsigned)wid * 1024u;
    const int aoff = lds_byte(wr * 64 + fr, fq * 8), boff = lds_byte(wc * 32 + fr, fq * 8);
#define PG8_SA(b, h) (((b) * 2 + (h)) * HTB)
#define PG8_SB(b, h) ((4 + (b) * 2 + (h)) * HTB)
#define PG8_STAGE(bufoff, gbase, voff) do { _Pragma("unroll") for (int _i = 0; _i < 2; ++_i) \
        __builtin_amdgcn_global_load_lds((const unsigned*)((const char*)(gbase) + (voff)[_i]), (LAS unsigned*)(lds + (bufoff) + ldsw + _i * 8192), 16, 0, 0); } while (0)
#define PG8_LDA(dst, b, h) do { _Pragma("unroll") for (int m = 0; m < 4; ++m) _Pragma("unroll") for (int k = 0; k < 2; ++k) dst[m][k] = *(const LAS bf16x8*)(lds + PG8_SA(b, h) + aoff + m * 2048 + k * 1024); } while (0)
#define PG8_LDB(dst, b, h) do { _Pragma("unroll") for (int n = 0; n < 2; ++n) _Pragma("unroll") for (int k = 0; k < 2; ++k) dst[n][k] = *(const LAS bf16x8*)(lds + PG8_SB(b, h) + boff + n * 2048 + k * 1024); } while (0)
#define PG8_MMA(ai, bj, At, Bt) do { __builtin_amdgcn_s_setprio(1); _Pragma("unroll") for (int m = 0; m < 4; ++m) _Pragma("unroll") for (int n = 0; n < 2; ++n) _Pragma("unroll") for (int k = 0; k < 2; ++k) \
        acc[ai][bj][m][n] = __builtin_amdgcn_mfma_f32_16x16x32_bf16(Bt[n][k], At[m][k], acc[ai][bj][m][n], 0, 0, 0); __builtin_amdgcn_s_setprio(0); } while (0)
#define PG8_WAIT_V(n) asm volatile("s_waitcnt vmcnt(" #n ")" ::: "memory")
#define PG8_WAIT_L(n) asm volatile("s_waitcnt lgkmcnt(" #n ")" ::: "memory")
#define PG8_BAR __builtin_amdgcn_s_barrier()
#define PG8_SCHED __builtin_amdgcn_sched_barrier(0)
    Unit cur, nxt; int ui = 0;
    if (!S.next(0, cur)) return;
    f32x4 acc[2][2][4][2];
#pragma unroll
    for (int a = 0; a < 2; ++a)
#pragma unroll
        for (int b = 0; b < 2; ++b)
#pragma unroll
            for (int m = 0; m < 4; ++m)
#pragma unroll
                for (int n = 0; n < 2; ++n) acc[a][b][m][n] = (f32x4){0.f, 0.f, 0.f, 0.f};
    bf16x8 At[4][2], B0[2][2], B1[2][2];
    unsigned vA[2][2], vN[2][2];
#pragma unroll
    for (int h = 0; h < 2; ++h)
#pragma unroll
        for (int i = 0; i < 2; ++i) { vA[h][i] = g.a_off(cur, h * HALF + sR[i], sC[i]); vN[h][i] = vA[h][i]; }
    const char* cA = g.a_base(cur); const char* cB = g.b_base(cur);
    PG8_STAGE(PG8_SB(0, 0), cB, voffB); PG8_STAGE(PG8_SB(0, 1), cB + hstepB, voffB); PG8_STAGE(PG8_SA(0, 0), cA, vA[0]); PG8_STAGE(PG8_SA(0, 1), cA, vA[1]);
    if (wr == 1) PG8_BAR;
    PG8_WAIT_V(2); PG8_BAR;
    PG8_STAGE(PG8_SB(1, 0), cB + kstep, voffB); PG8_STAGE(PG8_SA(1, 0), cA + kstep, vA[0]); PG8_STAGE(PG8_SB(1, 1), cB + hstepB + kstep, voffB);
    PG8_WAIT_V(6); PG8_BAR;
    for (;;) {
        const bool has_next = S.next(ui + 1, nxt);
        const char* nA = has_next ? g.a_base(nxt) : cA; const char* nB = has_next ? g.b_base(nxt) : cB;
        if (Prob::GATHER) {
#pragma unroll
            for (int h = 0; h < 2; ++h)
#pragma unroll
                for (int i = 0; i < 2; ++i) vN[h][i] = has_next ? g.a_off(nxt, h * HALF + sR[i], sC[i]) : vA[h][i];
        }
        for (int t = 0; t < nt; t += 2) {
            const bool last = (t == nt - 2);
            const char* a1 = cA + (size_t)(t + 1) * kstep;
            const char* a2 = last ? nA : cA + (size_t)(t + 2) * kstep; const char* b2 = last ? nB : cB + (size_t)(t + 2) * kstep;
            const char* a3 = a2 + kstep; const char* b3 = b2 + kstep;
            unsigned v2[2][2];
#pragma unroll
            for (int h = 0; h < 2; ++h)
#pragma unroll
                for (int i = 0; i < 2; ++i) v2[h][i] = (Prob::GATHER && last) ? vN[h][i] : vA[h][i];
            PG8_LDB(B0, 0, 0); PG8_LDB(B1, 0, 1); PG8_SCHED; PG8_LDA(At, 0, 0); PG8_STAGE(PG8_SA(1, 1), a1, vA[1]);
            PG8_WAIT_V(8); PG8_WAIT_L(0); PG8_BAR; PG8_MMA(0, 0, At, B0); PG8_MMA(0, 1, At, B1); PG8_BAR; PG8_SCHED;
            PG8_LDA(At, 0, 1); PG8_STAGE(PG8_SB(0, 0), b2, voffB); PG8_STAGE(PG8_SB(0, 1), b2 + hstepB, voffB); PG8_STAGE(PG8_SA(0, 0), a2, v2[0]);
            PG8_WAIT_V(8); PG8_WAIT_L(0); PG8_BAR; PG8_MMA(1, 0, At, B0); PG8_MMA(1, 1, At, B1); PG8_BAR; PG8_SCHED;
            PG8_LDB(B0, 1, 0); PG8_LDB(B1, 1, 1); PG8_SCHED; PG8_LDA(At, 1, 0); PG8_STAGE(PG8_SA(0, 1), a2, v2[1]);
            PG8_WAIT_V(8); PG8_WAIT_L(0); PG8_BAR; PG8_MMA(0, 0, At, B0); PG8_MMA(0, 1, At, B1); PG8_BAR; PG8_SCHED;
            PG8_LDA(At, 1, 1); PG8_STAGE(PG8_SB(1, 0), b3, voffB); PG8_STAGE(PG8_SB(1, 1), b3 + hstepB, voffB); PG8_STAGE(PG8_SA(1, 0), a3, v2[0]);
            PG8_WAIT_V(8); PG8_WAIT_L(0); PG8_BAR; PG8_MMA(1, 0, At, B0); PG8_MMA(1, 1, At, B1); PG8_BAR; PG8_SCHED;
        }
        if constexpr (ALIGN_EPI) { if (wr == 0) PG8_BAR; }
        E(acc, cur, wr, wc, fr, fq);
        if (!has_next) break;
#pragma unroll
        for (int a = 0; a < 2; ++a)
#pragma unroll
            for (int b = 0; b < 2; ++b)
#pragma unroll
                for (int m = 0; m < 4; ++m)
#pragma unroll
                    for (int n = 0; n < 2; ++n) acc[a][b][m][n] = (f32x4){0.f, 0.f, 0.f, 0.f};
        cur = nxt; cA = nA; cB = nB; ++ui;
        if (Prob::GATHER) {
#pragma unroll
            for (int h = 0; h < 2; ++h)
#pragma unroll
                for (int i = 0; i < 2; ++i) vA[h][i] = vN[h][i];
        }
        if constexpr (ALIGN_EPI) { if (wr == 1) PG8_BAR; }
    }
    PG8_WAIT_V(0);
    if constexpr (!ALIGN_EPI) { if (wr == 0) PG8_BAR; }
    PG8_BAR;
#undef PG8_SA
#undef PG8_SB
#undef PG8_STAGE
#undef PG8_LDA
#undef PG8_LDB
#undef PG8_MMA
#undef PG8_WAIT_V
#undef PG8_WAIT_L
#undef PG8_BAR
#undef PG8_SCHED
}
}
namespace epi {
using pg8::Unit; using pg8::BM; using pg8::HALF;
typedef const f32x4 (&AccRef)[2][2][4][2];

struct Proj {
    static constexpr bool PERM = true;
    bf16_t* O; const float* gate_b;
    __device__ __forceinline__ void operator()(AccRef acc, const Unit& u, int wr, int wc, int fr, int fq) const {
        const int row0 = u.pm * BM + wr * 64 + fr, col0 = u.pn * BM + wc * 32 + 8 * fq;
        const int mode = (u.pn >= 20) ? 2 : ((u.pn >= 4 && u.pn < 8) ? 1 : 0);
        f32x4 bv[2][2];
#pragma unroll
        for (int bj = 0; bj < 2; ++bj)
#pragma unroll
            for (int n = 0; n < 2; ++n) bv[bj][n] = (mode == 2) ? *(const f32x4*)(gate_b + (col0 - C_GB) + bj * HALF + 4 * n) : (f32x4){0.f, 0.f, 0.f, 0.f};
#pragma unroll
        for (int ai = 0; ai < 2; ++ai)
#pragma unroll
            for (int m = 0; m < 4; ++m) { bf16_t* rowp = O + (size_t)(row0 + ai * HALF + m * 16) * INC + col0;
#pragma unroll
                for (int bj = 0; bj < 2; ++bj) { f32x4 v0 = acc[ai][bj][m][0] + bv[bj][0], v1 = acc[ai][bj][m][1] + bv[bj][1];
                    if (mode == 1) {
#pragma unroll
                        for (int j = 0; j < 4; ++j) { v0[j] = gelu_tanh_f(v0[j]); v1[j] = gelu_tanh_f(v1[j]); } }
                    if (mode == 2) {
#pragma unroll
                        for (int j = 0; j < 4; ++j) { v0[j] = sigmoid_f(v0[j]); v1[j] = sigmoid_f(v1[j]); } }
                    u32x4 w; w.x = pk2(v0[0], v0[1]); w.y = pk2(v0[2], v0[3]); w.z = pk2(v1[0], v1[1]); w.w = pk2(v1[2], v1[3]);
                    *(u32x4*)(rowp + bj * HALF) = w; } }
    }
};

template <int STEP> struct Branch {
    static constexpr bool PERM = false;
    const bf16_t* proj; float* P; bf16_t* merged;
    __device__ __forceinline__ void operator()(AccRef acc, const Unit& u, int wr, int wc, int fr, int fq) const {
        const int row0 = u.pm * BM + wr * 64 + fr, col0 = u.pn * BM + wc * 32 + 4 * fq;
#pragma unroll
        for (int ai = 0; ai < 2; ++ai)
#pragma unroll
            for (int m = 0; m < 4; ++m) { const size_t row = (size_t)(row0 + ai * HALF + m * 16);
#pragma unroll
                for (int bj = 0; bj < 2; ++bj)
#pragma unroll
                    for (int n = 0; n < 2; ++n) { const int col = col0 + bj * HALF + n * 16;
                        const u32x2 gw = *(const u32x2*)(proj + row * INC + C_GB + STEP * 1024 + col);
                        const f32x4 gv = {bf2f(gw.x & 0xffffu), bf2f(gw.x >> 16), bf2f(gw.y & 0xffffu), bf2f(gw.y >> 16)};
                        f32x4 v = acc[ai][bj][m][n] * gv;
                        float* pp = P + row * D + col;
                        if (STEP >= 1) v += *(const f32x4*)pp;
                        if (STEP <= 1) *(f32x4*)pp = v;
                        else { u32x2 w; w.x = pk2(v[0], v[1]); w.y = pk2(v[2], v[3]); *(u32x2*)(merged + row * D + col) = w; } } }
    }
};

struct Resid {
    static constexpr bool PERM = false;
    const float* base; float* out; const float* gate;
    __device__ __forceinline__ void operator()(AccRef acc, const Unit& u, int wr, int wc, int fr, int fq) const {
        const int row0 = u.pm * BM + wr * 64 + fr, col0 = u.pn * BM + wc * 32 + 4 * fq;
        const float* gp = gate + (size_t)((u.pm * BM) / SEQ) * (6 * D) + col0;
        f32x4 gv[2][2];
#pragma unroll
        for (int bj = 0; bj < 2; ++bj)
#pragma unroll
            for (int n = 0; n < 2; ++n) gv[bj][n] = *(const f32x4*)(gp + bj * HALF + n * 16);
#pragma unroll
        for (int ai = 0; ai < 2; ++ai)
#pragma unroll
            for (int m = 0; m < 4; ++m) { const size_t off = (size_t)(row0 + ai * HALF + m * 16) * D + col0;
#pragma unroll
                for (int bj = 0; bj < 2; ++bj)
#pragma unroll
                    for (int n = 0; n < 2; ++n) { const f32x4 bs = *(const f32x4*)(base + off + bj * HALF + n * 16);
                        *(f32x4*)(out + off + bj * HALF + n * 16) = bs + gv[bj][n] * acc[ai][bj][m][n]; } }
    }
};

struct SwiGLU {
    static constexpr bool PERM = true;
    bf16_t* O;
    __device__ __forceinline__ void operator()(AccRef acc, const Unit& u, int wr, int wc, int fr, int fq) const {
        const int row0 = u.pm * BM + wr * 64 + fr, col0 = u.pn * HALF + wc * 32 + 8 * fq;
#pragma unroll
        for (int ai = 0; ai < 2; ++ai)
#pragma unroll
            for (int m = 0; m < 4; ++m) { bf16_t* rowp = O + (size_t)(row0 + ai * HALF + m * 16) * DFF + col0;
                f32x4 v0, v1;
#pragma unroll
                for (int j = 0; j < 4; ++j) { v0[j] = silu_f(acc[ai][0][m][0][j]) * acc[ai][1][m][0][j]; v1[j] = silu_f(acc[ai][0][m][1][j]) * acc[ai][1][m][1][j]; }
                u32x4 w; w.x = pk2(v0[0], v0[1]); w.y = pk2(v0[2], v0[3]); w.z = pk2(v1[0], v1[1]); w.w = pk2(v1[2], v1[3]);
                *(u32x4*)rowp = w; }
    }
};

struct MoeDown {
    static constexpr bool PERM = false;
    const int* rowdst; const float* roww; bf16_t* yslot;
    __device__ __forceinline__ void operator()(AccRef acc, const Unit& u, int wr, int wc, int fr, int fq) const {
        const int row0 = u.pm * BM + wr * 64 + fr, col0 = u.pn * BM + wc * 32 + 4 * fq;
#pragma unroll
        for (int ai = 0; ai < 2; ++ai)
#pragma unroll
            for (int m = 0; m < 4; ++m) { const int p = row0 + ai * HALF + m * 16; const int dst = rowdst[p]; const float w = roww[p];
                if (dst >= 0) { bf16_t* rowp = yslot + (size_t)dst * D + col0;
#pragma unroll
                    for (int bj = 0; bj < 2; ++bj)
#pragma unroll
                        for (int n = 0; n < 2; ++n) { const f32x4 v = acc[ai][bj][m][n] * w; u32x2 o; o.x = pk2(v[0], v[1]); o.y = pk2(v[2], v[3]); *(u32x2*)(rowp + bj * HALF + n * 16) = o; } } }
    }
};
}
namespace attn {
constexpr int KSTR = 144;
constexpr int VSTR128 = 320, VSTR64 = 192;
constexpr int LDS_K = 0, LDS_V = 64 * KSTR, LDS_BYTES = LDS_V + 64 * VSTR128;
constexpr float NEGF = -1e30f;
__device__ __forceinline__ int crow(int r, int hi) { return (r & 3) + 8 * (r >> 2) + 4 * hi; }
__device__ __forceinline__ float swapmax(float m) { auto rr = __builtin_amdgcn_permlane32_swap(__float_as_uint(m), __float_as_uint(m), false, false); return fmaxf(__uint_as_float(rr[0]), __uint_as_float(rr[1])); }
__device__ __forceinline__ float swapsum(float m) { auto rr = __builtin_amdgcn_permlane32_swap(__float_as_uint(m), __float_as_uint(m), false, false); return __uint_as_float(rr[0]) + __uint_as_float(rr[1]); }
typedef short v4i16_t __attribute__((ext_vector_type(4)));
__device__ __forceinline__ s16x4 vtr(const LAS char* p) { return __builtin_bit_cast(s16x4, __builtin_amdgcn_ds_read_tr16_b64_v4i16((LAS v4i16_t*)p)); }

__device__ __forceinline__ void qk_tile(f32x16& sA, f32x16& sB, const LAS char* Kt, const bf16x8 (&qf)[4], int r, int h) {
    const LAS char* kb = Kt + r * KSTR + h * 16;
#pragma unroll
    for (int j = 0; j < 16; ++j) { sA[j] = 0.f; sB[j] = 0.f; }
#pragma unroll
    for (int ks = 0; ks < 4; ++ks) {
        const bf16x8 a0 = *(const LAS bf16x8*)(kb + ks * 32);
        const bf16x8 a1 = *(const LAS bf16x8*)(kb + 32 * KSTR + ks * 32);
        sA = __builtin_amdgcn_mfma_f32_32x32x16_bf16(a0, qf[ks], sA, 0, 0, 0);
        sB = __builtin_amdgcn_mfma_f32_32x32x16_bf16(a1, qf[ks], sB, 0, 0, 0);
    }
}
template <int NDB, int VSTR>
__device__ __forceinline__ void pv_tile(f32x16 (&o)[NDB], const LAS char* Vt, const bf16x8 (&pf)[4], int lane) {
    const int h = lane >> 5, q = (lane & 15) >> 2, p = lane & 3, g1 = (lane >> 4) & 1;
    const LAS char* vb = Vt + (4 * h + q) * VSTR + (16 * g1 + 4 * p) * 2;
#pragma unroll
    for (int db = 0; db < NDB; ++db)
#pragma unroll
        for (int kb = 0; kb < 2; ++kb)
#pragma unroll
            for (int s = 0; s < 2; ++s) {
                const int r0 = kb * 32 + 16 * s;
                const s16x4 lo = vtr(vb + r0 * VSTR + db * 64), hi = vtr(vb + (r0 + 8) * VSTR + db * 64);
                const bf16x8 vf = {lo[0], lo[1], lo[2], lo[3], hi[0], hi[1], hi[2], hi[3]};
                o[db] = __builtin_amdgcn_mfma_f32_32x32x16_bf16(pf[kb * 2 + s], vf, o[db], 0, 0, 0);
            }
}
template <int NDB, int VSTR>
__device__ __forceinline__ void softmax_pv(f32x16& sA, f32x16& sB, f32x16 (&o)[NDB], float& mrow, float& lrow, const LAS char* Vt, int lane) {
    const int h = lane >> 5;
    float mx = fmaxf(sA[0], sB[0]);
#pragma unroll
    for (int j = 1; j < 16; ++j) mx = fmaxf(mx, fmaxf(sA[j], sB[j]));
    mx = swapmax(mx);
    const float mnew = fmaxf(mrow, mx), alpha = fexp2(mrow - mnew);
    mrow = mnew;
    float rs = 0.f;
#pragma unroll
    for (int j = 0; j < 16; ++j) { sA[j] = fexp2(sA[j] - mnew); sB[j] = fexp2(sB[j] - mnew); rs += sA[j] + sB[j]; }
    rs = swapsum(rs);
    lrow = lrow * alpha + rs;
    if (__any(alpha != 1.0f)) {
#pragma unroll
        for (int j = 0; j < 16; ++j) { const float a = __shfl(alpha, crow(j, h));
#pragma unroll
            for (int db = 0; db < NDB; ++db) o[db][j] *= a; }
    }
    bf16x8 pf[4];
    { u32x4 w;
      w.x = pk2(sA[0], sA[1]); w.y = pk2(sA[2], sA[3]); w.z = pk2(sA[4], sA[5]); w.w = pk2(sA[6], sA[7]); pf[0] = __builtin_bit_cast(bf16x8, w);
      w.x = pk2(sA[8], sA[9]); w.y = pk2(sA[10], sA[11]); w.z = pk2(sA[12], sA[13]); w.w = pk2(sA[14], sA[15]); pf[1] = __builtin_bit_cast(bf16x8, w);
      w.x = pk2(sB[0], sB[1]); w.y = pk2(sB[2], sB[3]); w.z = pk2(sB[4], sB[5]); w.w = pk2(sB[6], sB[7]); pf[2] = __builtin_bit_cast(bf16x8, w);
      w.x = pk2(sB[8], sB[9]); w.y = pk2(sB[10], sB[11]); w.z = pk2(sB[12], sB[13]); w.w = pk2(sB[14], sB[15]); pf[3] = __builtin_bit_cast(bf16x8, w); }
    pv_tile<NDB, VSTR>(o, Vt, pf, lane);
}

template <int DV> struct TileRegs { u32x4 k; u32x4 v[DV / 64]; };
template <int DV>
__device__ __forceinline__ void tile_load(TileRegs<DV>& t, const bf16_t* Kg, const bf16_t* Vg, int key0, int tid) {
    t.k = *(const u32x4*)(Kg + (size_t)(key0 + (tid >> 3)) * INC + (tid & 7) * 8);
    if (DV == 64) t.v[0] = *(const u32x4*)(Vg + (size_t)(key0 + (tid >> 3)) * INC + (tid & 7) * 8);
    else {
#pragma unroll
        for (int i = 0; i < DV / 64; ++i) t.v[i] = *(const u32x4*)(Vg + (size_t)(key0 + (tid >> 4) + 32 * i) * INC + (tid & 15) * 8);
    }
}
template <int DV, int VSTR>
__device__ __forceinline__ void tile_store(const TileRegs<DV>& t, LAS char* lds, int tid) {
    *(LAS u32x4*)(lds + LDS_K + (tid >> 3) * KSTR + (tid & 7) * 16) = t.k;
    if (DV == 64) *(LAS u32x4*)(lds + LDS_V + (tid >> 3) * VSTR + (tid & 7) * 16) = t.v[0];
    else {
#pragma unroll
        for (int i = 0; i < DV / 64; ++i) *(LAS u32x4*)(lds + LDS_V + ((tid >> 4) + 32 * i) * VSTR + (tid & 15) * 16) = t.v[i];
    }
}

template <int DV, int VSTR>
__device__ __forceinline__ void causal_pass(f32x16 (&o)[DV / 32], float& mrow, float& lrow, const bf16x8 (&qf)[4], const bf16_t* Kg, const bf16_t* Vg,
                                            int ntiles, int qw0, LAS char* lds, int tid) {
    const int lane = tid & 63, r = lane & 31, h = lane >> 5;
    TileRegs<DV> tr;
    tile_load<DV>(tr, Kg, Vg, 0, tid);
    for (int t = 0; t < ntiles; ++t) {
        __syncthreads();
        tile_store<DV, VSTR>(tr, lds, tid);
        __syncthreads();
        if (t + 1 < ntiles) tile_load<DV>(tr, Kg, Vg, (t + 1) * 64, tid);
        const int key0 = t * 64;
        if (key0 <= qw0 + 31) {
            f32x16 sA, sB;
            qk_tile(sA, sB, lds + LDS_K, qf, r, h);
            if (key0 + 63 > qw0) {
                const int qpos = qw0 + r;
#pragma unroll
                for (int j = 0; j < 16; ++j) { const int kp = key0 + crow(j, h); if (kp > qpos) sA[j] = NEGF; if (kp + 32 > qpos) sB[j] = NEGF; }
            }
            softmax_pv<DV / 32, VSTR>(sA, sB, o, mrow, lrow, lds + LDS_V, lane);
        }
    }
}

__device__ __forceinline__ void diff_unit(int b, int hd, int qt, const bf16_t* proj, bf16_t* yabc, const float* subln, float lam, float one_m_laminit, LAS char* lds) {
    int tid_l = threadIdx.x; asm volatile("" : "+v"(tid_l));
    const int tid = tid_l, lane = tid & 63, wid = tid >> 6, r = lane & 31, h = lane >> 5;
    const int qw0 = qt * 256 + wid * 32;
    const size_t rowb = (size_t)b * SEQ;
    const int ntiles = 4 * (qt + 1);
    unsigned o0p[4][8];
#pragma unroll
    for (int j = 0; j < 2; ++j) {
        const bf16_t* qp = proj + (rowb + qw0 + r) * INC + C_DQ + (hd * 2 + j) * 64 + h * 8;
        bf16x8 qf[4];
#pragma unroll
        for (int ks = 0; ks < 4; ++ks) qf[ks] = *(const bf16x8*)(qp + ks * 16);
        f32x16 o[4];
#pragma unroll
        for (int db = 0; db < 4; ++db)
#pragma unroll
            for (int i = 0; i < 16; ++i) o[db][i] = 0.f;
        float mrow = NEGF, lrow = 0.f;
        causal_pass<128, VSTR128>(o, mrow, lrow, qf, proj + rowb * INC + C_DK + (hd * 2 + j) * 64, proj + rowb * INC + C_DV + hd * 128, ntiles, qw0, lds, tid);
        const float il = frcp(lrow);
        if (j == 0) {
#pragma unroll
            for (int i = 0; i < 16; i += 2) { const float a0 = __shfl(il, crow(i, h)), a1 = __shfl(il, crow(i + 1, h));
#pragma unroll
                for (int db = 0; db < 4; ++db) o0p[db][i >> 1] = pk2(o[db][i] * a0, o[db][i + 1] * a1); }
        } else {
#pragma unroll
            for (int i = 0; i < 16; ++i) { const float a = __shfl(il, crow(i, h)) * lam;
                float ss = 0.f; float cv[4];
#pragma unroll
                for (int db = 0; db < 4; ++db) { const unsigned w = o0p[db][i >> 1]; const float x0 = (i & 1) ? bf2f(w >> 16) : bf2f(w & 0xffffu); const float c = x0 - o[db][i] * a; cv[db] = c; ss += c * c; }
                ss += __shfl_xor(ss, 1); ss += __shfl_xor(ss, 2); ss += __shfl_xor(ss, 4); ss += __shfl_xor(ss, 8); ss += __shfl_xor(ss, 16);
                const float rn = rsqrtf(ss * (1.0f / 128.0f) + EPS) * one_m_laminit;
                bf16_t* yp = yabc + (rowb + qw0 + crow(i, h)) * YW + Y_B + hd * 128 + r;
#pragma unroll
                for (int db = 0; db < 4; ++db) yp[db * 32] = (bf16_t)f2bf(cv[db] * rn * subln[db * 32 + r]);
            }
        }
    }
}

__device__ __forceinline__ void moba_unit(int b, int hd, int cur, const bf16_t* proj, bf16_t* yabc, const float* kmean, LAS char* lds) {
    int tid_l = threadIdx.x; asm volatile("" : "+v"(tid_l));
    const int tid = tid_l, lane = tid & 63, wid = tid >> 6, r = lane & 31, h = lane >> 5;
    const int qw0 = cur * 256 + wid * 32;
    const size_t rowb = (size_t)b * SEQ;
    const bf16_t* qp = proj + (rowb + qw0 + r) * INC + C_MQ + hd * 64 + h * 8;
    bf16x8 qf[4];
#pragma unroll
    for (int ks = 0; ks < 4; ++ks) qf[ks] = *(const bf16x8*)(qp + ks * 16);
    unsigned selmask = 0u;
    if (cur > 0) {
        float gate[8];
#pragma unroll
        for (int n = 0; n < 8; ++n) {
            float g = 0.f;
            if (n < cur) {
                const float* km = kmean + ((size_t)((b * 8 + hd) * 8 + n)) * 64 + h * 8;
#pragma unroll
                for (int ks = 0; ks < 4; ++ks)
#pragma unroll
                    for (int j = 0; j < 8; ++j) g += bf2f((unsigned)(unsigned short)qf[ks][j]) * km[ks * 16 + j];
                g = swapsum(g);
            } else g = -3.0e38f;
            gate[n] = g;
        }
        const int nsel = cur < 3 ? cur : 3;
        for (int s = 0; s < nsel; ++s) {
            float best = -3.0e38f; int bi = 0;
#pragma unroll
            for (int n = 0; n < 8; ++n) { const bool tk = (n < cur) && !((selmask >> n) & 1u) && (gate[n] > best); if (tk) { best = gate[n]; bi = n; } }
            selmask |= 1u << bi;
        }
    }
    f32x16 o[2];
#pragma unroll
    for (int db = 0; db < 2; ++db)
#pragma unroll
        for (int i = 0; i < 16; ++i) o[db][i] = 0.f;
    float mrow = NEGF, lrow = 0.f;
    const bf16_t* Kg = proj + rowb * INC + C_MK + hd * 64; const bf16_t* Vg = proj + rowb * INC + C_MV + hd * 64;
    const int ntiles = 4 * (cur + 1);
    TileRegs<64> tr;
    tile_load<64>(tr, Kg, Vg, cur * 256, tid);
    for (int t = 0; t < ntiles; ++t) {
        __syncthreads();
        tile_store<64, VSTR64>(tr, lds, tid);
        __syncthreads();
        const int blk = (t < 4) ? cur : (t >> 2) - 1;
        if (t + 1 < ntiles) { const int t1 = t + 1; const int blk1 = (t1 < 4) ? cur : (t1 >> 2) - 1; tile_load<64>(tr, Kg, Vg, blk1 * 256 + (t1 & 3) * 64, tid); }
        const int key0 = blk * 256 + (t & 3) * 64;
        const bool own = (t < 4);
        const bool lane_on = own ? true : (((selmask >> blk) & 1u) != 0u);
        const bool wave_on = own ? (key0 <= qw0 + 31) : (__any(lane_on) != 0);
        if (wave_on) {
            f32x16 sA, sB;
            qk_tile(sA, sB, lds + LDS_K, qf, r, h);
            if (own) {
                if (key0 + 63 > qw0) {
                    const int qpos = qw0 + r;
#pragma unroll
                    for (int j = 0; j < 16; ++j) { const int kp = key0 + crow(j, h); if (kp > qpos) sA[j] = NEGF; if (kp + 32 > qpos) sB[j] = NEGF; }
                }
            } else if (!lane_on) {
#pragma unroll
                for (int j = 0; j < 16; ++j) { sA[j] = NEGF; sB[j] = NEGF; }
            }
            softmax_pv<2, VSTR64>(sA, sB, o, mrow, lrow, lds + LDS_V, lane);
        }
    }
    const float il = frcp(lrow);
#pragma unroll
    for (int i = 0; i < 16; ++i) { const float a = __shfl(il, crow(i, h));
        bf16_t* yp = yabc + (rowb + qw0 + crow(i, h)) * YW + Y_C + hd * 64 + r;
#pragma unroll
        for (int db = 0; db < 2; ++db) yp[db * 32] = (bf16_t)f2bf(o[db][i] * a); }
}
}
namespace thin {
__device__ __forceinline__ void transpose_item(const float* W, int K, int N, bf16_t* WT, int row_off, int mode, LAS float* scr, int item, int lane) {
    const int nblk = N / 32, kb = item / nblk, nb = item % nblk, k0 = 64 * kb, n0 = 32 * nb;
#pragma unroll 8
    for (int i = 0; i < 32; ++i) { const int kk = 2 * i + (lane >> 5); scr[kk * 33 + (lane & 31)] = W[(size_t)(k0 + kk) * N + n0 + (lane & 31)]; }
    asm volatile("s_waitcnt lgkmcnt(0)" ::: "memory");
    const int c = lane & 7;
#pragma unroll
    for (int j = 0; j < 4; ++j) { const int n = (lane >> 3) + 8 * j; const LAS float* s = scr + (8 * c) * 33 + n;
        u32x4 o; o.x = pk2(s[0 * 33], s[1 * 33]); o.y = pk2(s[2 * 33], s[3 * 33]); o.z = pk2(s[4 * 33], s[5 * 33]); o.w = pk2(s[6 * 33], s[7 * 33]);
        const int nn = n0 + n; const int row = row_off + (mode == 0 ? nn : ((nn >> 7) * 256 + (mode == 2 ? 128 : 0) + (nn & 127)));
        *(u32x4*)(WT + (size_t)row * K + k0 + 8 * c) = o; }
    asm volatile("s_waitcnt lgkmcnt(0)" ::: "memory");
}
__device__ __forceinline__ void transpose_matrix(const float* W, int K, int N, bf16_t* WT, int row_off, int mode, LAS float* scr, int gw, int ngw, int lane) {
    const int nitems = (K / 64) * (N / 32);
    for (int it = gw; it < nitems; it += ngw) transpose_item(W, K, N, WT, row_off, mode, scr, it, lane);
}

__device__ __forceinline__ void mod_body(const float* c, const float* ada_w, const float* ada_b, float* mod, int gtid, int ngt) {
    for (int idx = gtid; idx < 2 * 6 * D; idx += ngt) {
        const int l = idx / (6 * D), j = idx % (6 * D);
        float acc[NB];
#pragma unroll
        for (int b = 0; b < NB; ++b) acc[b] = 0.f;
        const float* w = ada_w + (size_t)l * D * 6 * D + j;
        for (int k = 0; k < D; ++k) { const float wv = w[(size_t)k * 6 * D];
#pragma unroll
            for (int b = 0; b < NB; ++b) acc[b] += c[b * D + k] * wv; }
#pragma unroll
        for (int b = 0; b < NB; ++b) mod[((size_t)l * NB + b) * 6 * D + j] = acc[b] + ada_b[l * 6 * D + j];
    }
}
__device__ __forceinline__ void rope_body(const int* positions, f32x2* cs, int gtid, int ngt) {
    for (int idx = gtid; idx < M * 32; idx += ngt) {
        const int tok = idx >> 5, i = idx & 31;
        const float inv = 1.0f / powf(10000.0f, (float)(2 * i) / 64.0f);
        const float ang = (float)positions[tok] * inv;
        float s, c; sincosf(ang, &s, &c);
        cs[idx] = (f32x2){c, s};
    }
}
__device__ __forceinline__ void norm_row(const float* xrow, const float* g, const float* shift, const float* scale, bf16_t* orow, int lane, f32x4 (&y)[4]) {
    const f32x4* xr = (const f32x4*)xrow + lane;
    f32x4 v[4]; float ss = 0.f;
#pragma unroll
    for (int j = 0; j < 4; ++j) { v[j] = xr[64 * j]; ss += (v[j].x * v[j].x + v[j].y * v[j].y) + (v[j].z * v[j].z + v[j].w * v[j].w); }
    const float rn = rsqrtf(wave_sum(ss) * (1.0f / D) + EPS);
    u32x2* o8 = (u32x2*)orow + lane;
#pragma unroll
    for (int j = 0; j < 4; ++j) { const int col = 4 * lane + 256 * j;
        const f32x4 gg = *(const f32x4*)(g + col), sc = *(const f32x4*)(scale + col), sh = *(const f32x4*)(shift + col);
        y[j] = v[j] * rn * gg * (sc + 1.0f) + sh;
        u32x2 w; w.x = pk2(y[j].x, y[j].y); w.y = pk2(y[j].z, y[j].w); o8[64 * j] = w; }
}
__device__ __forceinline__ void norm_body(const float* x, const float* g, const float* shift, const float* scale, bf16_t* out, int gw, int ngw, int lane) {
    for (int m = gw; m < M; m += ngw) { const int b = m / SEQ; f32x4 y[4]; norm_row(x + (size_t)m * D, g, shift + b * 6 * D, scale + b * 6 * D, out + (size_t)m * D, lane, y); }
}
__device__ __forceinline__ void norm_router_body(const float* x, const float* g, const float* shift, const float* scale, bf16_t* out,
                                                 const float* rw, const float* rb, int* topi, float* topw, int gw, int ngw, int lane) {
    for (int m = gw; m < M; m += ngw) { const int b = m / SEQ; f32x4 y[4];
        norm_row(x + (size_t)m * D, g, shift + b * 6 * D, scale + b * 6 * D, out + (size_t)m * D, lane, y);
        float lg[NE];
#pragma unroll
        for (int e = 0; e < NE; ++e) lg[e] = 0.f;
#pragma unroll
        for (int j = 0; j < 4; ++j)
#pragma unroll
            for (int q = 0; q < 4; ++q) { const int col = 4 * lane + 256 * j + q; const f32x4 w0 = *(const f32x4*)(rw + col * NE), w1 = *(const f32x4*)(rw + col * NE + 4); const float hv = y[j][q];
                lg[0] += hv * w0.x; lg[1] += hv * w0.y; lg[2] += hv * w0.z; lg[3] += hv * w0.w; lg[4] += hv * w1.x; lg[5] += hv * w1.y; lg[6] += hv * w1.z; lg[7] += hv * w1.w; }
#pragma unroll
        for (int e = 0; e < NE; ++e) lg[e] = wave_sum(lg[e]) + rb[e];
        int i0 = 0; float v0 = lg[0];
#pragma unroll
        for (int e = 1; e < NE; ++e) if (lg[e] > v0) { v0 = lg[e]; i0 = e; }
        int i1 = -1; float v1 = -3.0e38f;
#pragma unroll
        for (int e = 0; e < NE; ++e) if (e != i0 && lg[e] > v1) { v1 = lg[e]; i1 = e; }
        const float w1v = 1.0f / (1.0f + expf(v0 - v1)), w0v = 1.0f - w1v;
        if (lane == 0) { topi[2 * m] = i0; topi[2 * m + 1] = i1; topw[2 * m] = w0v; topw[2 * m + 1] = w1v; }
    }
}
__device__ __forceinline__ void qknorm_body(bf16_t* proj, const f32x2* cs, const float* dqn, const float* dkn, const float* mqn, const float* mkn, int gtid, int ngt) {
    for (long idx = gtid; idx < (long)M * 32 * 32; idx += ngt) {
        const int i = (int)(idx & 31); const long pair = idx >> 5; const int hh = (int)(pair & 31); const int tok = (int)(pair >> 5);
        const int grp = hh >> 3, hi = hh & 7;
        const int cb = (grp == 0 ? C_DQ : grp == 1 ? C_DK : grp == 2 ? C_MQ : C_MK) + hi * 64;
        const float* gn = grp == 0 ? dqn : grp == 1 ? dkn : grp == 2 ? mqn : mkn;
        bf16_t* p = proj + (size_t)tok * INC + cb;
        const float x1 = bf2f(p[i]), x2 = bf2f(p[i + 32]);
        float ss = x1 * x1 + x2 * x2;
        ss += __shfl_xor(ss, 1); ss += __shfl_xor(ss, 2); ss += __shfl_xor(ss, 4); ss += __shfl_xor(ss, 8); ss += __shfl_xor(ss, 16);
        const float rn = rsqrtf(ss * (1.0f / 64.0f) + EPS);
        const float y1 = x1 * rn * gn[i], y2 = x2 * rn * gn[i + 32];
        const f32x2 c = cs[(size_t)tok * 32 + i];
        float o1 = y1 * c.x - y2 * c.y, o2 = y2 * c.x + y1 * c.y;
        if ((grp & 1) == 0) { o1 *= QSCALE; o2 *= QSCALE; }
        p[i] = (bf16_t)f2bf(o1); p[i + 32] = (bf16_t)f2bf(o2);
    }
}
__device__ __forceinline__ void kmean_body(const bf16_t* proj, float* kmean, int gw, int ngw, int lane) {
    for (int it = gw; it < NB * 8 * 8; it += ngw) { const int blk = it & 7, hd = (it >> 3) & 7, b = it >> 6;
        const bf16_t* p = proj + ((size_t)b * SEQ + blk * 256) * INC + C_MK + hd * 64 + lane;
        float s = 0.f;
        for (int t = 0; t < 256; ++t) s += bf2f(p[(size_t)t * INC]);
        kmean[(size_t)it * 64 + lane] = s * (1.0f / 256.0f); }
}
__device__ __forceinline__ void moe_combine_body(const float* x1, const bf16_t* yslot, const float* gate, float* out, int gtid, int ngt) {
    for (long idx = gtid; idx < (long)M * D / 4; idx += ngt) { const int m = (int)(idx >> 8), c4 = (int)(idx & 255) * 4; const int b = m / SEQ;
        const f32x4 xv = *(const f32x4*)(x1 + (size_t)m * D + c4), gv = *(const f32x4*)(gate + b * 6 * D + c4);
        const u32x2 a = *(const u32x2*)(yslot + (size_t)m * D + c4), c = *(const u32x2*)(yslot + ((size_t)M + m) * D + c4);
        f32x4 y = {bf2f(a.x & 0xffffu) + bf2f(c.x & 0xffffu), bf2f(a.x >> 16) + bf2f(c.x >> 16), bf2f(a.y & 0xffffu) + bf2f(c.y & 0xffffu), bf2f(a.y >> 16) + bf2f(c.y >> 16)};
        *(f32x4*)(out + (size_t)m * D + c4) = xv + gv * y; }
}
}
namespace qk {
constexpr int LDS_BYTES = 8 * 64 * 8 * 4;
__device__ __forceinline__ void unit(int b, int blk, int grp, bf16_t* proj, const f32x2* cs, const float* gn, float* kmean, LAS char* lds) {
    int tid_l = threadIdx.x; asm volatile("" : "+v"(tid_l));
    const int tid = tid_l, lane = tid & 63, wid = tid >> 6;
    const int hd = lane >> 3, half = (lane >> 2) & 1, j = lane & 3;
    const int cb = (grp == 0 ? C_DQ : grp == 1 ? C_DK : grp == 2 ? C_MQ : C_MK) + hd * 64 + half * 32 + 8 * j;
    float gnv[8];
#pragma unroll
    for (int e = 0; e < 8; ++e) gnv[e] = gn[half * 32 + 8 * j + e];
    const float qs = ((grp & 1) == 0) ? QSCALE : 1.0f;
    const float sgn = half ? 1.0f : -1.0f;
    float ksum[8];
#pragma unroll
    for (int e = 0; e < 8; ++e) ksum[e] = 0.f;
    for (int i = 0; i < 32; ++i) {
        const size_t tok = (size_t)b * SEQ + blk * 256 + wid + 8 * i;
        bf16_t* p = proj + tok * INC + cb;
        const u32x4 raw = *(const u32x4*)p;
        float x[8] = {bf2f(raw.x & 0xffffu), bf2f(raw.x >> 16), bf2f(raw.y & 0xffffu), bf2f(raw.y >> 16), bf2f(raw.z & 0xffffu), bf2f(raw.z >> 16), bf2f(raw.w & 0xffffu), bf2f(raw.w >> 16)};
        float ss = 0.f;
#pragma unroll
        for (int e = 0; e < 8; ++e) ss += x[e] * x[e];
        ss += __shfl_xor(ss, 1); ss += __shfl_xor(ss, 2); ss += __shfl_xor(ss, 4);
        const float rn = rsqrtf(ss * (1.0f / 64.0f) + EPS);
        const f32x4* cp = (const f32x4*)(cs + tok * 32 + 8 * j);
        const f32x4 c0 = cp[0], c1 = cp[1], c2 = cp[2], c3 = cp[3];
        const float cc[8] = {c0.x, c0.z, c1.x, c1.z, c2.x, c2.z, c3.x, c3.z}, sn[8] = {c0.y, c0.w, c1.y, c1.w, c2.y, c2.w, c3.y, c3.w};
        float o[8];
#pragma unroll
        for (int e = 0; e < 8; ++e) { const float y = x[e] * rn * gnv[e]; const float py = __shfl_xor(y, 4); o[e] = (y * cc[e] + sgn * py * sn[e]) * qs; }
        u32x4 w; w.x = pk2(o[0], o[1]); w.y = pk2(o[2], o[3]); w.z = pk2(o[4], o[5]); w.w = pk2(o[6], o[7]);
        *(u32x4*)p = w;
        if (grp == 3) { ksum[0] += bf2f(w.x & 0xffffu); ksum[1] += bf2f(w.x >> 16); ksum[2] += bf2f(w.y & 0xffffu); ksum[3] += bf2f(w.y >> 16);
                        ksum[4] += bf2f(w.z & 0xffffu); ksum[5] += bf2f(w.z >> 16); ksum[6] += bf2f(w.w & 0xffffu); ksum[7] += bf2f(w.w >> 16); }
    }
    if (grp == 3) {
        LAS float* red = (LAS float*)lds;
        __syncthreads();
#pragma unroll
        for (int e = 0; e < 8; ++e) red[(wid * 64 + lane) * 8 + e] = ksum[e];
        __syncthreads();
        { const int ln = tid >> 3, e = tid & 7; float s = 0.f;
#pragma unroll
          for (int w = 0; w < 8; ++w) s += red[(w * 64 + ln) * 8 + e];
          const int h2 = ln >> 3, hf = (ln >> 2) & 1, jj = ln & 3;
          kmean[((size_t)((b * 8 + h2) * 8 + blk)) * 64 + hf * 32 + 8 * jj + e] = s * (1.0f / 256.0f); }
        __syncthreads();
    }
}
}
namespace rglru {
constexpr int TT = 32;
constexpr int LDS_WA = 0, LDS_WX = 16384, LDS_XC = 32768, LDS_A = LDS_XC + TT * 65 * 4, LDS_U = LDS_A + TT * 64 * 4, LDS_BYTES = LDS_U + TT * 64 * 4;
__device__ __forceinline__ void unit(int b, int n, const bf16_t* proj, bf16_t* yabc, const float* conv_w, const float* conv_b, const float* wa, const float* ba,
                                     const float* wx, const float* bx, const float* lam, LAS char* lds) {
    int tid_l = threadIdx.x; asm volatile("" : "+v"(tid_l));
    const int tid = tid_l;
    LAS float* Wa = (LAS float*)(lds + LDS_WA); LAS float* Wx = (LAS float*)(lds + LDS_WX); LAS float* XC = (LAS float*)(lds + LDS_XC);
    LAS float* AV = (LAS float*)(lds + LDS_A); LAS float* UV = (LAS float*)(lds + LDS_U);
    __syncthreads();
    for (int i = tid; i < 4096; i += 512) { Wa[i] = wa[(size_t)n * 4096 + i]; Wx[i] = wx[(size_t)n * 4096 + i]; }
    const int cc = tid & 63, ct = tid >> 6;
    const int ch = n * 64 + cc;
    const float cw0 = conv_w[0 * D + ch], cw1 = conv_w[1 * D + ch], cw2 = conv_w[2 * D + ch], cw3 = conv_w[3 * D + ch], cb = conv_b[ch];
    const int gt = tid >> 4, eq = tid & 15;
    float gba[4], gbx[4], gsp[4];
#pragma unroll
    for (int j = 0; j < 4; ++j) { const int e = n * 64 + eq * 4 + j; gba[j] = ba[e]; gbx[j] = bx[e]; const float x = -lam[e]; gsp[j] = fmaxf(x, 0.f) + log1pf(expf(-fabsf(x))); }
    float hstate = 0.f;
    const size_t rowb = (size_t)b * SEQ;
    __syncthreads();
    for (int t0 = 0; t0 < SEQ; t0 += TT) {
#pragma unroll
        for (int i = 0; i < 4; ++i) { const int tt = ct + 8 * i, t = t0 + tt;
            const bf16_t* p = proj + (rowb + t) * INC + C_XR + ch;
            float acc = cb + cw3 * bf2f(p[0]);
            if (t >= 1) acc += cw2 * bf2f(*(p - INC));
            if (t >= 2) acc += cw1 * bf2f(*(p - 2 * INC));
            if (t >= 3) acc += cw0 * bf2f(*(p - 3 * INC));
            XC[tt * 65 + cc] = acc; }
        __syncthreads();
        { f32x4 ar = {0.f, 0.f, 0.f, 0.f}, ai = {0.f, 0.f, 0.f, 0.f};
#pragma unroll 8
          for (int d = 0; d < 64; ++d) { const float xv = XC[gt * 65 + d]; ar += *(const LAS f32x4*)(Wa + d * 64 + eq * 4) * xv; ai += *(const LAS f32x4*)(Wx + d * 64 + eq * 4) * xv; }
#pragma unroll
          for (int j = 0; j < 4; ++j) { const int e = eq * 4 + j;
              const float rg = 1.0f / (1.0f + expf(-(ar[j] + gba[j]))), ig = 1.0f / (1.0f + expf(-(ai[j] + gbx[j])));
              const float log_a = -8.0f * rg * gsp[j]; const float a = expf(log_a); const float mult = sqrtf(-expm1f(2.0f * log_a));
              AV[gt * 64 + e] = a; UV[gt * 64 + e] = mult * ig * XC[gt * 65 + e]; } }
        __syncthreads();
        if (tid < 64) {
            for (int tt = 0; tt < TT; ++tt) { hstate = AV[tt * 64 + tid] * hstate + UV[tt * 64 + tid];
                const size_t row = rowb + t0 + tt;
                const float g = bf2f(proj[row * INC + C_GR + n * 64 + tid]);
                yabc[row * YW + Y_A + n * 64 + tid] = (bf16_t)f2bf(g * hstate); }
        }
        __syncthreads();
    }
}
}

namespace moe {
__device__ __forceinline__ void assign(const int* topi, const float* topw, int* rowtok, int* rowdst, float* roww, int* tile_e, int* ntiles, LAS int* sm) {
    const int tid = threadIdx.x, nthr = blockDim.x, per = M / nthr, t0 = tid * per;
    int cnt[NE];
#pragma unroll
    for (int e = 0; e < NE; ++e) cnt[e] = 0;
    for (int t = t0; t < t0 + per; ++t) { const int e0 = topi[2 * t], e1 = topi[2 * t + 1];
#pragma unroll
        for (int e = 0; e < NE; ++e) cnt[e] += (e0 == e) + (e1 == e); }
#pragma unroll
    for (int e = 0; e < NE; ++e) sm[e * nthr + tid] = cnt[e];
    __syncthreads();
    if (tid < NE) { int run = 0; for (int i = 0; i < nthr; ++i) { const int v = sm[tid * nthr + i]; sm[tid * nthr + i] = run; run += v; } sm[NE * nthr + tid] = run; }
    __syncthreads();
    if (tid == 0) { int p = 0, nt = 0;
        for (int e = 0; e < NE; ++e) { const int tot = sm[NE * nthr + e]; sm[NE * nthr + 8 + e] = p; const int nte = (tot + 255) >> 8; for (int i = 0; i < nte; ++i) tile_e[nt++] = e; p += nte * 256; }
        *ntiles = nt; }
    __syncthreads();
    for (int e = 0; e < NE; ++e) { const int tot = sm[NE * nthr + e], base = sm[NE * nthr + 8 + e], padded = ((tot + 255) >> 8) << 8;
        for (int i = tot + tid; i < padded; i += nthr) { rowtok[base + i] = 0; rowdst[base + i] = -1; roww[base + i] = 0.f; } }
    int pos[NE];
#pragma unroll
    for (int e = 0; e < NE; ++e) pos[e] = sm[NE * nthr + 8 + e] + sm[e * nthr + tid];
    for (int t = t0; t < t0 + per; ++t) {
#pragma unroll
        for (int k = 0; k < 2; ++k) { const int ek = topi[2 * t + k]; int p = 0;
#pragma unroll
            for (int e = 0; e < NE; ++e) { if (ek == e) { p = pos[e]; pos[e] = p + 1; } }
            rowtok[p] = t; rowdst[p] = k * M + t; roww[p] = topw[2 * t + k]; } }
}
struct Order {
    const int* tile_e; const int* ntiles_p; int nN, G, c, ntiles;
    __device__ __forceinline__ void dev_init(int G_, int c_) { G = G_; c = c_; ntiles = *ntiles_p; }
    __device__ __forceinline__ bool next(int i, pg8::Unit& u) const { const int L = i * G + c; if (L >= ntiles * nN) return false; u.pm = L / nN; u.pn = L % nN; u.e = tile_e[u.pm]; u.aux = 0; return true; }
};
struct ProbUp {
    static constexpr bool GATHER = true;
    const bf16_t* A; const bf16_t* Bt; const int* rowtok; int K, lda, ldb, pad;
    __device__ __forceinline__ const char* a_base(const pg8::Unit&) const { return (const char*)A; }
    __device__ __forceinline__ const char* b_base(const pg8::Unit& u) const { return (const char*)Bt + ((size_t)u.e * DFF2 + (size_t)u.pn * 256) * ldb * 2; }
    __device__ __forceinline__ unsigned a_off(const pg8::Unit& u, int row, int col) const { return (unsigned)(rowtok[u.pm * 256 + row] * lda + col) * 2u; }
};
struct ProbDown {
    static constexpr bool GATHER = false;
    const bf16_t* A; const bf16_t* Bt; int K, lda, ldb, pad;
    __device__ __forceinline__ const char* a_base(const pg8::Unit& u) const { return (const char*)A + (size_t)u.pm * 256 * lda * 2; }
    __device__ __forceinline__ const char* b_base(const pg8::Unit& u) const { return (const char*)Bt + ((size_t)u.e * D + (size_t)u.pn * 256) * ldb * 2; }
    __device__ __forceinline__ unsigned a_off(const pg8::Unit&, int row, int col) const { return (unsigned)(row * lda + col) * 2u; }
};
}
constexpr size_t MiB = 1u << 20;
constexpr size_t WS_CTL = 0, CTL_ZERO_BYTES = 64 * 1024, WS_ROWTOK = 256 * 1024, WS_ROWDST = 400 * 1024, WS_ROWW = 544 * 1024, WS_TILEE = 700 * 1024, WS_NTILES = 702 * 1024;
constexpr size_t WS_MOD = 1 * MiB, WS_CS = 1 * MiB + 512 * 1024, WS_KMEAN = 5 * MiB + 512 * 1024, WS_TOPI = 5 * MiB + 640 * 1024, WS_TOPW = 5 * MiB + 768 * 1024;
constexpr size_t WS_L1W = 6 * MiB, WS_H = 28 * MiB, WS_YABC = 60 * MiB, WS_PROJ = 124 * MiB, WS_XA = 380 * MiB, WS_END = 444 * MiB;
constexpr size_t WS_MOEW13 = 6 * MiB, WS_MOEW2 = 94 * MiB, WS_HMID_MOE = 138 * MiB, WS_YSLOT = 325 * MiB, WS_H2L1 = 412 * MiB;
constexpr size_t LW_IN = 0, LW_BRA = 16 * MiB, LW_BRB = 18 * MiB, LW_BRC = 19 * MiB, LW_OUT = 20 * MiB, LW_W13 = 22 * MiB, LW_W2 = 33 * MiB;
constexpr int CW_TMO = 0, CW_QUEUE = 64  , CW_BAR = 4096;
constexpr int LDS_MISC = 131072 + 8192, LDS_TOTAL = 147456;


#define XB_TMO      128
#define XB_XCNT(j)  (256  + 64 * (j))
#define XB_XSUB(j)  (1280 + 64 * (j))
#define XB_XGEN(j)  (2304 + 64 * (j))
#define XB_TOP      3328
#define XB_TOPGEN   3392
#define XCD_BAR_WORDS 3456
#define XB_SPIN_CAP (1u << 18)

__device__ __forceinline__ unsigned xb_ld(unsigned* p)              { return __hip_atomic_load(p, __ATOMIC_RELAXED, __HIP_MEMORY_SCOPE_AGENT); }
__device__ __forceinline__ unsigned xb_add(unsigned* p, unsigned v) { return __hip_atomic_fetch_add(p, v, __ATOMIC_RELAXED, __HIP_MEMORY_SCOPE_AGENT); }
__device__ __forceinline__ unsigned xb_xcc_id() { return (unsigned)__builtin_amdgcn_s_getreg((3 << 11) | 20) & 0xFu; }
#define XB_SPIN(cond, bar) do { unsigned _sp = 0; while (cond) { __builtin_amdgcn_s_sleep(1); \
    if ((++_sp & 255u) == 0u) { if (xb_ld(&(bar)[XB_TMO])) break; if (_sp > XB_SPIN_CAP) { atomicAdd(&(bar)[XB_TMO], 1u); break; } } } } while (0)

struct XcdBarrier {
    unsigned* bar; unsigned x;
    volatile LAS unsigned* st;
};

__device__ __forceinline__ XcdBarrier xcd_barrier_post(unsigned* bar, volatile LAS unsigned* st) {
    XcdBarrier b; b.bar = bar; b.x = xb_xcc_id(); b.st = st;
    if (threadIdx.x == 0) (void)xb_add(&bar[XB_XCNT(b.x)], 1u);
    return b;
}
__device__ __forceinline__ void xcd_barrier_complete(unsigned* bar, unsigned x, unsigned& nloc, unsigned& nx) {
    const unsigned G = gridDim.x * gridDim.y * gridDim.z;
    unsigned sum, cnt, mine, sp = 0u;
    for (;;) {
        sum = 0u; cnt = 0u; mine = 0u;
#pragma unroll
        for (unsigned j = 0; j < 16; ++j) { const unsigned c = xb_ld(&bar[XB_XCNT(j)]); sum += c; cnt += (c > 0u) ? 1u : 0u; mine = (j == x) ? c : mine; }
        if (sum == G) break;
        __builtin_amdgcn_s_sleep(1);
        if ((++sp & 255u) == 0u) { if (xb_ld(&bar[XB_TMO])) break; if (sp > XB_SPIN_CAP) { atomicAdd(&bar[XB_TMO], 1u); break; } }
    }
    nloc = mine > 0u ? mine : 1u; nx = cnt > 0u ? cnt : 1u;
}

__device__ __forceinline__ void xcd_barrier(const XcdBarrier& b) {
    asm volatile("s_waitcnt vmcnt(0)" ::: "memory");
    __syncthreads();
    if (threadIdx.x == 0) {
        unsigned* bar = b.bar;
        __builtin_amdgcn_s_waitcnt(0);
        unsigned nloc = b.st[0], nx = b.st[1];
        if (nloc == 0u) { xcd_barrier_complete(bar, b.x, nloc, nx); b.st[0] = nloc; b.st[1] = nx; }
        const unsigned old = xb_add(&bar[XB_XSUB(b.x)], 1u);
        const unsigned gen = old / nloc;
        if (old + 1u == (gen + 1u) * nloc) {
            __builtin_amdgcn_fence(__ATOMIC_RELEASE, "agent");
            asm volatile("s_waitcnt vmcnt(0)" ::: "memory");
            const unsigned og = xb_add(&bar[XB_TOP], 1u);
            const unsigned tg = og / nx;
            if (og + 1u == (tg + 1u) * nx) xb_add(&bar[XB_TOPGEN], 1u);
            else XB_SPIN(xb_ld(&bar[XB_TOPGEN]) == tg, bar);
            __builtin_amdgcn_fence(__ATOMIC_ACQUIRE, "agent");
            xb_add(&bar[XB_XGEN(b.x)], 1u);
            asm volatile("s_waitcnt vmcnt(0)" ::: "memory");
        } else {
            XB_SPIN(xb_ld(&bar[XB_XGEN(b.x)]) == gen, bar);
            __builtin_amdgcn_fence(__ATOMIC_ACQUIRE, "agent");
            asm volatile("s_waitcnt vmcnt(0)" ::: "memory");
        }
    }
    __syncthreads();
}


#ifndef PHMASK
#define PHMASK 0xFFFFF
#endif
#define PH(k) if constexpr ((PHMASK >> (k)) & 1)
__device__ __forceinline__ const float* ldptr(const LAS unsigned long long* PT, int i) {
    const unsigned long long v = PT[i];
    const unsigned lo = __builtin_amdgcn_readfirstlane((unsigned)v), hi = __builtin_amdgcn_readfirstlane((unsigned)(v >> 32));
    return (const float*)(const __attribute__((address_space(1))) float*)(((unsigned long long)hi << 32) | lo);
}
struct Args { const float* in[37]; float* out; unsigned char* ws; };

__device__ __forceinline__ float diff_lambda(const float* lq1, const float* lk1, const float* lq2, const float* lk2, float lam_init) {
    float s1 = 0.f, s2 = 0.f; for (int i = 0; i < 64; ++i) { s1 += lq1[i] * lk1[i]; s2 += lq2[i] * lk2[i]; } return expf(s1) - expf(s2) + lam_init; }

constexpr int NQ_RG = 128, NQ_TOTAL = 128 + 256 + 512;
__global__ void __launch_bounds__(512, 2) mega_fwd(Args a) {
    extern __shared__ __attribute__((aligned(16))) unsigned char lds_raw[];
    LAS unsigned char* lds = (LAS unsigned char*)lds_raw;
    volatile LAS unsigned* MISC = (volatile LAS unsigned*)(lds + LDS_MISC);
    const int tid0 = threadIdx.x, lane0 = tid0 & 63, wid0 = __builtin_amdgcn_readfirstlane(tid0 >> 6);
    const int G = gridDim.x, bid = blockIdx.x;
    if (tid0 < 64) MISC[tid0] = 0u;
    LAS unsigned long long* PT = (LAS unsigned long long*)(lds + LDS_MISC + 256);
    if (tid0 == 0) {
#pragma unroll
        for (int i = 0; i < 37; ++i) PT[i] = (unsigned long long)a.in[i];
    }
    __syncthreads();
    XcdBarrier bar = xcd_barrier_post((unsigned*)(a.ws + WS_CTL) + CW_BAR, MISC + 8);
#define F(i) ldptr(PT, (i))
#define PHASE_VARS(lv) \
    unsigned long long ws_u = (unsigned long long)a.ws, out_u = (unsigned long long)a.out; const int l = (lv); int lane = lane0; int tid = tid0; int wid = wid0; \
    asm volatile("" : "+s"(ws_u), "+s"(out_u), "+v"(lane), "+v"(tid), "+s"(wid)); \
    unsigned char* ws = (unsigned char*)(__attribute__((address_space(1))) unsigned char*)ws_u; float* outp = (float*)(__attribute__((address_space(1))) float*)out_u; \
    const int gw = bid * 8 + wid, ngw = G * 8, gtid = bid * 512 + tid, ngt = G * 512; (void)gw; (void)ngw; (void)gtid; (void)ngt; (void)lane; (void)l; \
    char* outb = (char*)outp; (void)outb; \
    float* mod = (float*)(ws + WS_MOD); f32x2* cs = (f32x2*)(ws + WS_CS); float* kmean = (float*)(ws + WS_KMEAN); (void)mod; (void)cs; (void)kmean; \
    bf16_t* H = (bf16_t*)(ws + WS_H); bf16_t* YABC = (bf16_t*)(ws + WS_YABC); bf16_t* PROJ = (bf16_t*)(ws + WS_PROJ); float* XA = (float*)(ws + WS_XA); (void)H; (void)YABC; (void)PROJ; (void)XA; \
    const float* xin = (l == 0) ? F(0) : (const float*)XA; float* x1 = (l == 0) ? XA : outp; const char* lwb = (l == 0) ? (const char*)outb : (const char*)ws + WS_L1W; \
    const float* modl = mod + (size_t)l * NB * 6 * D; (void)xin; (void)x1; (void)lwb; (void)modl;

    PH(0) { PHASE_VARS(0)
        LAS float* scr = (LAS float*)(lds + wid * 8448);
#pragma unroll 1
        for (int ll = 0; ll < 2; ++ll) {
            char* lw2 = ll == 0 ? outb : (char*)ws + WS_L1W;
            thin::transpose_matrix(F(7) + (size_t)ll * D * INC, D, INC, (bf16_t*)(lw2 + LW_IN), 0, 0, scr, gw, ngw, lane);
            thin::transpose_matrix(F(25) + (size_t)ll * D * D, D, D, (bf16_t*)(lw2 + LW_BRA), 0, 0, scr, gw, ngw, lane);
            thin::transpose_matrix(F(26) + (size_t)ll * 512 * D, 512, D, (bf16_t*)(lw2 + LW_BRB), 0, 0, scr, gw, ngw, lane);
            thin::transpose_matrix(F(27) + (size_t)ll * 512 * D, 512, D, (bf16_t*)(lw2 + LW_BRC), 0, 0, scr, gw, ngw, lane);
            thin::transpose_matrix(F(28) + (size_t)ll * D * D, D, D, (bf16_t*)(lw2 + LW_OUT), 0, 0, scr, gw, ngw, lane);
        }
        thin::transpose_matrix(F(29), D, DFF, (bf16_t*)(outb + LW_W13), 0, 1, scr, gw, ngw, lane);
        thin::transpose_matrix(F(30), D, DFF, (bf16_t*)(outb + LW_W13), 0, 2, scr, gw, ngw, lane);
        thin::transpose_matrix(F(31), DFF, D, (bf16_t*)(outb + LW_W2), 0, 0, scr, gw, ngw, lane);
        thin::mod_body(F(1), F(3), F(4), mod, gtid, ngt);
        thin::rope_body((const int*)F(2), cs, gtid, ngt);
    }
    xcd_barrier(bar);

    {
        PH(1) { PHASE_VARS(0) thin::norm_body(xin, F(5) + l * D, modl + 0 * D, modl + 1 * D, H, gw, ngw, lane); }
        xcd_barrier(bar);
        PH(2) { PHASE_VARS(0) pg8::DenseProb g{H, (const bf16_t*)(lwb + LW_IN), D, D, D, 0}; pg8::StaticOrder S; S.init(M, INC, G, bid);
          pg8::gemm_phase<pg8::DenseProb, epi::Proj, pg8::StaticOrder, true>(lds, g, S, epi::Proj{PROJ, F(8) + l * 3 * D}); }
        xcd_barrier(bar);
        PH(3) { PHASE_VARS(0) for (int u = bid; u < 256; u += G) { const int grp = u & 3;
            qk::unit(u >> 5, (u >> 2) & 7, grp, PROJ, cs, (grp == 0 ? F(16) : grp == 1 ? F(17) : grp == 2 ? F(23) : F(24)) + l * 64, kmean, (LAS char*)lds); } }
        xcd_barrier(bar);
        {
#define POP_Q() do { __syncthreads(); if (tid == 0) MISC[16] = __hip_atomic_fetch_add((unsigned*)(ws + WS_CTL) + CW_QUEUE + 64 * l, 1u, __ATOMIC_RELAXED, __HIP_MEMORY_SCOPE_AGENT); __syncthreads(); q = (int)MISC[16]; } while (0)
            int q;
            { PHASE_VARS(0) POP_Q(); }
            PH(4) { PHASE_VARS(0)
#pragma unroll 1
              while (q < NQ_RG) {
                rglru::unit(q >> 4, q & 15, PROJ, YABC, F(9) + l * 4 * D, F(10) + l * D, F(11) + (size_t)l * 16 * 4096, F(12) + l * D, F(13) + (size_t)l * 16 * 4096, F(14) + l * D, F(15) + l * D, (LAS char*)lds);
                POP_Q(); } }
            PH(5) { PHASE_VARS(0)
              const float lam_init = 0.8f - 0.6f * expf(-0.3f * (float)l);
              const float lam = diff_lambda(F(18) + l * 64, F(19) + l * 64, F(20) + l * 64, F(21) + l * 64, lam_init);
#pragma unroll 1
              while (q < NQ_RG + 256) { const int i = q - NQ_RG;
                attn::diff_unit((i & 31) >> 2, i & 3, 7 - (i >> 5), PROJ, YABC, F(22) + l * 128, lam, 1.0f - lam_init, (LAS char*)lds);
                POP_Q(); } }
            PH(6) { PHASE_VARS(0)
#pragma unroll 1
              while (q < NQ_TOTAL) { const int i = q - NQ_RG - 256;
                attn::moba_unit((i & 63) >> 3, i & 7, 7 - (i >> 6), PROJ, YABC, kmean, (LAS char*)lds);
                POP_Q(); } }
#undef POP_Q
        }
        xcd_barrier(bar);
        PH(7) { { PHASE_VARS(0) pg8::StaticOrder S; S.init(M, D, G, bid); pg8::DenseProb g{YABC + Y_A, (const bf16_t*)(lwb + LW_BRA), D, YW, D, 0}; pg8::gemm_phase<pg8::DenseProb, epi::Branch<0>, pg8::StaticOrder, true>(lds, g, S, epi::Branch<0>{PROJ, x1, H}); }
                { PHASE_VARS(0) pg8::StaticOrder S; S.init(M, D, G, bid); pg8::DenseProb g{YABC + Y_B, (const bf16_t*)(lwb + LW_BRB), 512, YW, 512, 0}; pg8::gemm_phase<pg8::DenseProb, epi::Branch<1>, pg8::StaticOrder, true>(lds, g, S, epi::Branch<1>{PROJ, x1, H}); }
                { PHASE_VARS(0) pg8::StaticOrder S; S.init(M, D, G, bid); pg8::DenseProb g{YABC + Y_C, (const bf16_t*)(lwb + LW_BRC), 512, YW, 512, 0}; pg8::gemm_phase<pg8::DenseProb, epi::Branch<2>, pg8::StaticOrder, true>(lds, g, S, epi::Branch<2>{PROJ, x1, H}); } }
        xcd_barrier(bar);
        PH(8) { PHASE_VARS(0) pg8::DenseProb g{H, (const bf16_t*)(lwb + LW_OUT), D, D, D, 0}; pg8::StaticOrder S; S.init(M, D, G, bid);
          pg8::gemm_phase<pg8::DenseProb, epi::Resid, pg8::StaticOrder, true>(lds, g, S, epi::Resid{xin, x1, modl + 2 * D}); }
        xcd_barrier(bar);
        if (0 == 0) {
            PH(9) { PHASE_VARS(0) thin::norm_body(x1, F(6) + l * D, modl + 3 * D, modl + 4 * D, H, gw, ngw, lane); }
            xcd_barrier(bar);
            PH(10) { PHASE_VARS(0) pg8::DenseProb g{H, (const bf16_t*)(lwb + LW_W13), D, D, D, 0}; pg8::StaticOrder S; S.init(M, DFF2, G, bid);
              pg8::gemm_phase<pg8::DenseProb, epi::SwiGLU, pg8::StaticOrder, true>(lds, g, S, epi::SwiGLU{PROJ}); }
            xcd_barrier(bar);
            PH(11) { PHASE_VARS(0) pg8::DenseProb g{PROJ, (const bf16_t*)(lwb + LW_W2), DFF, DFF, DFF, 0}; pg8::StaticOrder S; S.init(M, D, G, bid);
              pg8::gemm_phase<pg8::DenseProb, epi::Resid, pg8::StaticOrder, true>(lds, g, S, epi::Resid{x1, x1, modl + 5 * D}); }
            xcd_barrier(bar);
        } else {
#define MOE_VARS \
            bf16_t* W13 = (bf16_t*)(ws + WS_MOEW13); bf16_t* W2 = (bf16_t*)(ws + WS_MOEW2); bf16_t* h2 = (bf16_t*)(ws + WS_H2L1); bf16_t* hmid = (bf16_t*)(ws + WS_HMID_MOE); bf16_t* yslot = (bf16_t*)(ws + WS_YSLOT); \
            int* topi = (int*)(ws + WS_TOPI); float* topw = (float*)(ws + WS_TOPW); int* rowtok = (int*)(ws + WS_ROWTOK); int* rowdst = (int*)(ws + WS_ROWDST); float* roww = (float*)(ws + WS_ROWW); int* tile_e = (int*)(ws + WS_TILEE); int* ntiles = (int*)(ws + WS_NTILES); \
            (void)W13; (void)W2; (void)h2; (void)hmid; (void)yslot; (void)topi; (void)topw; (void)rowtok; (void)rowdst; (void)roww; (void)tile_e; (void)ntiles;
            PH(12) { PHASE_VARS(0) MOE_VARS thin::norm_router_body(x1, F(6) + l * D, modl + 3 * D, modl + 4 * D, h2, F(32), F(33), topi, topw, gw, ngw, lane); }
            PH(13) { PHASE_VARS(0) MOE_VARS LAS float* scr = (LAS float*)(lds + wid * 8448);
#pragma unroll 1
              for (int e = 0; e < NE; ++e) {
                thin::transpose_matrix(F(34) + (size_t)e * D * DFF, D, DFF, W13, e * DFF2, 1, scr, gw, ngw, lane);
                thin::transpose_matrix(F(35) + (size_t)e * D * DFF, D, DFF, W13, e * DFF2, 2, scr, gw, ngw, lane);
                thin::transpose_matrix(F(36) + (size_t)e * DFF * D, DFF, D, W2, e * D, 0, scr, gw, ngw, lane); } }
            xcd_barrier(bar);
            PH(14) { PHASE_VARS(0) MOE_VARS if (bid == 0) moe::assign(topi, topw, rowtok, rowdst, roww, tile_e, ntiles, (LAS int*)lds); }
            xcd_barrier(bar);
            PH(15) { PHASE_VARS(0) MOE_VARS moe::Order S{tile_e, ntiles, DFF2 / 256, 0, 0, 0}; S.dev_init(G, bid);
              pg8::gemm_phase<moe::ProbUp, epi::SwiGLU, moe::Order, true>(lds, moe::ProbUp{h2, W13, rowtok, D, D, D, 0}, S, epi::SwiGLU{hmid}); }
            xcd_barrier(bar);
            PH(16) { PHASE_VARS(0) MOE_VARS moe::Order S{tile_e, ntiles, D / 256, 0, 0, 0}; S.dev_init(G, bid);
              pg8::gemm_phase<moe::ProbDown, epi::MoeDown, moe::Order, true>(lds, moe::ProbDown{hmid, W2, DFF, DFF, DFF, 0}, S, epi::MoeDown{rowdst, roww, yslot}); }
            xcd_barrier(bar);
            PH(17) { PHASE_VARS(0) MOE_VARS thin::moe_combine_body(x1, yslot, modl + 5 * D, outp, gtid, ngt); }
#undef MOE_VARS
        }
    }
    {
        PH(1) { PHASE_VARS(1) thin::norm_body(xin, F(5) + l * D, modl + 0 * D, modl + 1 * D, H, gw, ngw, lane); }
        xcd_barrier(bar);
        PH(2) { PHASE_VARS(1) pg8::DenseProb g{H, (const bf16_t*)(lwb + LW_IN), D, D, D, 0}; pg8::StaticOrder S; S.init(M, INC, G, bid);
          pg8::gemm_phase<pg8::DenseProb, epi::Proj, pg8::StaticOrder, true>(lds, g, S, epi::Proj{PROJ, F(8) + l * 3 * D}); }
        xcd_barrier(bar);
        PH(3) { PHASE_VARS(1) for (int u = bid; u < 256; u += G) { const int grp = u & 3;
            qk::unit(u >> 5, (u >> 2) & 7, grp, PROJ, cs, (grp == 0 ? F(16) : grp == 1 ? F(17) : grp == 2 ? F(23) : F(24)) + l * 64, kmean, (LAS char*)lds); } }
        xcd_barrier(bar);
        {
#define POP_Q() do { __syncthreads(); if (tid == 0) MISC[16] = __hip_atomic_fetch_add((unsigned*)(ws + WS_CTL) + CW_QUEUE + 64 * l, 1u, __ATOMIC_RELAXED, __HIP_MEMORY_SCOPE_AGENT); __syncthreads(); q = (int)MISC[16]; } while (0)
            int q;
            { PHASE_VARS(1) POP_Q(); }
            PH(4) { PHASE_VARS(1)
#pragma unroll 1
              while (q < NQ_RG) {
                rglru::unit(q >> 4, q & 15, PROJ, YABC, F(9) + l * 4 * D, F(10) + l * D, F(11) + (size_t)l * 16 * 4096, F(12) + l * D, F(13) + (size_t)l * 16 * 4096, F(14) + l * D, F(15) + l * D, (LAS char*)lds);
                POP_Q(); } }
            PH(5) { PHASE_VARS(1)
              const float lam_init = 0.8f - 0.6f * expf(-0.3f * (float)l);
              const float lam = diff_lambda(F(18) + l * 64, F(19) + l * 64, F(20) + l * 64, F(21) + l * 64, lam_init);
#pragma unroll 1
              while (q < NQ_RG + 256) { const int i = q - NQ_RG;
                attn::diff_unit((i & 31) >> 2, i & 3, 7 - (i >> 5), PROJ, YABC, F(22) + l * 128, lam, 1.0f - lam_init, (LAS char*)lds);
                POP_Q(); } }
            PH(6) { PHASE_VARS(1)
#pragma unroll 1
              while (q < NQ_TOTAL) { const int i = q - NQ_RG - 256;
                attn::moba_unit((i & 63) >> 3, i & 7, 7 - (i >> 6), PROJ, YABC, kmean, (LAS char*)lds);
                POP_Q(); } }
#undef POP_Q
        }
        xcd_barrier(bar);
        PH(7) { { PHASE_VARS(1) pg8::StaticOrder S; S.init(M, D, G, bid); pg8::DenseProb g{YABC + Y_A, (const bf16_t*)(lwb + LW_BRA), D, YW, D, 0}; pg8::gemm_phase<pg8::DenseProb, epi::Branch<0>, pg8::StaticOrder, true>(lds, g, S, epi::Branch<0>{PROJ, x1, H}); }
                { PHASE_VARS(1) pg8::StaticOrder S; S.init(M, D, G, bid); pg8::DenseProb g{YABC + Y_B, (const bf16_t*)(lwb + LW_BRB), 512, YW, 512, 0}; pg8::gemm_phase<pg8::DenseProb, epi::Branch<1>, pg8::StaticOrder, true>(lds, g, S, epi::Branch<1>{PROJ, x1, H}); }
                { PHASE_VARS(1) pg8::StaticOrder S; S.init(M, D, G, bid); pg8::DenseProb g{YABC + Y_C, (const bf16_t*)(lwb + LW_BRC), 512, YW, 512, 0}; pg8::gemm_phase<pg8::DenseProb, epi::Branch<2>, pg8::StaticOrder, true>(lds, g, S, epi::Branch<2>{PROJ, x1, H}); } }
        xcd_barrier(bar);
        PH(8) { PHASE_VARS(1) pg8::DenseProb g{H, (const bf16_t*)(lwb + LW_OUT), D, D, D, 0}; pg8::StaticOrder S; S.init(M, D, G, bid);
          pg8::gemm_phase<pg8::DenseProb, epi::Resid, pg8::StaticOrder, true>(lds, g, S, epi::Resid{xin, x1, modl + 2 * D}); }
        xcd_barrier(bar);
        if (1 == 0) {
            PH(9) { PHASE_VARS(1) thin::norm_body(x1, F(6) + l * D, modl + 3 * D, modl + 4 * D, H, gw, ngw, lane); }
            xcd_barrier(bar);
            PH(10) { PHASE_VARS(1) pg8::DenseProb g{H, (const bf16_t*)(lwb + LW_W13), D, D, D, 0}; pg8::StaticOrder S; S.init(M, DFF2, G, bid);
              pg8::gemm_phase<pg8::DenseProb, epi::SwiGLU, pg8::StaticOrder, true>(lds, g, S, epi::SwiGLU{PROJ}); }
            xcd_barrier(bar);
            PH(11) { PHASE_VARS(1) pg8::DenseProb g{PROJ, (const bf16_t*)(lwb + LW_W2), DFF, DFF, DFF, 0}; pg8::StaticOrder S; S.init(M, D, G, bid);
              pg8::gemm_phase<pg8::DenseProb, epi::Resid, pg8::StaticOrder, true>(lds, g, S, epi::Resid{x1, x1, modl + 5 * D}); }
            xcd_barrier(bar);
        } else {
#define MOE_VARS \
            bf16_t* W13 = (bf16_t*)(ws + WS_MOEW13); bf16_t* W2 = (bf16_t*)(ws + WS_MOEW2); bf16_t* h2 = (bf16_t*)(ws + WS_H2L1); bf16_t* hmid = (bf16_t*)(ws + WS_HMID_MOE); bf16_t* yslot = (bf16_t*)(ws + WS_YSLOT); \
            int* topi = (int*)(ws + WS_TOPI); float* topw = (float*)(ws + WS_TOPW); int* rowtok = (int*)(ws + WS_ROWTOK); int* rowdst = (int*)(ws + WS_ROWDST); float* roww = (float*)(ws + WS_ROWW); int* tile_e = (int*)(ws + WS_TILEE); int* ntiles = (int*)(ws + WS_NTILES); \
            (void)W13; (void)W2; (void)h2; (void)hmid; (void)yslot; (void)topi; (void)topw; (void)rowtok; (void)rowdst; (void)roww; (void)tile_e; (void)ntiles;
            PH(12) { PHASE_VARS(1) MOE_VARS thin::norm_router_body(x1, F(6) + l * D, modl + 3 * D, modl + 4 * D, h2, F(32), F(33), topi, topw, gw, ngw, lane); }
            PH(13) { PHASE_VARS(1) MOE_VARS LAS float* scr = (LAS float*)(lds + wid * 8448);
#pragma unroll 1
              for (int e = 0; e < NE; ++e) {
                thin::transpose_matrix(F(34) + (size_t)e * D * DFF, D, DFF, W13, e * DFF2, 1, scr, gw, ngw, lane);
                thin::transpose_matrix(F(35) + (size_t)e * D * DFF, D, DFF, W13, e * DFF2, 2, scr, gw, ngw, lane);
                thin::transpose_matrix(F(36) + (size_t)e * DFF * D, DFF, D, W2, e * D, 0, scr, gw, ngw, lane); } }
            xcd_barrier(bar);
            PH(14) { PHASE_VARS(1) MOE_VARS if (bid == 0) moe::assign(topi, topw, rowtok, rowdst, roww, tile_e, ntiles, (LAS int*)lds); }
            xcd_barrier(bar);
            PH(15) { PHASE_VARS(1) MOE_VARS moe::Order S{tile_e, ntiles, DFF2 / 256, 0, 0, 0}; S.dev_init(G, bid);
              pg8::gemm_phase<moe::ProbUp, epi::SwiGLU, moe::Order, true>(lds, moe::ProbUp{h2, W13, rowtok, D, D, D, 0}, S, epi::SwiGLU{hmid}); }
            xcd_barrier(bar);
            PH(16) { PHASE_VARS(1) MOE_VARS moe::Order S{tile_e, ntiles, D / 256, 0, 0, 0}; S.dev_init(G, bid);
              pg8::gemm_phase<moe::ProbDown, epi::MoeDown, moe::Order, true>(lds, moe::ProbDown{hmid, W2, DFF, DFF, DFF, 0}, S, epi::MoeDown{rowdst, roww, yslot}); }
            xcd_barrier(bar);
            PH(17) { PHASE_VARS(1) MOE_VARS thin::moe_combine_body(x1, yslot, modl + 5 * D, outp, gtid, ngt); }
#undef MOE_VARS
        }
    }
#undef F
#undef PHASE_VARS
}

extern "C" void kernel_launch(void* const* d_in, const int* in_sizes, int n_in, void* d_out, int out_size, void* d_ws, size_t ws_size, hipStream_t stream) {
    static int grid = 0;
    if (grid == 0) {
        if (n_in != 37 || ws_size < WS_END) { fprintf(stderr, "kernel_launch: unexpected n_in %d / ws_size %zu (need %zu)\n", n_in, ws_size, (size_t)WS_END); grid = -1; return; }
        int dev = 0, cus = 0, per_cu = 0;
        if (hipGetDevice(&dev) != hipSuccess || hipDeviceGetAttribute(&cus, hipDeviceAttributeMultiprocessorCount, dev) != hipSuccess) { grid = -1; return; }
        if (hipFuncSetAttribute((const void*)mega_fwd, hipFuncAttributeMaxDynamicSharedMemorySize, LDS_TOTAL) != hipSuccess) { fprintf(stderr, "kernel_launch: hipFuncSetAttribute failed\n"); grid = -1; return; }
        if (hipOccupancyMaxActiveBlocksPerMultiprocessor(&per_cu, (const void*)mega_fwd, 512, LDS_TOTAL) != hipSuccess || per_cu < 1) fprintf(stderr, "kernel_launch: occupancy query says %d\n", per_cu);
        (void)hipGetLastError();
        grid = cus;
    }
    if (grid < 0) return;
    (void)hipMemsetAsync((char*)d_ws + WS_CTL, 0, CTL_ZERO_BYTES, stream);
    Args a{};
    for (int i = 0; i < 37; ++i) a.in[i] = (const float*)d_in[i];
    a.out = (float*)d_out; a.ws = (unsigned char*)d_ws;
    hipLaunchKernelGGL(mega_fwd, dim3(grid), dim3(512), LDS_TOTAL, stream, a);
}
```

```cpp
#include <hip/hip_runtime.h>
#include <stdint.h>
#include <stdio.h>

#define LAS __attribute__((address_space(3)))
typedef unsigned short bf16_t;
typedef short bf16x8 __attribute__((ext_vector_type(8)));
typedef short s16x4 __attribute__((ext_vector_type(4)));
typedef float f32x2 __attribute__((ext_vector_type(2)));
typedef float f32x4 __attribute__((ext_vector_type(4)));
typedef float f32x16 __attribute__((ext_vector_type(16)));
typedef unsigned u32x2 __attribute__((ext_vector_type(2)));
typedef unsigned u32x4 __attribute__((ext_vector_type(4)));

constexpr int D = 1024, NB = 8, SEQ = 2048, M = NB * SEQ, INC = 8192, DFF = 2816, NE = 8, DFF2 = 2 * DFF;
constexpr int C_XR = 0, C_GR = 1024, C_DQ = 2048, C_DK = 2560, C_DV = 3072, C_MQ = 3584, C_MK = 4096, C_MV = 4608, C_GB = 5120;
constexpr int YW = 2048, Y_A = 0, Y_B = 1024, Y_C = 1536;
constexpr float EPS = 1e-6f;
constexpr float QSCALE = 0.125f * 1.4426950408889634f;
constexpr int MOE_MAXROWS = 34816, MOE_MAXTILES = MOE_MAXROWS / 256;

__device__ __forceinline__ float bf2f(unsigned v) { return __uint_as_float(v << 16); }
__device__ __forceinline__ unsigned f2bf(float f) { unsigned u = __float_as_uint(f); return (u + 0x7fffu + ((u >> 16) & 1u)) >> 16; }
__device__ __forceinline__ unsigned pk2(float lo, float hi) { unsigned r; asm volatile("v_cvt_pk_bf16_f32 %0, %1, %2" : "=v"(r) : "v"(lo), "v"(hi)); return r; }
__device__ __forceinline__ float fexp2(float x) { return __builtin_amdgcn_exp2f(x); }
__device__ __forceinline__ float frcp(float x) { return __builtin_amdgcn_rcpf(x); }
__device__ __forceinline__ float sigmoid_f(float x) { return frcp(1.0f + fexp2(-1.4426950408889634f * x)); }
__device__ __forceinline__ float gelu_tanh_f(float x) { return x * sigmoid_f(1.5957691216057308f * (x + 0.044715f * x * x * x)); }
__device__ __forceinline__ float silu_f(float x) { return x * sigmoid_f(x); }
__device__ __forceinline__ float wave_sum(float v) {
#pragma unroll
    for (int o = 1; o < 64; o <<= 1) v += __shfl_xor(v, o);
    return v;
}
namespace pg8 {
constexpr int BM = 256, BK = 64, HALF = 128, HTB = HALF * BK * 2  , STAGE_BYTES = 8 * HTB, NXCD = 8, WGM = 8;

__host__ __device__ __forceinline__ int lds_byte(int r, int c) { const int st = (r >> 4) * 2 + (c >> 5), rr = r & 15, cc = c & 31, ob = rr * 64 + cc * 2; return st * 1024 + (ob ^ (((ob >> 9) & 1) << 5)); }
__host__ __device__ __forceinline__ void stage_rc(int b, int& R, int& C) { const int st = b / 1024, sb = b % 1024, swz = sb ^ (((sb >> 9) & 1) << 5); R = (st >> 1) * 16 + swz / 64; C = (st & 1) * 32 + (swz % 64) / 2; }
__host__ __device__ __forceinline__ int perm32(int rho) { const int n = rho >> 4, i = rho & 15; return 8 * (i >> 2) + 4 * n + (i & 3); }

struct Unit { int pm, pn, e, aux; };

struct StaticOrder {
    int nM, nN, nwg, G, c;
    __host__ __device__ void init(int M, int N, int G_, int c_) { nM = M / BM; nN = N / BM; nwg = nM * nN; G = G_; c = c_; }
    __device__ __forceinline__ bool next(int i, Unit& u) const {
        const long L = (long)i * G + c; if (L >= nwg) return false;
        int wgid = (int)L; { const int q = nwg / NXCD, r = nwg % NXCD, xcd = wgid % NXCD, off = wgid / NXCD; wgid = (xcd < r ? xcd * (q + 1) : r * (q + 1) + (xcd - r) * q) + off; }
        const int nig = WGM * nN, gid = wgid / nig, fm = gid * WGM, gsz = (nM - fm) < WGM ? (nM - fm) : WGM;
        u.pm = fm + ((wgid % nig) % gsz); u.pn = (wgid % nig) / gsz; u.e = 0; u.aux = 0; return true;
    }
};

struct DenseProb {
    static constexpr bool GATHER = false;
    const bf16_t* A; const bf16_t* Bt; int K, lda, ldb, pad;
    __device__ __forceinline__ const char* a_base(const Unit& u) const { return (const char*)A + (size_t)u.pm * BM * lda * 2; }
    __device__ __forceinline__ const char* b_base(const Unit& u) const { return (const char*)Bt + (size_t)u.pn * BM * ldb * 2; }
    __device__ __forceinline__ unsigned a_off(const Unit&, int row, int col) const { return (unsigned)(row * lda + col) * 2u; }
};

template <class Prob, class Epi, class Sched, bool ALIGN_EPI = true>
__device__ __forceinline__ void gemm_phase(LAS unsigned char* lds, const Prob& g, const Sched& S, const Epi& E) {
    int tid_l = threadIdx.x; asm volatile("" : "+v"(tid_l));
    const int tid = tid_l, wid = __builtin_amdgcn_readfirstlane(tid >> 6), lane = tid & 63, wr = wid >> 2, wc = wid & 3, fr = lane & 15, fq = lane >> 4;
    const int K = g.K, nt = K / BK;
    int sR[2], sC[2]; unsigned voffB[2];
#pragma unroll
    for (int i = 0; i < 2; ++i) { int R, C; stage_rc(tid * 16 + i * 8192, R, C); sR[i] = R; sC[i] = C; const int Rb = Epi::PERM ? ((R & ~31) + perm32(R & 31)) : R; voffB[i] = (unsigned)(Rb * g.ldb + C) * 2u; }
    const size_t kstep = (size_t)(BK * 2);
    const size_t hstepB = (size_t)HALF * g.ldb * 2;
    const unsigned ldsw = (unsigned)wid * 1024u;
    const int aoff = lds_byte(wr * 64 + fr, fq * 8), boff = lds_byte(wc * 32 + fr, fq * 8);
#define PG8_SA(b, h) (((b) * 2 + (h)) * HTB)
#define PG8_SB(b, h) ((4 + (b) * 2 + (h)) * HTB)
#define PG8_STAGE(bufoff, gbase, voff) do { _Pragma("unroll") for (int _i = 0; _i < 2; ++_i) \
        __builtin_amdgcn_global_load_lds((const unsigned*)((const char*)(gbase) + (voff)[_i]), (LAS unsigned*)(lds + (bufoff) + ldsw + _i * 8192), 16, 0, 0); } while (0)
#define PG8_LDA(dst, b, h) do { _Pragma("unroll") for (int m = 0; m < 4; ++m) _Pragma("unroll") for (int k = 0; k < 2; ++k) dst[m][k] = *(const LAS bf16x8*)(lds + PG8_SA(b, h) + aoff + m * 2048 + k * 1024); } while (0)
#define PG8_LDB(dst, b, h) do { _Pragma("unroll") for (int n = 0; n < 2; ++n) _Pragma("unroll") for (int k = 0; k < 2; ++k) dst[n][k] = *(const LAS bf16x8*)(lds + PG8_SB(b, h) + boff + n * 2048 + k * 1024); } while (0)
#define PG8_MMA(ai, bj, At, Bt) do { __builtin_amdgcn_s_setprio(1); _Pragma("unroll") for (int m = 0; m < 4; ++m) _Pragma("unroll") for (int n = 0; n < 2; ++n) _Pragma("unroll") for (int k = 0; k < 2; ++k) \
        acc[ai][bj][m][n] = __builtin_amdgcn_mfma_f32_16x16x32_bf16(Bt[n][k], At[m][k], acc[ai][bj][m][n], 0, 0, 0); __builtin_amdgcn_s_setprio(0); } while (0)
#define PG8_WAIT_V(n) asm volatile("s_waitcnt vmcnt(" #n ")" ::: "memory")
#define PG8_WAIT_L(n) asm volatile("s_waitcnt lgkmcnt(" #n ")" ::: "memory")
#define PG8_BAR __builtin_amdgcn_s_barrier()
#define PG8_SCHED __builtin_amdgcn_sched_barrier(0)
    Unit cur, nxt; int ui = 0;
    if (!S.next(0, cur)) return;
    f32x4 acc[2][2][4][2];
#pragma unroll
    for (int a = 0; a < 2; ++a)
#pragma unroll
        for (int b = 0; b < 2; ++b)
#pragma unroll
            for (int m = 0; m < 4; ++m)
#pragma unroll
                for (int n = 0; n < 2; ++n) acc[a][b][m][n] = (f32x4){0.f, 0.f, 0.f, 0.f};
    bf16x8 At[4][2], B0[2][2], B1[2][2];
    unsigned vA[2][2], vN[2][2];
#pragma unroll
    for (int h = 0; h < 2; ++h)
#pragma unroll
        for (int i = 0; i < 2; ++i) { vA[h][i] = g.a_off(cur, h * HALF + sR[i], sC[i]); vN[h][i] = vA[h][i]; }
    const char* cA = g.a_base(cur); const char* cB = g.b_base(cur);
    PG8_STAGE(PG8_SB(0, 0), cB, voffB); PG8_STAGE(PG8_SB(0, 1), cB + hstepB, voffB); PG8_STAGE(PG8_SA(0, 0), cA, vA[0]); PG8_STAGE(PG8_SA(0, 1), cA, vA[1]);
    if (wr == 1) PG8_BAR;
    PG8_WAIT_V(2); PG8_BAR;
    PG8_STAGE(PG8_SB(1, 0), cB + kstep, voffB); PG8_STAGE(PG8_SA(1, 0), cA + kstep, vA[0]); PG8_STAGE(PG8_SB(1, 1), cB + hstepB + kstep, voffB);
    PG8_WAIT_V(6); PG8_BAR;
    for (;;) {
        const bool has_next = S.next(ui + 1, nxt);
        const char* nA = has_next ? g.a_base(nxt) : cA; const char* nB = has_next ? g.b_base(nxt) : cB;
        if (Prob::GATHER) {
#pragma unroll
            for (int h = 0; h < 2; ++h)
#pragma unroll
                for (int i = 0; i < 2; ++i) vN[h][i] = has_next ? g.a_off(nxt, h * HALF + sR[i], sC[i]) : vA[h][i];
        }
        for (int t = 0; t < nt; t += 2) {
            const bool last = (t == nt - 2);
            const char* a1 = cA + (size_t)(t + 1) * kstep;
            const char* a2 = last ? nA : cA + (size_t)(t + 2) * kstep; const char* b2 = last ? nB : cB + (size_t)(t + 2) * kstep;
            const char* a3 = a2 + kstep; const char* b3 = b2 + kstep;
            unsigned v2[2][2];
#pragma unroll
            for (int h = 0; h < 2; ++h)
#pragma unroll
                for (int i = 0; i < 2; ++i) v2[h][i] = (Prob::GATHER && last) ? vN[h][i] : vA[h][i];
            PG8_LDB(B0, 0, 0); PG8_LDB(B1, 0, 1); PG8_SCHED; PG8_LDA(At, 0, 0); PG8_STAGE(PG8_SA(1, 1), a1, vA[1]);
            PG8_WAIT_V(8); PG8_WAIT_L(0); PG8_BAR; PG8_MMA(0, 0, At, B0); PG8_MMA(0, 1, At, B1); PG8_BAR; PG8_SCHED;
            PG8_LDA(At, 0, 1); PG8_STAGE(PG8_SB(0, 0), b2, voffB); PG8_STAGE(PG8_SB(0, 1), b2 + hstepB, voffB); PG8_STAGE(PG8_SA(0, 0), a2, v2[0]);
            PG8_WAIT_V(8); PG8_WAIT_L(0); PG8_BAR; PG8_MMA(1, 0, At, B0); PG8_MMA(1, 1, At, B1); PG8_BAR; PG8_SCHED;
            PG8_LDB(B0, 1, 0); PG8_LDB(B1, 1, 1); PG8_SCHED; PG8_LDA(At, 1, 0); PG8_STAGE(PG8_SA(0, 1), a2, v2[1]);
            PG8_WAIT_V(8); PG8_WAIT_L(0); PG8_BAR; PG8_MMA(0, 0, At, B0); PG8_MMA(0, 1, At, B1); PG8_BAR; PG8_SCHED;
            PG8_LDA(At, 1, 1); PG8_STAGE(PG8_SB(1, 0), b3, voffB); PG8_STAGE(PG8_SB(1, 1), b3 + hstepB, voffB); PG8_STAGE(PG8_SA(1, 0), a3, v2[0]);
            PG8_WAIT_V(8); PG8_WAIT_L(0); PG8_BAR; PG8_MMA(1, 0, At, B0); PG8_MMA(1, 1, At, B1); PG8_BAR; PG8_SCHED;
        }
        if constexpr (ALIGN_EPI) { if (wr == 0) PG8_BAR; }
        E(acc, cur, wr, wc, fr, fq);
        if (!has_next) break;
#pragma unroll
        for (int a = 0; a < 2; ++a)
#pragma unroll
            for (int b = 0; b < 2; ++b)
#pragma unroll
                for (int m = 0; m < 4; ++m)
#pragma unroll
                    for (int n = 0; n < 2; ++n) acc[a][b][m][n] = (f32x4){0.f, 0.f, 0.f, 0.f};
        cur = nxt; cA = nA; cB = nB; ++ui;
        if (Prob::GATHER) {
#pragma unroll
            for (int h = 0; h < 2; ++h)
#pragma unroll
                for (int i = 0; i < 2; ++i) vA[h][i] = vN[h][i];
        }
        if constexpr (ALIGN_EPI) { if (wr == 1) PG8_BAR; }
    }
    PG8_WAIT_V(0);
    if constexpr (!ALIGN_EPI) { if (wr == 0) PG8_BAR; }
    PG8_BAR;
#undef PG8_SA
#undef PG8_SB
#undef PG8_STAGE
#undef PG8_LDA
#undef PG8_LDB
#undef PG8_MMA
#undef PG8_WAIT_V
#undef PG8_WAIT_L
#undef PG8_BAR
#undef PG8_SCHED
}
}
namespace epi {
using pg8::Unit; using pg8::BM; using pg8::HALF;
typedef const f32x4 (&AccRef)[2][2][4][2];

struct Proj {
    static constexpr bool PERM = true;
    bf16_t* O; const float* gate_b;
    __device__ __forceinline__ void operator()(AccRef acc, const Unit& u, int wr, int wc, int fr, int fq) const {
        const int row0 = u.pm * BM + wr * 64 + fr, col0 = u.pn * BM + wc * 32 + 8 * fq;
        const int mode = (u.pn >= 20) ? 2 : ((u.pn >= 4 && u.pn < 8) ? 1 : 0);
        f32x4 bv[2][2];
#pragma unroll
        for (int bj = 0; bj < 2; ++bj)
#pragma unroll
            for (int n = 0; n < 2; ++n) bv[bj][n] = (mode == 2) ? *(const f32x4*)(gate_b + (col0 - C_GB) + bj * HALF + 4 * n) : (f32x4){0.f, 0.f, 0.f, 0.f};
#pragma unroll
        for (int ai = 0; ai < 2; ++ai)
#pragma unroll
            for (int m = 0; m < 4; ++m) { bf16_t* rowp = O + (size_t)(row0 + ai * HALF + m * 16) * INC + col0;
#pragma unroll
                for (int bj = 0; bj < 2; ++bj) { f32x4 v0 = acc[ai][bj][m][0] + bv[bj][0], v1 = acc[ai][bj][m][1] + bv[bj][1];
                    if (mode == 1) {
#pragma unroll
                        for (int j = 0; j < 4; ++j) { v0[j] = gelu_tanh_f(v0[j]); v1[j] = gelu_tanh_f(v1[j]); } }
                    if (mode == 2) {
#pragma unroll
                        for (int j = 0; j < 4; ++j) { v0[j] = sigmoid_f(v0[j]); v1[j] = sigmoid_f(v1[j]); } }
                    u32x4 w; w.x = pk2(v0[0], v0[1]); w.y = pk2(v0[2], v0[3]); w.z = pk2(v1[0], v1[1]); w.w = pk2(v1[2], v1[3]);
                    *(u32x4*)(rowp + bj * HALF) = w; } }
    }
};

template <int STEP> struct Branch {
    static constexpr bool PERM = false;
    const bf16_t* proj; float* P; bf16_t* merged;
    __device__ __forceinline__ void operator()(AccRef acc, const Unit& u, int wr, int wc, int fr, int fq) const {
        const int row0 = u.pm * BM + wr * 64 + fr, col0 = u.pn * BM + wc * 32 + 4 * fq;
#pragma unroll
        for (int ai = 0; ai < 2; ++ai)
#pragma unroll
            for (int m = 0; m < 4; ++m) { const size_t row = (size_t)(row0 + ai * HALF + m * 16);
#pragma unroll
                for (int bj = 0; bj < 2; ++bj)
#pragma unroll
                    for (int n = 0; n < 2; ++n) { const int col = col0 + bj * HALF + n * 16;
                        const u32x2 gw = *(const u32x2*)(proj + row * INC + C_GB + STEP * 1024 + col);
                        const f32x4 gv = {bf2f(gw.x & 0xffffu), bf2f(gw.x >> 16), bf2f(gw.y & 0xffffu), bf2f(gw.y >> 16)};
                        f32x4 v = acc[ai][bj][m][n] * gv;
                        float* pp = P + row * D + col;
                        if (STEP >= 1) v += *(const f32x4*)pp;
                        if (STEP <= 1) *(f32x4*)pp = v;
                        else { u32x2 w; w.x = pk2(v[0], v[1]); w.y = pk2(v[2], v[3]); *(u32x2*)(merged + row * D + col) = w; } } }
    }
};

struct Resid {
    static constexpr bool PERM = false;
    const float* base; float* out; const float* gate;
    __device__ __forceinline__ void operator()(AccRef acc, const Unit& u, int wr, int wc, int fr, int fq) const {
        const int row0 = u.pm * BM + wr * 64 + fr, col0 = u.pn * BM + wc * 32 + 4 * fq;
        const float* gp = gate + (size_t)((u.pm * BM) / SEQ) * (6 * D) + col0;
        f32x4 gv[2][2];
#pragma unroll
        for (int bj = 0; bj < 2; ++bj)
#pragma unroll
            for (int n = 0; n < 2; ++n) gv[bj][n] = *(const f32x4*)(gp + bj * HALF + n * 16);
#pragma unroll
        for (int ai = 0; ai < 2; ++ai)
#pragma unroll
            for (int m = 0; m < 4; ++m) { const size_t off = (size_t)(row0 + ai * HALF + m * 16) * D + col0;
#pragma unroll
                for (int bj = 0; bj < 2; ++bj)
#pragma unroll
                    for (int n = 0; n < 2; ++n) { const f32x4 bs = *(const f32x4*)(base + off + bj * HALF + n * 16);
                        *(f32x4*)(out + off + bj * HALF + n * 16) = bs + gv[bj][n] * acc[ai][bj][m][n]; } }
    }
};

struct SwiGLU {
    static constexpr bool PERM = true;
    bf16_t* O;
    __device__ __forceinline__ void operator()(AccRef acc, const Unit& u, int wr, int wc, int fr, int fq) const {
        const int row0 = u.pm * BM + wr * 64 + fr, col0 = u.pn * HALF + wc * 32 + 8 * fq;
#pragma unroll
        for (int ai = 0; ai < 2; ++ai)
#pragma unroll
            for (int m = 0; m < 4; ++m) { bf16_t* rowp = O + (size_t)(row0 + ai * HALF + m * 16) * DFF + col0;
                f32x4 v0, v1;
#pragma unroll
                for (int j = 0; j < 4; ++j) { v0[j] = silu_f(acc[ai][0][m][0][j]) * acc[ai][1][m][0][j]; v1[j] = silu_f(acc[ai][0][m][1][j]) * acc[ai][1][m][1][j]; }
                u32x4 w; w.x = pk2(v0[0], v0[1]); w.y = pk2(v0[2], v0[3]); w.z = pk2(v1[0], v1[1]); w.w = pk2(v1[2], v1[3]);
                *(u32x4*)rowp = w; }
    }
};

struct MoeDown {
    static constexpr bool PERM = false;
    const int* rowdst; const float* roww; bf16_t* yslot;
    __device__ __forceinline__ void operator()(AccRef acc, const Unit& u, int wr, int wc, int fr, int fq) const {
        const int row0 = u.pm * BM + wr * 64 + fr, col0 = u.pn * BM + wc * 32 + 4 * fq;
#pragma unroll
        for (int ai = 0; ai < 2; ++ai)
#pragma unroll
            for (int m = 0; m < 4; ++m) { const int p = row0 + ai * HALF + m * 16; const int dst = rowdst[p]; const float w = roww[p];
                if (dst >= 0) { bf16_t* rowp = yslot + (size_t)dst * D + col0;
#pragma unroll
                    for (int bj = 0; bj < 2; ++bj)
#pragma unroll
                        for (int n = 0; n < 2; ++n) { const f32x4 v = acc[ai][bj][m][n] * w; u32x2 o; o.x = pk2(v[0], v[1]); o.y = pk2(v[2], v[3]); *(u32x2*)(rowp + bj * HALF + n * 16) = o; } } }
    }
};
}
namespace attn {
constexpr int KSTR = 144;
constexpr int VSTR128 = 320, VSTR64 = 192;
constexpr int LDS_K = 0, LDS_V = 64 * KSTR, LDS_BYTES = LDS_V + 64 * VSTR128;
constexpr float NEGF = -1e30f;
__device__ __forceinline__ int crow(int r, int hi) { return (r & 3) + 8 * (r >> 2) + 4 * hi; }
__device__ __forceinline__ float swapmax(float m) { auto rr = __builtin_amdgcn_permlane32_swap(__float_as_uint(m), __float_as_uint(m), false, false); return fmaxf(__uint_as_float(rr[0]), __uint_as_float(rr[1])); }
__device__ __forceinline__ float swapsum(float m) { auto rr = __builtin_amdgcn_permlane32_swap(__float_as_uint(m), __float_as_uint(m), false, false); return __uint_as_float(rr[0]) + __uint_as_float(rr[1]); }
typedef short v4i16_t __attribute__((ext_vector_type(4)));
__device__ __forceinline__ s16x4 vtr(const LAS char* p) { return __builtin_bit_cast(s16x4, __builtin_amdgcn_ds_read_tr16_b64_v4i16((LAS v4i16_t*)p)); }

__device__ __forceinline__ void qk_tile(f32x16& sA, f32x16& sB, const LAS char* Kt, const bf16x8 (&qf)[4], int r, int h) {
    const LAS char* kb = Kt + r * KSTR + h * 16;
#pragma unroll
    for (int j = 0; j < 16; ++j) { sA[j] = 0.f; sB[j] = 0.f; }
#pragma unroll
    for (int ks = 0; ks < 4; ++ks) {
        const bf16x8 a0 = *(const LAS bf16x8*)(kb + ks * 32);
        const bf16x8 a1 = *(const LAS bf16x8*)(kb + 32 * KSTR + ks * 32);
        sA = __builtin_amdgcn_mfma_f32_32x32x16_bf16(a0, qf[ks], sA, 0, 0, 0);
        sB = __builtin_amdgcn_mfma_f32_32x32x16_bf16(a1, qf[ks], sB, 0, 0, 0);
    }
}
template <int NDB, int VSTR>
__device__ __forceinline__ void pv_tile(f32x16 (&o)[NDB], const LAS char* Vt, const bf16x8 (&pf)[4], int lane) {
    const int h = lane >> 5, q = (lane & 15) >> 2, p = lane & 3, g1 = (lane >> 4) & 1;
    const LAS char* vb = Vt + (4 * h + q) * VSTR + (16 * g1 + 4 * p) * 2;
#pragma unroll
    for (int db = 0; db < NDB; ++db)
#pragma unroll
        for (int kb = 0; kb < 2; ++kb)
#pragma unroll
            for (int s = 0; s < 2; ++s) {
                const int r0 = kb * 32 + 16 * s;
                const s16x4 lo = vtr(vb + r0 * VSTR + db * 64), hi = vtr(vb + (r0 + 8) * VSTR + db * 64);
                const bf16x8 vf = {lo[0], lo[1], lo[2], lo[3], hi[0], hi[1], hi[2], hi[3]};
                o[db] = __builtin_amdgcn_mfma_f32_32x32x16_bf16(pf[kb * 2 + s], vf, o[db], 0, 0, 0);
            }
}
template <int NDB, int VSTR>
__device__ __forceinline__ void softmax_pv(f32x16& sA, f32x16& sB, f32x16 (&o)[NDB], float& mrow, float& lrow, const LAS char* Vt, int lane) {
    const int h = lane >> 5;
    float mx = fmaxf(sA[0], sB[0]);
#pragma unroll
    for (int j = 1; j < 16; ++j) mx = fmaxf(mx, fmaxf(sA[j], sB[j]));
    mx = swapmax(mx);
    const float mnew = fmaxf(mrow, mx), alpha = fexp2(mrow - mnew);
    mrow = mnew;
    float rs = 0.f;
#pragma unroll
    for (int j = 0; j < 16; ++j) { sA[j] = fexp2(sA[j] - mnew); sB[j] = fexp2(sB[j] - mnew); rs += sA[j] + sB[j]; }
    rs = swapsum(rs);
    lrow = lrow * alpha + rs;
    if (__any(alpha != 1.0f)) {
#pragma unroll
        for (int j = 0; j < 16; ++j) { const float a = __shfl(alpha, crow(j, h));
#pragma unroll
            for (int db = 0; db < NDB; ++db) o[db][j] *= a; }
    }
    bf16x8 pf[4];
    { u32x4 w;
      w.x = pk2(sA[0], sA[1]); w.y = pk2(sA[2], sA[3]); w.z = pk2(sA[4], sA[5]); w.w = pk2(sA[6], sA[7]); pf[0] = __builtin_bit_cast(bf16x8, w);
      w.x = pk2(sA[8], sA[9]); w.y = pk2(sA[10], sA[11]); w.z = pk2(sA[12], sA[13]); w.w = pk2(sA[14], sA[15]); pf[1] = __builtin_bit_cast(bf16x8, w);
      w.x = pk2(sB[0], sB[1]); w.y = pk2(sB[2], sB[3]); w.z = pk2(sB[4], sB[5]); w.w = pk2(sB[6], sB[7]); pf[2] = __builtin_bit_cast(bf16x8, w);
      w.x = pk2(sB[8], sB[9]); w.y = pk2(sB[10], sB[11]); w.z = pk2(sB[12], sB[13]); w.w = pk2(sB[14], sB[15]); pf[3] = __builtin_bit_cast(bf16x8, w); }
    pv_tile<NDB, VSTR>(o, Vt, pf, lane);
}

template <int DV> struct TileRegs { u32x4 k; u32x4 v[DV / 64]; };
template <int DV>
__device__ __forceinline__ void tile_load(TileRegs<DV>& t, const bf16_t* Kg, const bf16_t* Vg, int key0, int tid) {
    t.k = *(const u32x4*)(Kg + (size_t)(key0 + (tid >> 3)) * INC + (tid & 7) * 8);
    if (DV == 64) t.v[0] = *(const u32x4*)(Vg + (size_t)(key0 + (tid >> 3)) * INC + (tid & 7) * 8);
    else {
#pragma unroll
        for (int i = 0; i < DV / 64; ++i) t.v[i] = *(const u32x4*)(Vg + (size_t)(key0 + (tid >> 4) + 32 * i) * INC + (tid & 15) * 8);
    }
}
template <int DV, int VSTR>
__device__ __forceinline__ void tile_store(const TileRegs<DV>& t, LAS char* lds, int tid) {
    *(LAS u32x4*)(lds + LDS_K + (tid >> 3) * KSTR + (tid & 7) * 16) = t.k;
    if (DV == 64) *(LAS u32x4*)(lds + LDS_V + (tid >> 3) * VSTR + (tid & 7) * 16) = t.v[0];
    else {
#pragma unroll
        for (int i = 0; i < DV / 64; ++i) *(LAS u32x4*)(lds + LDS_V + ((tid >> 4) + 32 * i) * VSTR + (tid & 15) * 16) = t.v[i];
    }
}

template <int DV, int VSTR>
__device__ __forceinline__ void causal_pass(f32x16 (&o)[DV / 32], float& mrow, float& lrow, const bf16x8 (&qf)[4], const bf16_t* Kg, const bf16_t* Vg,
                                            int ntiles, int qw0, LAS char* lds, int tid) {
    const int lane = tid & 63, r = lane & 31, h = lane >> 5;
    TileRegs<DV> tr;
    tile_load<DV>(tr, Kg, Vg, 0, tid);
    for (int t = 0; t < ntiles; ++t) {
        __syncthreads();
        tile_store<DV, VSTR>(tr, lds, tid);
        __syncthreads();
        if (t + 1 < ntiles) tile_load<DV>(tr, Kg, Vg, (t + 1) * 64, tid);
        const int key0 = t * 64;
        if (key0 <= qw0 + 31) {
            f32x16 sA, sB;
            qk_tile(sA, sB, lds + LDS_K, qf, r, h);
            if (key0 + 63 > qw0) {
                const int qpos = qw0 + r;
#pragma unroll
                for (int j = 0; j < 16; ++j) { const int kp = key0 + crow(j, h); if (kp > qpos) sA[j] = NEGF; if (kp + 32 > qpos) sB[j] = NEGF; }
            }
            softmax_pv<DV / 32, VSTR>(sA, sB, o, mrow, lrow, lds + LDS_V, lane);
        }
    }
}

__device__ __forceinline__ void diff_unit(int b, int hd, int qt, const bf16_t* proj, bf16_t* yabc, const float* subln, float lam, float one_m_laminit, LAS char* lds) {
    int tid_l = threadIdx.x; asm volatile("" : "+v"(tid_l));
    const int tid = tid_l, lane = tid & 63, wid = tid >> 6, r = lane & 31, h = lane >> 5;
    const int qw0 = qt * 256 + wid * 32;
    const size_t rowb = (size_t)b * SEQ;
    const int ntiles = 4 * (qt + 1);
    unsigned o0p[4][8];
#pragma unroll
    for (int j = 0; j < 2; ++j) {
        const bf16_t* qp = proj + (rowb + qw0 + r) * INC + C_DQ + (hd * 2 + j) * 64 + h * 8;
        bf16x8 qf[4];
#pragma unroll
        for (int ks = 0; ks < 4; ++ks) qf[ks] = *(const bf16x8*)(qp + ks * 16);
        f32x16 o[4];
#pragma unroll
        for (int db = 0; db < 4; ++db)
#pragma unroll
            for (int i = 0; i < 16; ++i) o[db][i] = 0.f;
        float mrow = NEGF, lrow = 0.f;
        causal_pass<128, VSTR128>(o, mrow, lrow, qf, proj + rowb * INC + C_DK + (hd * 2 + j) * 64, proj + rowb * INC + C_DV + hd * 128, ntiles, qw0, lds, tid);
        const float il = frcp(lrow);
        if (j == 0) {
#pragma unroll
            for (int i = 0; i < 16; i += 2) { const float a0 = __shfl(il, crow(i, h)), a1 = __shfl(il, crow(i + 1, h));
#pragma unroll
                for (int db = 0; db < 4; ++db) o0p[db][i >> 1] = pk2(o[db][i] * a0, o[db][i + 1] * a1); }
        } else {
#pragma unroll
            for (int i = 0; i < 16; ++i) { const float a = __shfl(il, crow(i, h)) * lam;
                float ss = 0.f; float cv[4];
#pragma unroll
                for (int db = 0; db < 4; ++db) { const unsigned w = o0p[db][i >> 1]; const float x0 = (i & 1) ? bf2f(w >> 16) : bf2f(w & 0xffffu); const float c = x0 - o[db][i] * a; cv[db] = c; ss += c * c; }
                ss += __shfl_xor(ss, 1); ss += __shfl_xor(ss, 2); ss += __shfl_xor(ss, 4); ss += __shfl_xor(ss, 8); ss += __shfl_xor(ss, 16);
                const float rn = rsqrtf(ss * (1.0f / 128.0f) + EPS) * one_m_laminit;
                bf16_t* yp = yabc + (rowb + qw0 + crow(i, h)) * YW + Y_B + hd * 128 + r;
#pragma unroll
                for (int db = 0; db < 4; ++db) yp[db * 32] = (bf16_t)f2bf(cv[db] * rn * subln[db * 32 + r]);
            }
        }
    }
}

__device__ __forceinline__ void moba_unit(int b, int hd, int cur, const bf16_t* proj, bf16_t* yabc, const float* kmean, LAS char* lds) {
    int tid_l = threadIdx.x; asm volatile("" : "+v"(tid_l));
    const int tid = tid_l, lane = tid & 63, wid = tid >> 6, r = lane & 31, h = lane >> 5;
    const int qw0 = cur * 256 + wid * 32;
    const size_t rowb = (size_t)b * SEQ;
    const bf16_t* qp = proj + (rowb + qw0 + r) * INC + C_MQ + hd * 64 + h * 8;
    bf16x8 qf[4];
#pragma unroll
    for (int ks = 0; ks < 4; ++ks) qf[ks] = *(const bf16x8*)(qp + ks * 16);
    unsigned selmask = 0u;
    if (cur > 0) {
        float gate[8];
#pragma unroll
        for (int n = 0; n < 8; ++n) {
            float g = 0.f;
            if (n < cur) {
                const float* km = kmean + ((size_t)((b * 8 + hd) * 8 + n)) * 64 + h * 8;
#pragma unroll
                for (int ks = 0; ks < 4; ++ks)
#pragma unroll
                    for (int j = 0; j < 8; ++j) g += bf2f((unsigned)(unsigned short)qf[ks][j]) * km[ks * 16 + j];
                g = swapsum(g);
            } else g = -3.0e38f;
            gate[n] = g;
        }
        const int nsel = cur < 3 ? cur : 3;
        for (int s = 0; s < nsel; ++s) {
            float best = -3.0e38f; int bi = 0;
#pragma unroll
            for (int n = 0; n < 8; ++n) { const bool tk = (n < cur) && !((selmask >> n) & 1u) && (gate[n] > best); if (tk) { best = gate[n]; bi = n; } }
            selmask |= 1u << bi;
        }
    }
    f32x16 o[2];
#pragma unroll
    for (int db = 0; db < 2; ++db)
#pragma unroll
        for (int i = 0; i < 16; ++i) o[db][i] = 0.f;
    float mrow = NEGF, lrow = 0.f;
    const bf16_t* Kg = proj + rowb * INC + C_MK + hd * 64; const bf16_t* Vg = proj + rowb * INC + C_MV + hd * 64;
    const int ntiles = 4 * (cur + 1);
    TileRegs<64> tr;
    tile_load<64>(tr, Kg, Vg, cur * 256, tid);
    for (int t = 0; t < ntiles; ++t) {
        __syncthreads();
        tile_store<64, VSTR64>(tr, lds, tid);
        __syncthreads();
        const int blk = (t < 4) ? cur : (t >> 2) - 1;
        if (t + 1 < ntiles) { const int t1 = t + 1; const int blk1 = (t1 < 4) ? cur : (t1 >> 2) - 1; tile_load<64>(tr, Kg, Vg, blk1 * 256 + (t1 & 3) * 64, tid); }
        const int key0 = blk * 256 + (t & 3) * 64;
        const bool own = (t < 4);
        const bool lane_on = own ? true : (((selmask >> blk) & 1u) != 0u);
        const bool wave_on = own ? (key0 <= qw0 + 31) : (__any(lane_on) != 0);
        if (wave_on) {
            f32x16 sA, sB;
            qk_tile(sA, sB, lds + LDS_K, qf, r, h);
            if (own) {
                if (key0 + 63 > qw0) {
                    const int qpos = qw0 + r;
#pragma unroll
                    for (int j = 0; j < 16; ++j) { const int kp = key0 + crow(j, h); if (kp > qpos) sA[j] = NEGF; if (kp + 32 > qpos) sB[j] = NEGF; }
                }
            } else if (!lane_on) {
#pragma unroll
                for (int j = 0; j < 16; ++j) { sA[j] = NEGF; sB[j] = NEGF; }
            }
            softmax_pv<2, VSTR64>(sA, sB, o, mrow, lrow, lds + LDS_V, lane);
        }
    }
    const float il = frcp(lrow);
#pragma unroll
    for (int i = 0; i < 16; ++i) { const float a = __shfl(il, crow(i, h));
        bf16_t* yp = yabc + (rowb + qw0 + crow(i, h)) * YW + Y_C + hd * 64 + r;
#pragma unroll
        for (int db = 0; db < 2; ++db) yp[db * 32] = (bf16_t)f2bf(o[db][i] * a); }
}
}
namespace thin {
__device__ __forceinline__ void transpose_item(const float* W, int K, int N, bf16_t* WT, int row_off, int mode, LAS float* scr, int item, int lane) {
    const int nblk = N / 32, kb = item / nblk, nb = item % nblk, k0 = 64 * kb, n0 = 32 * nb;
#pragma unroll 8
    for (int i = 0; i < 32; ++i) { const int kk = 2 * i + (lane >> 5); scr[kk * 33 + (lane & 31)] = W[(size_t)(k0 + kk) * N + n0 + (lane & 31)]; }
    asm volatile("s_waitcnt lgkmcnt(0)" ::: "memory");
    const int c = lane & 7;
#pragma unroll
    for (int j = 0; j < 4; ++j) { const int n = (lane >> 3) + 8 * j; const LAS float* s = scr + (8 * c) * 33 + n;
        u32x4 o; o.x = pk2(s[0 * 33], s[1 * 33]); o.y = pk2(s[2 * 33], s[3 * 33]); o.z = pk2(s[4 * 33], s[5 * 33]); o.w = pk2(s[6 * 33], s[7 * 33]);
        const int nn = n0 + n; const int row = row_off + (mode == 0 ? nn : ((nn >> 7) * 256 + (mode == 2 ? 128 : 0) + (nn & 127)));
        *(u32x4*)(WT + (size_t)row * K + k0 + 8 * c) = o; }
    asm volatile("s_waitcnt lgkmcnt(0)" ::: "memory");
}
__device__ __forceinline__ void transpose_matrix(const float* W, int K, int N, bf16_t* WT, int row_off, int mode, LAS float* scr, int gw, int ngw, int lane) {
    const int nitems = (K / 64) * (N / 32);
    for (int it = gw; it < nitems; it += ngw) transpose_item(W, K, N, WT, row_off, mode, scr, it, lane);
}

__device__ __forceinline__ void mod_body(const float* c, const float* ada_w, const float* ada_b, float* mod, int gtid, int ngt) {
    for (int idx = gtid; idx < 2 * 6 * D; idx += ngt) {
        const int l = idx / (6 * D), j = idx % (6 * D);
        float acc[NB];
#pragma unroll
        for (int b = 0; b < NB; ++b) acc[b] = 0.f;
        const float* w = ada_w + (size_t)l * D * 6 * D + j;
        for (int k = 0; k < D; ++k) { const float wv = w[(size_t)k * 6 * D];
#pragma unroll
            for (int b = 0; b < NB; ++b) acc[b] += c[b * D + k] * wv; }
#pragma unroll
        for (int b = 0; b < NB; ++b) mod[((size_t)l * NB + b) * 6 * D + j] = acc[b] + ada_b[l * 6 * D + j];
    }
}
__device__ __forceinline__ void rope_body(const int* positions, f32x2* cs, int gtid, int ngt) {
    for (int idx = gtid; idx < M * 32; idx += ngt) {
        const int tok = idx >> 5, i = idx & 31;
        const float inv = 1.0f / powf(10000.0f, (float)(2 * i) / 64.0f);
        const float ang = (float)positions[tok] * inv;
        float s, c; sincosf(ang, &s, &c);
        cs[idx] = (f32x2){c, s};
    }
}
__device__ __forceinline__ void norm_row(const float* xrow, const float* g, const float* shift, const float* scale, bf16_t* orow, int lane, f32x4 (&y)[4]) {
    const f32x4* xr = (const f32x4*)xrow + lane;
    f32x4 v[4]; float ss = 0.f;
#pragma unroll
    for (int j = 0; j < 4; ++j) { v[j] = xr[64 * j]; ss += (v[j].x * v[j].x + v[j].y * v[j].y) + (v[j].z * v[j].z + v[j].w * v[j].w); }
    const float rn = rsqrtf(wave_sum(ss) * (1.0f / D) + EPS);
    u32x2* o8 = (u32x2*)orow + lane;
#pragma unroll
    for (int j = 0; j < 4; ++j) { const int col = 4 * lane + 256 * j;
        const f32x4 gg = *(const f32x4*)(g + col), sc = *(const f32x4*)(scale + col), sh = *(const f32x4*)(shift + col);
        y[j] = v[j] * rn * gg * (sc + 1.0f) + sh;
        u32x2 w; w.x = pk2(y[j].x, y[j].y); w.y = pk2(y[j].z, y[j].w); o8[64 * j] = w; }
}
__device__ __forceinline__ void norm_body(const float* x, const float* g, const float* shift, const float* scale, bf16_t* out, int gw, int ngw, int lane) {
    for (int m = gw; m < M; m += ngw) { const int b = m / SEQ; f32x4 y[4]; norm_row(x + (size_t)m * D, g, shift + b * 6 * D, scale + b * 6 * D, out + (size_t)m * D, lane, y); }
}
__device__ __forceinline__ void norm_router_body(const float* x, const float* g, const float* shift, const float* scale, bf16_t* out,
                                                 const float* rw, const float* rb, int* topi, float* topw, int gw, int ngw, int lane) {
    for (int m = gw; m < M; m += ngw) { const int b = m / SEQ; f32x4 y[4];
        norm_row(x + (size_t)m * D, g, shift + b * 6 * D, scale + b * 6 * D, out + (size_t)m * D, lane, y);
        float lg[NE];
#pragma unroll
        for (int e = 0; e < NE; ++e) lg[e] = 0.f;
#pragma unroll
        for (int j = 0; j < 4; ++j)
#pragma unroll
            for (int q = 0; q < 4; ++q) { const int col = 4 * lane + 256 * j + q; const f32x4 w0 = *(const f32x4*)(rw + col * NE), w1 = *(const f32x4*)(rw + col * NE + 4); const float hv = y[j][q];
                lg[0] += hv * w0.x; lg[1] += hv * w0.y; lg[2] += hv * w0.z; lg[3] += hv * w0.w; lg[4] += hv * w1.x; lg[5] += hv * w1.y; lg[6] += hv * w1.z; lg[7] += hv * w1.w; }
#pragma unroll
        for (int e = 0; e < NE; ++e) lg[e] = wave_sum(lg[e]) + rb[e];
        int i0 = 0; float v0 = lg[0];
#pragma unroll
        for (int e = 1; e < NE; ++e) if (lg[e] > v0) { v0 = lg[e]; i0 = e; }
        int i1 = -1; float v1 = -3.0e38f;
#pragma unroll
        for (int e = 0; e < NE; ++e) if (e != i0 && lg[e] > v1) { v1 = lg[e]; i1 = e; }
        const float w1v = 1.0f / (1.0f + expf(v0 - v1)), w0v = 1.0f - w1v;
        if (lane == 0) { topi[2 * m] = i0; topi[2 * m + 1] = i1; topw[2 * m] = w0v; topw[2 * m + 1] = w1v; }
    }
}
__device__ __forceinline__ void qknorm_body(bf16_t* proj, const f32x2* cs, const float* dqn, const float* dkn, const float* mqn, const float* mkn, int gtid, int ngt) {
    for (long idx = gtid; idx < (long)M * 32 * 32; idx += ngt) {
        const int i = (int)(idx & 31); const long pair = idx >> 5; const int hh = (int)(pair & 31); const int tok = (int)(pair >> 5);
        const int grp = hh >> 3, hi = hh & 7;
        const int cb = (grp == 0 ? C_DQ : grp == 1 ? C_DK : grp == 2 ? C_MQ : C_MK) + hi * 64;
        const float* gn = grp == 0 ? dqn : grp == 1 ? dkn : grp == 2 ? mqn : mkn;
        bf16_t* p = proj + (size_t)tok * INC + cb;
        const float x1 = bf2f(p[i]), x2 = bf2f(p[i + 32]);
        float ss = x1 * x1 + x2 * x2;
        ss += __shfl_xor(ss, 1); ss += __shfl_xor(ss, 2); ss += __shfl_xor(ss, 4); ss += __shfl_xor(ss, 8); ss += __shfl_xor(ss, 16);
        const float rn = rsqrtf(ss * (1.0f / 64.0f) + EPS);
        const float y1 = x1 * rn * gn[i], y2 = x2 * rn * gn[i + 32];
        const f32x2 c = cs[(size_t)tok * 32 + i];
        float o1 = y1 * c.x - y2 * c.y, o2 = y2 * c.x + y1 * c.y;
        if ((grp & 1) == 0) { o1 *= QSCALE; o2 *= QSCALE; }
        p[i] = (bf16_t)f2bf(o1); p[i + 32] = (bf16_t)f2bf(o2);
    }
}
__device__ __forceinline__ void kmean_body(const bf16_t* proj, float* kmean, int gw, int ngw, int lane) {
    for (int it = gw; it < NB * 8 * 8; it += ngw) { const int blk = it & 7, hd = (it >> 3) & 7, b = it >> 6;
        const bf16_t* p = proj + ((size_t)b * SEQ + blk * 256) * INC + C_MK + hd * 64 + lane;
        float s = 0.f;
        for (int t = 0; t < 256; ++t) s += bf2f(p[(size_t)t * INC]);
        kmean[(size_t)it * 64 + lane] = s * (1.0f / 256.0f); }
}
__device__ __forceinline__ void moe_combine_body(const float* x1, const bf16_t* yslot, const float* gate, float* out, int gtid, int ngt) {
    for (long idx = gtid; idx < (long)M * D / 4; idx += ngt) { const int m = (int)(idx >> 8), c4 = (int)(idx & 255) * 4; const int b = m / SEQ;
        const f32x4 xv = *(const f32x4*)(x1 + (size_t)m * D + c4), gv = *(const f32x4*)(gate + b * 6 * D + c4);
        const u32x2 a = *(const u32x2*)(yslot + (size_t)m * D + c4), c = *(const u32x2*)(yslot + ((size_t)M + m) * D + c4);
        f32x4 y = {bf2f(a.x & 0xffffu) + bf2f(c.x & 0xffffu), bf2f(a.x >> 16) + bf2f(c.x >> 16), bf2f(a.y & 0xffffu) + bf2f(c.y & 0xffffu), bf2f(a.y >> 16) + bf2f(c.y >> 16)};
        *(f32x4*)(out + (size_t)m * D + c4) = xv + gv * y; }
}
}
namespace qk {
constexpr int LDS_BYTES = 8 * 64 * 8 * 4;
__device__ __forceinline__ void unit(int b, int blk, int grp, bf16_t* proj, const f32x2* cs, const float* gn, float* kmean, LAS char* lds) {
    int tid_l = threadIdx.x; asm volatile("" : "+v"(tid_l));
    const int tid = tid_l, lane = tid & 63, wid = tid >> 6;
    const int hd = lane >> 3, half = (lane >> 2) & 1, j = lane & 3;
    const int cb = (grp == 0 ? C_DQ : grp == 1 ? C_DK : grp == 2 ? C_MQ : C_MK) + hd * 64 + half * 32 + 8 * j;
    float gnv[8];
#pragma unroll
    for (int e = 0; e < 8; ++e) gnv[e] = gn[half * 32 + 8 * j + e];
    const float qs = ((grp & 1) == 0) ? QSCALE : 1.0f;
    const float sgn = half ? 1.0f : -1.0f;
    float ksum[8];
#pragma unroll
    for (int e = 0; e < 8; ++e) ksum[e] = 0.f;
    for (int i = 0; i < 32; ++i) {
        const size_t tok = (size_t)b * SEQ + blk * 256 + wid + 8 * i;
        bf16_t* p = proj + tok * INC + cb;
        const u32x4 raw = *(const u32x4*)p;
        float x[8] = {bf2f(raw.x & 0xffffu), bf2f(raw.x >> 16), bf2f(raw.y & 0xffffu), bf2f(raw.y >> 16), bf2f(raw.z & 0xffffu), bf2f(raw.z >> 16), bf2f(raw.w & 0xffffu), bf2f(raw.w >> 16)};
        float ss = 0.f;
#pragma unroll
        for (int e = 0; e < 8; ++e) ss += x[e] * x[e];
        ss += __shfl_xor(ss, 1); ss += __shfl_xor(ss, 2); ss += __shfl_xor(ss, 4);
        const float rn = rsqrtf(ss * (1.0f / 64.0f) + EPS);
        const f32x4* cp = (const f32x4*)(cs + tok * 32 + 8 * j);
        const f32x4 c0 = cp[0], c1 = cp[1], c2 = cp[2], c3 = cp[3];
        const float cc[8] = {c0.x, c0.z, c1.x, c1.z, c2.x, c2.z, c3.x, c3.z}, sn[8] = {c0.y, c0.w, c1.y, c1.w, c2.y, c2.w, c3.y, c3.w};
        float o[8];
#pragma unroll
        for (int e = 0; e < 8; ++e) { const float y = x[e] * rn * gnv[e]; const float py = __shfl_xor(y, 4); o[e] = (y * cc[e] + sgn * py * sn[e]) * qs; }
        u32x4 w; w.x = pk2(o[0], o[1]); w.y = pk2(o[2], o[3]); w.z = pk2(o[4], o[5]); w.w = pk2(o[6], o[7]);
        *(u32x4*)p = w;
        if (grp == 3) { ksum[0] += bf2f(w.x & 0xffffu); ksum[1] += bf2f(w.x >> 16); ksum[2] += bf2f(w.y & 0xffffu); ksum[3] += bf2f(w.y >> 16);
                        ksum[4] += bf2f(w.z & 0xffffu); ksum[5] += bf2f(w.z >> 16); ksum[6] += bf2f(w.w & 0xffffu); ksum[7] += bf2f(w.w >> 16); }
    }
    if (grp == 3) {
        LAS float* red = (LAS float*)lds;
        __syncthreads();
#pragma unroll
        for (int e = 0; e < 8; ++e) red[(wid * 64 + lane) * 8 + e] = ksum[e];
        __syncthreads();
        { const int ln = tid >> 3, e = tid & 7; float s = 0.f;
#pragma unroll
          for (int w = 0; w < 8; ++w) s += red[(w * 64 + ln) * 8 + e];
          const int h2 = ln >> 3, hf = (ln >> 2) & 1, jj = ln & 3;
          kmean[((size_t)((b * 8 + h2) * 8 + blk)) * 64 + hf * 32 + 8 * jj + e] = s * (1.0f / 256.0f); }
        __syncthreads();
    }
}
}
namespace rglru {
constexpr int TT = 32;
constexpr int LDS_WA = 0, LDS_WX = 16384, LDS_XC = 32768, LDS_A = LDS_XC + TT * 65 * 4, LDS_U = LDS_A + TT * 64 * 4, LDS_BYTES = LDS_U + TT * 64 * 4;
__device__ __forceinline__ void unit(int b, int n, const bf16_t* proj, bf16_t* yabc, const float* conv_w, const float* conv_b, const float* wa, const float* ba,
                                     const float* wx, const float* bx, const float* lam, LAS char* lds) {
    int tid_l = threadIdx.x; asm volatile("" : "+v"(tid_l));
    const int tid = tid_l;
    LAS float* Wa = (LAS float*)(lds + LDS_WA); LAS float* Wx = (LAS float*)(lds + LDS_WX); LAS float* XC = (LAS float*)(lds + LDS_XC);
    LAS float* AV = (LAS float*)(lds + LDS_A); LAS float* UV = (LAS float*)(lds + LDS_U);
    __syncthreads();
    for (int i = tid; i < 4096; i += 512) { Wa[i] = wa[(size_t)n * 4096 + i]; Wx[i] = wx[(size_t)n * 4096 + i]; }
    const int cc = tid & 63, ct = tid >> 6;
    const int ch = n * 64 + cc;
    const float cw0 = conv_w[0 * D + ch], cw1 = conv_w[1 * D + ch], cw2 = conv_w[2 * D + ch], cw3 = conv_w[3 * D + ch], cb = conv_b[ch];
    const int gt = tid >> 4, eq = tid & 15;
    float gba[4], gbx[4], gsp[4];
#pragma unroll
    for (int j = 0; j < 4; ++j) { const int e = n * 64 + eq * 4 + j; gba[j] = ba[e]; gbx[j] = bx[e]; const float x = -lam[e]; gsp[j] = fmaxf(x, 0.f) + log1pf(expf(-fabsf(x))); }
    float hstate = 0.f;
    const size_t rowb = (size_t)b * SEQ;
    __syncthreads();
    for (int t0 = 0; t0 < SEQ; t0 += TT) {
#pragma unroll
        for (int i = 0; i < 4; ++i) { const int tt = ct + 8 * i, t = t0 + tt;
            const bf16_t* p = proj + (rowb + t) * INC + C_XR + ch;
            float acc = cb + cw3 * bf2f(p[0]);
            if (t >= 1) acc += cw2 * bf2f(*(p - INC));
            if (t >= 2) acc += cw1 * bf2f(*(p - 2 * INC));
            if (t >= 3) acc += cw0 * bf2f(*(p - 3 * INC));
            XC[tt * 65 + cc] = acc; }
        __syncthreads();
        { f32x4 ar = {0.f, 0.f, 0.f, 0.f}, ai = {0.f, 0.f, 0.f, 0.f};
#pragma unroll 8
          for (int d = 0; d < 64; ++d) { const float xv = XC[gt * 65 + d]; ar += *(const LAS f32x4*)(Wa + d * 64 + eq * 4) * xv; ai += *(const LAS f32x4*)(Wx + d * 64 + eq * 4) * xv; }
#pragma unroll
          for (int j = 0; j < 4; ++j) { const int e = eq * 4 + j;
              const float rg = 1.0f / (1.0f + expf(-(ar[j] + gba[j]))), ig = 1.0f / (1.0f + expf(-(ai[j] + gbx[j])));
              const float log_a = -8.0f * rg * gsp[j]; const float a = expf(log_a); const float mult = sqrtf(-expm1f(2.0f * log_a));
              AV[gt * 64 + e] = a; UV[gt * 64 + e] = mult * ig * XC[gt * 65 + e]; } }
        __syncthreads();
        if (tid < 64) {
            for (int tt = 0; tt < TT; ++tt) { hstate = AV[tt * 64 + tid] * hstate + UV[tt * 64 + tid];
                const size_t row = rowb + t0 + tt;
                const float g = bf2f(proj[row * INC + C_GR + n * 64 + tid]);
                yabc[row * YW + Y_A + n * 64 + tid] = (bf16_t)f2bf(g * hstate); }
        }
        __syncthreads();
    }
}
}

namespace moe {
__device__ __forceinline__ void assign(const int* topi, const float* topw, int* rowtok, int* rowdst, float* roww, int* tile_e, int* ntiles, LAS int* sm) {
    const int tid = threadIdx.x, nthr = blockDim.x, per = M / nthr, t0 = tid * per;
    int cnt[NE];
#pragma unroll
    for (int e = 0; e < NE; ++e) cnt[e] = 0;
    for (int t = t0; t < t0 + per; ++t) { const int e0 = topi[2 * t], e1 = topi[2 * t + 1];
#pragma unroll
        for (int e = 0; e < NE; ++e) cnt[e] += (e0 == e) + (e1 == e); }
#pragma unroll
    for (int e = 0; e < NE; ++e) sm[e * nthr + tid] = cnt[e];
    __syncthreads();
    if (tid < NE) { int run = 0; for (int i = 0; i < nthr; ++i) { const int v = sm[tid * nthr + i]; sm[tid * nthr + i] = run; run += v; } sm[NE * nthr + tid] = run; }
    __syncthreads();
    if (tid == 0) { int p = 0, nt = 0;
        for (int e = 0; e < NE; ++e) { const int tot = sm[NE * nthr + e]; sm[NE * nthr + 8 + e] = p; const int nte = (tot + 255) >> 8; for (int i = 0; i < nte; ++i) tile_e[nt++] = e; p += nte * 256; }
        *ntiles = nt; }
    __syncthreads();
    for (int e = 0; e < NE; ++e) { const int tot = sm[NE * nthr + e], base = sm[NE * nthr + 8 + e], padded = ((tot + 255) >> 8) << 8;
        for (int i = tot + tid; i < padded; i += nthr) { rowtok[base + i] = 0; rowdst[base + i] = -1; roww[base + i] = 0.f; } }
    int pos[NE];
#pragma unroll
    for (int e = 0; e < NE; ++e) pos[e] = sm[NE * nthr + 8 + e] + sm[e * nthr + tid];
    for (int t = t0; t < t0 + per; ++t) {
#pragma unroll
        for (int k = 0; k < 2; ++k) { const int ek = topi[2 * t + k]; int p = 0;
#pragma unroll
            for (int e = 0; e < NE; ++e) { if (ek == e) { p = pos[e]; pos[e] = p + 1; } }
            rowtok[p] = t; rowdst[p] = k * M + t; roww[p] = topw[2 * t + k]; } }
}
struct Order {
    const int* tile_e; const int* ntiles_p; int nN, G, c, ntiles;
    __device__ __forceinline__ void dev_init(int G_, int c_) { G = G_; c = c_; ntiles = *ntiles_p; }
    __device__ __forceinline__ bool next(int i, pg8::Unit& u) const { const int L = i * G + c; if (L >= ntiles * nN) return false; u.pm = L / nN; u.pn = L % nN; u.e = tile_e[u.pm]; u.aux = 0; return true; }
};
struct ProbUp {
    static constexpr bool GATHER = true;
    const bf16_t* A; const bf16_t* Bt; const int* rowtok; int K, lda, ldb, pad;
    __device__ __forceinline__ const char* a_base(const pg8::Unit&) const { return (const char*)A; }
    __device__ __forceinline__ const char* b_base(const pg8::Unit& u) const { return (const char*)Bt + ((size_t)u.e * DFF2 + (size_t)u.pn * 256) * ldb * 2; }
    __device__ __forceinline__ unsigned a_off(const pg8::Unit& u, int row, int col) const { return (unsigned)(rowtok[u.pm * 256 + row] * lda + col) * 2u; }
};
struct ProbDown {
    static constexpr bool GATHER = false;
    const bf16_t* A; const bf16_t* Bt; int K, lda, ldb, pad;
    __device__ __forceinline__ const char* a_base(const pg8::Unit& u) const { return (const char*)A + (size_t)u.pm * 256 * lda * 2; }
    __device__ __forceinline__ const char* b_base(const pg8::Unit& u) const { return (const char*)Bt + ((size_t)u.e * D + (size_t)u.pn * 256) * ldb * 2; }
    __device__ __forceinline__ unsigned a_off(const pg8::Unit&, int row, int col) const { return (unsigned)(row * lda + col) * 2u; }
};
}
namespace rg2 {
constexpr int TT = 128, XS = 144  , FS = 36  ;
constexpr int L_XCB = 0, L_XCF = L_XCB + TT * XS, L_AV = L_XCF + TT * FS * 4, L_UV = L_AV + TT * FS * 4, L_WA = L_UV + TT * FS * 4, L_WX = L_WA + 32 * XS,
              L_CW = L_WX + 32 * XS, L_SEGA = L_CW + 5 * 64 * 4, L_SEGH = L_SEGA + 16 * 32 * 4, L_CARRY = L_SEGH + 16 * 32 * 4, LDS_BYTES = L_CARRY + 2 * 32 * 4;
__device__ __forceinline__ void unit(int b, int n, int hf, const bf16_t* proj, bf16_t* yabc, const float* conv_w, const float* conv_b, const float* wa, const float* ba,
                                     const float* wx, const float* bx, const float* lam, LAS char* lds) {
    int tid_l = threadIdx.x; asm volatile("" : "+v"(tid_l));
    const int tid = tid_l, lane = tid & 63, wid = tid >> 6;
    LAS float* XCF = (LAS float*)(lds + L_XCF); LAS float* AV = (LAS float*)(lds + L_AV); LAS float* UV = (LAS float*)(lds + L_UV);
    LAS float* CW = (LAS float*)(lds + L_CW); LAS float* SEGA = (LAS float*)(lds + L_SEGA); LAS float* SEGH = (LAS float*)(lds + L_SEGH); LAS float* CARRY = (LAS float*)(lds + L_CARRY);
    const int ch0 = n * 64;
    const int oc0 = ch0 + hf * 32;
    __syncthreads();
    for (int i = tid; i < 2048; i += 512) { const int d = i >> 5, e = i & 31;
        *(LAS bf16_t*)(lds + L_WA + e * XS + d * 2) = (bf16_t)f2bf(wa[(size_t)n * 4096 + d * 64 + hf * 32 + e]);
        *(LAS bf16_t*)(lds + L_WX + e * XS + d * 2) = (bf16_t)f2bf(wx[(size_t)n * 4096 + d * 64 + hf * 32 + e]); }
    if (tid < 320) { const int k = tid >> 6, c = tid & 63; CW[tid] = (k < 4) ? conv_w[k * D + ch0 + c] : conv_b[ch0 + c]; }
    if (tid < 64) CARRY[tid] = 0.f;
    const int crow_ = tid >> 2, cg = tid & 3;
    const int mt = wid & 3, chh = wid >> 2;
    const int g4 = lane >> 4, e16 = lane & 15;
    const int eo = chh * 16 + e16;
    const float gba = ba[oc0 + eo], gbx = bx[oc0 + eo];
    float gsp; { const float x = -lam[oc0 + eo]; gsp = fmaxf(x, 0.f) + log1pf(expf(-fabsf(x))); }
    const int sc = tid & 31, ss = tid >> 5;
    const size_t rowb = (size_t)b * SEQ;
    const bf16_t* xbase = proj + rowb * INC + C_XR + ch0 + cg * 16;
    const bf16_t* gbase = proj + rowb * INC + C_GR + oc0 + sc;
    bf16_t* ybase = yabc + rowb * YW + Y_A + oc0 + sc;
    u32x4 xr[4][2]; unsigned short gv[8];
#define RG2_LOADX(T0) do { _Pragma("unroll") for (int k = 0; k < 4; ++k) { const int t = (T0) + crow_ - 3 + k; \
        if (t >= 0) { const bf16_t* p = xbase + (size_t)t * INC; xr[k][0] = *(const u32x4*)p; xr[k][1] = *(const u32x4*)(p + 8); } \
        else { xr[k][0] = (u32x4){0u, 0u, 0u, 0u}; xr[k][1] = (u32x4){0u, 0u, 0u, 0u}; } } } while (0)
    RG2_LOADX(0);
    __syncthreads();
    for (int ti = 0; ti < SEQ / TT; ++ti) {
        const int t0 = ti * TT;
        {
            float xc[16];
#pragma unroll
            for (int j = 0; j < 16; ++j) xc[j] = CW[4 * 64 + cg * 16 + j];
#pragma unroll
            for (int k = 0; k < 4; ++k) {
#pragma unroll
                for (int q = 0; q < 2; ++q) { const u32x4 w = xr[k][q]; const unsigned ww[4] = {w.x, w.y, w.z, w.w};
#pragma unroll
                    for (int j = 0; j < 4; ++j) { const int c = q * 8 + 2 * j;
                        xc[c] += CW[k * 64 + cg * 16 + c] * bf2f(ww[j] & 0xffffu); xc[c + 1] += CW[k * 64 + cg * 16 + c + 1] * bf2f(ww[j] >> 16); } } }
            u32x4 o0, o1;
            o0.x = pk2(xc[0], xc[1]); o0.y = pk2(xc[2], xc[3]); o0.z = pk2(xc[4], xc[5]); o0.w = pk2(xc[6], xc[7]);
            o1.x = pk2(xc[8], xc[9]); o1.y = pk2(xc[10], xc[11]); o1.z = pk2(xc[12], xc[13]); o1.w = pk2(xc[14], xc[15]);
            *(LAS u32x4*)(lds + L_XCB + crow_ * XS + cg * 32) = o0; *(LAS u32x4*)(lds + L_XCB + crow_ * XS + cg * 32 + 16) = o1;
            if ((cg >> 1) == hf) { LAS float* d = XCF + crow_ * FS + (cg & 1) * 16;
#pragma unroll
                for (int j = 0; j < 4; ++j) *(LAS f32x4*)(d + 4 * j) = (f32x4){xc[4 * j], xc[4 * j + 1], xc[4 * j + 2], xc[4 * j + 3]}; }
        }
#pragma unroll
        for (int k = 0; k < 8; ++k) gv[k] = gbase[(size_t)(t0 + ss * 8 + k) * INC];
        __syncthreads();
        if (ti + 1 < SEQ / TT) RG2_LOADX(t0 + TT);
        {
            f32x4 ar[2], ai[2];
#pragma unroll
            for (int s = 0; s < 2; ++s) { ar[s] = (f32x4){0.f, 0.f, 0.f, 0.f}; ai[s] = (f32x4){0.f, 0.f, 0.f, 0.f}; }
#pragma unroll
            for (int kk = 0; kk < 2; ++kk) {
                const bf16x8 bwa = *(const LAS bf16x8*)(lds + L_WA + eo * XS + (32 * kk + 8 * g4) * 2);
                const bf16x8 bwx = *(const LAS bf16x8*)(lds + L_WX + eo * XS + (32 * kk + 8 * g4) * 2);
#pragma unroll
                for (int s = 0; s < 2; ++s) {
                    const bf16x8 av = *(const LAS bf16x8*)(lds + L_XCB + (mt * 32 + 16 * s + e16) * XS + (32 * kk + 8 * g4) * 2);
                    ar[s] = __builtin_amdgcn_mfma_f32_16x16x32_bf16(av, bwa, ar[s], 0, 0, 0);
                    ai[s] = __builtin_amdgcn_mfma_f32_16x16x32_bf16(av, bwx, ai[s], 0, 0, 0);
                }
            }
#pragma unroll
            for (int s = 0; s < 2; ++s)
#pragma unroll
                for (int rg = 0; rg < 4; ++rg) {
                    const int tok = mt * 32 + 16 * s + 4 * g4 + rg;
                    const float rgt = sigmoid_f(ar[s][rg] + gba), igt = sigmoid_f(ai[s][rg] + gbx);
                    const float log_a = -8.0f * rgt * gsp;
                    const float a = fexp2(log_a * 1.4426950408889634f);
                    const float z = 2.0f * log_a;
                    const float poly = z * (1.0f + z * (0.5f + z * (0.16666667f + z * (0.041666668f + z * (0.0083333338f + z * 0.0013888889f)))));
                    const float om = (z > -0.25f) ? -poly : (1.0f - a * a);
                    const float u = sqrtf(om) * igt * XCF[tok * FS + eo];
                    AV[tok * FS + eo] = a; UV[tok * FS + eo] = u;
                }
        }
        __syncthreads();
        float hl[8], ac[8];
        { float Hh = 0.f, Aa = 1.f;
#pragma unroll
          for (int k = 0; k < 8; ++k) { const float a = AV[(ss * 8 + k) * FS + sc], u = UV[(ss * 8 + k) * FS + sc]; Hh = a * Hh + u; Aa *= a; hl[k] = Hh; ac[k] = Aa; }
          SEGA[ss * 32 + sc] = Aa; SEGH[ss * 32 + sc] = Hh; }
        __syncthreads();
        { float cin = CARRY[(ti & 1) * 32 + sc];
          for (int s2 = 0; s2 < ss; ++s2) cin = SEGA[s2 * 32 + sc] * cin + SEGH[s2 * 32 + sc];
#pragma unroll
          for (int k = 0; k < 8; ++k) { const float hv = hl[k] + ac[k] * cin; hl[k] = hv;
              ybase[(size_t)(t0 + ss * 8 + k) * YW] = (bf16_t)f2bf(bf2f(gv[k]) * hv); }
          if (ss == 15) CARRY[((ti + 1) & 1) * 32 + sc] = hl[7]; }
    }
    __syncthreads();
#undef RG2_LOADX
}
}
constexpr size_t MiB = 1u << 20;
constexpr size_t WS_CTL = 0, CTL_ZERO_BYTES = 64 * 1024, WS_ROWTOK = 256 * 1024, WS_ROWDST = 400 * 1024, WS_ROWW = 544 * 1024, WS_TILEE = 700 * 1024, WS_NTILES = 702 * 1024;
constexpr size_t WS_MOD = 1 * MiB, WS_CS = 1 * MiB + 512 * 1024, WS_KMEAN = 5 * MiB + 512 * 1024, WS_TOPI = 5 * MiB + 640 * 1024, WS_TOPW = 5 * MiB + 768 * 1024;
constexpr size_t WS_L1W = 6 * MiB, WS_H = 28 * MiB, WS_YABC = 60 * MiB, WS_PROJ = 124 * MiB, WS_XA = 380 * MiB, WS_END = 444 * MiB;
constexpr size_t WS_MOEW13 = 6 * MiB, WS_MOEW2 = 94 * MiB, WS_HMID_MOE = 138 * MiB, WS_YSLOT = 325 * MiB, WS_H2L1 = 412 * MiB;
constexpr size_t LW_IN = 0, LW_BRA = 16 * MiB, LW_BRB = 18 * MiB, LW_BRC = 19 * MiB, LW_OUT = 20 * MiB, LW_W13 = 22 * MiB, LW_W2 = 33 * MiB;
constexpr int CW_TMO = 0, CW_QUEUE = 64  , CW_BAR = 4096;
constexpr int LDS_MISC = 131072 + 8192, LDS_TOTAL = 147456;


#define XB_TMO      128
#define XB_XCNT(j)  (256  + 64 * (j))
#define XB_XSUB(j)  (1280 + 64 * (j))
#define XB_XGEN(j)  (2304 + 64 * (j))
#define XB_TOP      3328
#define XB_TOPGEN   3392
#define XCD_BAR_WORDS 3456
#define XB_SPIN_CAP (1u << 18)

__device__ __forceinline__ unsigned xb_ld(unsigned* p)              { return __hip_atomic_load(p, __ATOMIC_RELAXED, __HIP_MEMORY_SCOPE_AGENT); }
__device__ __forceinline__ unsigned xb_add(unsigned* p, unsigned v) { return __hip_atomic_fetch_add(p, v, __ATOMIC_RELAXED, __HIP_MEMORY_SCOPE_AGENT); }
__device__ __forceinline__ unsigned xb_xcc_id() { return (unsigned)__builtin_amdgcn_s_getreg((3 << 11) | 20) & 0xFu; }
#define XB_SPIN(cond, bar) do { unsigned _sp = 0; while (cond) { __builtin_amdgcn_s_sleep(1); \
    if ((++_sp & 255u) == 0u) { if (xb_ld(&(bar)[XB_TMO])) break; if (_sp > XB_SPIN_CAP) { atomicAdd(&(bar)[XB_TMO], 1u); break; } } } } while (0)

struct XcdBarrier {
    unsigned* bar; unsigned x;
    volatile LAS unsigned* st;
};

__device__ __forceinline__ XcdBarrier xcd_barrier_post(unsigned* bar, volatile LAS unsigned* st) {
    XcdBarrier b; b.bar = bar; b.x = xb_xcc_id(); b.st = st;
    if (threadIdx.x == 0) (void)xb_add(&bar[XB_XCNT(b.x)], 1u);
    return b;
}
__device__ __forceinline__ void xcd_barrier_complete(unsigned* bar, unsigned x, unsigned& nloc, unsigned& nx) {
    const unsigned G = gridDim.x * gridDim.y * gridDim.z;
    unsigned sum, cnt, mine, sp = 0u;
    for (;;) {
        sum = 0u; cnt = 0u; mine = 0u;
#pragma unroll
        for (unsigned j = 0; j < 16; ++j) { const unsigned c = xb_ld(&bar[XB_XCNT(j)]); sum += c; cnt += (c > 0u) ? 1u : 0u; mine = (j == x) ? c : mine; }
        if (sum == G) break;
        __builtin_amdgcn_s_sleep(1);
        if ((++sp & 255u) == 0u) { if (xb_ld(&bar[XB_TMO])) break; if (sp > XB_SPIN_CAP) { atomicAdd(&bar[XB_TMO], 1u); break; } }
    }
    nloc = mine > 0u ? mine : 1u; nx = cnt > 0u ? cnt : 1u;
}

__device__ __forceinline__ void xcd_barrier(const XcdBarrier& b) {
    asm volatile("s_waitcnt vmcnt(0)" ::: "memory");
    __syncthreads();
    if (threadIdx.x == 0) {
        unsigned* bar = b.bar;
        __builtin_amdgcn_s_waitcnt(0);
        unsigned nloc = b.st[0], nx = b.st[1];
        if (nloc == 0u) { xcd_barrier_complete(bar, b.x, nloc, nx); b.st[0] = nloc; b.st[1] = nx; }
        const unsigned old = xb_add(&bar[XB_XSUB(b.x)], 1u);
        const unsigned gen = old / nloc;
        if (old + 1u == (gen + 1u) * nloc) {
            __builtin_amdgcn_fence(__ATOMIC_RELEASE, "agent");
            asm volatile("s_waitcnt vmcnt(0)" ::: "memory");
            const unsigned og = xb_add(&bar[XB_TOP], 1u);
            const unsigned tg = og / nx;
            if (og + 1u == (tg + 1u) * nx) xb_add(&bar[XB_TOPGEN], 1u);
            else XB_SPIN(xb_ld(&bar[XB_TOPGEN]) == tg, bar);
            __builtin_amdgcn_fence(__ATOMIC_ACQUIRE, "agent");
            xb_add(&bar[XB_XGEN(b.x)], 1u);
            asm volatile("s_waitcnt vmcnt(0)" ::: "memory");
        } else {
            XB_SPIN(xb_ld(&bar[XB_XGEN(b.x)]) == gen, bar);
            __builtin_amdgcn_fence(__ATOMIC_ACQUIRE, "agent");
            asm volatile("s_waitcnt vmcnt(0)" ::: "memory");
        }
    }
    __syncthreads();
}


#ifndef PHMASK
#define PHMASK 0xFFFFF
#endif
#define PH(k) if constexpr ((PHMASK >> (k)) & 1)
__device__ __forceinline__ const float* ldptr(const LAS unsigned long long* PT, int i) {
    const unsigned long long v = PT[i];
    const unsigned lo = __builtin_amdgcn_readfirstlane((unsigned)v), hi = __builtin_amdgcn_readfirstlane((unsigned)(v >> 32));
    return (const float*)(const __attribute__((address_space(1))) float*)(((unsigned long long)hi << 32) | lo);
}
struct Args { const float* in[37]; float* out; unsigned char* ws; };

__device__ __forceinline__ float diff_lambda(const float* lq1, const float* lk1, const float* lq2, const float* lk2, float lam_init) {
    float s1 = 0.f, s2 = 0.f; for (int i = 0; i < 64; ++i) { s1 += lq1[i] * lk1[i]; s2 += lq2[i] * lk2[i]; } return expf(s1) - expf(s2) + lam_init; }

constexpr int NQ_RG = 256, NQ_TOTAL = 256 + 256 + 512;
__global__ void __launch_bounds__(512, 2) mega_fwd(Args a) {
    extern __shared__ __attribute__((aligned(16))) unsigned char lds_raw[];
    LAS unsigned char* lds = (LAS unsigned char*)lds_raw;
    volatile LAS unsigned* MISC = (volatile LAS unsigned*)(lds + LDS_MISC);
    const int tid0 = threadIdx.x, lane0 = tid0 & 63, wid0 = __builtin_amdgcn_readfirstlane(tid0 >> 6);
    const int G = gridDim.x, bid = blockIdx.x;
    if (tid0 < 64) MISC[tid0] = 0u;
    LAS unsigned long long* PT = (LAS unsigned long long*)(lds + LDS_MISC + 256);
    if (tid0 == 0) {
#pragma unroll
        for (int i = 0; i < 37; ++i) PT[i] = (unsigned long long)a.in[i];
    }
    __syncthreads();
    XcdBarrier bar = xcd_barrier_post((unsigned*)(a.ws + WS_CTL) + CW_BAR, MISC + 8);
#define F(i) ldptr(PT, (i))
#define PHASE_VARS(lv) \
    unsigned long long ws_u = (unsigned long long)a.ws, out_u = (unsigned long long)a.out; const int l = (lv); int lane = lane0; int tid = tid0; int wid = wid0; \
    asm volatile("" : "+s"(ws_u), "+s"(out_u), "+v"(lane), "+v"(tid), "+s"(wid)); \
    unsigned char* ws = (unsigned char*)(__attribute__((address_space(1))) unsigned char*)ws_u; float* outp = (float*)(__attribute__((address_space(1))) float*)out_u; \
    const int gw = bid * 8 + wid, ngw = G * 8, gtid = bid * 512 + tid, ngt = G * 512; (void)gw; (void)ngw; (void)gtid; (void)ngt; (void)lane; (void)l; \
    char* outb = (char*)outp; (void)outb; \
    float* mod = (float*)(ws + WS_MOD); f32x2* cs = (f32x2*)(ws + WS_CS); float* kmean = (float*)(ws + WS_KMEAN); (void)mod; (void)cs; (void)kmean; \
    bf16_t* H = (bf16_t*)(ws + WS_H); bf16_t* YABC = (bf16_t*)(ws + WS_YABC); bf16_t* PROJ = (bf16_t*)(ws + WS_PROJ); float* XA = (float*)(ws + WS_XA); (void)H; (void)YABC; (void)PROJ; (void)XA; \
    const float* xin = (l == 0) ? F(0) : (const float*)XA; float* x1 = (l == 0) ? XA : outp; const char* lwb = (l == 0) ? (const char*)outb : (const char*)ws + WS_L1W; \
    const float* modl = mod + (size_t)l * NB * 6 * D; (void)xin; (void)x1; (void)lwb; (void)modl;

    PH(0) { PHASE_VARS(0)
        LAS float* scr = (LAS float*)(lds + wid * 8448);
#pragma unroll 1
        for (int ll = 0; ll < 2; ++ll) {
            char* lw2 = ll == 0 ? outb : (char*)ws + WS_L1W;
            thin::transpose_matrix(F(7) + (size_t)ll * D * INC, D, INC, (bf16_t*)(lw2 + LW_IN), 0, 0, scr, gw, ngw, lane);
            thin::transpose_matrix(F(25) + (size_t)ll * D * D, D, D, (bf16_t*)(lw2 + LW_BRA), 0, 0, scr, gw, ngw, lane);
            thin::transpose_matrix(F(26) + (size_t)ll * 512 * D, 512, D, (bf16_t*)(lw2 + LW_BRB), 0, 0, scr, gw, ngw, lane);
            thin::transpose_matrix(F(27) + (size_t)ll * 512 * D, 512, D, (bf16_t*)(lw2 + LW_BRC), 0, 0, scr, gw, ngw, lane);
            thin::transpose_matrix(F(28) + (size_t)ll * D * D, D, D, (bf16_t*)(lw2 + LW_OUT), 0, 0, scr, gw, ngw, lane);
        }
        thin::transpose_matrix(F(29), D, DFF, (bf16_t*)(outb + LW_W13), 0, 1, scr, gw, ngw, lane);
        thin::transpose_matrix(F(30), D, DFF, (bf16_t*)(outb + LW_W13), 0, 2, scr, gw, ngw, lane);
        thin::transpose_matrix(F(31), DFF, D, (bf16_t*)(outb + LW_W2), 0, 0, scr, gw, ngw, lane);
        thin::mod_body(F(1), F(3), F(4), mod, gtid, ngt);
        thin::rope_body((const int*)F(2), cs, gtid, ngt);
    }
    xcd_barrier(bar);

    {
        PH(1) { PHASE_VARS(0) thin::norm_body(xin, F(5) + l * D, modl + 0 * D, modl + 1 * D, H, gw, ngw, lane); }
        xcd_barrier(bar);
        PH(2) { PHASE_VARS(0) pg8::DenseProb g{H, (const bf16_t*)(lwb + LW_IN), D, D, D, 0}; pg8::StaticOrder S; S.init(M, INC, G, bid);
          pg8::gemm_phase<pg8::DenseProb, epi::Proj, pg8::StaticOrder, true>(lds, g, S, epi::Proj{PROJ, F(8) + l * 3 * D}); }
        xcd_barrier(bar);
        PH(3) { PHASE_VARS(0) for (int u = bid; u < 256; u += G) { const int grp = u & 3;
            qk::unit(u >> 5, (u >> 2) & 7, grp, PROJ, cs, (grp == 0 ? F(16) : grp == 1 ? F(17) : grp == 2 ? F(23) : F(24)) + l * 64, kmean, (LAS char*)lds); } }
        xcd_barrier(bar);
        {
#define POP_Q() do { __syncthreads(); if (tid == 0) MISC[16] = __hip_atomic_fetch_add((unsigned*)(ws + WS_CTL) + CW_QUEUE + 64 * l, 1u, __ATOMIC_RELAXED, __HIP_MEMORY_SCOPE_AGENT); __syncthreads(); q = (int)MISC[16]; } while (0)
            int q;
            { PHASE_VARS(0) POP_Q(); }
            PH(4) { PHASE_VARS(0)
#pragma unroll 1
              while (q < NQ_RG) {
                rg2::unit(q >> 5, (q >> 1) & 15, q & 1, PROJ, YABC, F(9) + l * 4 * D, F(10) + l * D, F(11) + (size_t)l * 16 * 4096, F(12) + l * D, F(13) + (size_t)l * 16 * 4096, F(14) + l * D, F(15) + l * D, (LAS char*)lds);
                POP_Q(); } }
            PH(5) { PHASE_VARS(0)
              const float lam_init = 0.8f - 0.6f * expf(-0.3f * (float)l);
              const float lam = diff_lambda(F(18) + l * 64, F(19) + l * 64, F(20) + l * 64, F(21) + l * 64, lam_init);
#pragma unroll 1
              while (q < NQ_RG + 256) { const int i = q - NQ_RG;
                attn::diff_unit((i & 31) >> 2, i & 3, 7 - (i >> 5), PROJ, YABC, F(22) + l * 128, lam, 1.0f - lam_init, (LAS char*)lds);
                POP_Q(); } }
            PH(6) { PHASE_VARS(0)
#pragma unroll 1
              while (q < NQ_TOTAL) { const int i = q - NQ_RG - 256;
                attn::moba_unit((i & 63) >> 3, i & 7, 7 - (i >> 6), PROJ, YABC, kmean, (LAS char*)lds);
                POP_Q(); } }
#undef POP_Q
        }
        xcd_barrier(bar);
        PH(7) { { PHASE_VARS(0) pg8::StaticOrder S; S.init(M, D, G, bid); pg8::DenseProb g{YABC + Y_A, (const bf16_t*)(lwb + LW_BRA), D, YW, D, 0}; pg8::gemm_phase<pg8::DenseProb, epi::Branch<0>, pg8::StaticOrder, true>(lds, g, S, epi::Branch<0>{PROJ, x1, H}); }
                { PHASE_VARS(0) pg8::StaticOrder S; S.init(M, D, G, bid); pg8::DenseProb g{YABC + Y_B, (const bf16_t*)(lwb + LW_BRB), 512, YW, 512, 0}; pg8::gemm_phase<pg8::DenseProb, epi::Branch<1>, pg8::StaticOrder, true>(lds, g, S, epi::Branch<1>{PROJ, x1, H}); }
                { PHASE_VARS(0) pg8::StaticOrder S; S.init(M, D, G, bid); pg8::DenseProb g{YABC + Y_C, (const bf16_t*)(lwb + LW_BRC), 512, YW, 512, 0}; pg8::gemm_phase<pg8::DenseProb, epi::Branch<2>, pg8::StaticOrder, true>(lds, g, S, epi::Branch<2>{PROJ, x1, H}); } }
        xcd_barrier(bar);
        PH(8) { PHASE_VARS(0) pg8::DenseProb g{H, (const bf16_t*)(lwb + LW_OUT), D, D, D, 0}; pg8::StaticOrder S; S.init(M, D, G, bid);
          pg8::gemm_phase<pg8::DenseProb, epi::Resid, pg8::StaticOrder, true>(lds, g, S, epi::Resid{xin, x1, modl + 2 * D}); }
        xcd_barrier(bar);
        if (0 == 0) {
            PH(9) { PHASE_VARS(0) thin::norm_body(x1, F(6) + l * D, modl + 3 * D, modl + 4 * D, H, gw, ngw, lane); }
            xcd_barrier(bar);
            PH(10) { PHASE_VARS(0) pg8::DenseProb g{H, (const bf16_t*)(lwb + LW_W13), D, D, D, 0}; pg8::StaticOrder S; S.init(M, DFF2, G, bid);
              pg8::gemm_phase<pg8::DenseProb, epi::SwiGLU, pg8::StaticOrder, true>(lds, g, S, epi::SwiGLU{PROJ}); }
            xcd_barrier(bar);
            PH(11) { PHASE_VARS(0) pg8::DenseProb g{PROJ, (const bf16_t*)(lwb + LW_W2), DFF, DFF, DFF, 0}; pg8::StaticOrder S; S.init(M, D, G, bid);
              pg8::gemm_phase<pg8::DenseProb, epi::Resid, pg8::StaticOrder, true>(lds, g, S, epi::Resid{x1, x1, modl + 5 * D}); }
            xcd_barrier(bar);
        } else {
#define MOE_VARS \
            bf16_t* W13 = (bf16_t*)(ws + WS_MOEW13); bf16_t* W2 = (bf16_t*)(ws + WS_MOEW2); bf16_t* h2 = (bf16_t*)(ws + WS_H2L1); bf16_t* hmid = (bf16_t*)(ws + WS_HMID_MOE); bf16_t* yslot = (bf16_t*)(ws + WS_YSLOT); \
            int* topi = (int*)(ws + WS_TOPI); float* topw = (float*)(ws + WS_TOPW); int* rowtok = (int*)(ws + WS_ROWTOK); int* rowdst = (int*)(ws + WS_ROWDST); float* roww = (float*)(ws + WS_ROWW); int* tile_e = (int*)(ws + WS_TILEE); int* ntiles = (int*)(ws + WS_NTILES); \
            (void)W13; (void)W2; (void)h2; (void)hmid; (void)yslot; (void)topi; (void)topw; (void)rowtok; (void)rowdst; (void)roww; (void)tile_e; (void)ntiles;
            PH(12) { PHASE_VARS(0) MOE_VARS thin::norm_router_body(x1, F(6) + l * D, modl + 3 * D, modl + 4 * D, h2, F(32), F(33), topi, topw, gw, ngw, lane); }
            PH(13) { PHASE_VARS(0) MOE_VARS LAS float* scr = (LAS float*)(lds + wid * 8448);
#pragma unroll 1
              for (int e = 0; e < NE; ++e) {
                thin::transpose_matrix(F(34) + (size_t)e * D * DFF, D, DFF, W13, e * DFF2, 1, scr, gw, ngw, lane);
                thin::transpose_matrix(F(35) + (size_t)e * D * DFF, D, DFF, W13, e * DFF2, 2, scr, gw, ngw, lane);
                thin::transpose_matrix(F(36) + (size_t)e * DFF * D, DFF, D, W2, e * D, 0, scr, gw, ngw, lane); } }
            xcd_barrier(bar);
            PH(14) { PHASE_VARS(0) MOE_VARS if (bid == 0) moe::assign(topi, topw, rowtok, rowdst, roww, tile_e, ntiles, (LAS int*)lds); }
            xcd_barrier(bar);
            PH(15) { PHASE_VARS(0) MOE_VARS moe::Order S{tile_e, ntiles, DFF2 / 256, 0, 0, 0}; S.dev_init(G, bid);
              pg8::gemm_phase<moe::ProbUp, epi::SwiGLU, moe::Order, true>(lds, moe::ProbUp{h2, W13, rowtok, D, D, D, 0}, S, epi::SwiGLU{hmid}); }
            xcd_barrier(bar);
            PH(16) { PHASE_VARS(0) MOE_VARS moe::Order S{tile_e, ntiles, D / 256, 0, 0, 0}; S.dev_init(G, bid);
              pg8::gemm_phase<moe::ProbDown, epi::MoeDown, moe::Order, true>(lds, moe::ProbDown{hmid, W2, DFF, DFF, DFF, 0}, S, epi::MoeDown{rowdst, roww, yslot}); }
            xcd_barrier(bar);
            PH(17) { PHASE_VARS(0) MOE_VARS thin::moe_combine_body(x1, yslot, modl + 5 * D, outp, gtid, ngt); }
#undef MOE_VARS
        }
    }
    {
        PH(1) { PHASE_VARS(1) thin::norm_body(xin, F(5) + l * D, modl + 0 * D, modl + 1 * D, H, gw, ngw, lane); }
        xcd_barrier(bar);
        PH(2) { PHASE_VARS(1) pg8::DenseProb g{H, (const bf16_t*)(lwb + LW_IN), D, D, D, 0}; pg8::StaticOrder S; S.init(M, INC, G, bid);
          pg8::gemm_phase<pg8::DenseProb, epi::Proj, pg8::StaticOrder, true>(lds, g, S, epi::Proj{PROJ, F(8) + l * 3 * D}); }
        xcd_barrier(bar);
        PH(3) { PHASE_VARS(1) for (int u = bid; u < 256; u += G) { const int grp = u & 3;
            qk::unit(u >> 5, (u >> 2) & 7, grp, PROJ, cs, (grp == 0 ? F(16) : grp == 1 ? F(17) : grp == 2 ? F(23) : F(24)) + l * 64, kmean, (LAS char*)lds); } }
        xcd_barrier(bar);
        {
#define POP_Q() do { __syncthreads(); if (tid == 0) MISC[16] = __hip_atomic_fetch_add((unsigned*)(ws + WS_CTL) + CW_QUEUE + 64 * l, 1u, __ATOMIC_RELAXED, __HIP_MEMORY_SCOPE_AGENT); __syncthreads(); q = (int)MISC[16]; } while (0)
            int q;
            { PHASE_VARS(1) POP_Q(); }
            PH(4) { PHASE_VARS(1)
#pragma unroll 1
              while (q < NQ_RG) {
                rg2::unit(q >> 5, (q >> 1) & 15, q & 1, PROJ, YABC, F(9) + l * 4 * D, F(10) + l * D, F(11) + (size_t)l * 16 * 4096, F(12) + l * D, F(13) + (size_t)l * 16 * 4096, F(14) + l * D, F(15) + l * D, (LAS char*)lds);
                POP_Q(); } }
            PH(5) { PHASE_VARS(1)
              const float lam_init = 0.8f - 0.6f * expf(-0.3f * (float)l);
              const float lam = diff_lambda(F(18) + l * 64, F(19) + l * 64, F(20) + l * 64, F(21) + l * 64, lam_init);
#pragma unroll 1
              while (q < NQ_RG + 256) { const int i = q - NQ_RG;
                attn::diff_unit((i & 31) >> 2, i & 3, 7 - (i >> 5), PROJ, YABC, F(22) + l * 128, lam, 1.0f - lam_init, (LAS char*)lds);
                POP_Q(); } }
            PH(6) { PHASE_VARS(1)
#pragma unroll 1
              while (q < NQ_TOTAL) { const int i = q - NQ_RG - 256;
                attn::moba_unit((i & 63) >> 3, i & 7, 7 - (i >> 6), PROJ, YABC, kmean, (LAS char*)lds);
                POP_Q(); } }
#undef POP_Q
        }
        xcd_barrier(bar);
        PH(7) { { PHASE_VARS(1) pg8::StaticOrder S; S.init(M, D, G, bid); pg8::DenseProb g{YABC + Y_A, (const bf16_t*)(lwb + LW_BRA), D, YW, D, 0}; pg8::gemm_phase<pg8::DenseProb, epi::Branch<0>, pg8::StaticOrder, true>(lds, g, S, epi::Branch<0>{PROJ, x1, H}); }
                { PHASE_VARS(1) pg8::StaticOrder S; S.init(M, D, G, bid); pg8::DenseProb g{YABC + Y_B, (const bf16_t*)(lwb + LW_BRB), 512, YW, 512, 0}; pg8::gemm_phase<pg8::DenseProb, epi::Branch<1>, pg8::StaticOrder, true>(lds, g, S, epi::Branch<1>{PROJ, x1, H}); }
                { PHASE_VARS(1) pg8::StaticOrder S; S.init(M, D, G, bid); pg8::DenseProb g{YABC + Y_C, (const bf16_t*)(lwb + LW_BRC), 512, YW, 512, 0}; pg8::gemm_phase<pg8::DenseProb, epi::Branch<2>, pg8::StaticOrder, true>(lds, g, S, epi::Branch<2>{PROJ, x1, H}); } }
        xcd_barrier(bar);
        PH(8) { PHASE_VARS(1) pg8::DenseProb g{H, (const bf16_t*)(lwb + LW_OUT), D, D, D, 0}; pg8::StaticOrder S; S.init(M, D, G, bid);
          pg8::gemm_phase<pg8::DenseProb, epi::Resid, pg8::StaticOrder, true>(lds, g, S, epi::Resid{xin, x1, modl + 2 * D}); }
        xcd_barrier(bar);
        if (1 == 0) {
            PH(9) { PHASE_VARS(1) thin::norm_body(x1, F(6) + l * D, modl + 3 * D, modl + 4 * D, H, gw, ngw, lane); }
            xcd_barrier(bar);
            PH(10) { PHASE_VARS(1) pg8::DenseProb g{H, (const bf16_t*)(lwb + LW_W13), D, D, D, 0}; pg8::StaticOrder S; S.init(M, DFF2, G, bid);
              pg8::gemm_phase<pg8::DenseProb, epi::SwiGLU, pg8::StaticOrder, true>(lds, g, S, epi::SwiGLU{PROJ}); }
            xcd_barrier(bar);
            PH(11) { PHASE_VARS(1) pg8::DenseProb g{PROJ, (const bf16_t*)(lwb + LW_W2), DFF, DFF, DFF, 0}; pg8::StaticOrder S; S.init(M, D, G, bid);
              pg8::gemm_phase<pg8::DenseProb, epi::Resid, pg8::StaticOrder, true>(lds, g, S, epi::Resid{x1, x1, modl + 5 * D}); }
            xcd_barrier(bar);
        } else {
#define MOE_VARS \
            bf16_t* W13 = (bf16_t*)(ws + WS_MOEW13); bf16_t* W2 = (bf16_t*)(ws + WS_MOEW2); bf16_t* h2 = (bf16_t*)(ws + WS_H2L1); bf16_t* hmid = (bf16_t*)(ws + WS_HMID_MOE); bf16_t* yslot = (bf16_t*)(ws + WS_YSLOT); \
            int* topi = (int*)(ws + WS_TOPI); float* topw = (float*)(ws + WS_TOPW); int* rowtok = (int*)(ws + WS_ROWTOK); int* rowdst = (int*)(ws + WS_ROWDST); float* roww = (float*)(ws + WS_ROWW); int* tile_e = (int*)(ws + WS_TILEE); int* ntiles = (int*)(ws + WS_NTILES); \
            (void)W13; (void)W2; (void)h2; (void)hmid; (void)yslot; (void)topi; (void)topw; (void)rowtok; (void)rowdst; (void)roww; (void)tile_e; (void)ntiles;
            PH(12) { PHASE_VARS(1) MOE_VARS thin::norm_router_body(x1, F(6) + l * D, modl + 3 * D, modl + 4 * D, h2, F(32), F(33), topi, topw, gw, ngw, lane); }
            PH(13) { PHASE_VARS(1) MOE_VARS LAS float* scr = (LAS float*)(lds + wid * 8448);
#pragma unroll 1
              for (int e = 0; e < NE; ++e) {
                thin::transpose_matrix(F(34) + (size_t)e * D * DFF, D, DFF, W13, e * DFF2, 1, scr, gw, ngw, lane);
                thin::transpose_matrix(F(35) + (size_t)e * D * DFF, D, DFF, W13, e * DFF2, 2, scr, gw, ngw, lane);
                thin::transpose_matrix(F(36) + (size_t)e * DFF * D, DFF, D, W2, e * D, 0, scr, gw, ngw, lane); } }
            xcd_barrier(bar);
            PH(14) { PHASE_VARS(1) MOE_VARS if (bid == 0) moe::assign(topi, topw, rowtok, rowdst, roww, tile_e, ntiles, (LAS int*)lds); }
            xcd_barrier(bar);
            PH(15) { PHASE_VARS(1) MOE_VARS moe::Order S{tile_e, ntiles, DFF2 / 256, 0, 0, 0}; S.dev_init(G, bid);
              pg8::gemm_phase<moe::ProbUp, epi::SwiGLU, moe::Order, true>(lds, moe::ProbUp{h2, W13, rowtok, D, D, D, 0}, S, epi::SwiGLU{hmid}); }
            xcd_barrier(bar);
            PH(16) { PHASE_VARS(1) MOE_VARS moe::Order S{tile_e, ntiles, D / 256, 0, 0, 0}; S.dev_init(G, bid);
              pg8::gemm_phase<moe::ProbDown, epi::MoeDown, moe::Order, true>(lds, moe::ProbDown{hmid, W2, DFF, DFF, DFF, 0}, S, epi::MoeDown{rowdst, roww, yslot}); }
            xcd_barrier(bar);
            PH(17) { PHASE_VARS(1) MOE_VARS thin::moe_combine_body(x1, yslot, modl + 5 * D, outp, gtid, ngt); }
#undef MOE_VARS
        }
    }
#undef F
#undef PHASE_VARS
}

extern "C" void kernel_launch(void* const* d_in, const int* in_sizes, int n_in, void* d_out, int out_size, void* d_ws, size_t ws_size, hipStream_t stream) {
    static int grid = 0;
    if (grid == 0) {
        if (n_in != 37 || ws_size < WS_END) { fprintf(stderr, "kernel_launch: unexpected n_in %d / ws_size %zu (need %zu)\n", n_in, ws_size, (size_t)WS_END); grid = -1; return; }
        int dev = 0, cus = 0, per_cu = 0;
        if (hipGetDevice(&dev) != hipSuccess || hipDeviceGetAttribute(&cus, hipDeviceAttributeMultiprocessorCount, dev) != hipSuccess) { grid = -1; return; }
        if (hipFuncSetAttribute((const void*)mega_fwd, hipFuncAttributeMaxDynamicSharedMemorySize, LDS_TOTAL) != hipSuccess) { fprintf(stderr, "kernel_launch: hipFuncSetAttribute failed\n"); grid = -1; return; }
        if (hipOccupancyMaxActiveBlocksPerMultiprocessor(&per_cu, (const void*)mega_fwd, 512, LDS_TOTAL) != hipSuccess || per_cu < 1) fprintf(stderr, "kernel_launch: occupancy query says %d\n", per_cu);
        (void)hipGetLastError();
        grid = cus;
    }
    if (grid < 0) return;
    (void)hipMemsetAsync((char*)d_ws + WS_CTL, 0, CTL_ZERO_BYTES, stream);
    Args a{};
    for (int i = 0; i < 37; ++i) a.in[i] = (const float*)d_in[i];
    a.out = (float*)d_out; a.ws = (unsigned char*)d_ws;
    hipLaunchKernelGGL(mega_fwd, dim3(grid), dim3(512), LDS_TOTAL, stream, a);
}
```

```cpp
#include <hip/hip_runtime.h>
#include <stdint.h>
#include <stdio.h>

#define LAS __attribute__((address_space(3)))
typedef unsigned short bf16_t;
typedef short bf16x8 __attribute__((ext_vector_type(8)));
typedef short s16x4 __attribute__((ext_vector_type(4)));
typedef float f32x2 __attribute__((ext_vector_type(2)));
typedef float f32x4 __attribute__((ext_vector_type(4)));
typedef float f32x16 __attribute__((ext_vector_type(16)));
typedef unsigned u32x2 __attribute__((ext_vector_type(2)));
typedef unsigned u32x4 __attribute__((ext_vector_type(4)));

constexpr int D = 1024, NB = 8, SEQ = 2048, M = NB * SEQ, INC = 8192, DFF = 2816, NE = 8, DFF2 = 2 * DFF;
constexpr int C_XR = 0, C_GR = 1024, C_DQ = 2048, C_DK = 2560, C_DV = 3072, C_MQ = 3584, C_MK = 4096, C_MV = 4608, C_GB = 5120;
constexpr int YW = 2048, Y_A = 0, Y_B = 1024, Y_C = 1536;
constexpr float EPS = 1e-6f;
constexpr float QSCALE = 0.125f * 1.4426950408889634f;
constexpr int MOE_MAXROWS = 34816, MOE_MAXTILES = MOE_MAXROWS / 256;

__device__ __forceinline__ float bf2f(unsigned v) { return __uint_as_float(v << 16); }
__device__ __forceinline__ unsigned f2bf(float f) { unsigned u = __float_as_uint(f); return (u + 0x7fffu + ((u >> 16) & 1u)) >> 16; }
__device__ __forceinline__ unsigned pk2(float lo, float hi) { unsigned r; asm volatile("v_cvt_pk_bf16_f32 %0, %1, %2" : "=v"(r) : "v"(lo), "v"(hi)); return r; }
__device__ __forceinline__ float fexp2(float x) { return __builtin_amdgcn_exp2f(x); }
__device__ __forceinline__ float frcp(float x) { return __builtin_amdgcn_rcpf(x); }
__device__ __forceinline__ float sigmoid_f(float x) { return frcp(1.0f + fexp2(-1.4426950408889634f * x)); }
__device__ __forceinline__ float gelu_tanh_f(float x) { return x * sigmoid_f(1.5957691216057308f * (x + 0.044715f * x * x * x)); }
__device__ __forceinline__ float silu_f(float x) { return x * sigmoid_f(x); }
__device__ __forceinline__ float wave_sum(float v) {
#pragma unroll
    for (int o = 1; o < 64; o <<= 1) v += __shfl_xor(v, o);
    return v;
}
__device__ __forceinline__ int lane_fresh() { int l; asm volatile("v_mbcnt_lo_u32_b32 %0, -1, 0\n\tv_mbcnt_hi_u32_b32 %0, -1, %0" : "=v"(l)); return l; }
namespace pg8 {
constexpr int BM = 256, BK = 64, HALF = 128, HTB = HALF * BK * 2  , STAGE_BYTES = 8 * HTB, NXCD = 8, WGM = 8;

__host__ __device__ __forceinline__ int lds_byte(int r, int c) { const int st = (r >> 4) * 2 + (c >> 5), rr = r & 15, cc = c & 31, ob = rr * 64 + cc * 2; return st * 1024 + (ob ^ (((ob >> 9) & 1) << 5)); }
__host__ __device__ __forceinline__ void stage_rc(int b, int& R, int& C) { const int st = b / 1024, sb = b % 1024, swz = sb ^ (((sb >> 9) & 1) << 5); R = (st >> 1) * 16 + swz / 64; C = (st & 1) * 32 + (swz % 64) / 2; }
__host__ __device__ __forceinline__ int perm32(int rho) { const int n = rho >> 4, i = rho & 15; return 8 * (i >> 2) + 4 * n + (i & 3); }

struct Unit { int pm, pn, e, aux; };

struct StaticOrder {
    int nM, nN, nwg, G, c;
    __host__ __device__ void init(int M, int N, int G_, int c_) { nM = M / BM; nN = N / BM; nwg = nM * nN; G = G_; c = c_; }
    __device__ __forceinline__ bool next(int i, Unit& u) const {
        const long L = (long)i * G + c; if (L >= nwg) return false;
        int wgid = (int)L; { const int q = nwg / NXCD, r = nwg % NXCD, xcd = wgid % NXCD, off = wgid / NXCD; wgid = (xcd < r ? xcd * (q + 1) : r * (q + 1) + (xcd - r) * q) + off; }
        const int nig = WGM * nN, gid = wgid / nig, fm = gid * WGM, gsz = (nM - fm) < WGM ? (nM - fm) : WGM;
        u.pm = fm + ((wgid % nig) % gsz); u.pn = (wgid % nig) / gsz; u.e = 0; u.aux = 0; return true;
    }
};

struct RotOrder : StaticOrder {
    __device__ __forceinline__ bool next(int i, Unit& u) const { if (!StaticOrder::next(i, u)) return false; u.pn = (u.pn + 4 * i) % nN; return true; }
};

struct DenseProb {
    static constexpr bool GATHER = false;
    const bf16_t* A; const bf16_t* Bt; int K, lda, ldb, pad;
    __device__ __forceinline__ const char* a_base(const Unit& u) const { return (const char*)A + (size_t)u.pm * BM * lda * 2; }
    __device__ __forceinline__ const char* b_base(const Unit& u) const { return (const char*)Bt + (size_t)u.pn * BM * ldb * 2; }
    __device__ __forceinline__ unsigned a_off(const Unit&, int row, int col) const { return (unsigned)(row * lda + col) * 2u; }
};

template <class Prob, class Epi, class Sched, bool ALIGN_EPI = true>
__device__ __forceinline__ void gemm_phase(LAS unsigned char* lds, const Prob& g, const Sched& S, const Epi& E, int wid) {
    const int lane = lane_fresh(), tid = wid * 64 + lane, wr = wid >> 2, wc = wid & 3, fr = lane & 15, fq = lane >> 4;
    const int K = g.K, nt = K / BK;
    int sR[2], sC[2]; unsigned voffB[2];
#pragma unroll
    for (int i = 0; i < 2; ++i) { int R, C; stage_rc(tid * 16 + i * 8192, R, C); sR[i] = R; sC[i] = C; const int Rb = Epi::PERM ? ((R & ~31) + perm32(R & 31)) : R; voffB[i] = (unsigned)(Rb * g.ldb + C) * 2u; }
    const size_t kstep = (size_t)(BK * 2);
    const size_t hstepB = (size_t)HALF * g.ldb * 2;
    const unsigned ldsw = (unsigned)wid * 1024u;
    const int aoff = lds_byte(wr * 64 + fr, fq * 8), boff = lds_byte(wc * 32 + fr, fq * 8);
#define PG8_SA(b, h) (((b) * 2 + (h)) * HTB)
#define PG8_SB(b, h) ((4 + (b) * 2 + (h)) * HTB)
#define PG8_STAGE(bufoff, gbase, voff) do { _Pragma("unroll") for (int _i = 0; _i < 2; ++_i) \
        __builtin_amdgcn_global_load_lds((const unsigned*)((const char*)(gbase) + (voff)[_i]), (LAS unsigned*)(lds + (bufoff) + ldsw + _i * 8192), 16, 0, 0); } while (0)
#define PG8_LDA(dst, b, h) do { _Pragma("unroll") for (int m = 0; m < 4; ++m) _Pragma("unroll") for (int k = 0; k < 2; ++k) dst[m][k] = *(const LAS bf16x8*)(lds + PG8_SA(b, h) + aoff + m * 2048 + k * 1024); } while (0)
#define PG8_LDB(dst, b, h) do { _Pragma("unroll") for (int n = 0; n < 2; ++n) _Pragma("unroll") for (int k = 0; k < 2; ++k) dst[n][k] = *(const LAS bf16x8*)(lds + PG8_SB(b, h) + boff + n * 2048 + k * 1024); } while (0)
#define PG8_MMA(ai, bj, At, Bt) do { __builtin_amdgcn_s_setprio(1); _Pragma("unroll") for (int m = 0; m < 4; ++m) _Pragma("unroll") for (int n = 0; n < 2; ++n) _Pragma("unroll") for (int k = 0; k < 2; ++k) \
        acc[ai][bj][m][n] = __builtin_amdgcn_mfma_f32_16x16x32_bf16(Bt[n][k], At[m][k], acc[ai][bj][m][n], 0, 0, 0); __builtin_amdgcn_s_setprio(0); } while (0)
#define PG8_WAIT_V(n) asm volatile("s_waitcnt vmcnt(" #n ")" ::: "memory")
#define PG8_WAIT_L(n) asm volatile("s_waitcnt lgkmcnt(" #n ")" ::: "memory")
#define PG8_BAR __builtin_amdgcn_s_barrier()
#define PG8_SCHED __builtin_amdgcn_sched_barrier(0)
    Unit cur, nxt; int ui = 0;
    if (!S.next(0, cur)) return;
    f32x4 acc[2][2][4][2];
#pragma unroll
    for (int a = 0; a < 2; ++a)
#pragma unroll
        for (int b = 0; b < 2; ++b)
#pragma unroll
            for (int m = 0; m < 4; ++m)
#pragma unroll
                for (int n = 0; n < 2; ++n) acc[a][b][m][n] = (f32x4){0.f, 0.f, 0.f, 0.f};
    bf16x8 At[4][2], B0[2][2], B1[2][2];
    unsigned vA[2][2], vN[2][2];
#pragma unroll
    for (int h = 0; h < 2; ++h)
#pragma unroll
        for (int i = 0; i < 2; ++i) { vA[h][i] = g.a_off(cur, h * HALF + sR[i], sC[i]); vN[h][i] = vA[h][i]; }
    const char* cA = g.a_base(cur); const char* cB = g.b_base(cur);
    PG8_STAGE(PG8_SB(0, 0), cB, voffB); PG8_STAGE(PG8_SB(0, 1), cB + hstepB, voffB); PG8_STAGE(PG8_SA(0, 0), cA, vA[0]); PG8_STAGE(PG8_SA(0, 1), cA, vA[1]);
    if (wr == 1) PG8_BAR;
    PG8_WAIT_V(2); PG8_BAR;
    PG8_STAGE(PG8_SB(1, 0), cB + kstep, voffB); PG8_STAGE(PG8_SA(1, 0), cA + kstep, vA[0]); PG8_STAGE(PG8_SB(1, 1), cB + hstepB + kstep, voffB);
    PG8_WAIT_V(6); PG8_BAR;
    for (;;) {
        const bool has_next = S.next(ui + 1, nxt);
        const char* nA = has_next ? g.a_base(nxt) : cA; const char* nB = has_next ? g.b_base(nxt) : cB;
        if (Prob::GATHER) {
#pragma unroll
            for (int h = 0; h < 2; ++h)
#pragma unroll
                for (int i = 0; i < 2; ++i) vN[h][i] = has_next ? g.a_off(nxt, h * HALF + sR[i], sC[i]) : vA[h][i];
        }
        for (int t = 0; t < nt; t += 2) {
            const bool last = (t == nt - 2);
            if constexpr (Epi::KHOOK) { if (t == E.kh1 || t == E.kh2) E.khook(acc, cur, t, wr, wc, fr, fq); }
            const char* a1 = cA + (size_t)(t + 1) * kstep;
            const char* a2 = last ? nA : cA + (size_t)(t + 2) * kstep; const char* b2 = last ? nB : cB + (size_t)(t + 2) * kstep;
            const char* a3 = a2 + kstep; const char* b3 = b2 + kstep;
            unsigned v2[2][2];
#pragma unroll
            for (int h = 0; h < 2; ++h)
#pragma unroll
                for (int i = 0; i < 2; ++i) v2[h][i] = (Prob::GATHER && last) ? vN[h][i] : vA[h][i];
            PG8_LDB(B0, 0, 0); PG8_LDB(B1, 0, 1); PG8_SCHED; PG8_LDA(At, 0, 0); PG8_STAGE(PG8_SA(1, 1), a1, vA[1]);
            PG8_WAIT_V(8); PG8_WAIT_L(0); PG8_BAR; PG8_MMA(0, 0, At, B0); PG8_MMA(0, 1, At, B1); PG8_BAR; PG8_SCHED;
            PG8_LDA(At, 0, 1); PG8_STAGE(PG8_SB(0, 0), b2, voffB); PG8_STAGE(PG8_SB(0, 1), b2 + hstepB, voffB); PG8_STAGE(PG8_SA(0, 0), a2, v2[0]);
            PG8_WAIT_V(8); PG8_WAIT_L(0); PG8_BAR; PG8_MMA(1, 0, At, B0); PG8_MMA(1, 1, At, B1); PG8_BAR; PG8_SCHED;
            PG8_LDB(B0, 1, 0); PG8_LDB(B1, 1, 1); PG8_SCHED; PG8_LDA(At, 1, 0); PG8_STAGE(PG8_SA(0, 1), a2, v2[1]);
            PG8_WAIT_V(8); PG8_WAIT_L(0); PG8_BAR; PG8_MMA(0, 0, At, B0); PG8_MMA(0, 1, At, B1); PG8_BAR; PG8_SCHED;
            PG8_LDA(At, 1, 1); PG8_STAGE(PG8_SB(1, 0), b3, voffB); PG8_STAGE(PG8_SB(1, 1), b3 + hstepB, voffB); PG8_STAGE(PG8_SA(1, 0), a3, v2[0]);
            PG8_WAIT_V(8); PG8_WAIT_L(0); PG8_BAR; PG8_MMA(1, 0, At, B0); PG8_MMA(1, 1, At, B1); PG8_BAR; PG8_SCHED;
        }
        if constexpr (ALIGN_EPI) { if (wr == 0) PG8_BAR; }
        E(acc, cur, wr, wc, fr, fq);
        if (!has_next) break;
#pragma unroll
        for (int a = 0; a < 2; ++a)
#pragma unroll
            for (int b = 0; b < 2; ++b)
#pragma unroll
                for (int m = 0; m < 4; ++m)
#pragma unroll
                    for (int n = 0; n < 2; ++n) acc[a][b][m][n] = (f32x4){0.f, 0.f, 0.f, 0.f};
        cur = nxt; cA = nA; cB = nB; ++ui;
        if (Prob::GATHER) {
#pragma unroll
            for (int h = 0; h < 2; ++h)
#pragma unroll
                for (int i = 0; i < 2; ++i) vA[h][i] = vN[h][i];
        }
        if constexpr (ALIGN_EPI) { if (wr == 1) PG8_BAR; }
    }
    PG8_WAIT_V(0);
    if constexpr (!ALIGN_EPI) { if (wr == 0) PG8_BAR; }
    PG8_BAR;
#undef PG8_SA
#undef PG8_SB
#undef PG8_STAGE
#undef PG8_LDA
#undef PG8_LDB
#undef PG8_MMA
#undef PG8_WAIT_V
#undef PG8_WAIT_L
#undef PG8_BAR
#undef PG8_SCHED
}
}
namespace epi {
using pg8::Unit; using pg8::BM; using pg8::HALF;
typedef const f32x4 (&AccRef)[2][2][4][2];

struct Proj {
    static constexpr bool PERM = true, KHOOK = false;
    bf16_t* O; const float* gate_b;
    __device__ __forceinline__ void operator()(AccRef acc, const Unit& u, int wr, int wc, int fr, int fq) const {
        const int row0 = u.pm * BM + wr * 64 + fr, col0 = u.pn * BM + wc * 32 + 8 * fq;
        const int mode = (u.pn >= 20) ? 2 : ((u.pn >= 4 && u.pn < 8) ? 1 : 0);
        f32x4 bv[2][2];
#pragma unroll
        for (int bj = 0; bj < 2; ++bj)
#pragma unroll
            for (int n = 0; n < 2; ++n) bv[bj][n] = (mode == 2) ? *(const f32x4*)(gate_b + (col0 - C_GB) + bj * HALF + 4 * n) : (f32x4){0.f, 0.f, 0.f, 0.f};
#pragma unroll
        for (int ai = 0; ai < 2; ++ai)
#pragma unroll
            for (int m = 0; m < 4; ++m) { bf16_t* rowp = O + (size_t)(row0 + ai * HALF + m * 16) * INC + col0;
#pragma unroll
                for (int bj = 0; bj < 2; ++bj) { f32x4 v0 = acc[ai][bj][m][0] + bv[bj][0], v1 = acc[ai][bj][m][1] + bv[bj][1];
                    if (mode == 1) {
#pragma unroll
                        for (int j = 0; j < 4; ++j) { v0[j] = gelu_tanh_f(v0[j]); v1[j] = gelu_tanh_f(v1[j]); } }
                    if (mode == 2) {
#pragma unroll
                        for (int j = 0; j < 4; ++j) { v0[j] = sigmoid_f(v0[j]); v1[j] = sigmoid_f(v1[j]); } }
                    u32x4 w; w.x = pk2(v0[0], v0[1]); w.y = pk2(v0[2], v0[3]); w.z = pk2(v1[0], v1[1]); w.w = pk2(v1[2], v1[3]);
                    *(u32x4*)(rowp + bj * HALF) = w; } }
    }
};

template <int STEP> struct Branch {
    static constexpr bool PERM = false, KHOOK = false;
    const bf16_t* proj; float* P; bf16_t* merged;
    __device__ __forceinline__ void operator()(AccRef acc, const Unit& u, int wr, int wc, int fr, int fq) const {
        const int row0 = u.pm * BM + wr * 64 + fr, col0 = u.pn * BM + wc * 32 + 4 * fq;
#pragma unroll
        for (int ai = 0; ai < 2; ++ai)
#pragma unroll
            for (int m = 0; m < 4; ++m) { const size_t row = (size_t)(row0 + ai * HALF + m * 16);
#pragma unroll
                for (int bj = 0; bj < 2; ++bj)
#pragma unroll
                    for (int n = 0; n < 2; ++n) { const int col = col0 + bj * HALF + n * 16;
                        const u32x2 gw = *(const u32x2*)(proj + row * INC + C_GB + STEP * 1024 + col);
                        const f32x4 gv = {bf2f(gw.x & 0xffffu), bf2f(gw.x >> 16), bf2f(gw.y & 0xffffu), bf2f(gw.y >> 16)};
                        f32x4 v = acc[ai][bj][m][n] * gv;
                        float* pp = P + row * D + col;
                        if (STEP >= 1) v += *(const f32x4*)pp;
                        if (STEP <= 1) *(f32x4*)pp = v;
                        else { u32x2 w; w.x = pk2(v[0], v[1]); w.y = pk2(v[2], v[3]); *(u32x2*)(merged + row * D + col) = w; } } }
    }
};

struct Resid {
    static constexpr bool PERM = false, KHOOK = false;
    const float* base; float* out; const float* gate;
    __device__ __forceinline__ void operator()(AccRef acc, const Unit& u, int wr, int wc, int fr, int fq) const {
        const int row0 = u.pm * BM + wr * 64 + fr, col0 = u.pn * BM + wc * 32 + 4 * fq;
        const float* gp = gate + (size_t)((u.pm * BM) / SEQ) * (6 * D) + col0;
        f32x4 gv[2][2];
#pragma unroll
        for (int bj = 0; bj < 2; ++bj)
#pragma unroll
            for (int n = 0; n < 2; ++n) gv[bj][n] = *(const f32x4*)(gp + bj * HALF + n * 16);
#pragma unroll
        for (int ai = 0; ai < 2; ++ai)
#pragma unroll
            for (int m = 0; m < 4; ++m) { const size_t off = (size_t)(row0 + ai * HALF + m * 16) * D + col0;
#pragma unroll
                for (int bj = 0; bj < 2; ++bj)
#pragma unroll
                    for (int n = 0; n < 2; ++n) { const f32x4 bs = *(const f32x4*)(base + off + bj * HALF + n * 16);
                        *(f32x4*)(out + off + bj * HALF + n * 16) = bs + gv[bj][n] * acc[ai][bj][m][n]; } }
    }
};

struct SwiGLU {
    static constexpr bool PERM = true, KHOOK = false;
    bf16_t* O;
    __device__ __forceinline__ void operator()(AccRef acc, const Unit& u, int wr, int wc, int fr, int fq) const {
        const int row0 = u.pm * BM + wr * 64 + fr, col0 = u.pn * HALF + wc * 32 + 8 * fq;
#pragma unroll
        for (int ai = 0; ai < 2; ++ai)
#pragma unroll
            for (int m = 0; m < 4; ++m) { bf16_t* rowp = O + (size_t)(row0 + ai * HALF + m * 16) * DFF + col0;
                f32x4 v0, v1;
#pragma unroll
                for (int j = 0; j < 4; ++j) { v0[j] = silu_f(acc[ai][0][m][0][j]) * acc[ai][1][m][0][j]; v1[j] = silu_f(acc[ai][0][m][1][j]) * acc[ai][1][m][1][j]; }
                u32x4 w; w.x = pk2(v0[0], v0[1]); w.y = pk2(v0[2], v0[3]); w.z = pk2(v1[0], v1[1]); w.w = pk2(v1[2], v1[3]);
                *(u32x4*)rowp = w; }
    }
};

struct MoeDown {
    static constexpr bool PERM = false, KHOOK = false;
    const int* rowdst; const float* roww; bf16_t* yslot;
    __device__ __forceinline__ void operator()(AccRef acc, const Unit& u, int wr, int wc, int fr, int fq) const {
        const int row0 = u.pm * BM + wr * 64 + fr, col0 = u.pn * BM + wc * 32 + 4 * fq;
#pragma unroll
        for (int ai = 0; ai < 2; ++ai)
#pragma unroll
            for (int m = 0; m < 4; ++m) { const int p = row0 + ai * HALF + m * 16; const int dst = rowdst[p]; const float w = roww[p];
                if (dst >= 0) { bf16_t* rowp = yslot + (size_t)dst * D + col0;
#pragma unroll
                    for (int bj = 0; bj < 2; ++bj)
#pragma unroll
                        for (int n = 0; n < 2; ++n) { const f32x4 v = acc[ai][bj][m][n] * w; u32x2 o; o.x = pk2(v[0], v[1]); o.y = pk2(v[2], v[3]); *(u32x2*)(rowp + bj * HALF + n * 16) = o; } } }
    }
};

struct BranchMerge {
    static constexpr bool PERM = true, KHOOK = true;
    const bf16_t* proj; bf16_t* merged; int kh1, kh2;
    typedef f32x4 (&AccMut)[2][2][4][2];
    __device__ __forceinline__ static void unpack8(const u32x4 w, float (&f)[8]) {
        f[0] = bf2f(w.x & 0xffffu); f[1] = bf2f(w.x >> 16); f[2] = bf2f(w.y & 0xffffu); f[3] = bf2f(w.y >> 16); f[4] = bf2f(w.z & 0xffffu); f[5] = bf2f(w.z >> 16); f[6] = bf2f(w.w & 0xffffu); f[7] = bf2f(w.w >> 16); }
    __device__ __forceinline__ void khook(AccMut acc, const Unit& u, int t, int wr, int wc, int fr, int fq) const {
        const int gi = (t == kh1) ? 0 : 1;
        const unsigned off0 = (unsigned)(((u.pm * BM + wr * 64 + fr) * INC + C_GB + gi * 1024 + u.pn * BM + wc * 32 + 8 * fq) * 2);
        const char* pb = (const char*)proj;
#pragma unroll
        for (int ai = 0; ai < 2; ++ai) {
            u32x4 rn[4][2], rd[4][2];
#pragma unroll
            for (int m = 0; m < 4; ++m) { const unsigned off = off0 + (unsigned)((ai * HALF + m * 16) * INC * 2);
#pragma unroll
                for (int bj = 0; bj < 2; ++bj) { rn[m][bj] = *(const u32x4*)(pb + (size_t)(off + bj * HALF * 2)); rd[m][bj] = *(const u32x4*)(pb + (size_t)(off + 2048 + bj * HALF * 2)); } }
#pragma unroll
            for (int m = 0; m < 4; ++m)
#pragma unroll
                for (int bj = 0; bj < 2; ++bj) { float gn[8], gd[8]; unpack8(rn[m][bj], gn); unpack8(rd[m][bj], gd);
#pragma unroll
                    for (int j = 0; j < 4; ++j) { acc[ai][bj][m][0][j] *= gn[j] * frcp(fmaxf(gd[j], 1e-30f)); acc[ai][bj][m][1][j] *= gn[4 + j] * frcp(fmaxf(gd[4 + j], 1e-30f)); } }
            asm volatile("" ::: "memory");
        }
    }
    __device__ __forceinline__ void operator()(AccRef acc, const Unit& u, int wr, int wc, int fr, int fq) const {
        const int row0 = u.pm * BM + wr * 64 + fr, col0 = u.pn * BM + wc * 32 + 8 * fq;
#pragma unroll
        for (int ai = 0; ai < 2; ++ai)
#pragma unroll
            for (int m = 0; m < 4; ++m) { const size_t row = (size_t)(row0 + ai * HALF + m * 16);
#pragma unroll
                for (int bj = 0; bj < 2; ++bj) { float g2[8]; unpack8(*(const u32x4*)(proj + row * INC + C_GB + 2048 + col0 + bj * HALF), g2);
                    const f32x4 v0 = acc[ai][bj][m][0], v1 = acc[ai][bj][m][1];
                    u32x4 w; w.x = pk2(v0[0] * g2[0], v0[1] * g2[1]); w.y = pk2(v0[2] * g2[2], v0[3] * g2[3]); w.z = pk2(v1[0] * g2[4], v1[1] * g2[5]); w.w = pk2(v1[2] * g2[6], v1[3] * g2[7]);
                    *(u32x4*)(merged + row * D + col0 + bj * HALF) = w; } }
    }
};
}
namespace attn {
constexpr int NSLOT = 4, SLOT_K = 8192, SLOT128 = SLOT_K + 16384, SLOT64 = SLOT_K + 8192, LDS_BYTES = NSLOT * SLOT128;
constexpr float NEGF = -1e30f;
__device__ __forceinline__ int crow(int r, int hi) { return (r & 3) + 8 * (r >> 2) + 4 * hi; }
__device__ __forceinline__ float swapmax(float m) { auto rr = __builtin_amdgcn_permlane32_swap(__float_as_uint(m), __float_as_uint(m), false, false); return fmaxf(__uint_as_float(rr[0]), __uint_as_float(rr[1])); }
__device__ __forceinline__ float swapsum(float m) { auto rr = __builtin_amdgcn_permlane32_swap(__float_as_uint(m), __float_as_uint(m), false, false); return __uint_as_float(rr[0]) + __uint_as_float(rr[1]); }
typedef short v4i16_t __attribute__((ext_vector_type(4)));
__device__ __forceinline__ s16x4 vtr(const LAS char* p) { return __builtin_bit_cast(s16x4, __builtin_amdgcn_ds_read_tr16_b64_v4i16((LAS v4i16_t*)p)); }

__device__ __forceinline__ void qk_tile(f32x16& sA, f32x16& sB, const LAS char* Kt, const bf16x8 (&qf)[4], int r, int h, float noff) {
    const LAS char* kb = Kt + h * 1024 + r * 16;
#pragma unroll
    for (int j = 0; j < 16; ++j) { sA[j] = noff; sB[j] = noff; }
    bf16x8 kf[8];
#pragma unroll
    for (int ks = 0; ks < 4; ++ks) { kf[2 * ks] = *(const LAS bf16x8*)(kb + ks * 2048); kf[2 * ks + 1] = *(const LAS bf16x8*)(kb + ks * 2048 + 512); }
    __builtin_amdgcn_sched_barrier(0);
#pragma unroll
    for (int ks = 0; ks < 4; ++ks) {
        sA = __builtin_amdgcn_mfma_f32_32x32x16_bf16(kf[2 * ks], qf[ks], sA, 0, 0, 0);
        sB = __builtin_amdgcn_mfma_f32_32x32x16_bf16(kf[2 * ks + 1], qf[ks], sB, 0, 0, 0);
    }
}
template <int NDB>
__device__ __forceinline__ void pv_tile(f32x16 (&o)[NDB], const LAS char* Vt, const bf16x8 (&pf)[4], int lane) {
    const int h = lane >> 5, q = (lane & 15) >> 2, p = lane & 3, g1 = (lane >> 4) & 1;
    const LAS char* vb = Vt + (4 * h + q) * 64 + (16 * g1 + 4 * p) * 2;
#pragma unroll
    for (int kb = 0; kb < 2; ++kb) {
        bf16x8 vf[2][NDB];
#pragma unroll
        for (int s = 0; s < 2; ++s)
#pragma unroll
            for (int db = 0; db < NDB; ++db) { const int r0 = kb * 32 + 16 * s;
                const s16x4 lo = vtr(vb + r0 * 64 + db * 4096), hi = vtr(vb + (r0 + 8) * 64 + db * 4096);
                vf[s][db] = (bf16x8){lo[0], lo[1], lo[2], lo[3], hi[0], hi[1], hi[2], hi[3]}; }
        __builtin_amdgcn_sched_barrier(0);
#pragma unroll
        for (int s = 0; s < 2; ++s)
#pragma unroll
            for (int db = 0; db < NDB; ++db) o[db] = __builtin_amdgcn_mfma_f32_32x32x16_bf16(pf[kb * 2 + s], vf[s][db], o[db], 0, 0, 0);
    }
}
template <int NDB>
__device__ __forceinline__ void softmax_pv(f32x16& sA, f32x16& sB, f32x16 (&o)[NDB], float& lsum, const LAS char* Vt, int lane) {
    float rs0 = 0.f, rs1 = 0.f;
#pragma unroll
    for (int j = 0; j < 16; ++j) { sA[j] = fexp2(sA[j]); sB[j] = fexp2(sB[j]); rs0 += sA[j]; rs1 += sB[j]; }
    lsum += rs0 + rs1;
    bf16x8 pf[4];
    { u32x4 w;
      w.x = pk2(sA[0], sA[1]); w.y = pk2(sA[2], sA[3]); w.z = pk2(sA[4], sA[5]); w.w = pk2(sA[6], sA[7]); pf[0] = __builtin_bit_cast(bf16x8, w);
      w.x = pk2(sA[8], sA[9]); w.y = pk2(sA[10], sA[11]); w.z = pk2(sA[12], sA[13]); w.w = pk2(sA[14], sA[15]); pf[1] = __builtin_bit_cast(bf16x8, w);
      w.x = pk2(sB[0], sB[1]); w.y = pk2(sB[2], sB[3]); w.z = pk2(sB[4], sB[5]); w.w = pk2(sB[6], sB[7]); pf[2] = __builtin_bit_cast(bf16x8, w);
      w.x = pk2(sB[8], sB[9]); w.y = pk2(sB[10], sB[11]); w.z = pk2(sB[12], sB[13]); w.w = pk2(sB[14], sB[15]); pf[3] = __builtin_bit_cast(bf16x8, w); }
    pv_tile<NDB>(o, Vt, pf, lane);
}
__device__ __forceinline__ float score_shift(const float* gq, const float* gk, int lane) {
    float mq = fabsf(gq[lane]), mk = fabsf(gk[lane]);
#pragma unroll
    for (int o = 1; o < 64; o <<= 1) { mq = fmaxf(mq, __shfl_xor(mq, o)); mk = fmaxf(mk, __shfl_xor(mk, o)); }
    const float bound = QSCALE * 64.0f * mq * mk;
    return -fmaxf(0.f, bound - 24.0f);
}

template <int DV>
__device__ __forceinline__ void dma_tile(const bf16_t* Kg, const bf16_t* Vg, int key0, LAS char* slot, int wid, int lane) {
    __builtin_amdgcn_global_load_lds((const unsigned*)(Kg + (size_t)(key0 + lane) * INC + wid * 8), (LAS unsigned*)(slot + wid * 1024), 16, 0, 0);
#pragma unroll
    for (int i = 0; i < DV / 64; ++i) { const int p = wid + 8 * i, db = p >> 2, rg = p & 3;
        __builtin_amdgcn_global_load_lds((const unsigned*)(Vg + (size_t)(key0 + 16 * rg + (lane >> 2)) * INC + db * 32 + (lane & 3) * 8), (LAS unsigned*)(slot + SLOT_K + p * 1024), 16, 0, 0); }
}
template <int OPS> __device__ __forceinline__ void ring_wait(int ahead) {
    if (ahead >= 2) asm volatile("s_waitcnt vmcnt(%0) lgkmcnt(0)\n\ts_barrier" :: "n"(2 * OPS) : "memory");
    else if (ahead == 1) asm volatile("s_waitcnt vmcnt(%0) lgkmcnt(0)\n\ts_barrier" :: "n"(OPS) : "memory");
    else asm volatile("s_waitcnt vmcnt(0) lgkmcnt(0)\n\ts_barrier" ::: "memory");
}
template <int DV>
__device__ __forceinline__ void causal_pass(f32x16 (&o)[DV / 32], float& lsum, const bf16x8 (&qf)[4], const bf16_t* Kg, const bf16_t* Vg,
                                            int ntiles, int qw0, float noff, LAS char* lds, int tid) {
    constexpr int SLOT = SLOT_K + DV * 128, OPS = 1 + DV / 64;
    const int lane = tid & 63, r = lane & 31, h = lane >> 5, wid = __builtin_amdgcn_readfirstlane(tid >> 6);
    asm volatile("s_waitcnt vmcnt(0) lgkmcnt(0)\n\ts_barrier" ::: "memory");
#pragma unroll
    for (int t = 0; t < 3; ++t) if (t < ntiles) dma_tile<DV>(Kg, Vg, t * 64, lds + t * SLOT, wid, lane);
    __builtin_amdgcn_s_waitcnt(0);
    for (int t = 0; t < ntiles; ++t) {
        ring_wait<OPS>(ntiles - 1 - t);
        if (t + 3 < ntiles) dma_tile<DV>(Kg, Vg, (t + 3) * 64, lds + ((t + 3) & 3) * SLOT, wid, lane);
        const LAS char* slot = lds + (t & 3) * SLOT;
        const int key0 = t * 64;
        if (key0 <= qw0 + 31) {
            f32x16 sA, sB;
            qk_tile(sA, sB, slot, qf, r, h, noff);
            if (key0 + 63 > qw0) {
                const int qpos = qw0 + r;
#pragma unroll
                for (int j = 0; j < 16; ++j) { const int kp = key0 + crow(j, h); if (kp > qpos) sA[j] = NEGF; if (kp + 32 > qpos) sB[j] = NEGF; }
            }
            softmax_pv<DV / 32>(sA, sB, o, lsum, slot + SLOT_K, lane);
        }
    }
}

__device__ __forceinline__ void diff_unit(int b, int hd, int qt, const bf16_t* proj, bf16_t* yabc, const float* subln, float lam, float one_m_laminit, float noff, LAS char* lds, int wid) {
    const int lane = lane_fresh(), tid = wid * 64 + lane, r = lane & 31, h = lane >> 5;
    const int qw0 = qt * 256 + wid * 32;
    const size_t rowb = (size_t)b * SEQ;
    const int ntiles = 4 * (qt + 1);
    unsigned o0p[4][8];
#pragma unroll
    for (int j = 0; j < 2; ++j) {
        const bf16_t* qp = proj + (rowb + qw0 + r) * INC + C_DQ + (hd * 2 + j) * 64 + h * 8;
        bf16x8 qf[4];
#pragma unroll
        for (int ks = 0; ks < 4; ++ks) qf[ks] = *(const bf16x8*)(qp + ks * 16);
        f32x16 o[4];
#pragma unroll
        for (int db = 0; db < 4; ++db)
#pragma unroll
            for (int i = 0; i < 16; ++i) o[db][i] = 0.f;
        float lsum = 0.f;
        causal_pass<128>(o, lsum, qf, proj + rowb * INC + C_DK + (hd * 2 + j) * 64, proj + rowb * INC + C_DV + hd * 128, ntiles, qw0, noff, lds, tid);
        const float il = frcp(swapsum(lsum));
        if (j == 0) {
#pragma unroll
            for (int i = 0; i < 16; i += 2) { const float a0 = __shfl(il, crow(i, h)), a1 = __shfl(il, crow(i + 1, h));
#pragma unroll
                for (int db = 0; db < 4; ++db) o0p[db][i >> 1] = pk2(o[db][i] * a0, o[db][i + 1] * a1); }
        } else {
#pragma unroll
            for (int i = 0; i < 16; ++i) { const float a = __shfl(il, crow(i, h)) * lam;
                float ss = 0.f; float cv[4];
#pragma unroll
                for (int db = 0; db < 4; ++db) { const unsigned w = o0p[db][i >> 1]; const float x0 = (i & 1) ? bf2f(w >> 16) : bf2f(w & 0xffffu); const float c = x0 - o[db][i] * a; cv[db] = c; ss += c * c; }
                ss += __shfl_xor(ss, 1); ss += __shfl_xor(ss, 2); ss += __shfl_xor(ss, 4); ss += __shfl_xor(ss, 8); ss += __shfl_xor(ss, 16);
                const float rn = rsqrtf(ss * (1.0f / 128.0f) + EPS) * one_m_laminit;
                bf16_t* yp = yabc + (rowb + qw0 + crow(i, h)) * YW + Y_B + hd * 128 + r;
#pragma unroll
                for (int db = 0; db < 4; ++db) yp[db * 32] = (bf16_t)f2bf(cv[db] * rn * subln[db * 32 + r]);
            }
        }
    }
}

__device__ __forceinline__ void moba_unit(int b, int hd, int cur, const bf16_t* proj, bf16_t* yabc, const float* kmean, float noff, LAS char* lds, int wid) {
    const int lane = lane_fresh(), tid = wid * 64 + lane, r = lane & 31, h = lane >> 5;
    const int qw0 = cur * 256 + wid * 32;
    const size_t rowb = (size_t)b * SEQ;
    const bf16_t* qp = proj + (rowb + qw0 + r) * INC + C_MQ + hd * 64 + h * 8;
    bf16x8 qf[4];
#pragma unroll
    for (int ks = 0; ks < 4; ++ks) qf[ks] = *(const bf16x8*)(qp + ks * 16);
    unsigned selmask = 0u;
    if (cur > 0) {
        float gate[8];
#pragma unroll
        for (int n = 0; n < 8; ++n) {
            float g = 0.f;
            if (n < cur) {
                const float* km = kmean + ((size_t)((b * 8 + hd) * 8 + n)) * 64 + h * 8;
#pragma unroll
                for (int ks = 0; ks < 4; ++ks)
#pragma unroll
                    for (int j = 0; j < 8; ++j) g += bf2f((unsigned)(unsigned short)qf[ks][j]) * km[ks * 16 + j];
                g = swapsum(g);
            } else g = -3.0e38f;
            gate[n] = g;
        }
        const int nsel = cur < 3 ? cur : 3;
        for (int s = 0; s < nsel; ++s) {
            float best = -3.0e38f; int bi = 0;
#pragma unroll
            for (int n = 0; n < 8; ++n) { const bool tk = (n < cur) && !((selmask >> n) & 1u) && (gate[n] > best); if (tk) { best = gate[n]; bi = n; } }
            selmask |= 1u << bi;
        }
    }
    f32x16 o[2];
#pragma unroll
    for (int db = 0; db < 2; ++db)
#pragma unroll
        for (int i = 0; i < 16; ++i) o[db][i] = 0.f;
    float lsum = 0.f;
    const bf16_t* Kg = proj + rowb * INC + C_MK + hd * 64; const bf16_t* Vg = proj + rowb * INC + C_MV + hd * 64;
    const int ntiles = 4 * (cur + 1);
#define MOBA_KEY0(T) ((((T) < 4) ? cur : (((T) >> 2) - 1)) * 256 + ((T) & 3) * 64)
    const int widu = wid;
    asm volatile("s_waitcnt vmcnt(0) lgkmcnt(0)\n\ts_barrier" ::: "memory");
#pragma unroll
    for (int t = 0; t < 3; ++t) dma_tile<64>(Kg, Vg, MOBA_KEY0(t), lds + t * SLOT64, widu, lane);
    __builtin_amdgcn_s_waitcnt(0);
    for (int t = 0; t < ntiles; ++t) {
        ring_wait<2>(ntiles - 1 - t);
        if (t + 3 < ntiles) dma_tile<64>(Kg, Vg, MOBA_KEY0(t + 3), lds + ((t + 3) & 3) * SLOT64, widu, lane);
        const LAS char* slot = lds + (t & 3) * SLOT64;
        const int blk = (t < 4) ? cur : (t >> 2) - 1;
        const int key0 = blk * 256 + (t & 3) * 64;
        const bool own = (t < 4);
        const bool lane_on = own ? true : (((selmask >> blk) & 1u) != 0u);
        const bool wave_on = own ? (key0 <= qw0 + 31) : (__any(lane_on) != 0);
        if (wave_on) {
            f32x16 sA, sB;
            qk_tile(sA, sB, slot, qf, r, h, noff);
            if (own) {
                if (key0 + 63 > qw0) {
                    const int qpos = qw0 + r;
#pragma unroll
                    for (int j = 0; j < 16; ++j) { const int kp = key0 + crow(j, h); if (kp > qpos) sA[j] = NEGF; if (kp + 32 > qpos) sB[j] = NEGF; }
                }
            } else if (!lane_on) {
#pragma unroll
                for (int j = 0; j < 16; ++j) { sA[j] = NEGF; sB[j] = NEGF; }
            }
            softmax_pv<2>(sA, sB, o, lsum, slot + SLOT_K, lane);
        }
    }
#undef MOBA_KEY0
    const float il = frcp(swapsum(lsum));
#pragma unroll
    for (int i = 0; i < 16; ++i) { const float a = __shfl(il, crow(i, h));
        bf16_t* yp = yabc + (rowb + qw0 + crow(i, h)) * YW + Y_C + hd * 64 + r;
#pragma unroll
        for (int db = 0; db < 2; ++db) yp[db * 32] = (bf16_t)f2bf(o[db][i] * a); }
}
}
namespace thin {
struct TItem { f32x4 v[8][2]; };
__device__ __forceinline__ void titem_load(TItem& it, const float* W, int N, int item, int lane) {
    const int nblk = N >> 6, kb = item / nblk, nb = item - kb * nblk;
    const float* p = W + (size_t)(kb * 64 + 2 * (lane >> 4)) * N + nb * 64 + 4 * (lane & 15);
#pragma unroll
    for (int i = 0; i < 8; ++i) { it.v[i][0] = *(const f32x4*)(p + (size_t)(8 * i) * N); it.v[i][1] = *(const f32x4*)(p + (size_t)(8 * i + 1) * N); }
}
__device__ __forceinline__ void titem_store(const TItem& it, int N, bf16_t* WT, int ldk, int coff, int row_off, int mode, LAS unsigned* T, int item, int lane) {
    const int nblk = N >> 6, kb = item / nblk, nb = item - kb * nblk, k0 = kb * 64, n0 = nb * 64;
    const int kp = lane >> 4, np = lane & 15;
#pragma unroll
    for (int i = 0; i < 8; ++i) { const int col = (kp + 4 * i) ^ ((np & 7) << 2);
#pragma unroll
        for (int j = 0; j < 4; ++j) T[(4 * np + j) * 32 + col] = pk2(it.v[i][0][j], it.v[i][1][j]); }
    asm volatile("s_waitcnt lgkmcnt(0)" ::: "memory");
    const int c = lane & 7;
#pragma unroll
    for (int j = 0; j < 8; ++j) { const int n = (lane >> 3) + 8 * j;
        const u32x4 o = *(const LAS u32x4*)(T + n * 32 + 4 * (c ^ ((n >> 2) & 7)));
        const int nn = n0 + n; const int row = row_off + (mode == 0 ? nn : ((nn >> 7) * 256 + (mode == 2 ? 128 : 0) + (nn & 127)));
        *(u32x4*)(WT + (size_t)row * ldk + coff + k0 + 8 * c) = o; }
    asm volatile("s_waitcnt lgkmcnt(0)" ::: "memory");
}
__device__ __forceinline__ void transpose_matrix(const float* W, int K, int N, bf16_t* WT, int ldk, int coff, int row_off, int mode, LAS float* scr, int gw, int ngw, int lane) {
    const int nitems = (K >> 6) * (N >> 6);
    LAS unsigned* T = (LAS unsigned*)scr;
    TItem cur;
    int it = gw;
    if (it < nitems) titem_load(cur, W, N, it, lane);
    while (it < nitems) {
        const int nx = it + ngw;
        TItem nxt;
        if (nx < nitems) titem_load(nxt, W, N, nx, lane);
        titem_store(cur, N, WT, ldk, coff, row_off, mode, T, it, lane);
        cur = nxt; it = nx;
    }
}

__device__ __forceinline__ void mod_body(const float* c, const float* ada_w, const float* ada_b, float* mod, int bid, int G, int tid, LAS float* red) {
    for (int cb = bid; cb < (2 * 6 * D) / 48; cb += G) {
        const int kg = tid / 48, jj = tid - kg * 48;
        const int idx = cb * 48 + jj, l = idx / (6 * D), j = idx - l * (6 * D);
        float acc[NB];
#pragma unroll
        for (int b = 0; b < NB; ++b) acc[b] = 0.f;
        if (kg < 8) {
            const float* w = ada_w + (size_t)l * D * 6 * D + (size_t)(kg * 128) * 6 * D + j;
#pragma unroll 4
            for (int k = 0; k < 128; ++k) { const float wv = w[(size_t)k * 6 * D];
#pragma unroll
                for (int b = 0; b < NB; ++b) acc[b] += c[b * D + kg * 128 + k] * wv; }
#pragma unroll
            for (int b = 0; b < NB; ++b) red[(kg * 48 + jj) * NB + b] = acc[b];
        }
        __syncthreads();
        if (tid < 48 * NB) { const int j2 = tid >> 3, b = tid & 7; float s = 0.f;
#pragma unroll
            for (int g = 0; g < 8; ++g) s += red[(g * 48 + j2) * NB + b];
            const int idx2 = cb * 48 + j2, l2 = idx2 / (6 * D), jo = idx2 - l2 * (6 * D);
            mod[((size_t)l2 * NB + b) * 6 * D + jo] = s + ada_b[l2 * 6 * D + jo]; }
        __syncthreads();
    }
}
__device__ __forceinline__ void rope_body(const int* positions, f32x2* cs, int gtid, int ngt) {
    for (int idx = gtid; idx < M * 32; idx += ngt) {
        const int tok = idx >> 5, i = idx & 31;
        const float inv = 1.0f / powf(10000.0f, (float)(2 * i) / 64.0f);
        const float ang = (float)positions[tok] * inv;
        float s, c; sincosf(ang, &s, &c);
        cs[idx] = (f32x2){c, s};
    }
}
template <int R>
__device__ __forceinline__ void norm_rows(const float* xrow, const float* g, const float* shift, const float* scale, bf16_t* orow, int lane, f32x4 (&y)[R][4]) {
    f32x4 v[R][4]; float ss[R];
#pragma unroll
    for (int r = 0; r < R; ++r) { const f32x4* xr = (const f32x4*)(xrow + (size_t)r * D) + lane;
#pragma unroll
        for (int j = 0; j < 4; ++j) v[r][j] = xr[64 * j]; }
#pragma unroll
    for (int r = 0; r < R; ++r) { float s = 0.f;
#pragma unroll
        for (int j = 0; j < 4; ++j) s += (v[r][j].x * v[r][j].x + v[r][j].y * v[r][j].y) + (v[r][j].z * v[r][j].z + v[r][j].w * v[r][j].w);
        ss[r] = s; }
#pragma unroll
    for (int o = 1; o < 64; o <<= 1) {
#pragma unroll
        for (int r = 0; r < R; ++r) ss[r] += __shfl_xor(ss[r], o); }
#pragma unroll
    for (int j = 0; j < 4; ++j) { const int col = 4 * lane + 256 * j;
        const f32x4 gg = *(const f32x4*)(g + col), sc = *(const f32x4*)(scale + col), sh = *(const f32x4*)(shift + col);
        const f32x4 gs = gg * (sc + 1.0f);
#pragma unroll
        for (int r = 0; r < R; ++r) { const float rn = rsqrtf(ss[r] * (1.0f / D) + EPS);
            y[r][j] = v[r][j] * rn * gs + sh;
            u32x2 w; w.x = pk2(y[r][j].x, y[r][j].y); w.y = pk2(y[r][j].z, y[r][j].w); ((u32x2*)(orow + (size_t)r * D) + lane)[64 * j] = w; } }
}
__device__ __forceinline__ void norm_body(const float* x, const float* g, const float* shift, const float* scale, bf16_t* out, int gw, int ngw, int lane) {
    for (int m = gw * 4; m < M; m += ngw * 4) { const int b = m / SEQ; f32x4 y[4][4]; norm_rows<4>(x + (size_t)m * D, g, shift + b * 6 * D, scale + b * 6 * D, out + (size_t)m * D, lane, y); }
}
__device__ __forceinline__ void norm_router_body(const float* x, const float* g, const float* shift, const float* scale, bf16_t* out,
                                                 const float* rw, const float* rb, int* topi, float* topw, int gw, int ngw, int lane) {
    for (int m0 = gw * 2; m0 < M; m0 += ngw * 2) { const int b = m0 / SEQ; f32x4 y[2][4];
        norm_rows<2>(x + (size_t)m0 * D, g, shift + b * 6 * D, scale + b * 6 * D, out + (size_t)m0 * D, lane, y);
        float lg[2][NE];
#pragma unroll
        for (int r = 0; r < 2; ++r)
#pragma unroll
            for (int e = 0; e < NE; ++e) lg[r][e] = 0.f;
#pragma unroll
        for (int j = 0; j < 4; ++j)
#pragma unroll
            for (int q = 0; q < 4; ++q) { const int col = 4 * lane + 256 * j + q; const f32x4 w0 = *(const f32x4*)(rw + col * NE), w1 = *(const f32x4*)(rw + col * NE + 4);
#pragma unroll
                for (int r = 0; r < 2; ++r) { const float hv = y[r][j][q];
                    lg[r][0] += hv * w0.x; lg[r][1] += hv * w0.y; lg[r][2] += hv * w0.z; lg[r][3] += hv * w0.w; lg[r][4] += hv * w1.x; lg[r][5] += hv * w1.y; lg[r][6] += hv * w1.z; lg[r][7] += hv * w1.w; } }
#pragma unroll
        for (int o = 1; o < 64; o <<= 1) {
#pragma unroll
            for (int r = 0; r < 2; ++r)
#pragma unroll
                for (int e = 0; e < NE; ++e) lg[r][e] += __shfl_xor(lg[r][e], o); }
#pragma unroll
        for (int r = 0; r < 2; ++r) { const int m = m0 + r;
#pragma unroll
            for (int e = 0; e < NE; ++e) lg[r][e] += rb[e];
            int i0 = 0; float v0 = lg[r][0];
#pragma unroll
            for (int e = 1; e < NE; ++e) if (lg[r][e] > v0) { v0 = lg[r][e]; i0 = e; }
            int i1 = -1; float v1 = -3.0e38f;
#pragma unroll
            for (int e = 0; e < NE; ++e) if (e != i0 && lg[r][e] > v1) { v1 = lg[r][e]; i1 = e; }
            const float w1v = 1.0f / (1.0f + expf(v0 - v1)), w0v = 1.0f - w1v;
            if (lane == 0) { topi[2 * m] = i0; topi[2 * m + 1] = i1; topw[2 * m] = w0v; topw[2 * m + 1] = w1v; } }
    }
}
__device__ __forceinline__ void qknorm_body(bf16_t* proj, const f32x2* cs, const float* dqn, const float* dkn, const float* mqn, const float* mkn, int gtid, int ngt) {
    for (long idx = gtid; idx < (long)M * 32 * 32; idx += ngt) {
        const int i = (int)(idx & 31); const long pair = idx >> 5; const int hh = (int)(pair & 31); const int tok = (int)(pair >> 5);
        const int grp = hh >> 3, hi = hh & 7;
        const int cb = (grp == 0 ? C_DQ : grp == 1 ? C_DK : grp == 2 ? C_MQ : C_MK) + hi * 64;
        const float* gn = grp == 0 ? dqn : grp == 1 ? dkn : grp == 2 ? mqn : mkn;
        bf16_t* p = proj + (size_t)tok * INC + cb;
        const float x1 = bf2f(p[i]), x2 = bf2f(p[i + 32]);
        float ss = x1 * x1 + x2 * x2;
        ss += __shfl_xor(ss, 1); ss += __shfl_xor(ss, 2); ss += __shfl_xor(ss, 4); ss += __shfl_xor(ss, 8); ss += __shfl_xor(ss, 16);
        const float rn = rsqrtf(ss * (1.0f / 64.0f) + EPS);
        const float y1 = x1 * rn * gn[i], y2 = x2 * rn * gn[i + 32];
        const f32x2 c = cs[(size_t)tok * 32 + i];
        float o1 = y1 * c.x - y2 * c.y, o2 = y2 * c.x + y1 * c.y;
        if ((grp & 1) == 0) { o1 *= QSCALE; o2 *= QSCALE; }
        p[i] = (bf16_t)f2bf(o1); p[i + 32] = (bf16_t)f2bf(o2);
    }
}
__device__ __forceinline__ void kmean_body(const bf16_t* proj, float* kmean, int gw, int ngw, int lane) {
    for (int it = gw; it < NB * 8 * 8; it += ngw) { const int blk = it & 7, hd = (it >> 3) & 7, b = it >> 6;
        const bf16_t* p = proj + ((size_t)b * SEQ + blk * 256) * INC + C_MK + hd * 64 + lane;
        float s = 0.f;
        for (int t = 0; t < 256; ++t) s += bf2f(p[(size_t)t * INC]);
        kmean[(size_t)it * 64 + lane] = s * (1.0f / 256.0f); }
}
__device__ __forceinline__ void moe_combine_body(const float* x1, const bf16_t* yslot, const float* gate, float* out, int gtid, int ngt) {
    for (long idx = gtid; idx < (long)M * D / 4; idx += ngt) { const int m = (int)(idx >> 8), c4 = (int)(idx & 255) * 4; const int b = m / SEQ;
        const f32x4 xv = *(const f32x4*)(x1 + (size_t)m * D + c4), gv = *(const f32x4*)(gate + b * 6 * D + c4);
        const u32x2 a = *(const u32x2*)(yslot + (size_t)m * D + c4), c = *(const u32x2*)(yslot + ((size_t)M + m) * D + c4);
        f32x4 y = {bf2f(a.x & 0xffffu) + bf2f(c.x & 0xffffu), bf2f(a.x >> 16) + bf2f(c.x >> 16), bf2f(a.y & 0xffffu) + bf2f(c.y & 0xffffu), bf2f(a.y >> 16) + bf2f(c.y >> 16)};
        *(f32x4*)(out + (size_t)m * D + c4) = xv + gv * y; }
}
}
namespace qk {
constexpr int LDS_BYTES = 8 * 64 * 8 * 4;
__device__ __forceinline__ void unit(int b, int blk, int grp, bf16_t* proj, const f32x2* cs, const float* gn, float* kmean, LAS char* lds, int wid) {
    const int lane = lane_fresh(), tid = wid * 64 + lane;
    const int hd = lane >> 3, half = (lane >> 2) & 1, j = lane & 3;
    const int cb = (grp == 0 ? C_DQ : grp == 1 ? C_DK : grp == 2 ? C_MQ : C_MK) + hd * 64 + half * 32 + 8 * j;
    float gnv[8];
#pragma unroll
    for (int e = 0; e < 8; ++e) gnv[e] = gn[half * 32 + 8 * j + e];
    const float qs = ((grp & 1) == 0) ? QSCALE : 1.0f;
    const float sgn = half ? 1.0f : -1.0f;
    float ksum[8];
#pragma unroll
    for (int e = 0; e < 8; ++e) ksum[e] = 0.f;
    for (int i = 0; i < 32; ++i) {
        const size_t tok = (size_t)b * SEQ + blk * 256 + wid + 8 * i;
        bf16_t* p = proj + tok * INC + cb;
        const u32x4 raw = *(const u32x4*)p;
        float x[8] = {bf2f(raw.x & 0xffffu), bf2f(raw.x >> 16), bf2f(raw.y & 0xffffu), bf2f(raw.y >> 16), bf2f(raw.z & 0xffffu), bf2f(raw.z >> 16), bf2f(raw.w & 0xffffu), bf2f(raw.w >> 16)};
        float ss = 0.f;
#pragma unroll
        for (int e = 0; e < 8; ++e) ss += x[e] * x[e];
        ss += __shfl_xor(ss, 1); ss += __shfl_xor(ss, 2); ss += __shfl_xor(ss, 4);
        const float rn = rsqrtf(ss * (1.0f / 64.0f) + EPS);
        const f32x4* cp = (const f32x4*)(cs + tok * 32 + 8 * j);
        const f32x4 c0 = cp[0], c1 = cp[1], c2 = cp[2], c3 = cp[3];
        const float cc[8] = {c0.x, c0.z, c1.x, c1.z, c2.x, c2.z, c3.x, c3.z}, sn[8] = {c0.y, c0.w, c1.y, c1.w, c2.y, c2.w, c3.y, c3.w};
        float o[8];
#pragma unroll
        for (int e = 0; e < 8; ++e) { const float y = x[e] * rn * gnv[e]; const float py = __shfl_xor(y, 4); o[e] = (y * cc[e] + sgn * py * sn[e]) * qs; }
        u32x4 w; w.x = pk2(o[0], o[1]); w.y = pk2(o[2], o[3]); w.z = pk2(o[4], o[5]); w.w = pk2(o[6], o[7]);
        *(u32x4*)p = w;
        if (grp == 3) { ksum[0] += bf2f(w.x & 0xffffu); ksum[1] += bf2f(w.x >> 16); ksum[2] += bf2f(w.y & 0xffffu); ksum[3] += bf2f(w.y >> 16);
                        ksum[4] += bf2f(w.z & 0xffffu); ksum[5] += bf2f(w.z >> 16); ksum[6] += bf2f(w.w & 0xffffu); ksum[7] += bf2f(w.w >> 16); }
    }
    if (grp == 3) {
        LAS float* red = (LAS float*)lds;
        __syncthreads();
#pragma unroll
        for (int e = 0; e < 8; ++e) red[(wid * 64 + lane) * 8 + e] = ksum[e];
        __syncthreads();
        { const int ln = tid >> 3, e = tid & 7; float s = 0.f;
#pragma unroll
          for (int w = 0; w < 8; ++w) s += red[(w * 64 + ln) * 8 + e];
          const int h2 = ln >> 3, hf = (ln >> 2) & 1, jj = ln & 3;
          kmean[((size_t)((b * 8 + h2) * 8 + blk)) * 64 + hf * 32 + 8 * jj + e] = s * (1.0f / 256.0f); }
        __syncthreads();
    }
}
}
namespace rglru {
constexpr int TT = 32;
constexpr int LDS_WA = 0, LDS_WX = 16384, LDS_XC = 32768, LDS_A = LDS_XC + TT * 65 * 4, LDS_U = LDS_A + TT * 64 * 4, LDS_BYTES = LDS_U + TT * 64 * 4;
__device__ __forceinline__ void unit(int b, int n, const bf16_t* proj, bf16_t* yabc, const float* conv_w, const float* conv_b, const float* wa, const float* ba,
                                     const float* wx, const float* bx, const float* lam, LAS char* lds) {
    int tid_l = threadIdx.x; asm volatile("" : "+v"(tid_l));
    const int tid = tid_l;
    LAS float* Wa = (LAS float*)(lds + LDS_WA); LAS float* Wx = (LAS float*)(lds + LDS_WX); LAS float* XC = (LAS float*)(lds + LDS_XC);
    LAS float* AV = (LAS float*)(lds + LDS_A); LAS float* UV = (LAS float*)(lds + LDS_U);
    __syncthreads();
    for (int i = tid; i < 4096; i += 512) { Wa[i] = wa[(size_t)n * 4096 + i]; Wx[i] = wx[(size_t)n * 4096 + i]; }
    const int cc = tid & 63, ct = tid >> 6;
    const int ch = n * 64 + cc;
    const float cw0 = conv_w[0 * D + ch], cw1 = conv_w[1 * D + ch], cw2 = conv_w[2 * D + ch], cw3 = conv_w[3 * D + ch], cb = conv_b[ch];
    const int gt = tid >> 4, eq = tid & 15;
    float gba[4], gbx[4], gsp[4];
#pragma unroll
    for (int j = 0; j < 4; ++j) { const int e = n * 64 + eq * 4 + j; gba[j] = ba[e]; gbx[j] = bx[e]; const float x = -lam[e]; gsp[j] = fmaxf(x, 0.f) + log1pf(expf(-fabsf(x))); }
    float hstate = 0.f;
    const size_t rowb = (size_t)b * SEQ;
    __syncthreads();
    for (int t0 = 0; t0 < SEQ; t0 += TT) {
#pragma unroll
        for (int i = 0; i < 4; ++i) { const int tt = ct + 8 * i, t = t0 + tt;
            const bf16_t* p = proj + (rowb + t) * INC + C_XR + ch;
            float acc = cb + cw3 * bf2f(p[0]);
            if (t >= 1) acc += cw2 * bf2f(*(p - INC));
            if (t >= 2) acc += cw1 * bf2f(*(p - 2 * INC));
            if (t >= 3) acc += cw0 * bf2f(*(p - 3 * INC));
            XC[tt * 65 + cc] = acc; }
        __syncthreads();
        { f32x4 ar = {0.f, 0.f, 0.f, 0.f}, ai = {0.f, 0.f, 0.f, 0.f};
#pragma unroll 8
          for (int d = 0; d < 64; ++d) { const float xv = XC[gt * 65 + d]; ar += *(const LAS f32x4*)(Wa + d * 64 + eq * 4) * xv; ai += *(const LAS f32x4*)(Wx + d * 64 + eq * 4) * xv; }
#pragma unroll
          for (int j = 0; j < 4; ++j) { const int e = eq * 4 + j;
              const float rg = 1.0f / (1.0f + expf(-(ar[j] + gba[j]))), ig = 1.0f / (1.0f + expf(-(ai[j] + gbx[j])));
              const float log_a = -8.0f * rg * gsp[j]; const float a = expf(log_a); const float mult = sqrtf(-expm1f(2.0f * log_a));
              AV[gt * 64 + e] = a; UV[gt * 64 + e] = mult * ig * XC[gt * 65 + e]; } }
        __syncthreads();
        if (tid < 64) {
            for (int tt = 0; tt < TT; ++tt) { hstate = AV[tt * 64 + tid] * hstate + UV[tt * 64 + tid];
                const size_t row = rowb + t0 + tt;
                const float g = bf2f(proj[row * INC + C_GR + n * 64 + tid]);
                yabc[row * YW + Y_A + n * 64 + tid] = (bf16_t)f2bf(g * hstate); }
        }
        __syncthreads();
    }
}
}

namespace moe {
__device__ __forceinline__ void assign(const int* topi, const float* topw, int* rowtok, int* rowdst, float* roww, int* tile_e, int* ntiles, LAS int* sm, int tid) {
    const int nthr = 512, per = M / nthr, t0 = tid * per;
    int cnt[NE];
#pragma unroll
    for (int e = 0; e < NE; ++e) cnt[e] = 0;
    for (int t = t0; t < t0 + per; ++t) { const int e0 = topi[2 * t], e1 = topi[2 * t + 1];
#pragma unroll
        for (int e = 0; e < NE; ++e) cnt[e] += (e0 == e) + (e1 == e); }
#pragma unroll
    for (int e = 0; e < NE; ++e) sm[e * nthr + tid] = cnt[e];
    __syncthreads();
    if (tid < NE) { int run = 0; for (int i = 0; i < nthr; ++i) { const int v = sm[tid * nthr + i]; sm[tid * nthr + i] = run; run += v; } sm[NE * nthr + tid] = run; }
    __syncthreads();
    if (tid == 0) { int p = 0, nt = 0;
        for (int e = 0; e < NE; ++e) { const int tot = sm[NE * nthr + e]; sm[NE * nthr + 8 + e] = p; const int nte = (tot + 255) >> 8; for (int i = 0; i < nte; ++i) tile_e[nt++] = e; p += nte * 256; }
        *ntiles = nt; }
    __syncthreads();
    for (int e = 0; e < NE; ++e) { const int tot = sm[NE * nthr + e], base = sm[NE * nthr + 8 + e], padded = ((tot + 255) >> 8) << 8;
        for (int i = tot + tid; i < padded; i += nthr) { rowtok[base + i] = 0; rowdst[base + i] = -1; roww[base + i] = 0.f; } }
    int pos[NE];
#pragma unroll
    for (int e = 0; e < NE; ++e) pos[e] = sm[NE * nthr + 8 + e] + sm[e * nthr + tid];
    for (int t = t0; t < t0 + per; ++t) {
#pragma unroll
        for (int k = 0; k < 2; ++k) { const int ek = topi[2 * t + k]; int p = 0;
#pragma unroll
            for (int e = 0; e < NE; ++e) { if (ek == e) { p = pos[e]; pos[e] = p + 1; } }
            rowtok[p] = t; rowdst[p] = k * M + t; roww[p] = topw[2 * t + k]; } }
}
struct Order {
    const int* tile_e; const int* ntiles_p; int nN, G, c, ntiles;
    __device__ __forceinline__ void dev_init(int G_, int c_) { G = G_; c = c_; ntiles = *ntiles_p; }
    __device__ __forceinline__ bool next(int i, pg8::Unit& u) const { const int L = i * G + c; if (L >= ntiles * nN) return false; u.pm = L / nN; u.pn = L % nN; u.e = tile_e[u.pm]; u.aux = 0; return true; }
};
struct ProbUp {
    static constexpr bool GATHER = true;
    const bf16_t* A; const bf16_t* Bt; const int* rowtok; int K, lda, ldb, pad;
    __device__ __forceinline__ const char* a_base(const pg8::Unit&) const { return (const char*)A; }
    __device__ __forceinline__ const char* b_base(const pg8::Unit& u) const { return (const char*)Bt + ((size_t)u.e * DFF2 + (size_t)u.pn * 256) * ldb * 2; }
    __device__ __forceinline__ unsigned a_off(const pg8::Unit& u, int row, int col) const { return (unsigned)(rowtok[u.pm * 256 + row] * lda + col) * 2u; }
};
struct ProbDown {
    static constexpr bool GATHER = false;
    const bf16_t* A; const bf16_t* Bt; int K, lda, ldb, pad;
    __device__ __forceinline__ const char* a_base(const pg8::Unit& u) const { return (const char*)A + (size_t)u.pm * 256 * lda * 2; }
    __device__ __forceinline__ const char* b_base(const pg8::Unit& u) const { return (const char*)Bt + ((size_t)u.e * D + (size_t)u.pn * 256) * ldb * 2; }
    __device__ __forceinline__ unsigned a_off(const pg8::Unit&, int row, int col) const { return (unsigned)(row * lda + col) * 2u; }
};
}
namespace rg2 {
constexpr int TT = 128, XS = 144  , FS = 36  ;
constexpr int L_XCB = 0, L_XCF = L_XCB + TT * XS, L_AV = L_XCF + TT * FS * 4, L_UV = L_AV + TT * FS * 4, L_WA = L_UV + TT * FS * 4, L_WX = L_WA + 32 * XS,
              L_CW = L_WX + 32 * XS, L_SEGA = L_CW + 5 * 64 * 4, L_SEGH = L_SEGA + 16 * 32 * 4, L_CARRY = L_SEGH + 16 * 32 * 4, LDS_BYTES = L_CARRY + 2 * 32 * 4;
__device__ __forceinline__ void unit(int b, int n, int hf, const bf16_t* proj, bf16_t* yabc, const float* conv_w, const float* conv_b, const float* wa, const float* ba,
                                     const float* wx, const float* bx, const float* lam, LAS char* lds, int wid) {
    const int lane = lane_fresh(), tid = wid * 64 + lane;
    LAS float* XCF = (LAS float*)(lds + L_XCF); LAS float* AV = (LAS float*)(lds + L_AV); LAS float* UV = (LAS float*)(lds + L_UV);
    LAS float* CW = (LAS float*)(lds + L_CW); LAS float* SEGA = (LAS float*)(lds + L_SEGA); LAS float* SEGH = (LAS float*)(lds + L_SEGH); LAS float* CARRY = (LAS float*)(lds + L_CARRY);
    const int ch0 = n * 64;
    const int oc0 = ch0 + hf * 32;
    __syncthreads();
    for (int i = tid; i < 2048; i += 512) { const int d = i >> 5, e = i & 31;
        *(LAS bf16_t*)(lds + L_WA + e * XS + d * 2) = (bf16_t)f2bf(wa[(size_t)n * 4096 + d * 64 + hf * 32 + e]);
        *(LAS bf16_t*)(lds + L_WX + e * XS + d * 2) = (bf16_t)f2bf(wx[(size_t)n * 4096 + d * 64 + hf * 32 + e]); }
    if (tid < 320) { const int k = tid >> 6, c = tid & 63; CW[tid] = (k < 4) ? conv_w[k * D + ch0 + c] : conv_b[ch0 + c]; }
    if (tid < 64) CARRY[tid] = 0.f;
    const int crow_ = tid >> 2, cg = tid & 3;
    const int mt = wid & 3, chh = wid >> 2;
    const int g4 = lane >> 4, e16 = lane & 15;
    const int eo = chh * 16 + e16;
    const float gba = ba[oc0 + eo], gbx = bx[oc0 + eo];
    float gsp; { const float x = -lam[oc0 + eo]; gsp = fmaxf(x, 0.f) + log1pf(expf(-fabsf(x))); }
    const int sc = tid & 31, ss = tid >> 5;
    const size_t rowb = (size_t)b * SEQ;
    const bf16_t* xbase = proj + rowb * INC + C_XR + ch0 + cg * 16;
    const bf16_t* gbase = proj + rowb * INC + C_GR + oc0 + sc;
    bf16_t* ybase = yabc + rowb * YW + Y_A + oc0 + sc;
    u32x4 xr[4][2]; unsigned short gv[8];
#define RG2_LOADX(T0) do { _Pragma("unroll") for (int k = 0; k < 4; ++k) { const int t = (T0) + crow_ - 3 + k; \
        if (t >= 0) { const bf16_t* p = xbase + (size_t)t * INC; xr[k][0] = *(const u32x4*)p; xr[k][1] = *(const u32x4*)(p + 8); } \
        else { xr[k][0] = (u32x4){0u, 0u, 0u, 0u}; xr[k][1] = (u32x4){0u, 0u, 0u, 0u}; } } } while (0)
    RG2_LOADX(0);
    __syncthreads();
    for (int ti = 0; ti < SEQ / TT; ++ti) {
        const int t0 = ti * TT;
        {
            float xc[16];
#pragma unroll
            for (int j = 0; j < 16; ++j) xc[j] = CW[4 * 64 + cg * 16 + j];
#pragma unroll
            for (int k = 0; k < 4; ++k) {
#pragma unroll
                for (int q = 0; q < 2; ++q) { const u32x4 w = xr[k][q]; const unsigned ww[4] = {w.x, w.y, w.z, w.w};
#pragma unroll
                    for (int j = 0; j < 4; ++j) { const int c = q * 8 + 2 * j;
                        xc[c] += CW[k * 64 + cg * 16 + c] * bf2f(ww[j] & 0xffffu); xc[c + 1] += CW[k * 64 + cg * 16 + c + 1] * bf2f(ww[j] >> 16); } } }
            u32x4 o0, o1;
            o0.x = pk2(xc[0], xc[1]); o0.y = pk2(xc[2], xc[3]); o0.z = pk2(xc[4], xc[5]); o0.w = pk2(xc[6], xc[7]);
            o1.x = pk2(xc[8], xc[9]); o1.y = pk2(xc[10], xc[11]); o1.z = pk2(xc[12], xc[13]); o1.w = pk2(xc[14], xc[15]);
            *(LAS u32x4*)(lds + L_XCB + crow_ * XS + cg * 32) = o0; *(LAS u32x4*)(lds + L_XCB + crow_ * XS + cg * 32 + 16) = o1;
            if ((cg >> 1) == hf) { LAS float* d = XCF + crow_ * FS + (cg & 1) * 16;
#pragma unroll
                for (int j = 0; j < 4; ++j) *(LAS f32x4*)(d + 4 * j) = (f32x4){xc[4 * j], xc[4 * j + 1], xc[4 * j + 2], xc[4 * j + 3]}; }
        }
#pragma unroll
        for (int k = 0; k < 8; ++k) gv[k] = gbase[(size_t)(t0 + ss * 8 + k) * INC];
        __syncthreads();
        if (ti + 1 < SEQ / TT) RG2_LOADX(t0 + TT);
        {
            f32x4 ar[2], ai[2];
#pragma unroll
            for (int s = 0; s < 2; ++s) { ar[s] = (f32x4){0.f, 0.f, 0.f, 0.f}; ai[s] = (f32x4){0.f, 0.f, 0.f, 0.f}; }
#pragma unroll
            for (int kk = 0; kk < 2; ++kk) {
                const bf16x8 bwa = *(const LAS bf16x8*)(lds + L_WA + eo * XS + (32 * kk + 8 * g4) * 2);
                const bf16x8 bwx = *(const LAS bf16x8*)(lds + L_WX + eo * XS + (32 * kk + 8 * g4) * 2);
#pragma unroll
                for (int s = 0; s < 2; ++s) {
                    const bf16x8 av = *(const LAS bf16x8*)(lds + L_XCB + (mt * 32 + 16 * s + e16) * XS + (32 * kk + 8 * g4) * 2);
                    ar[s] = __builtin_amdgcn_mfma_f32_16x16x32_bf16(av, bwa, ar[s], 0, 0, 0);
                    ai[s] = __builtin_amdgcn_mfma_f32_16x16x32_bf16(av, bwx, ai[s], 0, 0, 0);
                }
            }
#pragma unroll
            for (int s = 0; s < 2; ++s)
#pragma unroll
                for (int rg = 0; rg < 4; ++rg) {
                    const int tok = mt * 32 + 16 * s + 4 * g4 + rg;
                    const float rgt = sigmoid_f(ar[s][rg] + gba), igt = sigmoid_f(ai[s][rg] + gbx);
                    const float log_a = -8.0f * rgt * gsp;
                    const float a = fexp2(log_a * 1.4426950408889634f);
                    const float z = 2.0f * log_a;
                    const float poly = z * (1.0f + z * (0.5f + z * (0.16666667f + z * (0.041666668f + z * (0.0083333338f + z * 0.0013888889f)))));
                    const float om = (z > -0.25f) ? -poly : (1.0f - a * a);
                    const float u = sqrtf(om) * igt * XCF[tok * FS + eo];
                    AV[tok * FS + eo] = a; UV[tok * FS + eo] = u;
                }
        }
        __syncthreads();
        float hl[8], ac[8];
        { float Hh = 0.f, Aa = 1.f;
#pragma unroll
          for (int k = 0; k < 8; ++k) { const float a = AV[(ss * 8 + k) * FS + sc], u = UV[(ss * 8 + k) * FS + sc]; Hh = a * Hh + u; Aa *= a; hl[k] = Hh; ac[k] = Aa; }
          SEGA[ss * 32 + sc] = Aa; SEGH[ss * 32 + sc] = Hh; }
        __syncthreads();
        { float cin = CARRY[(ti & 1) * 32 + sc];
          for (int s2 = 0; s2 < ss; ++s2) cin = SEGA[s2 * 32 + sc] * cin + SEGH[s2 * 32 + sc];
#pragma unroll
          for (int k = 0; k < 8; ++k) { const float hv = hl[k] + ac[k] * cin; hl[k] = hv;
              ybase[(size_t)(t0 + ss * 8 + k) * YW] = (bf16_t)f2bf(bf2f(gv[k]) * hv); }
          if (ss == 15) CARRY[((ti + 1) & 1) * 32 + sc] = hl[7]; }
    }
    __syncthreads();
#undef RG2_LOADX
}
}
constexpr size_t MiB = 1u << 20;
constexpr size_t WS_CTL = 0, CTL_ZERO_BYTES = 64 * 1024, WS_ROWTOK = 256 * 1024, WS_ROWDST = 400 * 1024, WS_ROWW = 544 * 1024, WS_TILEE = 700 * 1024, WS_NTILES = 702 * 1024;
constexpr size_t WS_MOD = 1 * MiB, WS_CS = 1 * MiB + 512 * 1024, WS_KMEAN = 5 * MiB + 512 * 1024, WS_TOPI = 5 * MiB + 640 * 1024, WS_TOPW = 5 * MiB + 768 * 1024;
constexpr size_t WS_L1W = 6 * MiB, WS_H = 28 * MiB, WS_YABC = 60 * MiB, WS_PROJ = 124 * MiB, WS_XA = 380 * MiB, WS_END = 444 * MiB;
constexpr size_t WS_MOEW13 = 6 * MiB, WS_MOEW2 = 94 * MiB, WS_HMID_MOE = 138 * MiB, WS_YSLOT = 325 * MiB, WS_H2L1 = 412 * MiB;
constexpr size_t LW_IN = 0, LW_BRA = 16 * MiB, LW_BRB = 18 * MiB, LW_BRC = 19 * MiB, LW_OUT = 20 * MiB, LW_W13 = 22 * MiB, LW_W2 = 33 * MiB;
constexpr int CW_TMO = 0, CW_QUEUE = 64  , CW_BAR = 4096;
constexpr int LDS_MISC = 131072 + 8192, LDS_TOTAL = 147456;


#define XB_TMO      128
#define XB_XCNT(j)  (256  + 64 * (j))
#define XB_XSUB(j)  (1280 + 64 * (j))
#define XB_XGEN(j)  (2304 + 64 * (j))
#define XB_TOP      3328
#define XB_TOPGEN   3392
#define XCD_BAR_WORDS 3456
#define XB_SPIN_CAP (1u << 18)

__device__ __forceinline__ unsigned xb_ld(unsigned* p)              { return __hip_atomic_load(p, __ATOMIC_RELAXED, __HIP_MEMORY_SCOPE_AGENT); }
__device__ __forceinline__ unsigned xb_add(unsigned* p, unsigned v) { return __hip_atomic_fetch_add(p, v, __ATOMIC_RELAXED, __HIP_MEMORY_SCOPE_AGENT); }
__device__ __forceinline__ unsigned xb_xcc_id() { return (unsigned)__builtin_amdgcn_s_getreg((3 << 11) | 20) & 0xFu; }
#define XB_SPIN(cond, bar) do { unsigned _sp = 0; while (cond) { __builtin_amdgcn_s_sleep(1); \
    if ((++_sp & 255u) == 0u) { if (xb_ld(&(bar)[XB_TMO])) break; if (_sp > XB_SPIN_CAP) { atomicAdd(&(bar)[XB_TMO], 1u); break; } } } } while (0)

struct XcdBarrier {
    unsigned* bar; unsigned x;
    volatile LAS unsigned* st;
};

__device__ __forceinline__ XcdBarrier xcd_barrier_post(unsigned* bar, volatile LAS unsigned* st) {
    XcdBarrier b; b.bar = bar; b.x = xb_xcc_id(); b.st = st;
    if (threadIdx.x == 0) (void)xb_add(&bar[XB_XCNT(b.x)], 1u);
    return b;
}
__device__ __forceinline__ void xcd_barrier_complete(unsigned* bar, unsigned x, unsigned& nloc, unsigned& nx) {
    const unsigned G = gridDim.x * gridDim.y * gridDim.z;
    unsigned sum, cnt, mine, sp = 0u;
    for (;;) {
        sum = 0u; cnt = 0u; mine = 0u;
#pragma unroll
        for (unsigned j = 0; j < 16; ++j) { const unsigned c = xb_ld(&bar[XB_XCNT(j)]); sum += c; cnt += (c > 0u) ? 1u : 0u; mine = (j == x) ? c : mine; }
        if (sum == G) break;
        __builtin_amdgcn_s_sleep(1);
        if ((++sp & 255u) == 0u) { if (xb_ld(&bar[XB_TMO])) break; if (sp > XB_SPIN_CAP) { atomicAdd(&bar[XB_TMO], 1u); break; } }
    }
    nloc = mine > 0u ? mine : 1u; nx = cnt > 0u ? cnt : 1u;
}

__device__ __forceinline__ void xcd_barrier(const XcdBarrier& b) {
    asm volatile("s_waitcnt vmcnt(0)" ::: "memory");
    __syncthreads();
    if (threadIdx.x == 0) {
        unsigned* bar = b.bar;
        __builtin_amdgcn_s_waitcnt(0);
        unsigned nloc = b.st[0], nx = b.st[1];
        if (nloc == 0u) { xcd_barrier_complete(bar, b.x, nloc, nx); b.st[0] = nloc; b.st[1] = nx; }
        const unsigned old = xb_add(&bar[XB_XSUB(b.x)], 1u);
        const unsigned gen = old / nloc;
        if (old + 1u == (gen + 1u) * nloc) {
            __builtin_amdgcn_fence(__ATOMIC_RELEASE, "agent");
            asm volatile("s_waitcnt vmcnt(0)" ::: "memory");
            const unsigned og = xb_add(&bar[XB_TOP], 1u);
            const unsigned tg = og / nx;
            if (og + 1u == (tg + 1u) * nx) xb_add(&bar[XB_TOPGEN], 1u);
            else XB_SPIN(xb_ld(&bar[XB_TOPGEN]) == tg, bar);
            __builtin_amdgcn_fence(__ATOMIC_ACQUIRE, "agent");
            xb_add(&bar[XB_XGEN(b.x)], 1u);
            asm volatile("s_waitcnt vmcnt(0)" ::: "memory");
        } else {
            XB_SPIN(xb_ld(&bar[XB_XGEN(b.x)]) == gen, bar);
            __builtin_amdgcn_fence(__ATOMIC_ACQUIRE, "agent");
            asm volatile("s_waitcnt vmcnt(0)" ::: "memory");
        }
    }
    __syncthreads();
}


#ifndef PHMASK
#define PHMASK 0xFFFFF
#endif
#define PH(k) if constexpr ((PHMASK >> (k)) & 1)
#define QOFF 0
__device__ __forceinline__ const float* ldptr(const LAS unsigned long long* PT, int i) {
    const unsigned long long v = PT[i];
    const unsigned lo = __builtin_amdgcn_readfirstlane((unsigned)v), hi = __builtin_amdgcn_readfirstlane((unsigned)(v >> 32));
    return (const float*)(const __attribute__((address_space(1))) float*)(((unsigned long long)hi << 32) | lo);
}
struct Args { const float* in[37]; float* out; unsigned char* ws; };

__device__ __forceinline__ float diff_lambda(const float* lq1, const float* lk1, const float* lq2, const float* lk2, float lam_init, int lane) {
    const float s1 = wave_sum(lq1[lane] * lk1[lane]), s2 = wave_sum(lq2[lane] * lk2[lane]); return expf(s1) - expf(s2) + lam_init; }

constexpr int NQ_RG = 256, NQ_TOTAL = 256 + 256 + 512;
__global__ void __launch_bounds__(512, 2) mega_fwd(Args a) {
    extern __shared__ __attribute__((aligned(16))) unsigned char lds_raw[];
    LAS unsigned char* lds = (LAS unsigned char*)lds_raw;
    volatile LAS unsigned* MISC = (volatile LAS unsigned*)(lds + LDS_MISC);
    const int tid0 = threadIdx.x, wid0 = __builtin_amdgcn_readfirstlane(tid0 >> 6);
    const int G = gridDim.x, bid = blockIdx.x;
    if (tid0 < 64) MISC[tid0] = 0u;
    LAS unsigned long long* PT = (LAS unsigned long long*)(lds + LDS_MISC + 256);
    if (tid0 == 0) {
#pragma unroll
        for (int i = 0; i < 37; ++i) PT[i] = (unsigned long long)a.in[i];
    }
    __syncthreads();
    XcdBarrier bar = xcd_barrier_post((unsigned*)(a.ws + WS_CTL) + CW_BAR, MISC + 8);
#define F(i) ldptr(PT, (i))
#define PHASE_VARS(lv) \
    unsigned long long ws_u = (unsigned long long)a.ws, out_u = (unsigned long long)a.out; const int l = (lv); int wid = wid0; \
    asm volatile("" : "+s"(ws_u), "+s"(out_u), "+s"(wid)); \
    const int lane = lane_fresh(), tid = wid * 64 + lane; \
    unsigned char* ws = (unsigned char*)(__attribute__((address_space(1))) unsigned char*)ws_u; float* outp = (float*)(__attribute__((address_space(1))) float*)out_u; \
    const int gw = bid * 8 + wid, ngw = G * 8, gtid = bid * 512 + tid, ngt = G * 512; (void)gw; (void)ngw; (void)gtid; (void)ngt; (void)lane; (void)l; (void)tid; \
    char* outb = (char*)outp; (void)outb; \
    float* mod = (float*)(ws + WS_MOD); f32x2* cs = (f32x2*)(ws + WS_CS); float* kmean = (float*)(ws + WS_KMEAN); (void)mod; (void)cs; (void)kmean; \
    bf16_t* H = (bf16_t*)(ws + WS_H); bf16_t* YABC = (bf16_t*)(ws + WS_YABC); bf16_t* PROJ = (bf16_t*)(ws + WS_PROJ); float* XA = (float*)(ws + WS_XA); (void)H; (void)YABC; (void)PROJ; (void)XA; \
    const float* xin = (l == 0) ? F(0) : (const float*)XA; float* x1 = (l == 0) ? XA : outp; const char* lwb = (l == 0) ? (const char*)outb : (const char*)ws + WS_L1W; \
    const float* modl = mod + (size_t)l * NB * 6 * D; (void)xin; (void)x1; (void)lwb; (void)modl;

    PH(0) { PHASE_VARS(0)
        LAS float* scr = (LAS float*)(lds + wid * 8192);
#pragma unroll 1
        for (int ll = 0; ll < 2; ++ll) {
            char* lw2 = ll == 0 ? outb : (char*)ws + WS_L1W;
            thin::transpose_matrix(F(7) + (size_t)ll * D * INC, D, INC, (bf16_t*)(lw2 + LW_IN), D, 0, 0, 0, scr, gw, ngw, lane);
            thin::transpose_matrix(F(25) + (size_t)ll * D * D, D, D, (bf16_t*)(lw2 + LW_BRA), 2048, 0, 0, 0, scr, gw, ngw, lane);
            thin::transpose_matrix(F(26) + (size_t)ll * 512 * D, 512, D, (bf16_t*)(lw2 + LW_BRA), 2048, 1024, 0, 0, scr, gw, ngw, lane);
            thin::transpose_matrix(F(27) + (size_t)ll * 512 * D, 512, D, (bf16_t*)(lw2 + LW_BRA), 2048, 1536, 0, 0, scr, gw, ngw, lane);
            thin::transpose_matrix(F(28) + (size_t)ll * D * D, D, D, (bf16_t*)(lw2 + LW_OUT), D, 0, 0, 0, scr, gw, ngw, lane);
        }
        thin::transpose_matrix(F(29), D, DFF, (bf16_t*)(outb + LW_W13), D, 0, 0, 1, scr, gw, ngw, lane);
        thin::transpose_matrix(F(30), D, DFF, (bf16_t*)(outb + LW_W13), D, 0, 0, 2, scr, gw, ngw, lane);
        thin::transpose_matrix(F(31), DFF, D, (bf16_t*)(outb + LW_W2), DFF, 0, 0, 0, scr, gw, ngw, lane);
        __syncthreads();
        thin::mod_body(F(1), F(3), F(4), mod, bid, G, tid, (LAS float*)(lds + 65536));
        thin::rope_body((const int*)F(2), cs, gtid, ngt);
    }
    xcd_barrier(bar);

    {
        PH(1) { PHASE_VARS(0) thin::norm_body(xin, F(5) + l * D, modl + 0 * D, modl + 1 * D, H, gw, ngw, lane); }
        xcd_barrier(bar);
        PH(2) { PHASE_VARS(0) pg8::DenseProb g{H, (const bf16_t*)(lwb + LW_IN), D, D, D, 0}; pg8::StaticOrder S; S.init(M, INC, G, bid);
          pg8::gemm_phase<pg8::DenseProb, epi::Proj, pg8::StaticOrder, true>(lds, g, S, epi::Proj{PROJ, F(8) + l * 3 * D}, wid); }
        xcd_barrier(bar);
        PH(3) { PHASE_VARS(0) for (int u = bid; u < 256; u += G) { const int grp = u & 3;
            qk::unit(u >> 5, (u >> 2) & 7, grp, PROJ, cs, (grp == 0 ? F(16) : grp == 1 ? F(17) : grp == 2 ? F(23) : F(24)) + l * 64, kmean, (LAS char*)lds, wid); } }
        xcd_barrier(bar);
        {
#define POP_Q() do { __syncthreads(); if (tid == 0) MISC[16] = __hip_atomic_fetch_add((unsigned*)(ws + WS_CTL) + CW_QUEUE + 64 * (l + QOFF), 1u, __ATOMIC_RELAXED, __HIP_MEMORY_SCOPE_AGENT); __syncthreads(); q = (int)MISC[16]; } while (0)
            int q;
            { PHASE_VARS(0) POP_Q(); }
            PH(5) { PHASE_VARS(0)
              const float lam_init = 0.8f - 0.6f * expf(-0.3f * (float)l);
              const float lam = diff_lambda(F(18) + l * 64, F(19) + l * 64, F(20) + l * 64, F(21) + l * 64, lam_init, lane);
              const float noff = attn::score_shift(F(16) + l * 64, F(17) + l * 64, lane);
#pragma unroll 1
              while (q < 256) { const int i = q;
                attn::diff_unit((i & 31) >> 2, i & 3, 7 - (i >> 5), PROJ, YABC, F(22) + l * 128, lam, 1.0f - lam_init, noff, (LAS char*)lds, wid);
                POP_Q(); } }
            PH(4) { PHASE_VARS(0)
#pragma unroll 1
              while (q < 256 + NQ_RG) { const int i = q - 256;
                rg2::unit(i >> 5, (i >> 1) & 15, i & 1, PROJ, YABC, F(9) + l * 4 * D, F(10) + l * D, F(11) + (size_t)l * 16 * 4096, F(12) + l * D, F(13) + (size_t)l * 16 * 4096, F(14) + l * D, F(15) + l * D, (LAS char*)lds, wid);
                POP_Q(); } }
            PH(6) { PHASE_VARS(0)
              const float noff = attn::score_shift(F(23) + l * 64, F(24) + l * 64, lane);
#pragma unroll 1
              while (q < NQ_TOTAL) { const int i = q - NQ_RG - 256;
                attn::moba_unit((i & 63) >> 3, i & 7, 7 - (i >> 6), PROJ, YABC, kmean, noff, (LAS char*)lds, wid);
                POP_Q(); } }
#undef POP_Q
        }
        xcd_barrier(bar);
        PH(7) { PHASE_VARS(0) pg8::StaticOrder S; S.init(M, D, G, bid); pg8::DenseProb g{YABC, (const bf16_t*)(lwb + LW_BRA), 2048, YW, 2048, 0};
          pg8::gemm_phase<pg8::DenseProb, epi::BranchMerge, pg8::StaticOrder, true>(lds, g, S, epi::BranchMerge{PROJ, H, 16, 24}, wid); }
        xcd_barrier(bar);
        PH(8) { PHASE_VARS(0) pg8::DenseProb g{H, (const bf16_t*)(lwb + LW_OUT), D, D, D, 0}; pg8::StaticOrder S; S.init(M, D, G, bid);
          pg8::gemm_phase<pg8::DenseProb, epi::Resid, pg8::StaticOrder, true>(lds, g, S, epi::Resid{xin, x1, modl + 2 * D}, wid); }
        xcd_barrier(bar);
        if (0 == 0) {
            PH(9) { PHASE_VARS(0) thin::norm_body(x1, F(6) + l * D, modl + 3 * D, modl + 4 * D, H, gw, ngw, lane); }
            xcd_barrier(bar);
            PH(10) { PHASE_VARS(0) pg8::DenseProb g{H, (const bf16_t*)(lwb + LW_W13), D, D, D, 0}; pg8::StaticOrder S; S.init(M, DFF2, G, bid);
              pg8::gemm_phase<pg8::DenseProb, epi::SwiGLU, pg8::StaticOrder, true>(lds, g, S, epi::SwiGLU{PROJ}, wid); }
            xcd_barrier(bar);
            PH(11) { PHASE_VARS(0) pg8::DenseProb g{PROJ, (const bf16_t*)(lwb + LW_W2), DFF, DFF, DFF, 0}; pg8::StaticOrder S; S.init(M, D, G, bid);
              pg8::gemm_phase<pg8::DenseProb, epi::Resid, pg8::StaticOrder, true>(lds, g, S, epi::Resid{x1, x1, modl + 5 * D}, wid); }
            xcd_barrier(bar);
        } else {
#define MOE_VARS \
            bf16_t* W13 = (bf16_t*)(ws + WS_MOEW13); bf16_t* W2 = (bf16_t*)(ws + WS_MOEW2); bf16_t* h2 = (bf16_t*)(ws + WS_H2L1); bf16_t* hmid = (bf16_t*)(ws + WS_HMID_MOE); bf16_t* yslot = (bf16_t*)(ws + WS_YSLOT); \
            int* topi = (int*)(ws + WS_TOPI); float* topw = (float*)(ws + WS_TOPW); int* rowtok = (int*)(ws + WS_ROWTOK); int* rowdst = (int*)(ws + WS_ROWDST); float* roww = (float*)(ws + WS_ROWW); int* tile_e = (int*)(ws + WS_TILEE); int* ntiles = (int*)(ws + WS_NTILES); \
            (void)W13; (void)W2; (void)h2; (void)hmid; (void)yslot; (void)topi; (void)topw; (void)rowtok; (void)rowdst; (void)roww; (void)tile_e; (void)ntiles;
            PH(12) { PHASE_VARS(0) MOE_VARS thin::norm_router_body(x1, F(6) + l * D, modl + 3 * D, modl + 4 * D, h2, F(32), F(33), topi, topw, gw, ngw, lane); }
            PH(13) { PHASE_VARS(0) MOE_VARS LAS float* scr = (LAS float*)(lds + wid * 8192);
#pragma unroll 1
              for (int e = 0; e < NE; ++e) {
                thin::transpose_matrix(F(34) + (size_t)e * D * DFF, D, DFF, W13, D, 0, e * DFF2, 1, scr, gw, ngw, lane);
                thin::transpose_matrix(F(35) + (size_t)e * D * DFF, D, DFF, W13, D, 0, e * DFF2, 2, scr, gw, ngw, lane);
                thin::transpose_matrix(F(36) + (size_t)e * DFF * D, DFF, D, W2, DFF, 0, e * D, 0, scr, gw, ngw, lane); } }
            xcd_barrier(bar);
            PH(14) { PHASE_VARS(0) MOE_VARS if (bid == 0) moe::assign(topi, topw, rowtok, rowdst, roww, tile_e, ntiles, (LAS int*)lds, tid); }
            xcd_barrier(bar);
            PH(15) { PHASE_VARS(0) MOE_VARS moe::Order S{tile_e, ntiles, DFF2 / 256, 0, 0, 0}; S.dev_init(G, bid);
              pg8::gemm_phase<moe::ProbUp, epi::SwiGLU, moe::Order, true>(lds, moe::ProbUp{h2, W13, rowtok, D, D, D, 0}, S, epi::SwiGLU{hmid}, wid); }
            xcd_barrier(bar);
            PH(16) { PHASE_VARS(0) MOE_VARS moe::Order S{tile_e, ntiles, D / 256, 0, 0, 0}; S.dev_init(G, bid);
              pg8::gemm_phase<moe::ProbDown, epi::MoeDown, moe::Order, true>(lds, moe::ProbDown{hmid, W2, DFF, DFF, DFF, 0}, S, epi::MoeDown{rowdst, roww, yslot}, wid); }
            xcd_barrier(bar);
            PH(17) { PHASE_VARS(0) MOE_VARS thin::moe_combine_body(x1, yslot, modl + 5 * D, outp, gtid, ngt); }
#undef MOE_VARS
        }
    }
    {
        PH(1) { PHASE_VARS(1) thin::norm_body(xin, F(5) + l * D, modl + 0 * D, modl + 1 * D, H, gw, ngw, lane); }
        xcd_barrier(bar);
        PH(2) { PHASE_VARS(1) pg8::DenseProb g{H, (const bf16_t*)(lwb + LW_IN), D, D, D, 0}; pg8::StaticOrder S; S.init(M, INC, G, bid);
          pg8::gemm_phase<pg8::DenseProb, epi::Proj, pg8::StaticOrder, true>(lds, g, S, epi::Proj{PROJ, F(8) + l * 3 * D}, wid); }
        xcd_barrier(bar);
        PH(3) { PHASE_VARS(1) for (int u = bid; u < 256; u += G) { const int grp = u & 3;
            qk::unit(u >> 5, (u >> 2) & 7, grp, PROJ, cs, (grp == 0 ? F(16) : grp == 1 ? F(17) : grp == 2 ? F(23) : F(24)) + l * 64, kmean, (LAS char*)lds, wid); } }
        xcd_barrier(bar);
        {
#define POP_Q() do { __syncthreads(); if (tid == 0) MISC[16] = __hip_atomic_fetch_add((unsigned*)(ws + WS_CTL) + CW_QUEUE + 64 * (l + QOFF), 1u, __ATOMIC_RELAXED, __HIP_MEMORY_SCOPE_AGENT); __syncthreads(); q = (int)MISC[16]; } while (0)
            int q;
            { PHASE_VARS(1) POP_Q(); }
            PH(5) { PHASE_VARS(1)
              const float lam_init = 0.8f - 0.6f * expf(-0.3f * (float)l);
              const float lam = diff_lambda(F(18) + l * 64, F(19) + l * 64, F(20) + l * 64, F(21) + l * 64, lam_init, lane);
              const float noff = attn::score_shift(F(16) + l * 64, F(17) + l * 64, lane);
#pragma unroll 1
              while (q < 256) { const int i = q;
                attn::diff_unit((i & 31) >> 2, i & 3, 7 - (i >> 5), PROJ, YABC, F(22) + l * 128, lam, 1.0f - lam_init, noff, (LAS char*)lds, wid);
                POP_Q(); } }
            PH(4) { PHASE_VARS(1)
#pragma unroll 1
              while (q < 256 + NQ_RG) { const int i = q - 256;
                rg2::unit(i >> 5, (i >> 1) & 15, i & 1, PROJ, YABC, F(9) + l * 4 * D, F(10) + l * D, F(11) + (size_t)l * 16 * 4096, F(12) + l * D, F(13) + (size_t)l * 16 * 4096, F(14) + l * D, F(15) + l * D, (LAS char*)lds, wid);
                POP_Q(); } }
            PH(6) { PHASE_VARS(1)
              const float noff = attn::score_shift(F(23) + l * 64, F(24) + l * 64, lane);
#pragma unroll 1
              while (q < NQ_TOTAL) { const int i = q - NQ_RG - 256;
                attn::moba_unit((i & 63) >> 3, i & 7, 7 - (i >> 6), PROJ, YABC, kmean, noff, (LAS char*)lds, wid);
                POP_Q(); } }
#undef POP_Q
        }
        xcd_barrier(bar);
        PH(7) { PHASE_VARS(1) pg8::StaticOrder S; S.init(M, D, G, bid); pg8::DenseProb g{YABC, (const bf16_t*)(lwb + LW_BRA), 2048, YW, 2048, 0};
          pg8::gemm_phase<pg8::DenseProb, epi::BranchMerge, pg8::StaticOrder, true>(lds, g, S, epi::BranchMerge{PROJ, H, 16, 24}, wid); }
        xcd_barrier(bar);
        PH(8) { PHASE_VARS(1) pg8::DenseProb g{H, (const bf16_t*)(lwb + LW_OUT), D, D, D, 0}; pg8::StaticOrder S; S.init(M, D, G, bid);
          pg8::gemm_phase<pg8::DenseProb, epi::Resid, pg8::StaticOrder, true>(lds, g, S, epi::Resid{xin, x1, modl + 2 * D}, wid); }
        xcd_barrier(bar);
        if (1 == 0) {
            PH(9) { PHASE_VARS(1) thin::norm_body(x1, F(6) + l * D, modl + 3 * D, modl + 4 * D, H, gw, ngw, lane); }
            xcd_barrier(bar);
            PH(10) { PHASE_VARS(1) pg8::DenseProb g{H, (const bf16_t*)(lwb + LW_W13), D, D, D, 0}; pg8::StaticOrder S; S.init(M, DFF2, G, bid);
              pg8::gemm_phase<pg8::DenseProb, epi::SwiGLU, pg8::StaticOrder, true>(lds, g, S, epi::SwiGLU{PROJ}, wid); }
            xcd_barrier(bar);
            PH(11) { PHASE_VARS(1) pg8::DenseProb g{PROJ, (const bf16_t*)(lwb + LW_W2), DFF, DFF, DFF, 0}; pg8::StaticOrder S; S.init(M, D, G, bid);
              pg8::gemm_phase<pg8::DenseProb, epi::Resid, pg8::StaticOrder, true>(lds, g, S, epi::Resid{x1, x1, modl + 5 * D}, wid); }
            xcd_barrier(bar);
        } else {
#define MOE_VARS \
            bf16_t* W13 = (bf16_t*)(ws + WS_MOEW13); bf16_t* W2 = (bf16_t*)(ws + WS_MOEW2); bf16_t* h2 = (bf16_t*)(ws + WS_H2L1); bf16_t* hmid = (bf16_t*)(ws + WS_HMID_MOE); bf16_t* yslot = (bf16_t*)(ws + WS_YSLOT); \
            int* topi = (int*)(ws + WS_TOPI); float* topw = (float*)(ws + WS_TOPW); int* rowtok = (int*)(ws + WS_ROWTOK); int* rowdst = (int*)(ws + WS_ROWDST); float* roww = (float*)(ws + WS_ROWW); int* tile_e = (int*)(ws + WS_TILEE); int* ntiles = (int*)(ws + WS_NTILES); \
            (void)W13; (void)W2; (void)h2; (void)hmid; (void)yslot; (void)topi; (void)topw; (void)rowtok; (void)rowdst; (void)roww; (void)tile_e; (void)ntiles;
            PH(12) { PHASE_VARS(1) MOE_VARS thin::norm_router_body(x1, F(6) + l * D, modl + 3 * D, modl + 4 * D, h2, F(32), F(33), topi, topw, gw, ngw, lane); }
            PH(13) { PHASE_VARS(1) MOE_VARS LAS float* scr = (LAS float*)(lds + wid * 8192);
#pragma unroll 1
              for (int e = 0; e < NE; ++e) {
                thin::transpose_matrix(F(34) + (size_t)e * D * DFF, D, DFF, W13, D, 0, e * DFF2, 1, scr, gw, ngw, lane);
                thin::transpose_matrix(F(35) + (size_t)e * D * DFF, D, DFF, W13, D, 0, e * DFF2, 2, scr, gw, ngw, lane);
                thin::transpose_matrix(F(36) + (size_t)e * DFF * D, DFF, D, W2, DFF, 0, e * D, 0, scr, gw, ngw, lane); } }
            xcd_barrier(bar);
            PH(14) { PHASE_VARS(1) MOE_VARS if (bid == 0) moe::assign(topi, topw, rowtok, rowdst, roww, tile_e, ntiles, (LAS int*)lds, tid); }
            xcd_barrier(bar);
            PH(15) { PHASE_VARS(1) MOE_VARS moe::Order S{tile_e, ntiles, DFF2 / 256, 0, 0, 0}; S.dev_init(G, bid);
              pg8::gemm_phase<moe::ProbUp, epi::SwiGLU, moe::Order, true>(lds, moe::ProbUp{h2, W13, rowtok, D, D, D, 0}, S, epi::SwiGLU{hmid}, wid); }
            xcd_barrier(bar);
            PH(16) { PHASE_VARS(1) MOE_VARS moe::Order S{tile_e, ntiles, D / 256, 0, 0, 0}; S.dev_init(G, bid);
              pg8::gemm_phase<moe::ProbDown, epi::MoeDown, moe::Order, true>(lds, moe::ProbDown{hmid, W2, DFF, DFF, DFF, 0}, S, epi::MoeDown{rowdst, roww, yslot}, wid); }
            xcd_barrier(bar);
            PH(17) { PHASE_VARS(1) MOE_VARS thin::moe_combine_body(x1, yslot, modl + 5 * D, outp, gtid, ngt); }
#undef MOE_VARS
        }
    }
#undef F
#undef PHASE_VARS
}

extern "C" void kernel_launch(void* const* d_in, const int* in_sizes, int n_in, void* d_out, int out_size, void* d_ws, size_t ws_size, hipStream_t stream) {
    static int grid = 0;
    if (grid == 0) {
        if (n_in != 37 || ws_size < WS_END) { fprintf(stderr, "kernel_launch: unexpected n_in %d / ws_size %zu (need %zu)\n", n_in, ws_size, (size_t)WS_END); grid = -1; return; }
        int dev = 0, cus = 0, per_cu = 0;
        if (hipGetDevice(&dev) != hipSuccess || hipDeviceGetAttribute(&cus, hipDeviceAttributeMultiprocessorCount, dev) != hipSuccess) { grid = -1; return; }
        if (hipFuncSetAttribute((const void*)mega_fwd, hipFuncAttributeMaxDynamicSharedMemorySize, LDS_TOTAL) != hipSuccess) { fprintf(stderr, "kernel_launch: hipFuncSetAttribute failed\n"); grid = -1; return; }
        if (hipOccupancyMaxActiveBlocksPerMultiprocessor(&per_cu, (const void*)mega_fwd, 512, LDS_TOTAL) != hipSuccess || per_cu < 1) fprintf(stderr, "kernel_launch: occupancy query says %d\n", per_cu);
        (void)hipGetLastError();
        grid = cus;
    }
    if (grid < 0) return;
    (void)hipMemsetAsync((char*)d_ws + WS_CTL, 0, CTL_ZERO_BYTES, stream);
    Args a{};
    for (int i = 0; i < 37; ++i) a.in[i] = (const float*)d_in[i];
    a.out = (float*)d_out; a.ws = (unsigned char*)d_ws;
    hipLaunchKernelGGL(mega_fwd, dim3(grid), dim3(512), LDS_TOTAL, stream, a);
}
```

```cpp
#include <hip/hip_runtime.h>
#include <stdint.h>
#include <stdio.h>

#define LAS __attribute__((address_space(3)))
typedef unsigned short bf16_t;
typedef short bf16x8 __attribute__((ext_vector_type(8)));
typedef short s16x4 __attribute__((ext_vector_type(4)));
typedef float f32x2 __attribute__((ext_vector_type(2)));
typedef float f32x4 __attribute__((ext_vector_type(4)));
typedef float f32x16 __attribute__((ext_vector_type(16)));
typedef unsigned u32x2 __attribute__((ext_vector_type(2)));
typedef unsigned u32x4 __attribute__((ext_vector_type(4)));

constexpr int D = 1024, NB = 8, SEQ = 2048, M = NB * SEQ, INC = 8192, DFF = 2816, NE = 8, DFF2 = 2 * DFF;
constexpr int C_XR = 0, C_GR = 1024, C_DQ = 2048, C_DK = 2560, C_DV = 3072, C_MQ = 3584, C_MK = 4096, C_MV = 4608, C_GB = 5120;
constexpr int YW = 2048, Y_A = 0, Y_B = 1024, Y_C = 1536;
constexpr float EPS = 1e-6f;
constexpr float QSCALE = 0.125f * 1.4426950408889634f;
constexpr int MOE_MAXROWS = 34816, MOE_MAXTILES = MOE_MAXROWS / 256;

__device__ __forceinline__ float bf2f(unsigned v) { return __uint_as_float(v << 16); }
__device__ __forceinline__ unsigned f2bf(float f) { unsigned u = __float_as_uint(f); return (u + 0x7fffu + ((u >> 16) & 1u)) >> 16; }
__device__ __forceinline__ unsigned pk2(float lo, float hi) { unsigned r; asm volatile("v_cvt_pk_bf16_f32 %0, %1, %2" : "=v"(r) : "v"(lo), "v"(hi)); return r; }
__device__ __forceinline__ float fexp2(float x) { return __builtin_amdgcn_exp2f(x); }
__device__ __forceinline__ float frcp(float x) { return __builtin_amdgcn_rcpf(x); }
__device__ __forceinline__ float sigmoid_f(float x) { return frcp(1.0f + fexp2(-1.4426950408889634f * x)); }
__device__ __forceinline__ float gelu_tanh_f(float x) { return x * sigmoid_f(1.5957691216057308f * (x + 0.044715f * x * x * x)); }
__device__ __forceinline__ float silu_f(float x) { return x * sigmoid_f(x); }
__device__ __forceinline__ float wave_sum(float v) {
#pragma unroll
    for (int o = 1; o < 64; o <<= 1) v += __shfl_xor(v, o);
    return v;
}
__device__ __forceinline__ int lane_fresh() { int l; asm volatile("v_mbcnt_lo_u32_b32 %0, -1, 0\n\tv_mbcnt_hi_u32_b32 %0, -1, %0" : "=v"(l)); return l; }
namespace pg8 {
constexpr int BM = 256, BK = 64, HALF = 128, HTB = HALF * BK * 2  , STAGE_BYTES = 8 * HTB, NXCD = 8, WGM = 8;

__host__ __device__ __forceinline__ int lds_byte(int r, int c) { const int st = (r >> 4) * 2 + (c >> 5), rr = r & 15, cc = c & 31, ob = rr * 64 + cc * 2; return st * 1024 + (ob ^ (((ob >> 9) & 1) << 5)); }
__host__ __device__ __forceinline__ void stage_rc(int b, int& R, int& C) { const int st = b / 1024, sb = b % 1024, swz = sb ^ (((sb >> 9) & 1) << 5); R = (st >> 1) * 16 + swz / 64; C = (st & 1) * 32 + (swz % 64) / 2; }
__host__ __device__ __forceinline__ int perm32(int rho) { const int n = rho >> 4, i = rho & 15; return 8 * (i >> 2) + 4 * n + (i & 3); }

struct Unit { int pm, pn, e, aux; };

struct StaticOrder {
    int nM, nN, nwg, G, c;
    __host__ __device__ void init(int M, int N, int G_, int c_) { nM = M / BM; nN = N / BM; nwg = nM * nN; G = G_; c = c_; }
    __device__ __forceinline__ bool next(int i, Unit& u) const {
        const long L = (long)i * G + c; if (L >= nwg) return false;
        int wgid = (int)L; { const int q = nwg / NXCD, r = nwg % NXCD, xcd = wgid % NXCD, off = wgid / NXCD; wgid = (xcd < r ? xcd * (q + 1) : r * (q + 1) + (xcd - r) * q) + off; }
        const int nig = WGM * nN, gid = wgid / nig, fm = gid * WGM, gsz = (nM - fm) < WGM ? (nM - fm) : WGM;
        u.pm = fm + ((wgid % nig) % gsz); u.pn = (wgid % nig) / gsz; u.e = 0; u.aux = 0; return true;
    }
};

struct RotOrder : StaticOrder {
    __device__ __forceinline__ bool next(int i, Unit& u) const { if (!StaticOrder::next(i, u)) return false; u.pn = (u.pn + 4 * i) % nN; return true; }
};

struct DenseProb {
    static constexpr bool GATHER = false;
    const bf16_t* A; const bf16_t* Bt; int K, lda, ldb, pad;
    __device__ __forceinline__ const char* a_base(const Unit& u) const { return (const char*)A + (size_t)u.pm * BM * lda * 2; }
    __device__ __forceinline__ const char* b_base(const Unit& u) const { return (const char*)Bt + (size_t)u.pn * BM * ldb * 2; }
    __device__ __forceinline__ unsigned a_off(const Unit&, int row, int col) const { return (unsigned)(row * lda + col) * 2u; }
};

template <class Prob, class Epi, class Sched, bool ALIGN_EPI = true>
__device__ __forceinline__ void gemm_phase(LAS unsigned char* lds, const Prob& g, const Sched& S, const Epi& E, int wid) {
    const int lane = lane_fresh(), tid = wid * 64 + lane, wr = wid >> 2, wc = wid & 3, fr = lane & 15, fq = lane >> 4;
    const int K = g.K, nt = K / BK;
    int sR[2], sC[2]; unsigned voffB[2];
#pragma unroll
    for (int i = 0; i < 2; ++i) { int R, C; stage_rc(tid * 16 + i * 8192, R, C); sR[i] = R; sC[i] = C; const int Rb = Epi::PERM ? ((R & ~31) + perm32(R & 31)) : R; voffB[i] = (unsigned)(Rb * g.ldb + C) * 2u; }
    const size_t kstep = (size_t)(BK * 2);
    const size_t hstepB = (size_t)HALF * g.ldb * 2;
    const unsigned ldsw = (unsigned)wid * 1024u;
    const int aoff = lds_byte(wr * 64 + fr, fq * 8), boff = lds_byte(wc * 32 + fr, fq * 8);
#define PG8_SA(b, h) (((b) * 2 + (h)) * HTB)
#define PG8_SB(b, h) ((4 + (b) * 2 + (h)) * HTB)
#define PG8_STAGE(bufoff, gbase, voff) do { _Pragma("unroll") for (int _i = 0; _i < 2; ++_i) \
        __builtin_amdgcn_global_load_lds((const unsigned*)((const char*)(gbase) + (voff)[_i]), (LAS unsigned*)(lds + (bufoff) + ldsw + _i * 8192), 16, 0, 0); } while (0)
#define PG8_LDA(dst, b, h) do { _Pragma("unroll") for (int m = 0; m < 4; ++m) _Pragma("unroll") for (int k = 0; k < 2; ++k) dst[m][k] = *(const LAS bf16x8*)(lds + PG8_SA(b, h) + aoff + m * 2048 + k * 1024); } while (0)
#define PG8_LDB(dst, b, h) do { _Pragma("unroll") for (int n = 0; n < 2; ++n) _Pragma("unroll") for (int k = 0; k < 2; ++k) dst[n][k] = *(const LAS bf16x8*)(lds + PG8_SB(b, h) + boff + n * 2048 + k * 1024); } while (0)
#define PG8_MMA(ai, bj, At, Bt) do { __builtin_amdgcn_s_setprio(1); _Pragma("unroll") for (int m = 0; m < 4; ++m) _Pragma("unroll") for (int n = 0; n < 2; ++n) _Pragma("unroll") for (int k = 0; k < 2; ++k) \
        acc[ai][bj][m][n] = __builtin_amdgcn_mfma_f32_16x16x32_bf16(Bt[n][k], At[m][k], acc[ai][bj][m][n], 0, 0, 0); __builtin_amdgcn_s_setprio(0); } while (0)
#define PG8_WAIT_V(n) asm volatile("s_waitcnt vmcnt(" #n ")" ::: "memory")
#define PG8_WAIT_L(n) asm volatile("s_waitcnt lgkmcnt(" #n ")" ::: "memory")
#define PG8_BAR __builtin_amdgcn_s_barrier()
#define PG8_SCHED __builtin_amdgcn_sched_barrier(0)
    Unit cur, nxt; int ui = 0;
    if (!S.next(0, cur)) return;
    f32x4 acc[2][2][4][2];
#pragma unroll
    for (int a = 0; a < 2; ++a)
#pragma unroll
        for (int b = 0; b < 2; ++b)
#pragma unroll
            for (int m = 0; m < 4; ++m)
#pragma unroll
                for (int n = 0; n < 2; ++n) acc[a][b][m][n] = (f32x4){0.f, 0.f, 0.f, 0.f};
    bf16x8 At[4][2], B0[2][2], B1[2][2];
    unsigned vA[2][2], vN[2][2];
#pragma unroll
    for (int h = 0; h < 2; ++h)
#pragma unroll
        for (int i = 0; i < 2; ++i) { vA[h][i] = g.a_off(cur, h * HALF + sR[i], sC[i]); vN[h][i] = vA[h][i]; }
    const char* cA = g.a_base(cur); const char* cB = g.b_base(cur);
    PG8_STAGE(PG8_SB(0, 0), cB, voffB); PG8_STAGE(PG8_SB(0, 1), cB + hstepB, voffB); PG8_STAGE(PG8_SA(0, 0), cA, vA[0]); PG8_STAGE(PG8_SA(0, 1), cA, vA[1]);
    if (wr == 1) PG8_BAR;
    PG8_WAIT_V(2); PG8_BAR;
    PG8_STAGE(PG8_SB(1, 0), cB + kstep, voffB); PG8_STAGE(PG8_SA(1, 0), cA + kstep, vA[0]); PG8_STAGE(PG8_SB(1, 1), cB + hstepB + kstep, voffB);
    PG8_WAIT_V(6); PG8_BAR;
    for (;;) {
        const bool has_next = S.next(ui + 1, nxt);
        const char* nA = has_next ? g.a_base(nxt) : cA; const char* nB = has_next ? g.b_base(nxt) : cB;
        if (Prob::GATHER) {
#pragma unroll
            for (int h = 0; h < 2; ++h)
#pragma unroll
                for (int i = 0; i < 2; ++i) vN[h][i] = has_next ? g.a_off(nxt, h * HALF + sR[i], sC[i]) : vA[h][i];
        }
        for (int t = 0; t < nt; t += 2) {
            const bool last = (t == nt - 2);
            if constexpr (Epi::KHOOK) { if (t == E.kh1 || t == E.kh2) E.khook(acc, cur, t, wr, wc, fr, fq); }
            const char* a1 = cA + (size_t)(t + 1) * kstep;
            const char* a2 = last ? nA : cA + (size_t)(t + 2) * kstep; const char* b2 = last ? nB : cB + (size_t)(t + 2) * kstep;
            const char* a3 = a2 + kstep; const char* b3 = b2 + kstep;
            unsigned v2[2][2];
#pragma unroll
            for (int h = 0; h < 2; ++h)
#pragma unroll
                for (int i = 0; i < 2; ++i) v2[h][i] = (Prob::GATHER && last) ? vN[h][i] : vA[h][i];
            PG8_LDB(B0, 0, 0); PG8_LDB(B1, 0, 1); PG8_SCHED; PG8_LDA(At, 0, 0); PG8_STAGE(PG8_SA(1, 1), a1, vA[1]);
            PG8_WAIT_V(8); PG8_WAIT_L(0); PG8_BAR; PG8_MMA(0, 0, At, B0); PG8_MMA(0, 1, At, B1); PG8_BAR; PG8_SCHED;
            PG8_LDA(At, 0, 1); PG8_STAGE(PG8_SB(0, 0), b2, voffB); PG8_STAGE(PG8_SB(0, 1), b2 + hstepB, voffB); PG8_STAGE(PG8_SA(0, 0), a2, v2[0]);
            PG8_WAIT_V(8); PG8_WAIT_L(0); PG8_BAR; PG8_MMA(1, 0, At, B0); PG8_MMA(1, 1, At, B1); PG8_BAR; PG8_SCHED;
            PG8_LDB(B0, 1, 0); PG8_LDB(B1, 1, 1); PG8_SCHED; PG8_LDA(At, 1, 0); PG8_STAGE(PG8_SA(0, 1), a2, v2[1]);
            PG8_WAIT_V(8); PG8_WAIT_L(0); PG8_BAR; PG8_MMA(0, 0, At, B0); PG8_MMA(0, 1, At, B1); PG8_BAR; PG8_SCHED;
            PG8_LDA(At, 1, 1); PG8_STAGE(PG8_SB(1, 0), b3, voffB); PG8_STAGE(PG8_SB(1, 1), b3 + hstepB, voffB); PG8_STAGE(PG8_SA(1, 0), a3, v2[0]);
            PG8_WAIT_V(8); PG8_WAIT_L(0); PG8_BAR; PG8_MMA(1, 0, At, B0); PG8_MMA(1, 1, At, B1); PG8_BAR; PG8_SCHED;
        }
        if constexpr (ALIGN_EPI) { if (wr == 0) PG8_BAR; }
        E(acc, cur, wr, wc, fr, fq);
        if (!has_next) break;
#pragma unroll
        for (int a = 0; a < 2; ++a)
#pragma unroll
            for (int b = 0; b < 2; ++b)
#pragma unroll
                for (int m = 0; m < 4; ++m)
#pragma unroll
                    for (int n = 0; n < 2; ++n) acc[a][b][m][n] = (f32x4){0.f, 0.f, 0.f, 0.f};
        cur = nxt; cA = nA; cB = nB; ++ui;
        if (Prob::GATHER) {
#pragma unroll
            for (int h = 0; h < 2; ++h)
#pragma unroll
                for (int i = 0; i < 2; ++i) vA[h][i] = vN[h][i];
        }
        if constexpr (ALIGN_EPI) { if (wr == 1) PG8_BAR; }
    }
    PG8_WAIT_V(0);
    if constexpr (!ALIGN_EPI) { if (wr == 0) PG8_BAR; }
    PG8_BAR;
#undef PG8_SA
#undef PG8_SB
#undef PG8_STAGE
#undef PG8_LDA
#undef PG8_LDB
#undef PG8_MMA
#undef PG8_WAIT_V
#undef PG8_WAIT_L
#undef PG8_BAR
#undef PG8_SCHED
}
}
namespace epi {
using pg8::Unit; using pg8::BM; using pg8::HALF;
typedef const f32x4 (&AccRef)[2][2][4][2];

struct Proj {
    static constexpr bool PERM = true, KHOOK = false;
    bf16_t* O; const float* gate_b;
    __device__ __forceinline__ void operator()(AccRef acc, const Unit& u, int wr, int wc, int fr, int fq) const {
        const int row0 = u.pm * BM + wr * 64 + fr, col0 = u.pn * BM + wc * 32 + 8 * fq;
        const int mode = (u.pn >= 20) ? 2 : ((u.pn >= 4 && u.pn < 8) ? 1 : 0);
        f32x4 bv[2][2];
#pragma unroll
        for (int bj = 0; bj < 2; ++bj)
#pragma unroll
            for (int n = 0; n < 2; ++n) bv[bj][n] = (mode == 2) ? *(const f32x4*)(gate_b + (col0 - C_GB) + bj * HALF + 4 * n) : (f32x4){0.f, 0.f, 0.f, 0.f};
#pragma unroll
        for (int ai = 0; ai < 2; ++ai)
#pragma unroll
            for (int m = 0; m < 4; ++m) { bf16_t* rowp = O + (size_t)(row0 + ai * HALF + m * 16) * INC + col0;
#pragma unroll
                for (int bj = 0; bj < 2; ++bj) { f32x4 v0 = acc[ai][bj][m][0] + bv[bj][0], v1 = acc[ai][bj][m][1] + bv[bj][1];
                    if (mode == 1) {
#pragma unroll
                        for (int j = 0; j < 4; ++j) { v0[j] = gelu_tanh_f(v0[j]); v1[j] = gelu_tanh_f(v1[j]); } }
                    if (mode == 2) {
#pragma unroll
                        for (int j = 0; j < 4; ++j) { v0[j] = sigmoid_f(v0[j]); v1[j] = sigmoid_f(v1[j]); } }
                    u32x4 w; w.x = pk2(v0[0], v0[1]); w.y = pk2(v0[2], v0[3]); w.z = pk2(v1[0], v1[1]); w.w = pk2(v1[2], v1[3]);
                    *(u32x4*)(rowp + bj * HALF) = w; } }
    }
};

template <int STEP> struct Branch {
    static constexpr bool PERM = false, KHOOK = false;
    const bf16_t* proj; float* P; bf16_t* merged;
    __device__ __forceinline__ void operator()(AccRef acc, const Unit& u, int wr, int wc, int fr, int fq) const {
        const int row0 = u.pm * BM + wr * 64 + fr, col0 = u.pn * BM + wc * 32 + 4 * fq;
#pragma unroll
        for (int ai = 0; ai < 2; ++ai)
#pragma unroll
            for (int m = 0; m < 4; ++m) { const size_t row = (size_t)(row0 + ai * HALF + m * 16);
#pragma unroll
                for (int bj = 0; bj < 2; ++bj)
#pragma unroll
                    for (int n = 0; n < 2; ++n) { const int col = col0 + bj * HALF + n * 16;
                        const u32x2 gw = *(const u32x2*)(proj + row * INC + C_GB + STEP * 1024 + col);
                        const f32x4 gv = {bf2f(gw.x & 0xffffu), bf2f(gw.x >> 16), bf2f(gw.y & 0xffffu), bf2f(gw.y >> 16)};
                        f32x4 v = acc[ai][bj][m][n] * gv;
                        float* pp = P + row * D + col;
                        if (STEP >= 1) v += *(const f32x4*)pp;
                        if (STEP <= 1) *(f32x4*)pp = v;
                        else { u32x2 w; w.x = pk2(v[0], v[1]); w.y = pk2(v[2], v[3]); *(u32x2*)(merged + row * D + col) = w; } } }
    }
};

struct Resid {
    static constexpr bool PERM = false, KHOOK = false;
    const float* base; float* out; const float* gate;
    __device__ __forceinline__ void operator()(AccRef acc, const Unit& u, int wr, int wc, int fr, int fq) const {
        const int row0 = u.pm * BM + wr * 64 + fr, col0 = u.pn * BM + wc * 32 + 4 * fq;
        const float* gp = gate + (size_t)((u.pm * BM) / SEQ) * (6 * D) + col0;
        f32x4 gv[2][2];
#pragma unroll
        for (int bj = 0; bj < 2; ++bj)
#pragma unroll
            for (int n = 0; n < 2; ++n) gv[bj][n] = *(const f32x4*)(gp + bj * HALF + n * 16);
#pragma unroll
        for (int ai = 0; ai < 2; ++ai)
#pragma unroll
            for (int m = 0; m < 4; ++m) { const size_t off = (size_t)(row0 + ai * HALF + m * 16) * D + col0;
#pragma unroll
                for (int bj = 0; bj < 2; ++bj)
#pragma unroll
                    for (int n = 0; n < 2; ++n) { const f32x4 bs = *(const f32x4*)(base + off + bj * HALF + n * 16);
                        *(f32x4*)(out + off + bj * HALF + n * 16) = bs + gv[bj][n] * acc[ai][bj][m][n]; } }
    }
};

struct SwiGLU {
    static constexpr bool PERM = true, KHOOK = false;
    bf16_t* O;
    __device__ __forceinline__ void operator()(AccRef acc, const Unit& u, int wr, int wc, int fr, int fq) const {
        const int row0 = u.pm * BM + wr * 64 + fr, col0 = u.pn * HALF + wc * 32 + 8 * fq;
#pragma unroll
        for (int ai = 0; ai < 2; ++ai)
#pragma unroll
            for (int m = 0; m < 4; ++m) { bf16_t* rowp = O + (size_t)(row0 + ai * HALF + m * 16) * DFF + col0;
                f32x4 v0, v1;
#pragma unroll
                for (int j = 0; j < 4; ++j) { v0[j] = silu_f(acc[ai][0][m][0][j]) * acc[ai][1][m][0][j]; v1[j] = silu_f(acc[ai][0][m][1][j]) * acc[ai][1][m][1][j]; }
                u32x4 w; w.x = pk2(v0[0], v0[1]); w.y = pk2(v0[2], v0[3]); w.z = pk2(v1[0], v1[1]); w.w = pk2(v1[2], v1[3]);
                *(u32x4*)rowp = w; }
    }
};

struct MoeDown {
    static constexpr bool PERM = false, KHOOK = false;
    const int* rowdst; const float* roww; bf16_t* yslot;
    __device__ __forceinline__ void operator()(AccRef acc, const Unit& u, int wr, int wc, int fr, int fq) const {
        const int row0 = u.pm * BM + wr * 64 + fr, col0 = u.pn * BM + wc * 32 + 4 * fq;
#pragma unroll
        for (int ai = 0; ai < 2; ++ai)
#pragma unroll
            for (int m = 0; m < 4; ++m) { const int p = row0 + ai * HALF + m * 16; const int dst = rowdst[p]; const float w = roww[p];
                if (dst >= 0) { bf16_t* rowp = yslot + (size_t)dst * D + col0;
#pragma unroll
                    for (int bj = 0; bj < 2; ++bj)
#pragma unroll
                        for (int n = 0; n < 2; ++n) { const f32x4 v = acc[ai][bj][m][n] * w; u32x2 o; o.x = pk2(v[0], v[1]); o.y = pk2(v[2], v[3]); *(u32x2*)(rowp + bj * HALF + n * 16) = o; } } }
    }
};

struct BranchMerge {
    static constexpr bool PERM = true, KHOOK = true;
    const bf16_t* proj; bf16_t* merged; int kh1, kh2;
    typedef f32x4 (&AccMut)[2][2][4][2];
    __device__ __forceinline__ static void unpack8(const u32x4 w, float (&f)[8]) {
        f[0] = bf2f(w.x & 0xffffu); f[1] = bf2f(w.x >> 16); f[2] = bf2f(w.y & 0xffffu); f[3] = bf2f(w.y >> 16); f[4] = bf2f(w.z & 0xffffu); f[5] = bf2f(w.z >> 16); f[6] = bf2f(w.w & 0xffffu); f[7] = bf2f(w.w >> 16); }
    __device__ __forceinline__ void khook(AccMut acc, const Unit& u, int t, int wr, int wc, int fr, int fq) const {
        const int gi = (t == kh1) ? 0 : 1;
        const unsigned off0 = (unsigned)(((u.pm * BM + wr * 64 + fr) * INC + C_GB + gi * 1024 + u.pn * BM + wc * 32 + 8 * fq) * 2);
        const char* pb = (const char*)proj;
#pragma unroll
        for (int ai = 0; ai < 2; ++ai) {
            u32x4 rn[4][2], rd[4][2];
#pragma unroll
            for (int m = 0; m < 4; ++m) { const unsigned off = off0 + (unsigned)((ai * HALF + m * 16) * INC * 2);
#pragma unroll
                for (int bj = 0; bj < 2; ++bj) { rn[m][bj] = *(const u32x4*)(pb + (size_t)(off + bj * HALF * 2)); rd[m][bj] = *(const u32x4*)(pb + (size_t)(off + 2048 + bj * HALF * 2)); } }
#pragma unroll
            for (int m = 0; m < 4; ++m)
#pragma unroll
                for (int bj = 0; bj < 2; ++bj) { float gn[8], gd[8]; unpack8(rn[m][bj], gn); unpack8(rd[m][bj], gd);
#pragma unroll
                    for (int j = 0; j < 4; ++j) { acc[ai][bj][m][0][j] *= gn[j] * frcp(fmaxf(gd[j], 1e-30f)); acc[ai][bj][m][1][j] *= gn[4 + j] * frcp(fmaxf(gd[4 + j], 1e-30f)); } }
            asm volatile("" ::: "memory");
        }
    }
    __device__ __forceinline__ void operator()(AccRef acc, const Unit& u, int wr, int wc, int fr, int fq) const {
        const int row0 = u.pm * BM + wr * 64 + fr, col0 = u.pn * BM + wc * 32 + 8 * fq;
#pragma unroll
        for (int ai = 0; ai < 2; ++ai)
#pragma unroll
            for (int m = 0; m < 4; ++m) { const size_t row = (size_t)(row0 + ai * HALF + m * 16);
#pragma unroll
                for (int bj = 0; bj < 2; ++bj) { float g2[8]; unpack8(*(const u32x4*)(proj + row * INC + C_GB + 2048 + col0 + bj * HALF), g2);
                    const f32x4 v0 = acc[ai][bj][m][0], v1 = acc[ai][bj][m][1];
                    u32x4 w; w.x = pk2(v0[0] * g2[0], v0[1] * g2[1]); w.y = pk2(v0[2] * g2[2], v0[3] * g2[3]); w.z = pk2(v1[0] * g2[4], v1[1] * g2[5]); w.w = pk2(v1[2] * g2[6], v1[3] * g2[7]);
                    *(u32x4*)(merged + row * D + col0 + bj * HALF) = w; } }
    }
};
}
namespace attn {
constexpr int NSLOT = 4, SLOT_K = 8192, SLOT128 = SLOT_K + 16384, SLOT64 = SLOT_K + 8192, LDS_BYTES = NSLOT * SLOT128;
constexpr float NEGF = -1e30f;
__device__ __forceinline__ int crow(int r, int hi) { return (r & 3) + 8 * (r >> 2) + 4 * hi; }
__device__ __forceinline__ float swapmax(float m) { auto rr = __builtin_amdgcn_permlane32_swap(__float_as_uint(m), __float_as_uint(m), false, false); return fmaxf(__uint_as_float(rr[0]), __uint_as_float(rr[1])); }
__device__ __forceinline__ float swapsum(float m) { auto rr = __builtin_amdgcn_permlane32_swap(__float_as_uint(m), __float_as_uint(m), false, false); return __uint_as_float(rr[0]) + __uint_as_float(rr[1]); }
typedef short v4i16_t __attribute__((ext_vector_type(4)));
__device__ __forceinline__ s16x4 vtr(const LAS char* p) { return __builtin_bit_cast(s16x4, __builtin_amdgcn_ds_read_tr16_b64_v4i16((LAS v4i16_t*)p)); }

__device__ __forceinline__ void qk_tile(f32x16& sA, f32x16& sB, const LAS char* Kt, const bf16x8 (&qf)[4], int r, int h, float noff) {
    const LAS char* kb = Kt + h * 1024 + r * 16;
#pragma unroll
    for (int j = 0; j < 16; ++j) { sA[j] = noff; sB[j] = noff; }
    bf16x8 kf[8];
#pragma unroll
    for (int ks = 0; ks < 4; ++ks) { kf[2 * ks] = *(const LAS bf16x8*)(kb + ks * 2048); kf[2 * ks + 1] = *(const LAS bf16x8*)(kb + ks * 2048 + 512); }
    __builtin_amdgcn_sched_barrier(0);
#pragma unroll
    for (int ks = 0; ks < 4; ++ks) {
        sA = __builtin_amdgcn_mfma_f32_32x32x16_bf16(kf[2 * ks], qf[ks], sA, 0, 0, 0);
        sB = __builtin_amdgcn_mfma_f32_32x32x16_bf16(kf[2 * ks + 1], qf[ks], sB, 0, 0, 0);
    }
}
template <int NDB>
__device__ __forceinline__ void pv_tile(f32x16 (&o)[NDB], const LAS char* Vt, const bf16x8 (&pf)[4], int lane) {
    const int h = lane >> 5, q = (lane & 15) >> 2, p = lane & 3, g1 = (lane >> 4) & 1;
    const LAS char* vb = Vt + (4 * h + q) * 64 + (16 * g1 + 4 * p) * 2;
#pragma unroll
    for (int kb = 0; kb < 2; ++kb) {
        bf16x8 vf[2][NDB];
#pragma unroll
        for (int s = 0; s < 2; ++s)
#pragma unroll
            for (int db = 0; db < NDB; ++db) { const int r0 = kb * 32 + 16 * s;
                const s16x4 lo = vtr(vb + r0 * 64 + db * 4096), hi = vtr(vb + (r0 + 8) * 64 + db * 4096);
                vf[s][db] = (bf16x8){lo[0], lo[1], lo[2], lo[3], hi[0], hi[1], hi[2], hi[3]}; }
        __builtin_amdgcn_sched_barrier(0);
#pragma unroll
        for (int s = 0; s < 2; ++s)
#pragma unroll
            for (int db = 0; db < NDB; ++db) o[db] = __builtin_amdgcn_mfma_f32_32x32x16_bf16(pf[kb * 2 + s], vf[s][db], o[db], 0, 0, 0);
    }
}
template <int NDB>
__device__ __forceinline__ void softmax_pv(f32x16& sA, f32x16& sB, f32x16 (&o)[NDB], float& lsum, const LAS char* Vt, int lane) {
    float rs0 = 0.f, rs1 = 0.f;
#pragma unroll
    for (int j = 0; j < 16; ++j) { sA[j] = fexp2(sA[j]); sB[j] = fexp2(sB[j]); rs0 += sA[j]; rs1 += sB[j]; }
    lsum += rs0 + rs1;
    bf16x8 pf[4];
    { u32x4 w;
      w.x = pk2(sA[0], sA[1]); w.y = pk2(sA[2], sA[3]); w.z = pk2(sA[4], sA[5]); w.w = pk2(sA[6], sA[7]); pf[0] = __builtin_bit_cast(bf16x8, w);
      w.x = pk2(sA[8], sA[9]); w.y = pk2(sA[10], sA[11]); w.z = pk2(sA[12], sA[13]); w.w = pk2(sA[14], sA[15]); pf[1] = __builtin_bit_cast(bf16x8, w);
      w.x = pk2(sB[0], sB[1]); w.y = pk2(sB[2], sB[3]); w.z = pk2(sB[4], sB[5]); w.w = pk2(sB[6], sB[7]); pf[2] = __builtin_bit_cast(bf16x8, w);
      w.x = pk2(sB[8], sB[9]); w.y = pk2(sB[10], sB[11]); w.z = pk2(sB[12], sB[13]); w.w = pk2(sB[14], sB[15]); pf[3] = __builtin_bit_cast(bf16x8, w); }
    pv_tile<NDB>(o, Vt, pf, lane);
}
__device__ __forceinline__ float score_shift(const float* gq, const float* gk, int lane) {
    float mq = fabsf(gq[lane]), mk = fabsf(gk[lane]);
#pragma unroll
    for (int o = 1; o < 64; o <<= 1) { mq = fmaxf(mq, __shfl_xor(mq, o)); mk = fmaxf(mk, __shfl_xor(mk, o)); }
    const float bound = QSCALE * 64.0f * mq * mk;
    return -fmaxf(0.f, bound - 24.0f);
}

template <int DV>
__device__ __forceinline__ void dma_tile(const bf16_t* Kg, const bf16_t* Vg, int key0, LAS char* slot, int wid, int lane) {
    __builtin_amdgcn_global_load_lds((const unsigned*)(Kg + (size_t)(key0 + lane) * INC + wid * 8), (LAS unsigned*)(slot + wid * 1024), 16, 0, 0);
#pragma unroll
    for (int i = 0; i < DV / 64; ++i) { const int p = wid + 8 * i, db = p >> 2, rg = p & 3;
        __builtin_amdgcn_global_load_lds((const unsigned*)(Vg + (size_t)(key0 + 16 * rg + (lane >> 2)) * INC + db * 32 + (lane & 3) * 8), (LAS unsigned*)(slot + SLOT_K + p * 1024), 16, 0, 0); }
}
template <int OPS> __device__ __forceinline__ void ring_wait(int ahead) {
    if (ahead >= 2) asm volatile("s_waitcnt vmcnt(%0) lgkmcnt(0)\n\ts_barrier" :: "n"(2 * OPS) : "memory");
    else if (ahead == 1) asm volatile("s_waitcnt vmcnt(%0) lgkmcnt(0)\n\ts_barrier" :: "n"(OPS) : "memory");
    else asm volatile("s_waitcnt vmcnt(0) lgkmcnt(0)\n\ts_barrier" ::: "memory");
}
template <int DV>
__device__ __forceinline__ void causal_pass(f32x16 (&o)[DV / 32], float& lsum, const bf16x8 (&qf)[4], const bf16_t* Kg, const bf16_t* Vg,
                                            int ntiles, int qw0, float noff, LAS char* lds, int tid) {
    constexpr int SLOT = SLOT_K + DV * 128, OPS = 1 + DV / 64;
    const int lane = tid & 63, r = lane & 31, h = lane >> 5, wid = __builtin_amdgcn_readfirstlane(tid >> 6);
    asm volatile("s_waitcnt vmcnt(0) lgkmcnt(0)\n\ts_barrier" ::: "memory");
#pragma unroll
    for (int t = 0; t < 3; ++t) if (t < ntiles) dma_tile<DV>(Kg, Vg, t * 64, lds + t * SLOT, wid, lane);
    __builtin_amdgcn_s_waitcnt(0);
    for (int t = 0; t < ntiles; ++t) {
        ring_wait<OPS>(ntiles - 1 - t);
        if (t + 3 < ntiles) dma_tile<DV>(Kg, Vg, (t + 3) * 64, lds + ((t + 3) & 3) * SLOT, wid, lane);
        const LAS char* slot = lds + (t & 3) * SLOT;
        const int key0 = t * 64;
        if (key0 <= qw0 + 31) {
            f32x16 sA, sB;
            qk_tile(sA, sB, slot, qf, r, h, noff);
            if (key0 + 63 > qw0) {
                const int qpos = qw0 + r;
#pragma unroll
                for (int j = 0; j < 16; ++j) { const int kp = key0 + crow(j, h); if (kp > qpos) sA[j] = NEGF; if (kp + 32 > qpos) sB[j] = NEGF; }
            }
            softmax_pv<DV / 32>(sA, sB, o, lsum, slot + SLOT_K, lane);
        }
    }
}

__device__ __forceinline__ void diff_unit(int b, int hd, int qt, const bf16_t* proj, bf16_t* yabc, const float* subln, float lam, float one_m_laminit, float noff, LAS char* lds, int wid) {
    const int lane = lane_fresh(), tid = wid * 64 + lane, r = lane & 31, h = lane >> 5;
    const int qw0 = qt * 256 + wid * 32;
    const size_t rowb = (size_t)b * SEQ;
    const int ntiles = 4 * (qt + 1);
    unsigned o0p[4][8];
#pragma unroll
    for (int j = 0; j < 2; ++j) {
        const bf16_t* qp = proj + (rowb + qw0 + r) * INC + C_DQ + (hd * 2 + j) * 64 + h * 8;
        bf16x8 qf[4];
#pragma unroll
        for (int ks = 0; ks < 4; ++ks) qf[ks] = *(const bf16x8*)(qp + ks * 16);
        f32x16 o[4];
#pragma unroll
        for (int db = 0; db < 4; ++db)
#pragma unroll
            for (int i = 0; i < 16; ++i) o[db][i] = 0.f;
        float lsum = 0.f;
        causal_pass<128>(o, lsum, qf, proj + rowb * INC + C_DK + (hd * 2 + j) * 64, proj + rowb * INC + C_DV + hd * 128, ntiles, qw0, noff, lds, tid);
        const float il = frcp(swapsum(lsum));
        if (j == 0) {
#pragma unroll
            for (int i = 0; i < 16; i += 2) { const float a0 = __shfl(il, crow(i, h)), a1 = __shfl(il, crow(i + 1, h));
#pragma unroll
                for (int db = 0; db < 4; ++db) o0p[db][i >> 1] = pk2(o[db][i] * a0, o[db][i + 1] * a1); }
        } else {
#pragma unroll
            for (int i = 0; i < 16; ++i) { const float a = __shfl(il, crow(i, h)) * lam;
                float ss = 0.f; float cv[4];
#pragma unroll
                for (int db = 0; db < 4; ++db) { const unsigned w = o0p[db][i >> 1]; const float x0 = (i & 1) ? bf2f(w >> 16) : bf2f(w & 0xffffu); const float c = x0 - o[db][i] * a; cv[db] = c; ss += c * c; }
                ss += __shfl_xor(ss, 1); ss += __shfl_xor(ss, 2); ss += __shfl_xor(ss, 4); ss += __shfl_xor(ss, 8); ss += __shfl_xor(ss, 16);
                const float rn = rsqrtf(ss * (1.0f / 128.0f) + EPS) * one_m_laminit;
                bf16_t* yp = yabc + (rowb + qw0 + crow(i, h)) * YW + Y_B + hd * 128 + r;
#pragma unroll
                for (int db = 0; db < 4; ++db) yp[db * 32] = (bf16_t)f2bf(cv[db] * rn * subln[db * 32 + r]);
            }
        }
    }
}

__device__ __forceinline__ void moba_unit(int b, int hd, int cur, const bf16_t* proj, bf16_t* yabc, const float* kmean, float noff, LAS char* lds, int wid) {
    const int lane = lane_fresh(), tid = wid * 64 + lane, r = lane & 31, h = lane >> 5;
    const int qw0 = cur * 256 + wid * 32;
    const size_t rowb = (size_t)b * SEQ;
    const bf16_t* qp = proj + (rowb + qw0 + r) * INC + C_MQ + hd * 64 + h * 8;
    bf16x8 qf[4];
#pragma unroll
    for (int ks = 0; ks < 4; ++ks) qf[ks] = *(const bf16x8*)(qp + ks * 16);
    unsigned selmask = 0u;
    if (cur > 0) {
        float gate[8];
#pragma unroll
        for (int n = 0; n < 8; ++n) {
            float g = 0.f;
            if (n < cur) {
                const float* km = kmean + ((size_t)((b * 8 + hd) * 8 + n)) * 64 + h * 8;
#pragma unroll
                for (int ks = 0; ks < 4; ++ks)
#pragma unroll
                    for (int j = 0; j < 8; ++j) g += bf2f((unsigned)(unsigned short)qf[ks][j]) * km[ks * 16 + j];
                g = swapsum(g);
            } else g = -3.0e38f;
            gate[n] = g;
        }
        const int nsel = cur < 3 ? cur : 3;
        for (int s = 0; s < nsel; ++s) {
            float best = -3.0e38f; int bi = 0;
#pragma unroll
            for (int n = 0; n < 8; ++n) { const bool tk = (n < cur) && !((selmask >> n) & 1u) && (gate[n] > best); if (tk) { best = gate[n]; bi = n; } }
            selmask |= 1u << bi;
        }
    }
    f32x16 o[2];
#pragma unroll
    for (int db = 0; db < 2; ++db)
#pragma unroll
        for (int i = 0; i < 16; ++i) o[db][i] = 0.f;
    float lsum = 0.f;
    const bf16_t* Kg = proj + rowb * INC + C_MK + hd * 64; const bf16_t* Vg = proj + rowb * INC + C_MV + hd * 64;
    const int ntiles = 4 * (cur + 1);
#define MOBA_KEY0(T) ((((T) < 4) ? cur : (((T) >> 2) - 1)) * 256 + ((T) & 3) * 64)
    const int widu = wid;
    asm volatile("s_waitcnt vmcnt(0) lgkmcnt(0)\n\ts_barrier" ::: "memory");
#pragma unroll
    for (int t = 0; t < 3; ++t) dma_tile<64>(Kg, Vg, MOBA_KEY0(t), lds + t * SLOT64, widu, lane);
    __builtin_amdgcn_s_waitcnt(0);
    for (int t = 0; t < ntiles; ++t) {
        ring_wait<2>(ntiles - 1 - t);
        if (t + 3 < ntiles) dma_tile<64>(Kg, Vg, MOBA_KEY0(t + 3), lds + ((t + 3) & 3) * SLOT64, widu, lane);
        const LAS char* slot = lds + (t & 3) * SLOT64;
        const int blk = (t < 4) ? cur : (t >> 2) - 1;
        const int key0 = blk * 256 + (t & 3) * 64;
        const bool own = (t < 4);
        const bool lane_on = own ? true : (((selmask >> blk) & 1u) != 0u);
        const bool wave_on = own ? (key0 <= qw0 + 31) : (__any(lane_on) != 0);
        if (wave_on) {
            f32x16 sA, sB;
            qk_tile(sA, sB, slot, qf, r, h, noff);
            if (own) {
                if (key0 + 63 > qw0) {
                    const int qpos = qw0 + r;
#pragma unroll
                    for (int j = 0; j < 16; ++j) { const int kp = key0 + crow(j, h); if (kp > qpos) sA[j] = NEGF; if (kp + 32 > qpos) sB[j] = NEGF; }
                }
            } else if (!lane_on) {
#pragma unroll
                for (int j = 0; j < 16; ++j) { sA[j] = NEGF; sB[j] = NEGF; }
            }
            softmax_pv<2>(sA, sB, o, lsum, slot + SLOT_K, lane);
        }
    }
#undef MOBA_KEY0
    const float il = frcp(swapsum(lsum));
#pragma unroll
    for (int i = 0; i < 16; ++i) { const float a = __shfl(il, crow(i, h));
        bf16_t* yp = yabc + (rowb + qw0 + crow(i, h)) * YW + Y_C + hd * 64 + r;
#pragma unroll
        for (int db = 0; db < 2; ++db) yp[db * 32] = (bf16_t)f2bf(o[db][i] * a); }
}
}
namespace thin {
struct TItem { f32x4 v[8][2]; };
__device__ __forceinline__ void titem_load(TItem& it, const float* W, int N, int item, int lane) {
    const int nblk = N >> 6, kb = item / nblk, nb = item - kb * nblk;
    const float* p = W + (size_t)(kb * 64 + 2 * (lane >> 4)) * N + nb * 64 + 4 * (lane & 15);
#pragma unroll
    for (int i = 0; i < 8; ++i) { it.v[i][0] = *(const f32x4*)(p + (size_t)(8 * i) * N); it.v[i][1] = *(const f32x4*)(p + (size_t)(8 * i + 1) * N); }
}
__device__ __forceinline__ void titem_store(const TItem& it, int N, bf16_t* WT, int ldk, int coff, int row_off, int mode, LAS unsigned* T, int item, int lane) {
    const int nblk = N >> 6, kb = item / nblk, nb = item - kb * nblk, k0 = kb * 64, n0 = nb * 64;
    const int kp = lane >> 4, np = lane & 15;
#pragma unroll
    for (int i = 0; i < 8; ++i) { const int col = (kp + 4 * i) ^ ((np & 7) << 2);
#pragma unroll
        for (int j = 0; j < 4; ++j) T[(4 * np + j) * 32 + col] = pk2(it.v[i][0][j], it.v[i][1][j]); }
    asm volatile("s_waitcnt lgkmcnt(0)" ::: "memory");
    const int c = lane & 7;
#pragma unroll
    for (int j = 0; j < 8; ++j) { const int n = (lane >> 3) + 8 * j;
        const u32x4 o = *(const LAS u32x4*)(T + n * 32 + 4 * (c ^ ((n >> 2) & 7)));
        const int nn = n0 + n; const int row = row_off + (mode == 0 ? nn : ((nn >> 7) * 256 + (mode == 2 ? 128 : 0) + (nn & 127)));
        const bf16_t* dstp = WT + (size_t)row * ldk + coff + k0 + 8 * c;
        asm volatile("global_store_dwordx4 %0, %1, off" :: "v"(dstp), "v"(o) : "memory"); }
    asm volatile("s_waitcnt lgkmcnt(0)" ::: "memory");
}
__device__ __forceinline__ void transpose_matrix(const float* W, int K, int N, bf16_t* WT, int ldk, int coff, int row_off, int mode, LAS float* scr, int gw, int ngw, int lane) {
    const int nitems = (K >> 6) * (N >> 6);
    LAS unsigned* T = (LAS unsigned*)scr;
    TItem cur;
    int it = gw;
    if (it < nitems) titem_load(cur, W, N, it, lane);
    while (it < nitems) {
        const int nx = it + ngw;
        TItem nxt;
        if (nx < nitems) titem_load(nxt, W, N, nx, lane);
        titem_store(cur, N, WT, ldk, coff, row_off, mode, T, it, lane);
        cur = nxt; it = nx;
    }
}

__device__ __forceinline__ void mod_body(const float* c, const float* ada_w, const float* ada_b, float* mod, int bid, int G, int tid, LAS float* red) {
    for (int cb = bid; cb < (2 * 6 * D) / 48; cb += G) {
        const int kg = tid / 48, jj = tid - kg * 48;
        const int idx = cb * 48 + jj, l = idx / (6 * D), j = idx - l * (6 * D);
        float acc[NB];
#pragma unroll
        for (int b = 0; b < NB; ++b) acc[b] = 0.f;
        if (kg < 8) {
            const float* w = ada_w + (size_t)l * D * 6 * D + (size_t)(kg * 128) * 6 * D + j;
#pragma unroll 4
            for (int k = 0; k < 128; ++k) { const float wv = w[(size_t)k * 6 * D];
#pragma unroll
                for (int b = 0; b < NB; ++b) acc[b] += c[b * D + kg * 128 + k] * wv; }
#pragma unroll
            for (int b = 0; b < NB; ++b) red[(kg * 48 + jj) * NB + b] = acc[b];
        }
        __syncthreads();
        if (tid < 48 * NB) { const int j2 = tid >> 3, b = tid & 7; float s = 0.f;
#pragma unroll
            for (int g = 0; g < 8; ++g) s += red[(g * 48 + j2) * NB + b];
            const int idx2 = cb * 48 + j2, l2 = idx2 / (6 * D), jo = idx2 - l2 * (6 * D);
            mod[((size_t)l2 * NB + b) * 6 * D + jo] = s + ada_b[l2 * 6 * D + jo]; }
        __syncthreads();
    }
}
__device__ __forceinline__ void rope_body(const int* positions, f32x2* cs, int gtid, int ngt) {
    for (int idx = gtid; idx < M * 32; idx += ngt) {
        const int tok = idx >> 5, i = idx & 31;
        const float inv = 1.0f / powf(10000.0f, (float)(2 * i) / 64.0f);
        const float ang = (float)positions[tok] * inv;
        float s, c; sincosf(ang, &s, &c);
        cs[idx] = (f32x2){c, s};
    }
}
template <int R>
__device__ __forceinline__ void norm_rows(const float* xrow, const float* g, const float* shift, const float* scale, bf16_t* orow, int lane, f32x4 (&y)[R][4]) {
    f32x4 v[R][4]; float ss[R];
#pragma unroll
    for (int r = 0; r < R; ++r) { const f32x4* xr = (const f32x4*)(xrow + (size_t)r * D) + lane;
#pragma unroll
        for (int j = 0; j < 4; ++j) v[r][j] = xr[64 * j]; }
#pragma unroll
    for (int r = 0; r < R; ++r) { float s = 0.f;
#pragma unroll
        for (int j = 0; j < 4; ++j) s += (v[r][j].x * v[r][j].x + v[r][j].y * v[r][j].y) + (v[r][j].z * v[r][j].z + v[r][j].w * v[r][j].w);
        ss[r] = s; }
#pragma unroll
    for (int o = 1; o < 64; o <<= 1) {
#pragma unroll
        for (int r = 0; r < R; ++r) ss[r] += __shfl_xor(ss[r], o); }
#pragma unroll
    for (int j = 0; j < 4; ++j) { const int col = 4 * lane + 256 * j;
        const f32x4 gg = *(const f32x4*)(g + col), sc = *(const f32x4*)(scale + col), sh = *(const f32x4*)(shift + col);
        const f32x4 gs = gg * (sc + 1.0f);
#pragma unroll
        for (int r = 0; r < R; ++r) { const float rn = rsqrtf(ss[r] * (1.0f / D) + EPS);
            y[r][j] = v[r][j] * rn * gs + sh;
            u32x2 w; w.x = pk2(y[r][j].x, y[r][j].y); w.y = pk2(y[r][j].z, y[r][j].w); ((u32x2*)(orow + (size_t)r * D) + lane)[64 * j] = w; } }
}
__device__ __forceinline__ void norm_body(const float* x, const float* g, const float* shift, const float* scale, bf16_t* out, int gw, int ngw, int lane) {
    for (int m = gw * 4; m < M; m += ngw * 4) { const int b = m / SEQ; f32x4 y[4][4]; norm_rows<4>(x + (size_t)m * D, g, shift + b * 6 * D, scale + b * 6 * D, out + (size_t)m * D, lane, y); }
}
__device__ __forceinline__ void norm_router_body(const float* x, const float* g, const float* shift, const float* scale, bf16_t* out,
                                                 const float* rw, const float* rb, int* topi, float* topw, int gw, int ngw, int lane) {
    for (int m0 = gw * 2; m0 < M; m0 += ngw * 2) { const int b = m0 / SEQ; f32x4 y[2][4];
        norm_rows<2>(x + (size_t)m0 * D, g, shift + b * 6 * D, scale + b * 6 * D, out + (size_t)m0 * D, lane, y);
        float lg[2][NE];
#pragma unroll
        for (int r = 0; r < 2; ++r)
#pragma unroll
            for (int e = 0; e < NE; ++e) lg[r][e] = 0.f;
#pragma unroll
        for (int j = 0; j < 4; ++j)
#pragma unroll
            for (int q = 0; q < 4; ++q) { const int col = 4 * lane + 256 * j + q; const f32x4 w0 = *(const f32x4*)(rw + col * NE), w1 = *(const f32x4*)(rw + col * NE + 4);
#pragma unroll
                for (int r = 0; r < 2; ++r) { const float hv = y[r][j][q];
                    lg[r][0] += hv * w0.x; lg[r][1] += hv * w0.y; lg[r][2] += hv * w0.z; lg[r][3] += hv * w0.w; lg[r][4] += hv * w1.x; lg[r][5] += hv * w1.y; lg[r][6] += hv * w1.z; lg[r][7] += hv * w1.w; } }
#pragma unroll
        for (int o = 1; o < 64; o <<= 1) {
#pragma unroll
            for (int r = 0; r < 2; ++r)
#pragma unroll
                for (int e = 0; e < NE; ++e) lg[r][e] += __shfl_xor(lg[r][e], o); }
#pragma unroll
        for (int r = 0; r < 2; ++r) { const int m = m0 + r;
#pragma unroll
            for (int e = 0; e < NE; ++e) lg[r][e] += rb[e];
            int i0 = 0; float v0 = lg[r][0];
#pragma unroll
            for (int e = 1; e < NE; ++e) if (lg[r][e] > v0) { v0 = lg[r][e]; i0 = e; }
            int i1 = -1; float v1 = -3.0e38f;
#pragma unroll
            for (int e = 0; e < NE; ++e) if (e != i0 && lg[r][e] > v1) { v1 = lg[r][e]; i1 = e; }
            const float w1v = 1.0f / (1.0f + expf(v0 - v1)), w0v = 1.0f - w1v;
            if (lane == 0) { topi[2 * m] = i0; topi[2 * m + 1] = i1; topw[2 * m] = w0v; topw[2 * m + 1] = w1v; } }
    }
}
__device__ __forceinline__ void qknorm_body(bf16_t* proj, const f32x2* cs, const float* dqn, const float* dkn, const float* mqn, const float* mkn, int gtid, int ngt) {
    for (long idx = gtid; idx < (long)M * 32 * 32; idx += ngt) {
        const int i = (int)(idx & 31); const long pair = idx >> 5; const int hh = (int)(pair & 31); const int tok = (int)(pair >> 5);
        const int grp = hh >> 3, hi = hh & 7;
        const int cb = (grp == 0 ? C_DQ : grp == 1 ? C_DK : grp == 2 ? C_MQ : C_MK) + hi * 64;
        const float* gn = grp == 0 ? dqn : grp == 1 ? dkn : grp == 2 ? mqn : mkn;
        bf16_t* p = proj + (size_t)tok * INC + cb;
        const float x1 = bf2f(p[i]), x2 = bf2f(p[i + 32]);
        float ss = x1 * x1 + x2 * x2;
        ss += __shfl_xor(ss, 1); ss += __shfl_xor(ss, 2); ss += __shfl_xor(ss, 4); ss += __shfl_xor(ss, 8); ss += __shfl_xor(ss, 16);
        const float rn = rsqrtf(ss * (1.0f / 64.0f) + EPS);
        const float y1 = x1 * rn * gn[i], y2 = x2 * rn * gn[i + 32];
        const f32x2 c = cs[(size_t)tok * 32 + i];
        float o1 = y1 * c.x - y2 * c.y, o2 = y2 * c.x + y1 * c.y;
        if ((grp & 1) == 0) { o1 *= QSCALE; o2 *= QSCALE; }
        p[i] = (bf16_t)f2bf(o1); p[i + 32] = (bf16_t)f2bf(o2);
    }
}
__device__ __forceinline__ void kmean_body(const bf16_t* proj, float* kmean, int gw, int ngw, int lane) {
    for (int it = gw; it < NB * 8 * 8; it += ngw) { const int blk = it & 7, hd = (it >> 3) & 7, b = it >> 6;
        const bf16_t* p = proj + ((size_t)b * SEQ + blk * 256) * INC + C_MK + hd * 64 + lane;
        float s = 0.f;
        for (int t = 0; t < 256; ++t) s += bf2f(p[(size_t)t * INC]);
        kmean[(size_t)it * 64 + lane] = s * (1.0f / 256.0f); }
}
__device__ __forceinline__ void moe_combine_body(const float* x1, const bf16_t* yslot, const float* gate, float* out, int gtid, int ngt) {
    for (long idx = gtid; idx < (long)M * D / 4; idx += ngt) { const int m = (int)(idx >> 8), c4 = (int)(idx & 255) * 4; const int b = m / SEQ;
        const f32x4 xv = *(const f32x4*)(x1 + (size_t)m * D + c4), gv = *(const f32x4*)(gate + b * 6 * D + c4);
        const u32x2 a = *(const u32x2*)(yslot + (size_t)m * D + c4), c = *(const u32x2*)(yslot + ((size_t)M + m) * D + c4);
        f32x4 y = {bf2f(a.x & 0xffffu) + bf2f(c.x & 0xffffu), bf2f(a.x >> 16) + bf2f(c.x >> 16), bf2f(a.y & 0xffffu) + bf2f(c.y & 0xffffu), bf2f(a.y >> 16) + bf2f(c.y >> 16)};
        *(f32x4*)(out + (size_t)m * D + c4) = xv + gv * y; }
}
}
namespace qk {
constexpr int LDS_BYTES = 8 * 64 * 8 * 4;
__device__ __forceinline__ void unit(int b, int blk, int grp, bf16_t* proj, const f32x2* cs, const float* gn, float* kmean, LAS char* lds, int wid) {
    const int lane = lane_fresh(), tid = wid * 64 + lane;
    const int hd = lane >> 3, half = (lane >> 2) & 1, j = lane & 3;
    const int cb = (grp == 0 ? C_DQ : grp == 1 ? C_DK : grp == 2 ? C_MQ : C_MK) + hd * 64 + half * 32 + 8 * j;
    float gnv[8];
#pragma unroll
    for (int e = 0; e < 8; ++e) gnv[e] = gn[half * 32 + 8 * j + e];
    const float qs = ((grp & 1) == 0) ? QSCALE : 1.0f;
    const float sgn = half ? 1.0f : -1.0f;
    float ksum[8];
#pragma unroll
    for (int e = 0; e < 8; ++e) ksum[e] = 0.f;
    for (int i = 0; i < 32; ++i) {
        const size_t tok = (size_t)b * SEQ + blk * 256 + wid + 8 * i;
        bf16_t* p = proj + tok * INC + cb;
        const u32x4 raw = *(const u32x4*)p;
        float x[8] = {bf2f(raw.x & 0xffffu), bf2f(raw.x >> 16), bf2f(raw.y & 0xffffu), bf2f(raw.y >> 16), bf2f(raw.z & 0xffffu), bf2f(raw.z >> 16), bf2f(raw.w & 0xffffu), bf2f(raw.w >> 16)};
        float ss = 0.f;
#pragma unroll
        for (int e = 0; e < 8; ++e) ss += x[e] * x[e];
        ss += __shfl_xor(ss, 1); ss += __shfl_xor(ss, 2); ss += __shfl_xor(ss, 4);
        const float rn = rsqrtf(ss * (1.0f / 64.0f) + EPS);
        const f32x4* cp = (const f32x4*)(cs + tok * 32 + 8 * j);
        const f32x4 c0 = cp[0], c1 = cp[1], c2 = cp[2], c3 = cp[3];
        const float cc[8] = {c0.x, c0.z, c1.x, c1.z, c2.x, c2.z, c3.x, c3.z}, sn[8] = {c0.y, c0.w, c1.y, c1.w, c2.y, c2.w, c3.y, c3.w};
        float o[8];
#pragma unroll
        for (int e = 0; e < 8; ++e) { const float y = x[e] * rn * gnv[e]; const float py = __shfl_xor(y, 4); o[e] = (y * cc[e] + sgn * py * sn[e]) * qs; }
        u32x4 w; w.x = pk2(o[0], o[1]); w.y = pk2(o[2], o[3]); w.z = pk2(o[4], o[5]); w.w = pk2(o[6], o[7]);
        *(u32x4*)p = w;
        if (grp == 3) { ksum[0] += bf2f(w.x & 0xffffu); ksum[1] += bf2f(w.x >> 16); ksum[2] += bf2f(w.y & 0xffffu); ksum[3] += bf2f(w.y >> 16);
                        ksum[4] += bf2f(w.z & 0xffffu); ksum[5] += bf2f(w.z >> 16); ksum[6] += bf2f(w.w & 0xffffu); ksum[7] += bf2f(w.w >> 16); }
    }
    if (grp == 3) {
        LAS float* red = (LAS float*)lds;
        __syncthreads();
#pragma unroll
        for (int e = 0; e < 8; ++e) red[(wid * 64 + lane) * 8 + e] = ksum[e];
        __syncthreads();
        { const int ln = tid >> 3, e = tid & 7; float s = 0.f;
#pragma unroll
          for (int w = 0; w < 8; ++w) s += red[(w * 64 + ln) * 8 + e];
          const int h2 = ln >> 3, hf = (ln >> 2) & 1, jj = ln & 3;
          kmean[((size_t)((b * 8 + h2) * 8 + blk)) * 64 + hf * 32 + 8 * jj + e] = s * (1.0f / 256.0f); }
        __syncthreads();
    }
}
}
namespace rglru {
constexpr int TT = 32;
constexpr int LDS_WA = 0, LDS_WX = 16384, LDS_XC = 32768, LDS_A = LDS_XC + TT * 65 * 4, LDS_U = LDS_A + TT * 64 * 4, LDS_BYTES = LDS_U + TT * 64 * 4;
__device__ __forceinline__ void unit(int b, int n, const bf16_t* proj, bf16_t* yabc, const float* conv_w, const float* conv_b, const float* wa, const float* ba,
                                     const float* wx, const float* bx, const float* lam, LAS char* lds) {
    int tid_l = threadIdx.x; asm volatile("" : "+v"(tid_l));
    const int tid = tid_l;
    LAS float* Wa = (LAS float*)(lds + LDS_WA); LAS float* Wx = (LAS float*)(lds + LDS_WX); LAS float* XC = (LAS float*)(lds + LDS_XC);
    LAS float* AV = (LAS float*)(lds + LDS_A); LAS float* UV = (LAS float*)(lds + LDS_U);
    __syncthreads();
    for (int i = tid; i < 4096; i += 512) { Wa[i] = wa[(size_t)n * 4096 + i]; Wx[i] = wx[(size_t)n * 4096 + i]; }
    const int cc = tid & 63, ct = tid >> 6;
    const int ch = n * 64 + cc;
    const float cw0 = conv_w[0 * D + ch], cw1 = conv_w[1 * D + ch], cw2 = conv_w[2 * D + ch], cw3 = conv_w[3 * D + ch], cb = conv_b[ch];
    const int gt = tid >> 4, eq = tid & 15;
    float gba[4], gbx[4], gsp[4];
#pragma unroll
    for (int j = 0; j < 4; ++j) { const int e = n * 64 + eq * 4 + j; gba[j] = ba[e]; gbx[j] = bx[e]; const float x = -lam[e]; gsp[j] = fmaxf(x, 0.f) + log1pf(expf(-fabsf(x))); }
    float hstate = 0.f;
    const size_t rowb = (size_t)b * SEQ;
    __syncthreads();
    for (int t0 = 0; t0 < SEQ; t0 += TT) {
#pragma unroll
        for (int i = 0; i < 4; ++i) { const int tt = ct + 8 * i, t = t0 + tt;
            const bf16_t* p = proj + (rowb + t) * INC + C_XR + ch;
            float acc = cb + cw3 * bf2f(p[0]);
            if (t >= 1) acc += cw2 * bf2f(*(p - INC));
            if (t >= 2) acc += cw1 * bf2f(*(p - 2 * INC));
            if (t >= 3) acc += cw0 * bf2f(*(p - 3 * INC));
            XC[tt * 65 + cc] = acc; }
        __syncthreads();
        { f32x4 ar = {0.f, 0.f, 0.f, 0.f}, ai = {0.f, 0.f, 0.f, 0.f};
#pragma unroll 8
          for (int d = 0; d < 64; ++d) { const float xv = XC[gt * 65 + d]; ar += *(const LAS f32x4*)(Wa + d * 64 + eq * 4) * xv; ai += *(const LAS f32x4*)(Wx + d * 64 + eq * 4) * xv; }
#pragma unroll
          for (int j = 0; j < 4; ++j) { const int e = eq * 4 + j;
              const float rg = 1.0f / (1.0f + expf(-(ar[j] + gba[j]))), ig = 1.0f / (1.0f + expf(-(ai[j] + gbx[j])));
              const float log_a = -8.0f * rg * gsp[j]; const float a = expf(log_a); const float mult = sqrtf(-expm1f(2.0f * log_a));
              AV[gt * 64 + e] = a; UV[gt * 64 + e] = mult * ig * XC[gt * 65 + e]; } }
        __syncthreads();
        if (tid < 64) {
            for (int tt = 0; tt < TT; ++tt) { hstate = AV[tt * 64 + tid] * hstate + UV[tt * 64 + tid];
                const size_t row = rowb + t0 + tt;
                const float g = bf2f(proj[row * INC + C_GR + n * 64 + tid]);
                yabc[row * YW + Y_A + n * 64 + tid] = (bf16_t)f2bf(g * hstate); }
        }
        __syncthreads();
    }
}
}

namespace moe {
__device__ __forceinline__ void assign(const int* topi, const float* topw, int* rowtok, int* rowdst, float* roww, int* tile_e, int* ntiles, LAS int* sm, int tid) {
    const int nthr = 512, per = M / nthr, t0 = tid * per;
    int cnt[NE];
#pragma unroll
    for (int e = 0; e < NE; ++e) cnt[e] = 0;
    for (int t = t0; t < t0 + per; ++t) { const int e0 = topi[2 * t], e1 = topi[2 * t + 1];
#pragma unroll
        for (int e = 0; e < NE; ++e) cnt[e] += (e0 == e) + (e1 == e); }
#pragma unroll
    for (int e = 0; e < NE; ++e) sm[e * nthr + tid] = cnt[e];
    __syncthreads();
    if (tid < NE) { int run = 0; for (int i = 0; i < nthr; ++i) { const int v = sm[tid * nthr + i]; sm[tid * nthr + i] = run; run += v; } sm[NE * nthr + tid] = run; }
    __syncthreads();
    if (tid == 0) { int p = 0, nt = 0;
        for (int e = 0; e < NE; ++e) { const int tot = sm[NE * nthr + e]; sm[NE * nthr + 8 + e] = p; const int nte = (tot + 255) >> 8; for (int i = 0; i < nte; ++i) tile_e[nt++] = e; p += nte * 256; }
        *ntiles = nt; }
    __syncthreads();
    for (int e = 0; e < NE; ++e) { const int tot = sm[NE * nthr + e], base = sm[NE * nthr + 8 + e], padded = ((tot + 255) >> 8) << 8;
        for (int i = tot + tid; i < padded; i += nthr) { rowtok[base + i] = 0; rowdst[base + i] = -1; roww[base + i] = 0.f; } }
    int pos[NE];
#pragma unroll
    for (int e = 0; e < NE; ++e) pos[e] = sm[NE * nthr + 8 + e] + sm[e * nthr + tid];
    for (int t = t0; t < t0 + per; ++t) {
#pragma unroll
        for (int k = 0; k < 2; ++k) { const int ek = topi[2 * t + k]; int p = 0;
#pragma unroll
            for (int e = 0; e < NE; ++e) { if (ek == e) { p = pos[e]; pos[e] = p + 1; } }
            rowtok[p] = t; rowdst[p] = k * M + t; roww[p] = topw[2 * t + k]; } }
}
struct Order {
    const int* tile_e; const int* ntiles_p; int nN, G, c, ntiles;
    __device__ __forceinline__ void dev_init(int G_, int c_) { G = G_; c = c_; ntiles = *ntiles_p; }
    __device__ __forceinline__ bool next(int i, pg8::Unit& u) const { const int L = i * G + c; if (L >= ntiles * nN) return false; u.pm = L / nN; u.pn = L % nN; u.e = tile_e[u.pm]; u.aux = 0; return true; }
};
struct ProbUp {
    static constexpr bool GATHER = true;
    const bf16_t* A; const bf16_t* Ba; const bf16_t* Bb; const bf16_t* Bc; const bf16_t* Bd; const int* rowtok; int K, lda, ldb, pad;
    __device__ __forceinline__ const char* a_base(const pg8::Unit&) const { return (const char*)A; }
    __device__ __forceinline__ const char* b_base(const pg8::Unit& u) const {
        const char* base = (u.e == 0) ? (const char*)Ba : (u.e < 5) ? (const char*)Bb + (size_t)(u.e - 1) * DFF2 * ldb * 2 : (u.e < 7) ? (const char*)Bc + (size_t)(u.e - 5) * DFF2 * ldb * 2 : (const char*)Bd;
        return base + (size_t)u.pn * 256 * ldb * 2; }
    __device__ __forceinline__ unsigned a_off(const pg8::Unit& u, int row, int col) const { return (unsigned)(rowtok[u.pm * 256 + row] * lda + col) * 2u; }
};
struct ProbDown {
    static constexpr bool GATHER = false;
    const bf16_t* A; const bf16_t* Bt; int K, lda, ldb, pad;
    __device__ __forceinline__ const char* a_base(const pg8::Unit& u) const { return (const char*)A + (size_t)u.pm * 256 * lda * 2; }
    __device__ __forceinline__ const char* b_base(const pg8::Unit& u) const { return (const char*)Bt + ((size_t)u.e * D + (size_t)u.pn * 256) * ldb * 2; }
    __device__ __forceinline__ unsigned a_off(const pg8::Unit&, int row, int col) const { return (unsigned)(row * lda + col) * 2u; }
};
}
namespace rg2 {
constexpr int TT = 128, XS = 144  , FS = 36  ;
constexpr int L_XCB = 0, L_XCF = L_XCB + TT * XS, L_AV = L_XCF + TT * FS * 4, L_UV = L_AV + TT * FS * 4, L_WA = L_UV + TT * FS * 4, L_WX = L_WA + 32 * XS,
              L_CW = L_WX + 32 * XS, L_SEGA = L_CW + 5 * 64 * 4, L_SEGH = L_SEGA + 16 * 32 * 4, L_CARRY = L_SEGH + 16 * 32 * 4, LDS_BYTES = L_CARRY + 2 * 32 * 4;
__device__ __forceinline__ void unit(int b, int n, int hf, const bf16_t* proj, bf16_t* yabc, const float* conv_w, const float* conv_b, const float* wa, const float* ba,
                                     const float* wx, const float* bx, const float* lam, LAS char* lds, int wid) {
    const int lane = lane_fresh(), tid = wid * 64 + lane;
    LAS float* XCF = (LAS float*)(lds + L_XCF); LAS float* AV = (LAS float*)(lds + L_AV); LAS float* UV = (LAS float*)(lds + L_UV);
    LAS float* CW = (LAS float*)(lds + L_CW); LAS float* SEGA = (LAS float*)(lds + L_SEGA); LAS float* SEGH = (LAS float*)(lds + L_SEGH); LAS float* CARRY = (LAS float*)(lds + L_CARRY);
    const int ch0 = n * 64;
    const int oc0 = ch0 + hf * 32;
    __syncthreads();
    for (int i = tid; i < 2048; i += 512) { const int d = i >> 5, e = i & 31;
        *(LAS bf16_t*)(lds + L_WA + e * XS + d * 2) = (bf16_t)f2bf(wa[(size_t)n * 4096 + d * 64 + hf * 32 + e]);
        *(LAS bf16_t*)(lds + L_WX + e * XS + d * 2) = (bf16_t)f2bf(wx[(size_t)n * 4096 + d * 64 + hf * 32 + e]); }
    if (tid < 320) { const int k = tid >> 6, c = tid & 63; CW[tid] = (k < 4) ? conv_w[k * D + ch0 + c] : conv_b[ch0 + c]; }
    if (tid < 64) CARRY[tid] = 0.f;
    const int crow_ = tid >> 2, cg = tid & 3;
    const int mt = wid & 3, chh = wid >> 2;
    const int g4 = lane >> 4, e16 = lane & 15;
    const int eo = chh * 16 + e16;
    const float gba = ba[oc0 + eo], gbx = bx[oc0 + eo];
    float gsp; { const float x = -lam[oc0 + eo]; gsp = fmaxf(x, 0.f) + log1pf(expf(-fabsf(x))); }
    const int sc = tid & 31, ss = tid >> 5;
    const size_t rowb = (size_t)b * SEQ;
    const bf16_t* xbase = proj + rowb * INC + C_XR + ch0 + cg * 16;
    const bf16_t* gbase = proj + rowb * INC + C_GR + oc0 + sc;
    bf16_t* ybase = yabc + rowb * YW + Y_A + oc0 + sc;
    u32x4 xr[4][2]; unsigned short gv[8];
#define RG2_LOADX(T0) do { _Pragma("unroll") for (int k = 0; k < 4; ++k) { const int t = (T0) + crow_ - 3 + k; \
        if (t >= 0) { const bf16_t* p = xbase + (size_t)t * INC; xr[k][0] = *(const u32x4*)p; xr[k][1] = *(const u32x4*)(p + 8); } \
        else { xr[k][0] = (u32x4){0u, 0u, 0u, 0u}; xr[k][1] = (u32x4){0u, 0u, 0u, 0u}; } } } while (0)
    RG2_LOADX(0);
    __syncthreads();
    for (int ti = 0; ti < SEQ / TT; ++ti) {
        const int t0 = ti * TT;
        {
            float xc[16];
#pragma unroll
            for (int j = 0; j < 16; ++j) xc[j] = CW[4 * 64 + cg * 16 + j];
#pragma unroll
            for (int k = 0; k < 4; ++k) {
#pragma unroll
                for (int q = 0; q < 2; ++q) { const u32x4 w = xr[k][q]; const unsigned ww[4] = {w.x, w.y, w.z, w.w};
#pragma unroll
                    for (int j = 0; j < 4; ++j) { const int c = q * 8 + 2 * j;
                        xc[c] += CW[k * 64 + cg * 16 + c] * bf2f(ww[j] & 0xffffu); xc[c + 1] += CW[k * 64 + cg * 16 + c + 1] * bf2f(ww[j] >> 16); } } }
            u32x4 o0, o1;
            o0.x = pk2(xc[0], xc[1]); o0.y = pk2(xc[2], xc[3]); o0.z = pk2(xc[4], xc[5]); o0.w = pk2(xc[6], xc[7]);
            o1.x = pk2(xc[8], xc[9]); o1.y = pk2(xc[10], xc[11]); o1.z = pk2(xc[12], xc[13]); o1.w = pk2(xc[14], xc[15]);
            *(LAS u32x4*)(lds + L_XCB + crow_ * XS + cg * 32) = o0; *(LAS u32x4*)(lds + L_XCB + crow_ * XS + cg * 32 + 16) = o1;
            if ((cg >> 1) == hf) { LAS float* d = XCF + crow_ * FS + (cg & 1) * 16;
#pragma unroll
                for (int j = 0; j < 4; ++j) *(LAS f32x4*)(d + 4 * j) = (f32x4){xc[4 * j], xc[4 * j + 1], xc[4 * j + 2], xc[4 * j + 3]}; }
        }
#pragma unroll
        for (int k = 0; k < 8; ++k) gv[k] = gbase[(size_t)(t0 + ss * 8 + k) * INC];
        __syncthreads();
        if (ti + 1 < SEQ / TT) RG2_LOADX(t0 + TT);
        {
            f32x4 ar[2], ai[2];
#pragma unroll
            for (int s = 0; s < 2; ++s) { ar[s] = (f32x4){0.f, 0.f, 0.f, 0.f}; ai[s] = (f32x4){0.f, 0.f, 0.f, 0.f}; }
#pragma unroll
            for (int kk = 0; kk < 2; ++kk) {
                const bf16x8 bwa = *(const LAS bf16x8*)(lds + L_WA + eo * XS + (32 * kk + 8 * g4) * 2);
                const bf16x8 bwx = *(const LAS bf16x8*)(lds + L_WX + eo * XS + (32 * kk + 8 * g4) * 2);
#pragma unroll
                for (int s = 0; s < 2; ++s) {
                    const bf16x8 av = *(const LAS bf16x8*)(lds + L_XCB + (mt * 32 + 16 * s + e16) * XS + (32 * kk + 8 * g4) * 2);
                    ar[s] = __builtin_amdgcn_mfma_f32_16x16x32_bf16(av, bwa, ar[s], 0, 0, 0);
                    ai[s] = __builtin_amdgcn_mfma_f32_16x16x32_bf16(av, bwx, ai[s], 0, 0, 0);
                }
            }
#pragma unroll
            for (int s = 0; s < 2; ++s)
#pragma unroll
                for (int rg = 0; rg < 4; ++rg) {
                    const int tok = mt * 32 + 16 * s + 4 * g4 + rg;
                    const float rgt = sigmoid_f(ar[s][rg] + gba), igt = sigmoid_f(ai[s][rg] + gbx);
                    const float log_a = -8.0f * rgt * gsp;
                    const float a = fexp2(log_a * 1.4426950408889634f);
                    const float z = 2.0f * log_a;
                    const float poly = z * (1.0f + z * (0.5f + z * (0.16666667f + z * (0.041666668f + z * (0.0083333338f + z * 0.0013888889f)))));
                    const float om = (z > -0.25f) ? -poly : (1.0f - a * a);
                    const float u = sqrtf(om) * igt * XCF[tok * FS + eo];
                    AV[tok * FS + eo] = a; UV[tok * FS + eo] = u;
                }
        }
        __syncthreads();
        float hl[8], ac[8];
        { float Hh = 0.f, Aa = 1.f;
#pragma unroll
          for (int k = 0; k < 8; ++k) { const float a = AV[(ss * 8 + k) * FS + sc], u = UV[(ss * 8 + k) * FS + sc]; Hh = a * Hh + u; Aa *= a; hl[k] = Hh; ac[k] = Aa; }
          SEGA[ss * 32 + sc] = Aa; SEGH[ss * 32 + sc] = Hh; }
        __syncthreads();
        { float cin = CARRY[(ti & 1) * 32 + sc];
          for (int s2 = 0; s2 < ss; ++s2) cin = SEGA[s2 * 32 + sc] * cin + SEGH[s2 * 32 + sc];
#pragma unroll
          for (int k = 0; k < 8; ++k) { const float hv = hl[k] + ac[k] * cin; hl[k] = hv;
              ybase[(size_t)(t0 + ss * 8 + k) * YW] = (bf16_t)f2bf(bf2f(gv[k]) * hv); }
          if (ss == 15) CARRY[((ti + 1) & 1) * 32 + sc] = hl[7]; }
    }
    __syncthreads();
#undef RG2_LOADX
}
}
constexpr size_t MiB = 1u << 20;
constexpr size_t WS_CTL = 0, CTL_ZERO_BYTES = 64 * 1024, WS_ROWTOK = 256 * 1024, WS_ROWDST = 400 * 1024, WS_ROWW = 544 * 1024, WS_TILEE = 700 * 1024, WS_NTILES = 702 * 1024;
constexpr size_t WS_MOD = 1 * MiB, WS_CS = 1 * MiB + 512 * 1024, WS_KMEAN = 5 * MiB + 512 * 1024, WS_TOPI = 5 * MiB + 640 * 1024, WS_TOPW = 5 * MiB + 768 * 1024;
constexpr size_t WS_L1W = 6 * MiB, WS_H = 28 * MiB, WS_YABC = 60 * MiB, WS_PROJ = 124 * MiB, WS_XA = 380 * MiB, WS_SPARE = 444 * MiB, WS_END = 488 * MiB;
constexpr size_t WS_HMID_MOE = 138 * MiB, OUT_W2 = 0, OUT_W13A = 44 * MiB, WS_W13B = 444 * MiB, WS_W13C = 6 * MiB, WS_W13D = 124 * MiB, W13_BYTES = 11 * MiB, W2_BYTES = 5 * MiB + 512 * 1024;
constexpr size_t LW_IN = 0, LW_BRA = 16 * MiB, LW_BRB = 18 * MiB, LW_BRC = 19 * MiB, LW_OUT = 20 * MiB, LW_W13 = 22 * MiB, LW_W2 = 33 * MiB;
constexpr int CW_TMO = 0, CW_QUEUE = 64  , CW_BAR = 4096;
constexpr int LDS_MISC = 131072 + 8192, LDS_TOTAL = 147456;


#define XB_TMO      128
#define XB_XCNT(j)  (256  + 64 * (j))
#define XB_XSUB(j)  (1280 + 64 * (j))
#define XB_XGEN(j)  (2304 + 64 * (j))
#define XB_TOP      3328
#define XB_TOPGEN   3392
#define XCD_BAR_WORDS 3456
#define XB_SPIN_CAP (1u << 18)

__device__ __forceinline__ unsigned xb_ld(unsigned* p)              { return __hip_atomic_load(p, __ATOMIC_RELAXED, __HIP_MEMORY_SCOPE_AGENT); }
__device__ __forceinline__ unsigned xb_add(unsigned* p, unsigned v) { return __hip_atomic_fetch_add(p, v, __ATOMIC_RELAXED, __HIP_MEMORY_SCOPE_AGENT); }
__device__ __forceinline__ unsigned xb_xcc_id() { return (unsigned)__builtin_amdgcn_s_getreg((3 << 11) | 20) & 0xFu; }
#define XB_SPIN(cond, bar) do { unsigned _sp = 0; while (cond) { __builtin_amdgcn_s_sleep(1); \
    if ((++_sp & 255u) == 0u) { if (xb_ld(&(bar)[XB_TMO])) break; if (_sp > XB_SPIN_CAP) { atomicAdd(&(bar)[XB_TMO], 1u); break; } } } } while (0)

struct XcdBarrier {
    unsigned* bar; unsigned x;
    volatile LAS unsigned* st;
};

__device__ __forceinline__ XcdBarrier xcd_barrier_post(unsigned* bar, volatile LAS unsigned* st) {
    XcdBarrier b; b.bar = bar; b.x = xb_xcc_id(); b.st = st;
    if (threadIdx.x == 0) (void)xb_add(&bar[XB_XCNT(b.x)], 1u);
    return b;
}
__device__ __forceinline__ void xcd_barrier_complete(unsigned* bar, unsigned x, unsigned& nloc, unsigned& nx) {
    const unsigned G = gridDim.x * gridDim.y * gridDim.z;
    unsigned sum, cnt, mine, sp = 0u;
    for (;;) {
        sum = 0u; cnt = 0u; mine = 0u;
#pragma unroll
        for (unsigned j = 0; j < 16; ++j) { const unsigned c = xb_ld(&bar[XB_XCNT(j)]); sum += c; cnt += (c > 0u) ? 1u : 0u; mine = (j == x) ? c : mine; }
        if (sum == G) break;
        __builtin_amdgcn_s_sleep(1);
        if ((++sp & 255u) == 0u) { if (xb_ld(&bar[XB_TMO])) break; if (sp > XB_SPIN_CAP) { atomicAdd(&bar[XB_TMO], 1u); break; } }
    }
    nloc = mine > 0u ? mine : 1u; nx = cnt > 0u ? cnt : 1u;
}

__device__ __forceinline__ void xcd_barrier(const XcdBarrier& b) {
    asm volatile("s_waitcnt vmcnt(0)" ::: "memory");
    __syncthreads();
    if (threadIdx.x == 0) {
        unsigned* bar = b.bar;
        __builtin_amdgcn_s_waitcnt(0);
        unsigned nloc = b.st[0], nx = b.st[1];
        if (nloc == 0u) { xcd_barrier_complete(bar, b.x, nloc, nx); b.st[0] = nloc; b.st[1] = nx; }
        const unsigned old = xb_add(&bar[XB_XSUB(b.x)], 1u);
        const unsigned gen = old / nloc;
        if (old + 1u == (gen + 1u) * nloc) {
            __builtin_amdgcn_fence(__ATOMIC_RELEASE, "agent");
            asm volatile("s_waitcnt vmcnt(0)" ::: "memory");
            const unsigned og = xb_add(&bar[XB_TOP], 1u);
            const unsigned tg = og / nx;
            if (og + 1u == (tg + 1u) * nx) xb_add(&bar[XB_TOPGEN], 1u);
            else XB_SPIN(xb_ld(&bar[XB_TOPGEN]) == tg, bar);
            __builtin_amdgcn_fence(__ATOMIC_ACQUIRE, "agent");
            xb_add(&bar[XB_XGEN(b.x)], 1u);
            asm volatile("s_waitcnt vmcnt(0)" ::: "memory");
        } else {
            XB_SPIN(xb_ld(&bar[XB_XGEN(b.x)]) == gen, bar);
            __builtin_amdgcn_fence(__ATOMIC_ACQUIRE, "agent");
            asm volatile("s_waitcnt vmcnt(0)" ::: "memory");
        }
    }
    __syncthreads();
}


#ifndef PHMASK
#define PHMASK 0xFFFFF
#endif
#define PH(k) if constexpr ((PHMASK >> (k)) & 1)
#define QOFF 0
__device__ __forceinline__ const float* ldptr(const LAS unsigned long long* PT, int i) {
    const unsigned long long v = PT[i];
    const unsigned lo = __builtin_amdgcn_readfirstlane((unsigned)v), hi = __builtin_amdgcn_readfirstlane((unsigned)(v >> 32));
    return (const float*)(const __attribute__((address_space(1))) float*)(((unsigned long long)hi << 32) | lo);
}
struct CvtD { unsigned long long src, dst; int K, N, ldk, coff, row_off, mode, nunits, pad; };
__device__ __forceinline__ void cvt_unit(const LAS CvtD* cd, int first, int u, LAS float* scr, int wid, int lane) {
    int d = first;
    while (u >= cd[d].nunits) { u -= cd[d].nunits; ++d; }
    const float* W = (const float*)(const __attribute__((address_space(1))) float*)cd[d].src; bf16_t* WT = (bf16_t*)(__attribute__((address_space(1))) bf16_t*)cd[d].dst;
    const int N = cd[d].N, ldk = cd[d].ldk, coff = cd[d].coff, row_off = cd[d].row_off, mode = cd[d].mode;
    LAS unsigned* T = (LAS unsigned*)scr;
    thin::TItem cur; thin::titem_load(cur, W, N, 64 * u + wid, lane);
#pragma unroll 1
    for (int i = 0; i < 8; ++i) { const int it = 64 * u + wid + 8 * i;
        thin::TItem nxt;
        if (i < 7) thin::titem_load(nxt, W, N, it + 8, lane);
        thin::titem_store(cur, N, WT, ldk, coff, row_off, mode, T, it, lane);
        cur = nxt; }
}
struct Args { const float* in[37]; float* out; unsigned char* ws; };

__device__ __forceinline__ float diff_lambda(const float* lq1, const float* lk1, const float* lq2, const float* lk2, float lam_init, int lane) {
    const float s1 = wave_sum(lq1[lane] * lk1[lane]), s2 = wave_sum(lq2[lane] * lk2[lane]); return expf(s1) - expf(s2) + lam_init; }

constexpr int NQ_RG = 256;
constexpr int NCVT0 = 77, NCVT1 = 198;
__global__ void __launch_bounds__(512, 2) mega_fwd(Args a) {
    extern __shared__ __attribute__((aligned(16))) unsigned char lds_raw[];
    LAS unsigned char* lds = (LAS unsigned char*)lds_raw;
    volatile LAS unsigned* MISC = (volatile LAS unsigned*)(lds + LDS_MISC);
    const int tid0 = threadIdx.x, wid0 = __builtin_amdgcn_readfirstlane(tid0 >> 6);
    const int G = gridDim.x, bid = blockIdx.x;
    if (tid0 < 64) MISC[tid0] = 0u;
    LAS unsigned long long* PT = (LAS unsigned long long*)(lds + LDS_MISC + 256);
    if (tid0 == 0) {
#pragma unroll
        for (int i = 0; i < 37; ++i) PT[i] = (unsigned long long)a.in[i];
    }
    LAS CvtD* CD = (LAS CvtD*)(lds + LDS_MISC + 1024);
    if (tid0 == 64) {
        const unsigned long long wsb = (unsigned long long)a.ws, ob = (unsigned long long)a.out;
#define CVT_PUT(i, SRC, DST, K_, N_, LDK, COFF, MODE) do { CD[i].src = (unsigned long long)(SRC); CD[i].dst = (DST); CD[i].K = (K_); CD[i].N = (N_); CD[i].ldk = (LDK); CD[i].coff = (COFF); CD[i].row_off = 0; CD[i].mode = (MODE); CD[i].nunits = ((K_) >> 6) * ((N_) >> 6) / 64; CD[i].pad = 0; } while (0)
        CVT_PUT(0, a.in[7] + (size_t)D * INC, wsb + WS_L1W + LW_IN, D, INC, D, 0, 0);
        CVT_PUT(1, a.in[25] + (size_t)D * D, wsb + WS_L1W + LW_BRA, D, D, 2048, 0, 0);
        CVT_PUT(2, a.in[26] + (size_t)512 * D, wsb + WS_L1W + LW_BRA, 512, D, 2048, 1024, 0);
        CVT_PUT(3, a.in[27] + (size_t)512 * D, wsb + WS_L1W + LW_BRA, 512, D, 2048, 1536, 0);
        CVT_PUT(4, a.in[28] + (size_t)D * D, wsb + WS_L1W + LW_OUT, D, D, D, 0, 0);
        CVT_PUT(5, a.in[29], ob + LW_W13, D, DFF, D, 0, 1);
        CVT_PUT(6, a.in[30], ob + LW_W13, D, DFF, D, 0, 2);
        CVT_PUT(7, a.in[31], ob + LW_W2, DFF, D, DFF, 0, 0);
#pragma unroll
        for (int e = 0; e < NE; ++e) CVT_PUT(8 + e, a.in[36] + (size_t)e * DFF * D, ob + OUT_W2 + e * W2_BYTES, DFF, D, DFF, 0, 0);
#pragma unroll
        for (int e = 0; e < 5; ++e) { const unsigned long long dst = (e == 0) ? ob + OUT_W13A : wsb + WS_W13B + (e - 1) * W13_BYTES;
            CVT_PUT(16 + 2 * e, a.in[34] + (size_t)e * D * DFF, dst, D, DFF, D, 0, 1); CVT_PUT(17 + 2 * e, a.in[35] + (size_t)e * D * DFF, dst, D, DFF, D, 0, 2); }
#undef CVT_PUT
    }
    __syncthreads();
    XcdBarrier bar = xcd_barrier_post((unsigned*)(a.ws + WS_CTL) + CW_BAR, MISC + 8);
#define F(i) ldptr(PT, (i))
#define PHASE_VARS(lv) \
    unsigned long long ws_u = (unsigned long long)a.ws, out_u = (unsigned long long)a.out; const int l = (lv); int wid = wid0; \
    asm volatile("" : "+s"(ws_u), "+s"(out_u), "+s"(wid)); \
    const int lane = lane_fresh(), tid = wid * 64 + lane; \
    unsigned char* ws = (unsigned char*)(__attribute__((address_space(1))) unsigned char*)ws_u; float* outp = (float*)(__attribute__((address_space(1))) float*)out_u; \
    const int gw = bid * 8 + wid, ngw = G * 8, gtid = bid * 512 + tid, ngt = G * 512; (void)gw; (void)ngw; (void)gtid; (void)ngt; (void)lane; (void)l; (void)tid; \
    char* outb = (char*)outp; (void)outb; \
    float* mod = (float*)(ws + WS_MOD); f32x2* cs = (f32x2*)(ws + WS_CS); float* kmean = (float*)(ws + WS_KMEAN); (void)mod; (void)cs; (void)kmean; \
    bf16_t* H = (bf16_t*)(ws + WS_H); bf16_t* YABC = (bf16_t*)(ws + WS_YABC); bf16_t* PROJ = (bf16_t*)(ws + WS_PROJ); float* XA = (float*)(ws + WS_XA); (void)H; (void)YABC; (void)PROJ; (void)XA; \
    const float* xin = (l == 0) ? F(0) : (const float*)XA; float* x1 = XA; const char* lwb = (l == 0) ? (const char*)outb : (const char*)ws + WS_L1W; \
    const float* modl = mod + (size_t)l * NB * 6 * D; (void)xin; (void)x1; (void)lwb; (void)modl;

    PH(0) { PHASE_VARS(0)
        LAS float* scr = (LAS float*)(lds + wid * 8192);
        thin::transpose_matrix(F(7), D, INC, (bf16_t*)(outb + LW_IN), D, 0, 0, 0, scr, gw, ngw, lane);
        thin::transpose_matrix(F(25), D, D, (bf16_t*)(outb + LW_BRA), 2048, 0, 0, 0, scr, gw, ngw, lane);
        thin::transpose_matrix(F(26), 512, D, (bf16_t*)(outb + LW_BRA), 2048, 1024, 0, 0, scr, gw, ngw, lane);
        thin::transpose_matrix(F(27), 512, D, (bf16_t*)(outb + LW_BRA), 2048, 1536, 0, 0, scr, gw, ngw, lane);
        thin::transpose_matrix(F(28), D, D, (bf16_t*)(outb + LW_OUT), D, 0, 0, 0, scr, gw, ngw, lane);
        __syncthreads();
        thin::mod_body(F(1), F(3), F(4), mod, bid, G, tid, (LAS float*)(lds + 65536));
        thin::rope_body((const int*)F(2), cs, gtid, ngt);
    }
    xcd_barrier(bar);

    {
        PH(1) { PHASE_VARS(0) thin::norm_body(xin, F(5) + l * D, modl + 0 * D, modl + 1 * D, H, gw, ngw, lane); }
        xcd_barrier(bar);
        PH(2) { PHASE_VARS(0) pg8::DenseProb g{H, (const bf16_t*)(lwb + LW_IN), D, D, D, 0}; pg8::StaticOrder S; S.init(M, INC, G, bid);
          pg8::gemm_phase<pg8::DenseProb, epi::Proj, pg8::StaticOrder, true>(lds, g, S, epi::Proj{PROJ, F(8) + l * 3 * D}, wid); }
        xcd_barrier(bar);
        PH(3) { PHASE_VARS(0) for (int u = bid; u < 256; u += G) { const int grp = u & 3;
            qk::unit(u >> 5, (u >> 2) & 7, grp, PROJ, cs, (grp == 0 ? F(16) : grp == 1 ? F(17) : grp == 2 ? F(23) : F(24)) + l * 64, kmean, (LAS char*)lds, wid); } }
        xcd_barrier(bar);
        {
#define POP_Q() do { __syncthreads(); if (tid == 0) MISC[16] = __hip_atomic_fetch_add((unsigned*)(ws + WS_CTL) + CW_QUEUE + 64 * (l + QOFF), 1u, __ATOMIC_RELAXED, __HIP_MEMORY_SCOPE_AGENT); __syncthreads(); q = (int)MISC[16]; } while (0)
            int q; constexpr int NCVT = (0 == 0) ? NCVT0 : NCVT1;
            { PHASE_VARS(0) POP_Q(); }
            PH(5) { PHASE_VARS(0)
              const float lam_init = 0.8f - 0.6f * expf(-0.3f * (float)l);
              const float lam = diff_lambda(F(18) + l * 64, F(19) + l * 64, F(20) + l * 64, F(21) + l * 64, lam_init, lane);
              const float noff = attn::score_shift(F(16) + l * 64, F(17) + l * 64, lane);
#pragma unroll 1
              while (q < 256) { const int i = q;
                attn::diff_unit((i & 31) >> 2, i & 3, 7 - (i >> 5), PROJ, YABC, F(22) + l * 128, lam, 1.0f - lam_init, noff, (LAS char*)lds, wid);
                POP_Q(); } }
            PH(18) { PHASE_VARS(0)
#pragma unroll 1
              while (q < 256 + NCVT) { __syncthreads(); cvt_unit(CD, l == 0 ? 0 : 8, q - 256, (LAS float*)(lds + wid * 8192), wid, lane);
                POP_Q(); } }
            PH(4) { PHASE_VARS(0)
#pragma unroll 1
              while (q < 256 + NCVT + NQ_RG) { const int i = q - 256 - NCVT;
                rg2::unit(i >> 5, (i >> 1) & 15, i & 1, PROJ, YABC, F(9) + l * 4 * D, F(10) + l * D, F(11) + (size_t)l * 16 * 4096, F(12) + l * D, F(13) + (size_t)l * 16 * 4096, F(14) + l * D, F(15) + l * D, (LAS char*)lds, wid);
                POP_Q(); } }
            PH(6) { PHASE_VARS(0)
              const float noff = attn::score_shift(F(23) + l * 64, F(24) + l * 64, lane);
#pragma unroll 1
              while (q < 256 + NCVT + NQ_RG + 512) { const int i = q - NQ_RG - 256 - NCVT;
                attn::moba_unit((i & 63) >> 3, i & 7, 7 - (i >> 6), PROJ, YABC, kmean, noff, (LAS char*)lds, wid);
                POP_Q(); } }
#undef POP_Q
        }
        xcd_barrier(bar);
        PH(7) { PHASE_VARS(0) pg8::StaticOrder S; S.init(M, D, G, bid); pg8::DenseProb g{YABC, (const bf16_t*)(lwb + LW_BRA), 2048, YW, 2048, 0};
          pg8::gemm_phase<pg8::DenseProb, epi::BranchMerge, pg8::StaticOrder, true>(lds, g, S, epi::BranchMerge{PROJ, H, 16, 24}, wid); }
        xcd_barrier(bar);
        PH(8) { PHASE_VARS(0) pg8::DenseProb g{H, (const bf16_t*)(lwb + LW_OUT), D, D, D, 0}; pg8::StaticOrder S; S.init(M, D, G, bid);
          pg8::gemm_phase<pg8::DenseProb, epi::Resid, pg8::StaticOrder, true>(lds, g, S, epi::Resid{xin, x1, modl + 2 * D}, wid); }
        xcd_barrier(bar);
        if (0 == 0) {
            PH(9) { PHASE_VARS(0) thin::norm_body(x1, F(6) + l * D, modl + 3 * D, modl + 4 * D, H, gw, ngw, lane); }
            xcd_barrier(bar);
            PH(10) { PHASE_VARS(0) pg8::DenseProb g{H, (const bf16_t*)(lwb + LW_W13), D, D, D, 0}; pg8::StaticOrder S; S.init(M, DFF2, G, bid);
              pg8::gemm_phase<pg8::DenseProb, epi::SwiGLU, pg8::StaticOrder, true>(lds, g, S, epi::SwiGLU{PROJ}, wid); }
            xcd_barrier(bar);
            PH(11) { PHASE_VARS(0) pg8::DenseProb g{PROJ, (const bf16_t*)(lwb + LW_W2), DFF, DFF, DFF, 0}; pg8::StaticOrder S; S.init(M, D, G, bid);
              pg8::gemm_phase<pg8::DenseProb, epi::Resid, pg8::StaticOrder, true>(lds, g, S, epi::Resid{x1, x1, modl + 5 * D}, wid); }
            xcd_barrier(bar);
        } else {
#define MOE_VARS \
            bf16_t* W2 = (bf16_t*)(outb + OUT_W2); bf16_t* h2 = H; bf16_t* hmid = (bf16_t*)(ws + WS_HMID_MOE); bf16_t* yslot = YABC; \
            int* topi = (int*)(ws + WS_TOPI); float* topw = (float*)(ws + WS_TOPW); int* rowtok = (int*)(ws + WS_ROWTOK); int* rowdst = (int*)(ws + WS_ROWDST); float* roww = (float*)(ws + WS_ROWW); int* tile_e = (int*)(ws + WS_TILEE); int* ntiles = (int*)(ws + WS_NTILES); \
            (void)W2; (void)h2; (void)hmid; (void)yslot; (void)topi; (void)topw; (void)rowtok; (void)rowdst; (void)roww; (void)tile_e; (void)ntiles;
            PH(12) { PHASE_VARS(0) MOE_VARS thin::norm_router_body(x1, F(6) + l * D, modl + 3 * D, modl + 4 * D, h2, F(32), F(33), topi, topw, gw, ngw, lane); }
            PH(13) { PHASE_VARS(0) MOE_VARS LAS float* scr = (LAS float*)(lds + wid * 8192);
#pragma unroll 1
              for (int e = 5; e < NE; ++e) { bf16_t* dst = (bf16_t*)((e < 7) ? (char*)ws + WS_W13C + (e - 5) * W13_BYTES : (char*)ws + WS_W13D);
                thin::transpose_matrix(F(34) + (size_t)e * D * DFF, D, DFF, dst, D, 0, 0, 1, scr, gw, ngw, lane);
                thin::transpose_matrix(F(35) + (size_t)e * D * DFF, D, DFF, dst, D, 0, 0, 2, scr, gw, ngw, lane); } }
            xcd_barrier(bar);
            PH(14) { PHASE_VARS(0) MOE_VARS if (bid == 0) moe::assign(topi, topw, rowtok, rowdst, roww, tile_e, ntiles, (LAS int*)lds, tid); }
            xcd_barrier(bar);
            PH(15) { PHASE_VARS(0) MOE_VARS moe::Order S{tile_e, ntiles, DFF2 / 256, 0, 0, 0}; S.dev_init(G, bid);
              pg8::gemm_phase<moe::ProbUp, epi::SwiGLU, moe::Order, true>(lds, moe::ProbUp{h2, (const bf16_t*)(outb + OUT_W13A), (const bf16_t*)(ws + WS_W13B), (const bf16_t*)(ws + WS_W13C), (const bf16_t*)(ws + WS_W13D), rowtok, D, D, D, 0}, S, epi::SwiGLU{hmid}, wid); }
            xcd_barrier(bar);
            PH(16) { PHASE_VARS(0) MOE_VARS moe::Order S{tile_e, ntiles, D / 256, 0, 0, 0}; S.dev_init(G, bid);
              pg8::gemm_phase<moe::ProbDown, epi::MoeDown, moe::Order, true>(lds, moe::ProbDown{hmid, W2, DFF, DFF, DFF, 0}, S, epi::MoeDown{rowdst, roww, yslot}, wid); }
            xcd_barrier(bar);
            PH(17) { PHASE_VARS(0) MOE_VARS thin::moe_combine_body(x1, yslot, modl + 5 * D, outp, gtid, ngt); }
#undef MOE_VARS
        }
    }
    {
        PH(1) { PHASE_VARS(1) thin::norm_body(xin, F(5) + l * D, modl + 0 * D, modl + 1 * D, H, gw, ngw, lane); }
        xcd_barrier(bar);
        PH(2) { PHASE_VARS(1) pg8::DenseProb g{H, (const bf16_t*)(lwb + LW_IN), D, D, D, 0}; pg8::StaticOrder S; S.init(M, INC, G, bid);
          pg8::gemm_phase<pg8::DenseProb, epi::Proj, pg8::StaticOrder, true>(lds, g, S, epi::Proj{PROJ, F(8) + l * 3 * D}, wid); }
        xcd_barrier(bar);
        PH(3) { PHASE_VARS(1) for (int u = bid; u < 256; u += G) { const int grp = u & 3;
            qk::unit(u >> 5, (u >> 2) & 7, grp, PROJ, cs, (grp == 0 ? F(16) : grp == 1 ? F(17) : grp == 2 ? F(23) : F(24)) + l * 64, kmean, (LAS char*)lds, wid); } }
        xcd_barrier(bar);
        {
#define POP_Q() do { __syncthreads(); if (tid == 0) MISC[16] = __hip_atomic_fetch_add((unsigned*)(ws + WS_CTL) + CW_QUEUE + 64 * (l + QOFF), 1u, __ATOMIC_RELAXED, __HIP_MEMORY_SCOPE_AGENT); __syncthreads(); q = (int)MISC[16]; } while (0)
            int q; constexpr int NCVT = (1 == 0) ? NCVT0 : NCVT1;
            { PHASE_VARS(1) POP_Q(); }
            PH(5) { PHASE_VARS(1)
              const float lam_init = 0.8f - 0.6f * expf(-0.3f * (float)l);
              const float lam = diff_lambda(F(18) + l * 64, F(19) + l * 64, F(20) + l * 64, F(21) + l * 64, lam_init, lane);
              const float noff = attn::score_shift(F(16) + l * 64, F(17) + l * 64, lane);
#pragma unroll 1
              while (q < 256) { const int i = q;
                attn::diff_unit((i & 31) >> 2, i & 3, 7 - (i >> 5), PROJ, YABC, F(22) + l * 128, lam, 1.0f - lam_init, noff, (LAS char*)lds, wid);
                POP_Q(); } }
            PH(18) { PHASE_VARS(1)
#pragma unroll 1
              while (q < 256 + NCVT) { __syncthreads(); cvt_unit(CD, l == 0 ? 0 : 8, q - 256, (LAS float*)(lds + wid * 8192), wid, lane);
                POP_Q(); } }
            PH(4) { PHASE_VARS(1)
#pragma unroll 1
              while (q < 256 + NCVT + NQ_RG) { const int i = q - 256 - NCVT;
                rg2::unit(i >> 5, (i >> 1) & 15, i & 1, PROJ, YABC, F(9) + l * 4 * D, F(10) + l * D, F(11) + (size_t)l * 16 * 4096, F(12) + l * D, F(13) + (size_t)l * 16 * 4096, F(14) + l * D, F(15) + l * D, (LAS char*)lds, wid);
                POP_Q(); } }
            PH(6) { PHASE_VARS(1)
              const float noff = attn::score_shift(F(23) + l * 64, F(24) + l * 64, lane);
#pragma unroll 1
              while (q < 256 + NCVT + NQ_RG + 512) { const int i = q - NQ_RG - 256 - NCVT;
                attn::moba_unit((i & 63) >> 3, i & 7, 7 - (i >> 6), PROJ, YABC, kmean, noff, (LAS char*)lds, wid);
                POP_Q(); } }
#undef POP_Q
        }
        xcd_barrier(bar);
        PH(7) { PHASE_VARS(1) pg8::StaticOrder S; S.init(M, D, G, bid); pg8::DenseProb g{YABC, (const bf16_t*)(lwb + LW_BRA), 2048, YW, 2048, 0};
          pg8::gemm_phase<pg8::DenseProb, epi::BranchMerge, pg8::StaticOrder, true>(lds, g, S, epi::BranchMerge{PROJ, H, 16, 24}, wid); }
        xcd_barrier(bar);
        PH(8) { PHASE_VARS(1) pg8::DenseProb g{H, (const bf16_t*)(lwb + LW_OUT), D, D, D, 0}; pg8::StaticOrder S; S.init(M, D, G, bid);
          pg8::gemm_phase<pg8::DenseProb, epi::Resid, pg8::StaticOrder, true>(lds, g, S, epi::Resid{xin, x1, modl + 2 * D}, wid); }
        xcd_barrier(bar);
        if (1 == 0) {
            PH(9) { PHASE_VARS(1) thin::norm_body(x1, F(6) + l * D, modl + 3 * D, modl + 4 * D, H, gw, ngw, lane); }
            xcd_barrier(bar);
            PH(10) { PHASE_VARS(1) pg8::DenseProb g{H, (const bf16_t*)(lwb + LW_W13), D, D, D, 0}; pg8::StaticOrder S; S.init(M, DFF2, G, bid);
              pg8::gemm_phase<pg8::DenseProb, epi::SwiGLU, pg8::StaticOrder, true>(lds, g, S, epi::SwiGLU{PROJ}, wid); }
            xcd_barrier(bar);
            PH(11) { PHASE_VARS(1) pg8::DenseProb g{PROJ, (const bf16_t*)(lwb + LW_W2), DFF, DFF, DFF, 0}; pg8::StaticOrder S; S.init(M, D, G, bid);
              pg8::gemm_phase<pg8::DenseProb, epi::Resid, pg8::StaticOrder, true>(lds, g, S, epi::Resid{x1, x1, modl + 5 * D}, wid); }
            xcd_barrier(bar);
        } else {
#define MOE_VARS \
            bf16_t* W2 = (bf16_t*)(outb + OUT_W2); bf16_t* h2 = H; bf16_t* hmid = (bf16_t*)(ws + WS_HMID_MOE); bf16_t* yslot = YABC; \
            int* topi = (int*)(ws + WS_TOPI); float* topw = (float*)(ws + WS_TOPW); int* rowtok = (int*)(ws + WS_ROWTOK); int* rowdst = (int*)(ws + WS_ROWDST); float* roww = (float*)(ws + WS_ROWW); int* tile_e = (int*)(ws + WS_TILEE); int* ntiles = (int*)(ws + WS_NTILES); \
            (void)W2; (void)h2; (void)hmid; (void)yslot; (void)topi; (void)topw; (void)rowtok; (void)rowdst; (void)roww; (void)tile_e; (void)ntiles;
            PH(12) { PHASE_VARS(1) MOE_VARS thin::norm_router_body(x1, F(6) + l * D, modl + 3 * D, modl + 4 * D, h2, F(32), F(33), topi, topw, gw, ngw, lane); }
            PH(13) { PHASE_VARS(1) MOE_VARS LAS float* scr = (LAS float*)(lds + wid * 8192);
#pragma unroll 1
              for (int e = 5; e < NE; ++e) { bf16_t* dst = (bf16_t*)((e < 7) ? (char*)ws + WS_W13C + (e - 5) * W13_BYTES : (char*)ws + WS_W13D);
                thin::transpose_matrix(F(34) + (size_t)e * D * DFF, D, DFF, dst, D, 0, 0, 1, scr, gw, ngw, lane);
                thin::transpose_matrix(F(35) + (size_t)e * D * DFF, D, DFF, dst, D, 0, 0, 2, scr, gw, ngw, lane); } }
            xcd_barrier(bar);
            PH(14) { PHASE_VARS(1) MOE_VARS if (bid == 0) moe::assign(topi, topw, rowtok, rowdst, roww, tile_e, ntiles, (LAS int*)lds, tid); }
            xcd_barrier(bar);
            PH(15) { PHASE_VARS(1) MOE_VARS moe::Order S{tile_e, ntiles, DFF2 / 256, 0, 0, 0}; S.dev_init(G, bid);
              pg8::gemm_phase<moe::ProbUp, epi::SwiGLU, moe::Order, true>(lds, moe::ProbUp{h2, (const bf16_t*)(outb + OUT_W13A), (const bf16_t*)(ws + WS_W13B), (const bf16_t*)(ws + WS_W13C), (const bf16_t*)(ws + WS_W13D), rowtok, D, D, D, 0}, S, epi::SwiGLU{hmid}, wid); }
            xcd_barrier(bar);
            PH(16) { PHASE_VARS(1) MOE_VARS moe::Order S{tile_e, ntiles, D / 256, 0, 0, 0}; S.dev_init(G, bid);
              pg8::gemm_phase<moe::ProbDown, epi::MoeDown, moe::Order, true>(lds, moe::ProbDown{hmid, W2, DFF, DFF, DFF, 0}, S, epi::MoeDown{rowdst, roww, yslot}, wid); }
            xcd_barrier(bar);
            PH(17) { PHASE_VARS(1) MOE_VARS thin::moe_combine_body(x1, yslot, modl + 5 * D, outp, gtid, ngt); }
#undef MOE_VARS
        }
    }
#undef F
#undef PHASE_VARS
}

extern "C" void kernel_launch(void* const* d_in, const int* in_sizes, int n_in, void* d_out, int out_size, void* d_ws, size_t ws_size, hipStream_t stream) {
    static int grid = 0;
    if (grid == 0) {
        if (n_in != 37 || ws_size < WS_END) { fprintf(stderr, "kernel_launch: unexpected n_in %d / ws_size %zu (need %zu)\n", n_in, ws_size, (size_t)WS_END); grid = -1; return; }
        int dev = 0, cus = 0, per_cu = 0;
        if (hipGetDevice(&dev) != hipSuccess || hipDeviceGetAttribute(&cus, hipDeviceAttributeMultiprocessorCount, dev) != hipSuccess) { grid = -1; return; }
        if (hipFuncSetAttribute((const void*)mega_fwd, hipFuncAttributeMaxDynamicSharedMemorySize, LDS_TOTAL) != hipSuccess) { fprintf(stderr, "kernel_launch: hipFuncSetAttribute failed\n"); grid = -1; return; }
        if (hipOccupancyMaxActiveBlocksPerMultiprocessor(&per_cu, (const void*)mega_fwd, 512, LDS_TOTAL) != hipSuccess || per_cu < 1) fprintf(stderr, "kernel_launch: occupancy query says %d\n", per_cu);
        (void)hipGetLastError();
        grid = cus;
    }
    if (grid < 0) return;
    (void)hipMemsetAsync((char*)d_ws + WS_CTL, 0, CTL_ZERO_BYTES, stream);
    Args a{};
    for (int i = 0; i < 37; ++i) a.in[i] = (const float*)d_in[i];
    a.out = (float*)d_out; a.ws = (unsigned char*)d_ws;
    hipLaunchKernelGGL(mega_fwd, dim3(grid), dim3(512), LDS_TOTAL, stream, a);
}
```

```cpp
#include <hip/hip_runtime.h>
#include <stdint.h>
#include <stdio.h>

#define LAS __attribute__((address_space(3)))
typedef unsigned short bf16_t;
typedef short bf16x8 __attribute__((ext_vector_type(8)));
typedef short s16x4 __attribute__((ext_vector_type(4)));
typedef float f32x2 __attribute__((ext_vector_type(2)));
typedef float f32x4 __attribute__((ext_vector_type(4)));
typedef float f32x16 __attribute__((ext_vector_type(16)));
typedef unsigned u32x2 __attribute__((ext_vector_type(2)));
typedef unsigned u32x4 __attribute__((ext_vector_type(4)));

constexpr int D = 1024, NB = 8, SEQ = 2048, M = NB * SEQ, INC = 8192, DFF = 2816, NE = 8, DFF2 = 2 * DFF;
constexpr int C_XR = 0, C_GR = 1024, C_DQ = 2048, C_DK = 2560, C_DV = 3072, C_MQ = 3584, C_MK = 4096, C_MV = 4608, C_GB = 5120;
constexpr int YW = 2048, Y_A = 0, Y_B = 1024, Y_C = 1536;
constexpr float EPS = 1e-6f;
constexpr float QSCALE = 0.125f * 1.4426950408889634f;
constexpr int MOE_MAXROWS = 34816, MOE_MAXTILES = MOE_MAXROWS / 256;

__device__ __forceinline__ float bf2f(unsigned v) { return __uint_as_float(v << 16); }
__device__ __forceinline__ unsigned f2bf(float f) { unsigned u = __float_as_uint(f); return (u + 0x7fffu + ((u >> 16) & 1u)) >> 16; }
__device__ __forceinline__ unsigned pk2(float lo, float hi) { unsigned r; asm volatile("v_cvt_pk_bf16_f32 %0, %1, %2" : "=v"(r) : "v"(lo), "v"(hi)); return r; }
__device__ __forceinline__ float fexp2(float x) { return __builtin_amdgcn_exp2f(x); }
__device__ __forceinline__ float frcp(float x) { return __builtin_amdgcn_rcpf(x); }
__device__ __forceinline__ float sigmoid_f(float x) { return frcp(1.0f + fexp2(-1.4426950408889634f * x)); }
__device__ __forceinline__ float gelu_tanh_f(float x) { return x * sigmoid_f(1.5957691216057308f * (x + 0.044715f * x * x * x)); }
__device__ __forceinline__ float silu_f(float x) { return x * sigmoid_f(x); }
__device__ __forceinline__ float wave_sum(float v) {
#pragma unroll
    for (int o = 1; o < 64; o <<= 1) v += __shfl_xor(v, o);
    return v;
}
__device__ __forceinline__ int lane_fresh() { int l; asm volatile("v_mbcnt_lo_u32_b32 %0, -1, 0\n\tv_mbcnt_hi_u32_b32 %0, -1, %0" : "=v"(l)); return l; }
namespace pg8 {
constexpr int BM = 256, BK = 64, HALF = 128, HTB = HALF * BK * 2  , STAGE_BYTES = 8 * HTB, NXCD = 8, WGM = 8;

__host__ __device__ __forceinline__ int lds_byte(int r, int c) { const int st = (r >> 4) * 2 + (c >> 5), rr = r & 15, cc = c & 31, ob = rr * 64 + cc * 2; return st * 1024 + (ob ^ (((ob >> 9) & 1) << 5)); }
__host__ __device__ __forceinline__ void stage_rc(int b, int& R, int& C) { const int st = b / 1024, sb = b % 1024, swz = sb ^ (((sb >> 9) & 1) << 5); R = (st >> 1) * 16 + swz / 64; C = (st & 1) * 32 + (swz % 64) / 2; }
__host__ __device__ __forceinline__ int perm32(int rho) { const int n = rho >> 4, i = rho & 15; return 8 * (i >> 2) + 4 * n + (i & 3); }

struct Unit { int pm, pn, e, aux; };

struct StaticOrder {
    int nM, nN, nwg, G, c;
    __host__ __device__ void init(int M, int N, int G_, int c_) { nM = M / BM; nN = N / BM; nwg = nM * nN; G = G_; c = c_; }
    __device__ __forceinline__ bool next(int i, Unit& u) const {
        const long L = (long)i * G + c; if (L >= nwg) return false;
        int wgid = (int)L; { const int q = nwg / NXCD, r = nwg % NXCD, xcd = wgid % NXCD, off = wgid / NXCD; wgid = (xcd < r ? xcd * (q + 1) : r * (q + 1) + (xcd - r) * q) + off; }
        const int nig = WGM * nN, gid = wgid / nig, fm = gid * WGM, gsz = (nM - fm) < WGM ? (nM - fm) : WGM;
        u.pm = fm + ((wgid % nig) % gsz); u.pn = (wgid % nig) / gsz; u.e = 0; u.aux = 0; return true;
    }
};

struct RotOrder : StaticOrder {
    __device__ __forceinline__ bool next(int i, Unit& u) const { if (!StaticOrder::next(i, u)) return false; u.pn = (u.pn + 4 * i) % nN; return true; }
};

struct DenseProb {
    static constexpr bool GATHER = false;
    const bf16_t* A; const bf16_t* Bt; int K, lda, ldb, pad;
    __device__ __forceinline__ const char* a_base(const Unit& u) const { return (const char*)A + (size_t)u.pm * BM * lda * 2; }
    __device__ __forceinline__ const char* b_base(const Unit& u) const { return (const char*)Bt + (size_t)u.pn * BM * ldb * 2; }
    __device__ __forceinline__ unsigned a_off(const Unit&, int row, int col) const { return (unsigned)(row * lda + col) * 2u; }
};

template <class Prob, class Epi, class Sched, bool ALIGN_EPI = true>
__device__ __forceinline__ void gemm_phase(LAS unsigned char* lds, const Prob& g, const Sched& S, const Epi& E, int wid) {
    const int lane = lane_fresh(), tid = wid * 64 + lane, wr = wid >> 2, wc = wid & 3, fr = lane & 15, fq = lane >> 4;
    const int K = g.K, nt = K / BK;
    int sR[2], sC[2]; unsigned voffB[2];
#pragma unroll
    for (int i = 0; i < 2; ++i) { int R, C; stage_rc(tid * 16 + i * 8192, R, C); sR[i] = R; sC[i] = C; const int Rb = Epi::PERM ? ((R & ~31) + perm32(R & 31)) : R; voffB[i] = (unsigned)(Rb * g.ldb + C) * 2u; }
    const size_t kstep = (size_t)(BK * 2);
    const size_t hstepB = (size_t)HALF * g.ldb * 2;
    const unsigned ldsw = (unsigned)wid * 1024u;
    const int aoff = lds_byte(wr * 64 + fr, fq * 8), boff = lds_byte(wc * 32 + fr, fq * 8);
#define PG8_SA(b, h) (((b) * 2 + (h)) * HTB)
#define PG8_SB(b, h) ((4 + (b) * 2 + (h)) * HTB)
#define PG8_STAGE(bufoff, gbase, voff) do { _Pragma("unroll") for (int _i = 0; _i < 2; ++_i) \
        __builtin_amdgcn_global_load_lds((const unsigned*)((const char*)(gbase) + (voff)[_i]), (LAS unsigned*)(lds + (bufoff) + ldsw + _i * 8192), 16, 0, 0); } while (0)
#define PG8_LDA(dst, b, h) do { _Pragma("unroll") for (int m = 0; m < 4; ++m) _Pragma("unroll") for (int k = 0; k < 2; ++k) dst[m][k] = *(const LAS bf16x8*)(lds + PG8_SA(b, h) + aoff + m * 2048 + k * 1024); } while (0)
#define PG8_LDB(dst, b, h) do { _Pragma("unroll") for (int n = 0; n < 2; ++n) _Pragma("unroll") for (int k = 0; k < 2; ++k) dst[n][k] = *(const LAS bf16x8*)(lds + PG8_SB(b, h) + boff + n * 2048 + k * 1024); } while (0)
#define PG8_MMA(ai, bj, At, Bt) do { __builtin_amdgcn_s_setprio(1); _Pragma("unroll") for (int m = 0; m < 4; ++m) _Pragma("unroll") for (int n = 0; n < 2; ++n) _Pragma("unroll") for (int k = 0; k < 2; ++k) \
        acc[ai][bj][m][n] = __builtin_amdgcn_mfma_f32_16x16x32_bf16(Bt[n][k], At[m][k], acc[ai][bj][m][n], 0, 0, 0); __builtin_amdgcn_s_setprio(0); } while (0)
#define PG8_WAIT_V(n) asm volatile("s_waitcnt vmcnt(" #n ")" ::: "memory")
#define PG8_WAIT_L(n) asm volatile("s_waitcnt lgkmcnt(" #n ")" ::: "memory")
#define PG8_BAR __builtin_amdgcn_s_barrier()
#define PG8_SCHED __builtin_amdgcn_sched_barrier(0)
    Unit cur, nxt; int ui = 0;
    if (!S.next(0, cur)) return;
    f32x4 acc[2][2][4][2];
#pragma unroll
    for (int a = 0; a < 2; ++a)
#pragma unroll
        for (int b = 0; b < 2; ++b)
#pragma unroll
            for (int m = 0; m < 4; ++m)
#pragma unroll
                for (int n = 0; n < 2; ++n) acc[a][b][m][n] = (f32x4){0.f, 0.f, 0.f, 0.f};
    bf16x8 At[4][2], B0[2][2], B1[2][2];
    unsigned vA[2][2], vN[2][2];
#pragma unroll
    for (int h = 0; h < 2; ++h)
#pragma unroll
        for (int i = 0; i < 2; ++i) { vA[h][i] = g.a_off(cur, h * HALF + sR[i], sC[i]); vN[h][i] = vA[h][i]; }
    const char* cA = g.a_base(cur); const char* cB = g.b_base(cur);
    PG8_STAGE(PG8_SB(0, 0), cB, voffB); PG8_STAGE(PG8_SB(0, 1), cB + hstepB, voffB); PG8_STAGE(PG8_SA(0, 0), cA, vA[0]); PG8_STAGE(PG8_SA(0, 1), cA, vA[1]);
    if (wr == 1) PG8_BAR;
    PG8_WAIT_V(2); PG8_BAR;
    PG8_STAGE(PG8_SB(1, 0), cB + kstep, voffB); PG8_STAGE(PG8_SA(1, 0), cA + kstep, vA[0]); PG8_STAGE(PG8_SB(1, 1), cB + hstepB + kstep, voffB);
    PG8_WAIT_V(6); PG8_BAR;
    for (;;) {
        const bool has_next = S.next(ui + 1, nxt);
        const char* nA = has_next ? g.a_base(nxt) : cA; const char* nB = has_next ? g.b_base(nxt) : cB;
        if (Prob::GATHER) {
#pragma unroll
            for (int h = 0; h < 2; ++h)
#pragma unroll
                for (int i = 0; i < 2; ++i) vN[h][i] = has_next ? g.a_off(nxt, h * HALF + sR[i], sC[i]) : vA[h][i];
        }
        for (int t = 0; t < nt; t += 2) {
            const bool last = (t == nt - 2);
            if constexpr (Epi::KHOOK) { if (t == E.kh1 || t == E.kh2) E.khook(acc, cur, t, wr, wc, fr, fq); }
            const char* a1 = cA + (size_t)(t + 1) * kstep;
            const char* a2 = last ? nA : cA + (size_t)(t + 2) * kstep; const char* b2 = last ? nB : cB + (size_t)(t + 2) * kstep;
            const char* a3 = a2 + kstep; const char* b3 = b2 + kstep;
            unsigned v2[2][2];
#pragma unroll
            for (int h = 0; h < 2; ++h)
#pragma unroll
                for (int i = 0; i < 2; ++i) v2[h][i] = (Prob::GATHER && last) ? vN[h][i] : vA[h][i];
            PG8_LDB(B0, 0, 0); PG8_LDB(B1, 0, 1); PG8_SCHED; PG8_LDA(At, 0, 0); PG8_STAGE(PG8_SA(1, 1), a1, vA[1]);
            PG8_WAIT_V(8); PG8_WAIT_L(0); PG8_BAR; PG8_MMA(0, 0, At, B0); PG8_MMA(0, 1, At, B1); PG8_BAR; PG8_SCHED;
            PG8_LDA(At, 0, 1); PG8_STAGE(PG8_SB(0, 0), b2, voffB); PG8_STAGE(PG8_SB(0, 1), b2 + hstepB, voffB); PG8_STAGE(PG8_SA(0, 0), a2, v2[0]);
            PG8_WAIT_V(8); PG8_WAIT_L(0); PG8_BAR; PG8_MMA(1, 0, At, B0); PG8_MMA(1, 1, At, B1); PG8_BAR; PG8_SCHED;
            PG8_LDB(B0, 1, 0); PG8_LDB(B1, 1, 1); PG8_SCHED; PG8_LDA(At, 1, 0); PG8_STAGE(PG8_SA(0, 1), a2, v2[1]);
            PG8_WAIT_V(8); PG8_WAIT_L(0); PG8_BAR; PG8_MMA(0, 0, At, B0); PG8_MMA(0, 1, At, B1); PG8_BAR; PG8_SCHED;
            PG8_LDA(At, 1, 1); PG8_STAGE(PG8_SB(1, 0), b3, voffB); PG8_STAGE(PG8_SB(1, 1), b3 + hstepB, voffB); PG8_STAGE(PG8_SA(1, 0), a3, v2[0]);
            PG8_WAIT_V(8); PG8_WAIT_L(0); PG8_BAR; PG8_MMA(1, 0, At, B0); PG8_MMA(1, 1, At, B1); PG8_BAR; PG8_SCHED;
        }
        if constexpr (ALIGN_EPI) { if (wr == 0) PG8_BAR; }
        E(acc, cur, wr, wc, fr, fq);
        if (!has_next) break;
#pragma unroll
        for (int a = 0; a < 2; ++a)
#pragma unroll
            for (int b = 0; b < 2; ++b)
#pragma unroll
                for (int m = 0; m < 4; ++m)
#pragma unroll
                    for (int n = 0; n < 2; ++n) acc[a][b][m][n] = (f32x4){0.f, 0.f, 0.f, 0.f};
        cur = nxt; cA = nA; cB = nB; ++ui;
        if (Prob::GATHER) {
#pragma unroll
            for (int h = 0; h < 2; ++h)
#pragma unroll
                for (int i = 0; i < 2; ++i) vA[h][i] = vN[h][i];
        }
        if constexpr (ALIGN_EPI) { if (wr == 1) PG8_BAR; }
    }
    PG8_WAIT_V(0);
    if constexpr (!ALIGN_EPI) { if (wr == 0) PG8_BAR; }
    PG8_BAR;
#undef PG8_SA
#undef PG8_SB
#undef PG8_STAGE
#undef PG8_LDA
#undef PG8_LDB
#undef PG8_MMA
#undef PG8_WAIT_V
#undef PG8_WAIT_L
#undef PG8_BAR
#undef PG8_SCHED
}
}
namespace epi {
using pg8::Unit; using pg8::BM; using pg8::HALF;
typedef const f32x4 (&AccRef)[2][2][4][2];

struct Proj {
    static constexpr bool PERM = true, KHOOK = false;
    bf16_t* O; const float* gate_b;
    __device__ __forceinline__ void operator()(AccRef acc, const Unit& u, int wr, int wc, int fr, int fq) const {
        const int row0 = u.pm * BM + wr * 64 + fr, col0 = u.pn * BM + wc * 32 + 8 * fq;
        const int mode = (u.pn >= 20) ? 2 : ((u.pn >= 4 && u.pn < 8) ? 1 : 0);
        f32x4 bv[2][2];
#pragma unroll
        for (int bj = 0; bj < 2; ++bj)
#pragma unroll
            for (int n = 0; n < 2; ++n) bv[bj][n] = (mode == 2) ? *(const f32x4*)(gate_b + (col0 - C_GB) + bj * HALF + 4 * n) : (f32x4){0.f, 0.f, 0.f, 0.f};
#pragma unroll
        for (int ai = 0; ai < 2; ++ai)
#pragma unroll
            for (int m = 0; m < 4; ++m) { bf16_t* rowp = O + (size_t)(row0 + ai * HALF + m * 16) * INC + col0;
#pragma unroll
                for (int bj = 0; bj < 2; ++bj) { f32x4 v0 = acc[ai][bj][m][0] + bv[bj][0], v1 = acc[ai][bj][m][1] + bv[bj][1];
                    if (mode == 1) {
#pragma unroll
                        for (int j = 0; j < 4; ++j) { v0[j] = gelu_tanh_f(v0[j]); v1[j] = gelu_tanh_f(v1[j]); } }
                    if (mode == 2) {
#pragma unroll
                        for (int j = 0; j < 4; ++j) { v0[j] = sigmoid_f(v0[j]); v1[j] = sigmoid_f(v1[j]); } }
                    u32x4 w; w.x = pk2(v0[0], v0[1]); w.y = pk2(v0[2], v0[3]); w.z = pk2(v1[0], v1[1]); w.w = pk2(v1[2], v1[3]);
                    *(u32x4*)(rowp + bj * HALF) = w; } }
    }
};

template <int STEP> struct Branch {
    static constexpr bool PERM = false, KHOOK = false;
    const bf16_t* proj; float* P; bf16_t* merged;
    __device__ __forceinline__ void operator()(AccRef acc, const Unit& u, int wr, int wc, int fr, int fq) const {
        const int row0 = u.pm * BM + wr * 64 + fr, col0 = u.pn * BM + wc * 32 + 4 * fq;
#pragma unroll
        for (int ai = 0; ai < 2; ++ai)
#pragma unroll
            for (int m = 0; m < 4; ++m) { const size_t row = (size_t)(row0 + ai * HALF + m * 16);
#pragma unroll
                for (int bj = 0; bj < 2; ++bj)
#pragma unroll
                    for (int n = 0; n < 2; ++n) { const int col = col0 + bj * HALF + n * 16;
                        const u32x2 gw = *(const u32x2*)(proj + row * INC + C_GB + STEP * 1024 + col);
                        const f32x4 gv = {bf2f(gw.x & 0xffffu), bf2f(gw.x >> 16), bf2f(gw.y & 0xffffu), bf2f(gw.y >> 16)};
                        f32x4 v = acc[ai][bj][m][n] * gv;
                        float* pp = P + row * D + col;
                        if (STEP >= 1) v += *(const f32x4*)pp;
                        if (STEP <= 1) *(f32x4*)pp = v;
                        else { u32x2 w; w.x = pk2(v[0], v[1]); w.y = pk2(v[2], v[3]); *(u32x2*)(merged + row * D + col) = w; } } }
    }
};

struct Resid {
    static constexpr bool PERM = false, KHOOK = false;
    const float* base; float* out; const float* gate;
    __device__ __forceinline__ void operator()(AccRef acc, const Unit& u, int wr, int wc, int fr, int fq) const {
        const int row0 = u.pm * BM + wr * 64 + fr, col0 = u.pn * BM + wc * 32 + 4 * fq;
        const float* gp = gate + (size_t)((u.pm * BM) / SEQ) * (6 * D) + col0;
        f32x4 gv[2][2];
#pragma unroll
        for (int bj = 0; bj < 2; ++bj)
#pragma unroll
            for (int n = 0; n < 2; ++n) gv[bj][n] = *(const f32x4*)(gp + bj * HALF + n * 16);
#pragma unroll
        for (int ai = 0; ai < 2; ++ai)
#pragma unroll
            for (int m = 0; m < 4; ++m) { const size_t off = (size_t)(row0 + ai * HALF + m * 16) * D + col0;
#pragma unroll
                for (int bj = 0; bj < 2; ++bj)
#pragma unroll
                    for (int n = 0; n < 2; ++n) { const f32x4 bs = *(const f32x4*)(base + off + bj * HALF + n * 16);
                        *(f32x4*)(out + off + bj * HALF + n * 16) = bs + gv[bj][n] * acc[ai][bj][m][n]; } }
    }
};

struct SwiGLU {
    static constexpr bool PERM = true, KHOOK = false;
    bf16_t* O;
    __device__ __forceinline__ void operator()(AccRef acc, const Unit& u, int wr, int wc, int fr, int fq) const {
        const int row0 = u.pm * BM + wr * 64 + fr, col0 = u.pn * HALF + wc * 32 + 8 * fq;
#pragma unroll
        for (int ai = 0; ai < 2; ++ai)
#pragma unroll
            for (int m = 0; m < 4; ++m) { bf16_t* rowp = O + (size_t)(row0 + ai * HALF + m * 16) * DFF + col0;
                f32x4 v0, v1;
#pragma unroll
                for (int j = 0; j < 4; ++j) { v0[j] = silu_f(acc[ai][0][m][0][j]) * acc[ai][1][m][0][j]; v1[j] = silu_f(acc[ai][0][m][1][j]) * acc[ai][1][m][1][j]; }
                u32x4 w; w.x = pk2(v0[0], v0[1]); w.y = pk2(v0[2], v0[3]); w.z = pk2(v1[0], v1[1]); w.w = pk2(v1[2], v1[3]);
                *(u32x4*)rowp = w; }
    }
};

struct MoeDown {
    static constexpr bool PERM = false, KHOOK = false;
    const int* rowdst; const float* roww; bf16_t* yslot;
    __device__ __forceinline__ void operator()(AccRef acc, const Unit& u, int wr, int wc, int fr, int fq) const {
        const int row0 = u.pm * BM + wr * 64 + fr, col0 = u.pn * BM + wc * 32 + 4 * fq;
#pragma unroll
        for (int ai = 0; ai < 2; ++ai)
#pragma unroll
            for (int m = 0; m < 4; ++m) { const int p = row0 + ai * HALF + m * 16; const int dst = rowdst[p]; const float w = roww[p];
                if (dst >= 0) { bf16_t* rowp = yslot + (size_t)dst * D + col0;
#pragma unroll
                    for (int bj = 0; bj < 2; ++bj)
#pragma unroll
                        for (int n = 0; n < 2; ++n) { const f32x4 v = acc[ai][bj][m][n] * w; u32x2 o; o.x = pk2(v[0], v[1]); o.y = pk2(v[2], v[3]); *(u32x2*)(rowp + bj * HALF + n * 16) = o; } } }
    }
};

struct BranchMerge {
    static constexpr bool PERM = true, KHOOK = true;
    const bf16_t* proj; bf16_t* merged; int kh1, kh2;
    typedef f32x4 (&AccMut)[2][2][4][2];
    __device__ __forceinline__ static void unpack8(const u32x4 w, float (&f)[8]) {
        f[0] = bf2f(w.x & 0xffffu); f[1] = bf2f(w.x >> 16); f[2] = bf2f(w.y & 0xffffu); f[3] = bf2f(w.y >> 16); f[4] = bf2f(w.z & 0xffffu); f[5] = bf2f(w.z >> 16); f[6] = bf2f(w.w & 0xffffu); f[7] = bf2f(w.w >> 16); }
    __device__ __forceinline__ void khook(AccMut acc, const Unit& u, int t, int wr, int wc, int fr, int fq) const {
        const int gi = (t == kh1) ? 0 : 1;
        const unsigned off0 = (unsigned)(((u.pm * BM + wr * 64 + fr) * INC + C_GB + gi * 1024 + u.pn * BM + wc * 32 + 8 * fq) * 2);
        const char* pb = (const char*)proj;
#pragma unroll
        for (int ai = 0; ai < 2; ++ai) {
            u32x4 rn[4][2], rd[4][2];
#pragma unroll
            for (int m = 0; m < 4; ++m) { const unsigned off = off0 + (unsigned)((ai * HALF + m * 16) * INC * 2);
#pragma unroll
                for (int bj = 0; bj < 2; ++bj) { rn[m][bj] = *(const u32x4*)(pb + (size_t)(off + bj * HALF * 2)); rd[m][bj] = *(const u32x4*)(pb + (size_t)(off + 2048 + bj * HALF * 2)); } }
#pragma unroll
            for (int m = 0; m < 4; ++m)
#pragma unroll
                for (int bj = 0; bj < 2; ++bj) { float gn[8], gd[8]; unpack8(rn[m][bj], gn); unpack8(rd[m][bj], gd);
#pragma unroll
                    for (int j = 0; j < 4; ++j) { acc[ai][bj][m][0][j] *= gn[j] * frcp(fmaxf(gd[j], 1e-30f)); acc[ai][bj][m][1][j] *= gn[4 + j] * frcp(fmaxf(gd[4 + j], 1e-30f)); } }
            asm volatile("" ::: "memory");
        }
    }
    __device__ __forceinline__ void operator()(AccRef acc, const Unit& u, int wr, int wc, int fr, int fq) const {
        const int row0 = u.pm * BM + wr * 64 + fr, col0 = u.pn * BM + wc * 32 + 8 * fq;
#pragma unroll
        for (int ai = 0; ai < 2; ++ai)
#pragma unroll
            for (int m = 0; m < 4; ++m) { const size_t row = (size_t)(row0 + ai * HALF + m * 16);
#pragma unroll
                for (int bj = 0; bj < 2; ++bj) { float g2[8]; unpack8(*(const u32x4*)(proj + row * INC + C_GB + 2048 + col0 + bj * HALF), g2);
                    const f32x4 v0 = acc[ai][bj][m][0], v1 = acc[ai][bj][m][1];
                    u32x4 w; w.x = pk2(v0[0] * g2[0], v0[1] * g2[1]); w.y = pk2(v0[2] * g2[2], v0[3] * g2[3]); w.z = pk2(v1[0] * g2[4], v1[1] * g2[5]); w.w = pk2(v1[2] * g2[6], v1[3] * g2[7]);
                    *(u32x4*)(merged + row * D + col0 + bj * HALF) = w; } }
    }
};
}
namespace attn {
constexpr int NSLOT = 4, SLOT_K = 8192, SLOT128 = SLOT_K + 16384, SLOT64 = SLOT_K + 8192, LDS_BYTES = NSLOT * SLOT128;
constexpr float NEGF = -1e30f;
__device__ __forceinline__ int crow(int r, int hi) { return (r & 3) + 8 * (r >> 2) + 4 * hi; }
__device__ __forceinline__ float swapmax(float m) { auto rr = __builtin_amdgcn_permlane32_swap(__float_as_uint(m), __float_as_uint(m), false, false); return fmaxf(__uint_as_float(rr[0]), __uint_as_float(rr[1])); }
__device__ __forceinline__ float swapsum(float m) { auto rr = __builtin_amdgcn_permlane32_swap(__float_as_uint(m), __float_as_uint(m), false, false); return __uint_as_float(rr[0]) + __uint_as_float(rr[1]); }
typedef short v4i16_t __attribute__((ext_vector_type(4)));
__device__ __forceinline__ s16x4 vtr(const LAS char* p) { return __builtin_bit_cast(s16x4, __builtin_amdgcn_ds_read_tr16_b64_v4i16((LAS v4i16_t*)p)); }

__device__ __forceinline__ void qk_tile(f32x16& sA, f32x16& sB, const LAS char* Kt, const bf16x8 (&qf)[4], int r, int h, float noff) {
    const LAS char* kb = Kt + h * 1024 + r * 16;
#pragma unroll
    for (int j = 0; j < 16; ++j) { sA[j] = noff; sB[j] = noff; }
    bf16x8 kf[8];
#pragma unroll
    for (int ks = 0; ks < 4; ++ks) { kf[2 * ks] = *(const LAS bf16x8*)(kb + ks * 2048); kf[2 * ks + 1] = *(const LAS bf16x8*)(kb + ks * 2048 + 512); }
    __builtin_amdgcn_sched_barrier(0);
#pragma unroll
    for (int ks = 0; ks < 4; ++ks) {
        sA = __builtin_amdgcn_mfma_f32_32x32x16_bf16(kf[2 * ks], qf[ks], sA, 0, 0, 0);
        sB = __builtin_amdgcn_mfma_f32_32x32x16_bf16(kf[2 * ks + 1], qf[ks], sB, 0, 0, 0);
    }
}
template <int NDB>
__device__ __forceinline__ void pv_tile(f32x16 (&o)[NDB], const LAS char* Vt, const bf16x8 (&pf)[4], int lane) {
    const int h = lane >> 5, q = (lane & 15) >> 2, p = lane & 3, g1 = (lane >> 4) & 1;
    const LAS char* vb = Vt + (4 * h + q) * 64 + (16 * g1 + 4 * p) * 2;
#pragma unroll
    for (int kb = 0; kb < 2; ++kb) {
        bf16x8 vf[2][NDB];
#pragma unroll
        for (int s = 0; s < 2; ++s)
#pragma unroll
            for (int db = 0; db < NDB; ++db) { const int r0 = kb * 32 + 16 * s;
                const s16x4 lo = vtr(vb + r0 * 64 + db * 4096), hi = vtr(vb + (r0 + 8) * 64 + db * 4096);
                vf[s][db] = (bf16x8){lo[0], lo[1], lo[2], lo[3], hi[0], hi[1], hi[2], hi[3]}; }
        __builtin_amdgcn_sched_barrier(0);
#pragma unroll
        for (int s = 0; s < 2; ++s)
#pragma unroll
            for (int db = 0; db < NDB; ++db) o[db] = __builtin_amdgcn_mfma_f32_32x32x16_bf16(pf[kb * 2 + s], vf[s][db], o[db], 0, 0, 0);
    }
}
template <int NDB>
__device__ __forceinline__ void softmax_pv(f32x16& sA, f32x16& sB, f32x16 (&o)[NDB], float& lsum, const LAS char* Vt, int lane) {
    float rs0 = 0.f, rs1 = 0.f;
#pragma unroll
    for (int j = 0; j < 16; ++j) { sA[j] = fexp2(sA[j]); sB[j] = fexp2(sB[j]); rs0 += sA[j]; rs1 += sB[j]; }
    lsum += rs0 + rs1;
    bf16x8 pf[4];
    { u32x4 w;
      w.x = pk2(sA[0], sA[1]); w.y = pk2(sA[2], sA[3]); w.z = pk2(sA[4], sA[5]); w.w = pk2(sA[6], sA[7]); pf[0] = __builtin_bit_cast(bf16x8, w);
      w.x = pk2(sA[8], sA[9]); w.y = pk2(sA[10], sA[11]); w.z = pk2(sA[12], sA[13]); w.w = pk2(sA[14], sA[15]); pf[1] = __builtin_bit_cast(bf16x8, w);
      w.x = pk2(sB[0], sB[1]); w.y = pk2(sB[2], sB[3]); w.z = pk2(sB[4], sB[5]); w.w = pk2(sB[6], sB[7]); pf[2] = __builtin_bit_cast(bf16x8, w);
      w.x = pk2(sB[8], sB[9]); w.y = pk2(sB[10], sB[11]); w.z = pk2(sB[12], sB[13]); w.w = pk2(sB[14], sB[15]); pf[3] = __builtin_bit_cast(bf16x8, w); }
    pv_tile<NDB>(o, Vt, pf, lane);
}
__device__ __forceinline__ float score_shift(const float* gq, const float* gk, int lane) {
    float mq = fabsf(gq[lane]), mk = fabsf(gk[lane]);
#pragma unroll
    for (int o = 1; o < 64; o <<= 1) { mq = fmaxf(mq, __shfl_xor(mq, o)); mk = fmaxf(mk, __shfl_xor(mk, o)); }
    const float bound = QSCALE * 64.0f * mq * mk;
    return -fmaxf(0.f, bound - 24.0f);
}

template <int DV>
__device__ __forceinline__ void dma_tile(const bf16_t* Kg, const bf16_t* Vg, int key0, LAS char* slot, int wid, int lane) {
    __builtin_amdgcn_global_load_lds((const unsigned*)(Kg + (size_t)(key0 + lane) * INC + wid * 8), (LAS unsigned*)(slot + wid * 1024), 16, 0, 0);
#pragma unroll
    for (int i = 0; i < DV / 64; ++i) { const int p = wid + 8 * i, db = p >> 2, rg = p & 3;
        __builtin_amdgcn_global_load_lds((const unsigned*)(Vg + (size_t)(key0 + 16 * rg + (lane >> 2)) * INC + db * 32 + (lane & 3) * 8), (LAS unsigned*)(slot + SLOT_K + p * 1024), 16, 0, 0); }
}
template <int OPS> __device__ __forceinline__ void ring_wait(int ahead) {
    if (ahead >= 2) asm volatile("s_waitcnt vmcnt(%0) lgkmcnt(0)\n\ts_barrier" :: "n"(2 * OPS) : "memory");
    else if (ahead == 1) asm volatile("s_waitcnt vmcnt(%0) lgkmcnt(0)\n\ts_barrier" :: "n"(OPS) : "memory");
    else asm volatile("s_waitcnt vmcnt(0) lgkmcnt(0)\n\ts_barrier" ::: "memory");
}
template <int DV>
__device__ __forceinline__ void causal_pass(f32x16 (&o)[DV / 32], float& lsum, const bf16x8 (&qf)[4], const bf16_t* Kg, const bf16_t* Vg,
                                            int ntiles, int qw0, float noff, LAS char* lds, int tid) {
    constexpr int SLOT = SLOT_K + DV * 128, OPS = 1 + DV / 64;
    const int lane = tid & 63, r = lane & 31, h = lane >> 5, wid = __builtin_amdgcn_readfirstlane(tid >> 6);
    asm volatile("s_waitcnt vmcnt(0) lgkmcnt(0)\n\ts_barrier" ::: "memory");
#pragma unroll
    for (int t = 0; t < 3; ++t) if (t < ntiles) dma_tile<DV>(Kg, Vg, t * 64, lds + t * SLOT, wid, lane);
    __builtin_amdgcn_s_waitcnt(0);
    for (int t = 0; t < ntiles; ++t) {
        ring_wait<OPS>(ntiles - 1 - t);
        if (t + 3 < ntiles) dma_tile<DV>(Kg, Vg, (t + 3) * 64, lds + ((t + 3) & 3) * SLOT, wid, lane);
        const LAS char* slot = lds + (t & 3) * SLOT;
        const int key0 = t * 64;
        if (key0 <= qw0 + 31) {
            f32x16 sA, sB;
            qk_tile(sA, sB, slot, qf, r, h, noff);
            if (key0 + 63 > qw0) {
                const int qpos = qw0 + r;
#pragma unroll
                for (int j = 0; j < 16; ++j) { const int kp = key0 + crow(j, h); if (kp > qpos) sA[j] = NEGF; if (kp + 32 > qpos) sB[j] = NEGF; }
            }
            softmax_pv<DV / 32>(sA, sB, o, lsum, slot + SLOT_K, lane);
        }
    }
}

__device__ __forceinline__ void diff_unit(int b, int hd, int qt, const bf16_t* proj, bf16_t* yabc, const float* subln, float lam, float one_m_laminit, float noff, LAS char* lds, int wid) {
    const int lane = lane_fresh(), tid = wid * 64 + lane, r = lane & 31, h = lane >> 5;
    const int qw0 = qt * 256 + wid * 32;
    const size_t rowb = (size_t)b * SEQ;
    const int ntiles = 4 * (qt + 1);
    unsigned o0p[4][8];
#pragma unroll
    for (int j = 0; j < 2; ++j) {
        const bf16_t* qp = proj + (rowb + qw0 + r) * INC + C_DQ + (hd * 2 + j) * 64 + h * 8;
        bf16x8 qf[4];
#pragma unroll
        for (int ks = 0; ks < 4; ++ks) qf[ks] = *(const bf16x8*)(qp + ks * 16);
        f32x16 o[4];
#pragma unroll
        for (int db = 0; db < 4; ++db)
#pragma unroll
            for (int i = 0; i < 16; ++i) o[db][i] = 0.f;
        float lsum = 0.f;
        causal_pass<128>(o, lsum, qf, proj + rowb * INC + C_DK + (hd * 2 + j) * 64, proj + rowb * INC + C_DV + hd * 128, ntiles, qw0, noff, lds, tid);
        const float il = frcp(swapsum(lsum));
        if (j == 0) {
#pragma unroll
            for (int i = 0; i < 16; i += 2) { const float a0 = __shfl(il, crow(i, h)), a1 = __shfl(il, crow(i + 1, h));
#pragma unroll
                for (int db = 0; db < 4; ++db) o0p[db][i >> 1] = pk2(o[db][i] * a0, o[db][i + 1] * a1); }
        } else {
#pragma unroll
            for (int i = 0; i < 16; ++i) { const float a = __shfl(il, crow(i, h)) * lam;
                float ss = 0.f; float cv[4];
#pragma unroll
                for (int db = 0; db < 4; ++db) { const unsigned w = o0p[db][i >> 1]; const float x0 = (i & 1) ? bf2f(w >> 16) : bf2f(w & 0xffffu); const float c = x0 - o[db][i] * a; cv[db] = c; ss += c * c; }
                ss += __shfl_xor(ss, 1); ss += __shfl_xor(ss, 2); ss += __shfl_xor(ss, 4); ss += __shfl_xor(ss, 8); ss += __shfl_xor(ss, 16);
                const float rn = rsqrtf(ss * (1.0f / 128.0f) + EPS) * one_m_laminit;
                bf16_t* yp = yabc + (rowb + qw0 + crow(i, h)) * YW + Y_B + hd * 128 + r;
#pragma unroll
                for (int db = 0; db < 4; ++db) yp[db * 32] = (bf16_t)f2bf(cv[db] * rn * subln[db * 32 + r]);
            }
        }
    }
}

__device__ __forceinline__ void moba_unit(int b, int hd, int cur, const bf16_t* proj, bf16_t* yabc, const float* kmean, float noff, LAS char* lds, int wid) {
    const int lane = lane_fresh(), tid = wid * 64 + lane, r = lane & 31, h = lane >> 5;
    const int qw0 = cur * 256 + wid * 32;
    const size_t rowb = (size_t)b * SEQ;
    const bf16_t* qp = proj + (rowb + qw0 + r) * INC + C_MQ + hd * 64 + h * 8;
    bf16x8 qf[4];
#pragma unroll
    for (int ks = 0; ks < 4; ++ks) qf[ks] = *(const bf16x8*)(qp + ks * 16);
    unsigned selmask = 0u;
    if (cur > 0) {
        float gate[8];
#pragma unroll
        for (int n = 0; n < 8; ++n) {
            float g = 0.f;
            if (n < cur) {
                const float* km = kmean + ((size_t)((b * 8 + hd) * 8 + n)) * 64 + h * 8;
#pragma unroll
                for (int ks = 0; ks < 4; ++ks)
#pragma unroll
                    for (int j = 0; j < 8; ++j) g += bf2f((unsigned)(unsigned short)qf[ks][j]) * km[ks * 16 + j];
                g = swapsum(g);
            } else g = -3.0e38f;
            gate[n] = g;
        }
        const int nsel = cur < 3 ? cur : 3;
        for (int s = 0; s < nsel; ++s) {
            float best = -3.0e38f; int bi = 0;
#pragma unroll
            for (int n = 0; n < 8; ++n) { const bool tk = (n < cur) && !((selmask >> n) & 1u) && (gate[n] > best); if (tk) { best = gate[n]; bi = n; } }
            selmask |= 1u << bi;
        }
    }
    f32x16 o[2];
#pragma unroll
    for (int db = 0; db < 2; ++db)
#pragma unroll
        for (int i = 0; i < 16; ++i) o[db][i] = 0.f;
    float lsum = 0.f;
    const bf16_t* Kg = proj + rowb * INC + C_MK + hd * 64; const bf16_t* Vg = proj + rowb * INC + C_MV + hd * 64;
    const int ntiles = 4 * (cur + 1);
#define MOBA_KEY0(T) ((((T) < 4) ? cur : (((T) >> 2) - 1)) * 256 + ((T) & 3) * 64)
    const int widu = wid;
    asm volatile("s_waitcnt vmcnt(0) lgkmcnt(0)\n\ts_barrier" ::: "memory");
#pragma unroll
    for (int t = 0; t < 3; ++t) dma_tile<64>(Kg, Vg, MOBA_KEY0(t), lds + t * SLOT64, widu, lane);
    __builtin_amdgcn_s_waitcnt(0);
    for (int t = 0; t < ntiles; ++t) {
        ring_wait<2>(ntiles - 1 - t);
        if (t + 3 < ntiles) dma_tile<64>(Kg, Vg, MOBA_KEY0(t + 3), lds + ((t + 3) & 3) * SLOT64, widu, lane);
        const LAS char* slot = lds + (t & 3) * SLOT64;
        const int blk = (t < 4) ? cur : (t >> 2) - 1;
        const int key0 = blk * 256 + (t & 3) * 64;
        const bool own = (t < 4);
        const bool lane_on = own ? true : (((selmask >> blk) & 1u) != 0u);
        const bool wave_on = own ? (key0 <= qw0 + 31) : (__any(lane_on) != 0);
        if (wave_on) {
            f32x16 sA, sB;
            qk_tile(sA, sB, slot, qf, r, h, noff);
            if (own) {
                if (key0 + 63 > qw0) {
                    const int qpos = qw0 + r;
#pragma unroll
                    for (int j = 0; j < 16; ++j) { const int kp = key0 + crow(j, h); if (kp > qpos) sA[j] = NEGF; if (kp + 32 > qpos) sB[j] = NEGF; }
                }
            } else if (!lane_on) {
#pragma unroll
                for (int j = 0; j < 16; ++j) { sA[j] = NEGF; sB[j] = NEGF; }
            }
            softmax_pv<2>(sA, sB, o, lsum, slot + SLOT_K, lane);
        }
    }
#undef MOBA_KEY0
    const float il = frcp(swapsum(lsum));
#pragma unroll
    for (int i = 0; i < 16; ++i) { const float a = __shfl(il, crow(i, h));
        bf16_t* yp = yabc + (rowb + qw0 + crow(i, h)) * YW + Y_C + hd * 64 + r;
#pragma unroll
        for (int db = 0; db < 2; ++db) yp[db * 32] = (bf16_t)f2bf(o[db][i] * a); }
}
}
namespace thin {
struct TItem { f32x4 v[8][2]; };
__device__ __forceinline__ void titem_load(TItem& it, const float* W, int N, int item, int lane) {
    const int nblk = N >> 6, kb = item / nblk, nb = item - kb * nblk;
    const float* p = W + (size_t)(kb * 64 + 2 * (lane >> 4)) * N + nb * 64 + 4 * (lane & 15);
#pragma unroll
    for (int i = 0; i < 8; ++i) { it.v[i][0] = *(const f32x4*)(p + (size_t)(8 * i) * N); it.v[i][1] = *(const f32x4*)(p + (size_t)(8 * i + 1) * N); }
}
__device__ __forceinline__ void titem_store(const TItem& it, int N, bf16_t* WT, int ldk, int coff, int row_off, int mode, LAS unsigned* T, int item, int lane) {
    const int nblk = N >> 6, kb = item / nblk, nb = item - kb * nblk, k0 = kb * 64, n0 = nb * 64;
    const int kp = lane >> 4, np = lane & 15;
#pragma unroll
    for (int i = 0; i < 8; ++i) { const int col = (kp + 4 * i) ^ ((np & 7) << 2);
#pragma unroll
        for (int j = 0; j < 4; ++j) T[(4 * np + j) * 32 + col] = pk2(it.v[i][0][j], it.v[i][1][j]); }
    asm volatile("s_waitcnt lgkmcnt(0)" ::: "memory");
    const int c = lane & 7;
#pragma unroll
    for (int j = 0; j < 8; ++j) { const int n = (lane >> 3) + 8 * j;
        const u32x4 o = *(const LAS u32x4*)(T + n * 32 + 4 * (c ^ ((n >> 2) & 7)));
        const int nn = n0 + n; const int row = row_off + (mode == 0 ? nn : ((nn >> 7) * 256 + (mode == 2 ? 128 : 0) + (nn & 127)));
        const bf16_t* dstp = WT + (size_t)row * ldk + coff + k0 + 8 * c;
        asm volatile("global_store_dwordx4 %0, %1, off\n\ts_nop 2" :: "v"(dstp), "v"(o) : "memory"); }
    asm volatile("s_waitcnt lgkmcnt(0)" ::: "memory");
}
__device__ __forceinline__ void transpose_matrix(const float* W, int K, int N, bf16_t* WT, int ldk, int coff, int row_off, int mode, LAS float* scr, int gw, int ngw, int lane) {
    const int nitems = (K >> 6) * (N >> 6);
    LAS unsigned* T = (LAS unsigned*)scr;
    TItem cur;
    int it = gw;
    if (it < nitems) titem_load(cur, W, N, it, lane);
    while (it < nitems) {
        const int nx = it + ngw;
        TItem nxt;
        if (nx < nitems) titem_load(nxt, W, N, nx, lane);
        titem_store(cur, N, WT, ldk, coff, row_off, mode, T, it, lane);
        cur = nxt; it = nx;
    }
}

__device__ __forceinline__ void mod_body(const float* c, const float* ada_w, const float* ada_b, float* mod, int bid, int G, int tid, LAS float* red) {
    for (int cb = bid; cb < (2 * 6 * D) / 48; cb += G) {
        const int kg = tid / 48, jj = tid - kg * 48;
        const int idx = cb * 48 + jj, l = idx / (6 * D), j = idx - l * (6 * D);
        float acc[NB];
#pragma unroll
        for (int b = 0; b < NB; ++b) acc[b] = 0.f;
        if (kg < 8) {
            const float* w = ada_w + (size_t)l * D * 6 * D + (size_t)(kg * 128) * 6 * D + j;
#pragma unroll 4
            for (int k = 0; k < 128; ++k) { const float wv = w[(size_t)k * 6 * D];
#pragma unroll
                for (int b = 0; b < NB; ++b) acc[b] += c[b * D + kg * 128 + k] * wv; }
#pragma unroll
            for (int b = 0; b < NB; ++b) red[(kg * 48 + jj) * NB + b] = acc[b];
        }
        __syncthreads();
        if (tid < 48 * NB) { const int j2 = tid >> 3, b = tid & 7; float s = 0.f;
#pragma unroll
            for (int g = 0; g < 8; ++g) s += red[(g * 48 + j2) * NB + b];
            const int idx2 = cb * 48 + j2, l2 = idx2 / (6 * D), jo = idx2 - l2 * (6 * D);
            mod[((size_t)l2 * NB + b) * 6 * D + jo] = s + ada_b[l2 * 6 * D + jo]; }
        __syncthreads();
    }
}
__device__ __forceinline__ void rope_body(const int* positions, f32x2* cs, int gtid, int ngt) {
    for (int idx = gtid; idx < M * 32; idx += ngt) {
        const int tok = idx >> 5, i = idx & 31;
        const float inv = 1.0f / powf(10000.0f, (float)(2 * i) / 64.0f);
        const float ang = (float)positions[tok] * inv;
        float s, c; sincosf(ang, &s, &c);
        cs[idx] = (f32x2){c, s};
    }
}
template <int R>
__device__ __forceinline__ void norm_rows(const float* xrow, const float* g, const float* shift, const float* scale, bf16_t* orow, int lane, f32x4 (&y)[R][4]) {
    f32x4 v[R][4]; float ss[R];
#pragma unroll
    for (int r = 0; r < R; ++r) { const f32x4* xr = (const f32x4*)(xrow + (size_t)r * D) + lane;
#pragma unroll
        for (int j = 0; j < 4; ++j) v[r][j] = xr[64 * j]; }
#pragma unroll
    for (int r = 0; r < R; ++r) { float s = 0.f;
#pragma unroll
        for (int j = 0; j < 4; ++j) s += (v[r][j].x * v[r][j].x + v[r][j].y * v[r][j].y) + (v[r][j].z * v[r][j].z + v[r][j].w * v[r][j].w);
        ss[r] = s; }
#pragma unroll
    for (int o = 1; o < 64; o <<= 1) {
#pragma unroll
        for (int r = 0; r < R; ++r) ss[r] += __shfl_xor(ss[r], o); }
#pragma unroll
    for (int j = 0; j < 4; ++j) { const int col = 4 * lane + 256 * j;
        const f32x4 gg = *(const f32x4*)(g + col), sc = *(const f32x4*)(scale + col), sh = *(const f32x4*)(shift + col);
        const f32x4 gs = gg * (sc + 1.0f);
#pragma unroll
        for (int r = 0; r < R; ++r) { const float rn = rsqrtf(ss[r] * (1.0f / D) + EPS);
            y[r][j] = v[r][j] * rn * gs + sh;
            u32x2 w; w.x = pk2(y[r][j].x, y[r][j].y); w.y = pk2(y[r][j].z, y[r][j].w); ((u32x2*)(orow + (size_t)r * D) + lane)[64 * j] = w; } }
}
__device__ __forceinline__ void norm_body(const float* x, const float* g, const float* shift, const float* scale, bf16_t* out, int gw, int ngw, int lane) {
    for (int m = gw * 4; m < M; m += ngw * 4) { const int b = m / SEQ; f32x4 y[4][4]; norm_rows<4>(x + (size_t)m * D, g, shift + b * 6 * D, scale + b * 6 * D, out + (size_t)m * D, lane, y); }
}
__device__ __forceinline__ void norm_router_body(const float* x, const float* g, const float* shift, const float* scale, bf16_t* out,
                                                 const float* rw, const float* rb, int* topi, float* topw, int gw, int ngw, int lane) {
    for (int m0 = gw * 2; m0 < M; m0 += ngw * 2) { const int b = m0 / SEQ; f32x4 y[2][4];
        norm_rows<2>(x + (size_t)m0 * D, g, shift + b * 6 * D, scale + b * 6 * D, out + (size_t)m0 * D, lane, y);
        float lg[2][NE];
#pragma unroll
        for (int r = 0; r < 2; ++r)
#pragma unroll
            for (int e = 0; e < NE; ++e) lg[r][e] = 0.f;
#pragma unroll
        for (int j = 0; j < 4; ++j)
#pragma unroll
            for (int q = 0; q < 4; ++q) { const int col = 4 * lane + 256 * j + q; const f32x4 w0 = *(const f32x4*)(rw + col * NE), w1 = *(const f32x4*)(rw + col * NE + 4);
#pragma unroll
                for (int r = 0; r < 2; ++r) { const float hv = y[r][j][q];
                    lg[r][0] += hv * w0.x; lg[r][1] += hv * w0.y; lg[r][2] += hv * w0.z; lg[r][3] += hv * w0.w; lg[r][4] += hv * w1.x; lg[r][5] += hv * w1.y; lg[r][6] += hv * w1.z; lg[r][7] += hv * w1.w; } }
#pragma unroll
        for (int o = 1; o < 64; o <<= 1) {
#pragma unroll
            for (int r = 0; r < 2; ++r)
#pragma unroll
                for (int e = 0; e < NE; ++e) lg[r][e] += __shfl_xor(lg[r][e], o); }
#pragma unroll
        for (int r = 0; r < 2; ++r) { const int m = m0 + r;
#pragma unroll
            for (int e = 0; e < NE; ++e) lg[r][e] += rb[e];
            int i0 = 0; float v0 = lg[r][0];
#pragma unroll
            for (int e = 1; e < NE; ++e) if (lg[r][e] > v0) { v0 = lg[r][e]; i0 = e; }
            int i1 = -1; float v1 = -3.0e38f;
#pragma unroll
            for (int e = 0; e < NE; ++e) if (e != i0 && lg[r][e] > v1) { v1 = lg[r][e]; i1 = e; }
            const float w1v = 1.0f / (1.0f + expf(v0 - v1)), w0v = 1.0f - w1v;
            if (lane == 0) { topi[2 * m] = i0; topi[2 * m + 1] = i1; topw[2 * m] = w0v; topw[2 * m + 1] = w1v; } }
    }
}
__device__ __forceinline__ void qknorm_body(bf16_t* proj, const f32x2* cs, const float* dqn, const float* dkn, const float* mqn, const float* mkn, int gtid, int ngt) {
    for (long idx = gtid; idx < (long)M * 32 * 32; idx += ngt) {
        const int i = (int)(idx & 31); const long pair = idx >> 5; const int hh = (int)(pair & 31); const int tok = (int)(pair >> 5);
        const int grp = hh >> 3, hi = hh & 7;
        const int cb = (grp == 0 ? C_DQ : grp == 1 ? C_DK : grp == 2 ? C_MQ : C_MK) + hi * 64;
        const float* gn = grp == 0 ? dqn : grp == 1 ? dkn : grp == 2 ? mqn : mkn;
        bf16_t* p = proj + (size_t)tok * INC + cb;
        const float x1 = bf2f(p[i]), x2 = bf2f(p[i + 32]);
        float ss = x1 * x1 + x2 * x2;
        ss += __shfl_xor(ss, 1); ss += __shfl_xor(ss, 2); ss += __shfl_xor(ss, 4); ss += __shfl_xor(ss, 8); ss += __shfl_xor(ss, 16);
        const float rn = rsqrtf(ss * (1.0f / 64.0f) + EPS);
        const float y1 = x1 * rn * gn[i], y2 = x2 * rn * gn[i + 32];
        const f32x2 c = cs[(size_t)tok * 32 + i];
        float o1 = y1 * c.x - y2 * c.y, o2 = y2 * c.x + y1 * c.y;
        if ((grp & 1) == 0) { o1 *= QSCALE; o2 *= QSCALE; }
        p[i] = (bf16_t)f2bf(o1); p[i + 32] = (bf16_t)f2bf(o2);
    }
}
__device__ __forceinline__ void kmean_body(const bf16_t* proj, float* kmean, int gw, int ngw, int lane) {
    for (int it = gw; it < NB * 8 * 8; it += ngw) { const int blk = it & 7, hd = (it >> 3) & 7, b = it >> 6;
        const bf16_t* p = proj + ((size_t)b * SEQ + blk * 256) * INC + C_MK + hd * 64 + lane;
        float s = 0.f;
        for (int t = 0; t < 256; ++t) s += bf2f(p[(size_t)t * INC]);
        kmean[(size_t)it * 64 + lane] = s * (1.0f / 256.0f); }
}
__device__ __forceinline__ void moe_combine_body(const float* x1, const bf16_t* yslot, const float* gate, float* out, int gtid, int ngt) {
    for (long idx = gtid; idx < (long)M * D / 4; idx += ngt) { const int m = (int)(idx >> 8), c4 = (int)(idx & 255) * 4; const int b = m / SEQ;
        const f32x4 xv = *(const f32x4*)(x1 + (size_t)m * D + c4), gv = *(const f32x4*)(gate + b * 6 * D + c4);
        const u32x2 a = *(const u32x2*)(yslot + (size_t)m * D + c4), c = *(const u32x2*)(yslot + ((size_t)M + m) * D + c4);
        f32x4 y = {bf2f(a.x & 0xffffu) + bf2f(c.x & 0xffffu), bf2f(a.x >> 16) + bf2f(c.x >> 16), bf2f(a.y & 0xffffu) + bf2f(c.y & 0xffffu), bf2f(a.y >> 16) + bf2f(c.y >> 16)};
        *(f32x4*)(out + (size_t)m * D + c4) = xv + gv * y; }
}
}
namespace qk {
constexpr int LDS_BYTES = 8 * 64 * 8 * 4;
__device__ __forceinline__ void unit(int b, int blk, int grp, bf16_t* proj, const f32x2* cs, const float* gn, float* kmean, LAS char* lds, int wid) {
    const int lane = lane_fresh(), tid = wid * 64 + lane;
    const int hd = lane >> 3, half = (lane >> 2) & 1, j = lane & 3;
    const int cb = (grp == 0 ? C_DQ : grp == 1 ? C_DK : grp == 2 ? C_MQ : C_MK) + hd * 64 + half * 32 + 8 * j;
    float gnv[8];
#pragma unroll
    for (int e = 0; e < 8; ++e) gnv[e] = gn[half * 32 + 8 * j + e];
    const float qs = ((grp & 1) == 0) ? QSCALE : 1.0f;
    const float sgn = half ? 1.0f : -1.0f;
    float ksum[8];
#pragma unroll
    for (int e = 0; e < 8; ++e) ksum[e] = 0.f;
    for (int i = 0; i < 32; ++i) {
        const size_t tok = (size_t)b * SEQ + blk * 256 + wid + 8 * i;
        bf16_t* p = proj + tok * INC + cb;
        const u32x4 raw = *(const u32x4*)p;
        float x[8] = {bf2f(raw.x & 0xffffu), bf2f(raw.x >> 16), bf2f(raw.y & 0xffffu), bf2f(raw.y >> 16), bf2f(raw.z & 0xffffu), bf2f(raw.z >> 16), bf2f(raw.w & 0xffffu), bf2f(raw.w >> 16)};
        float ss = 0.f;
#pragma unroll
        for (int e = 0; e < 8; ++e) ss += x[e] * x[e];
        ss += __shfl_xor(ss, 1); ss += __shfl_xor(ss, 2); ss += __shfl_xor(ss, 4);
        const float rn = rsqrtf(ss * (1.0f / 64.0f) + EPS);
        const f32x4* cp = (const f32x4*)(cs + tok * 32 + 8 * j);
        const f32x4 c0 = cp[0], c1 = cp[1], c2 = cp[2], c3 = cp[3];
        const float cc[8] = {c0.x, c0.z, c1.x, c1.z, c2.x, c2.z, c3.x, c3.z}, sn[8] = {c0.y, c0.w, c1.y, c1.w, c2.y, c2.w, c3.y, c3.w};
        float o[8];
#pragma unroll
        for (int e = 0; e < 8; ++e) { const float y = x[e] * rn * gnv[e]; const float py = __shfl_xor(y, 4); o[e] = (y * cc[e] + sgn * py * sn[e]) * qs; }
        u32x4 w; w.x = pk2(o[0], o[1]); w.y = pk2(o[2], o[3]); w.z = pk2(o[4], o[5]); w.w = pk2(o[6], o[7]);
        *(u32x4*)p = w;
        if (grp == 3) { ksum[0] += bf2f(w.x & 0xffffu); ksum[1] += bf2f(w.x >> 16); ksum[2] += bf2f(w.y & 0xffffu); ksum[3] += bf2f(w.y >> 16);
                        ksum[4] += bf2f(w.z & 0xffffu); ksum[5] += bf2f(w.z >> 16); ksum[6] += bf2f(w.w & 0xffffu); ksum[7] += bf2f(w.w >> 16); }
    }
    if (grp == 3) {
        LAS float* red = (LAS float*)lds;
        __syncthreads();
#pragma unroll
        for (int e = 0; e < 8; ++e) red[(wid * 64 + lane) * 8 + e] = ksum[e];
        __syncthreads();
        { const int ln = tid >> 3, e = tid & 7; float s = 0.f;
#pragma unroll
          for (int w = 0; w < 8; ++w) s += red[(w * 64 + ln) * 8 + e];
          const int h2 = ln >> 3, hf = (ln >> 2) & 1, jj = ln & 3;
          kmean[((size_t)((b * 8 + h2) * 8 + blk)) * 64 + hf * 32 + 8 * jj + e] = s * (1.0f / 256.0f); }
        __syncthreads();
    }
}
}
namespace rglru {
constexpr int TT = 32;
constexpr int LDS_WA = 0, LDS_WX = 16384, LDS_XC = 32768, LDS_A = LDS_XC + TT * 65 * 4, LDS_U = LDS_A + TT * 64 * 4, LDS_BYTES = LDS_U + TT * 64 * 4;
__device__ __forceinline__ void unit(int b, int n, const bf16_t* proj, bf16_t* yabc, const float* conv_w, const float* conv_b, const float* wa, const float* ba,
                                     const float* wx, const float* bx, const float* lam, LAS char* lds) {
    int tid_l = threadIdx.x; asm volatile("" : "+v"(tid_l));
    const int tid = tid_l;
    LAS float* Wa = (LAS float*)(lds + LDS_WA); LAS float* Wx = (LAS float*)(lds + LDS_WX); LAS float* XC = (LAS float*)(lds + LDS_XC);
    LAS float* AV = (LAS float*)(lds + LDS_A); LAS float* UV = (LAS float*)(lds + LDS_U);
    __syncthreads();
    for (int i = tid; i < 4096; i += 512) { Wa[i] = wa[(size_t)n * 4096 + i]; Wx[i] = wx[(size_t)n * 4096 + i]; }
    const int cc = tid & 63, ct = tid >> 6;
    const int ch = n * 64 + cc;
    const float cw0 = conv_w[0 * D + ch], cw1 = conv_w[1 * D + ch], cw2 = conv_w[2 * D + ch], cw3 = conv_w[3 * D + ch], cb = conv_b[ch];
    const int gt = tid >> 4, eq = tid & 15;
    float gba[4], gbx[4], gsp[4];
#pragma unroll
    for (int j = 0; j < 4; ++j) { const int e = n * 64 + eq * 4 + j; gba[j] = ba[e]; gbx[j] = bx[e]; const float x = -lam[e]; gsp[j] = fmaxf(x, 0.f) + log1pf(expf(-fabsf(x))); }
    float hstate = 0.f;
    const size_t rowb = (size_t)b * SEQ;
    __syncthreads();
    for (int t0 = 0; t0 < SEQ; t0 += TT) {
#pragma unroll
        for (int i = 0; i < 4; ++i) { const int tt = ct + 8 * i, t = t0 + tt;
            const bf16_t* p = proj + (rowb + t) * INC + C_XR + ch;
            float acc = cb + cw3 * bf2f(p[0]);
            if (t >= 1) acc += cw2 * bf2f(*(p - INC));
            if (t >= 2) acc += cw1 * bf2f(*(p - 2 * INC));
            if (t >= 3) acc += cw0 * bf2f(*(p - 3 * INC));
            XC[tt * 65 + cc] = acc; }
        __syncthreads();
        { f32x4 ar = {0.f, 0.f, 0.f, 0.f}, ai = {0.f, 0.f, 0.f, 0.f};
#pragma unroll 8
          for (int d = 0; d < 64; ++d) { const float xv = XC[gt * 65 + d]; ar += *(const LAS f32x4*)(Wa + d * 64 + eq * 4) * xv; ai += *(const LAS f32x4*)(Wx + d * 64 + eq * 4) * xv; }
#pragma unroll
          for (int j = 0; j < 4; ++j) { const int e = eq * 4 + j;
              const float rg = 1.0f / (1.0f + expf(-(ar[j] + gba[j]))), ig = 1.0f / (1.0f + expf(-(ai[j] + gbx[j])));
              const float log_a = -8.0f * rg * gsp[j]; const float a = expf(log_a); const float mult = sqrtf(-expm1f(2.0f * log_a));
              AV[gt * 64 + e] = a; UV[gt * 64 + e] = mult * ig * XC[gt * 65 + e]; } }
        __syncthreads();
        if (tid < 64) {
            for (int tt = 0; tt < TT; ++tt) { hstate = AV[tt * 64 + tid] * hstate + UV[tt * 64 + tid];
                const size_t row = rowb + t0 + tt;
                const float g = bf2f(proj[row * INC + C_GR + n * 64 + tid]);
                yabc[row * YW + Y_A + n * 64 + tid] = (bf16_t)f2bf(g * hstate); }
        }
        __syncthreads();
    }
}
}

namespace moe {
__device__ __forceinline__ void assign(const int* topi, const float* topw, int* rowtok, int* rowdst, float* roww, int* tile_e, int* ntiles, LAS int* sm, int tid) {
    const int nthr = 512, per = M / nthr, t0 = tid * per;
    int cnt[NE];
#pragma unroll
    for (int e = 0; e < NE; ++e) cnt[e] = 0;
    for (int t = t0; t < t0 + per; ++t) { const int e0 = topi[2 * t], e1 = topi[2 * t + 1];
#pragma unroll
        for (int e = 0; e < NE; ++e) cnt[e] += (e0 == e) + (e1 == e); }
#pragma unroll
    for (int e = 0; e < NE; ++e) sm[e * nthr + tid] = cnt[e];
    __syncthreads();
    if (tid < NE) { int run = 0; for (int i = 0; i < nthr; ++i) { const int v = sm[tid * nthr + i]; sm[tid * nthr + i] = run; run += v; } sm[NE * nthr + tid] = run; }
    __syncthreads();
    if (tid == 0) { int p = 0, nt = 0;
        for (int e = 0; e < NE; ++e) { const int tot = sm[NE * nthr + e]; sm[NE * nthr + 8 + e] = p; const int nte = (tot + 255) >> 8; for (int i = 0; i < nte; ++i) tile_e[nt++] = e; p += nte * 256; }
        *ntiles = nt; }
    __syncthreads();
    for (int e = 0; e < NE; ++e) { const int tot = sm[NE * nthr + e], base = sm[NE * nthr + 8 + e], padded = ((tot + 255) >> 8) << 8;
        for (int i = tot + tid; i < padded; i += nthr) { rowtok[base + i] = 0; rowdst[base + i] = -1; roww[base + i] = 0.f; } }
    int pos[NE];
#pragma unroll
    for (int e = 0; e < NE; ++e) pos[e] = sm[NE * nthr + 8 + e] + sm[e * nthr + tid];
    for (int t = t0; t < t0 + per; ++t) {
#pragma unroll
        for (int k = 0; k < 2; ++k) { const int ek = topi[2 * t + k]; int p = 0;
#pragma unroll
            for (int e = 0; e < NE; ++e) { if (ek == e) { p = pos[e]; pos[e] = p + 1; } }
            rowtok[p] = t; rowdst[p] = k * M + t; roww[p] = topw[2 * t + k]; } }
}
struct Order {
    const int* tile_e; const int* ntiles_p; int nN, G, c, ntiles;
    __device__ __forceinline__ void dev_init(int G_, int c_) { G = G_; c = c_; ntiles = *ntiles_p; }
    __device__ __forceinline__ bool next(int i, pg8::Unit& u) const { const int L = i * G + c; if (L >= ntiles * nN) return false; u.pm = L / nN; u.pn = L % nN; u.e = tile_e[u.pm]; u.aux = 0; return true; }
};
struct ProbUp {
    static constexpr bool GATHER = true;
    const bf16_t* A; const bf16_t* Ba; const bf16_t* Bb; const bf16_t* Bc; const bf16_t* Bd; const int* rowtok; int K, lda, ldb, pad;
    __device__ __forceinline__ const char* a_base(const pg8::Unit&) const { return (const char*)A; }
    __device__ __forceinline__ const char* b_base(const pg8::Unit& u) const {
        const char* base = (u.e == 0) ? (const char*)Ba : (u.e < 5) ? (const char*)Bb + (size_t)(u.e - 1) * DFF2 * ldb * 2 : (u.e < 7) ? (const char*)Bc + (size_t)(u.e - 5) * DFF2 * ldb * 2 : (const char*)Bd;
        return base + (size_t)u.pn * 256 * ldb * 2; }
    __device__ __forceinline__ unsigned a_off(const pg8::Unit& u, int row, int col) const { return (unsigned)(rowtok[u.pm * 256 + row] * lda + col) * 2u; }
};
struct ProbDown {
    static constexpr bool GATHER = false;
    const bf16_t* A; const bf16_t* Bt; int K, lda, ldb, pad;
    __device__ __forceinline__ const char* a_base(const pg8::Unit& u) const { return (const char*)A + (size_t)u.pm * 256 * lda * 2; }
    __device__ __forceinline__ const char* b_base(const pg8::Unit& u) const { return (const char*)Bt + ((size_t)u.e * D + (size_t)u.pn * 256) * ldb * 2; }
    __device__ __forceinline__ unsigned a_off(const pg8::Unit&, int row, int col) const { return (unsigned)(row * lda + col) * 2u; }
};
}
namespace rg2 {
constexpr int TT = 128, XS = 144  , FS = 36  ;
constexpr int L_XCB = 0, L_XCF = L_XCB + TT * XS, L_AV = L_XCF + TT * FS * 4, L_UV = L_AV + TT * FS * 4, L_WA = L_UV + TT * FS * 4, L_WX = L_WA + 32 * XS,
              L_CW = L_WX + 32 * XS, L_SEGA = L_CW + 5 * 64 * 4, L_SEGH = L_SEGA + 16 * 32 * 4, L_CARRY = L_SEGH + 16 * 32 * 4, LDS_BYTES = L_CARRY + 2 * 32 * 4;
__device__ __forceinline__ void unit(int b, int n, int hf, const bf16_t* proj, bf16_t* yabc, const float* conv_w, const float* conv_b, const float* wa, const float* ba,
                                     const float* wx, const float* bx, const float* lam, LAS char* lds, int wid) {
    const int lane = lane_fresh(), tid = wid * 64 + lane;
    LAS float* XCF = (LAS float*)(lds + L_XCF); LAS float* AV = (LAS float*)(lds + L_AV); LAS float* UV = (LAS float*)(lds + L_UV);
    LAS float* CW = (LAS float*)(lds + L_CW); LAS float* SEGA = (LAS float*)(lds + L_SEGA); LAS float* SEGH = (LAS float*)(lds + L_SEGH); LAS float* CARRY = (LAS float*)(lds + L_CARRY);
    const int ch0 = n * 64;
    const int oc0 = ch0 + hf * 32;
    __syncthreads();
    for (int i = tid; i < 2048; i += 512) { const int d = i >> 5, e = i & 31;
        *(LAS bf16_t*)(lds + L_WA + e * XS + d * 2) = (bf16_t)f2bf(wa[(size_t)n * 4096 + d * 64 + hf * 32 + e]);
        *(LAS bf16_t*)(lds + L_WX + e * XS + d * 2) = (bf16_t)f2bf(wx[(size_t)n * 4096 + d * 64 + hf * 32 + e]); }
    if (tid < 320) { const int k = tid >> 6, c = tid & 63; CW[tid] = (k < 4) ? conv_w[k * D + ch0 + c] : conv_b[ch0 + c]; }
    if (tid < 64) CARRY[tid] = 0.f;
    const int crow_ = tid >> 2, cg = tid & 3;
    const int mt = wid & 3, chh = wid >> 2;
    const int g4 = lane >> 4, e16 = lane & 15;
    const int eo = chh * 16 + e16;
    const float gba = ba[oc0 + eo], gbx = bx[oc0 + eo];
    float gk1; { const float x = -lam[oc0 + eo]; gk1 = -8.0f * 1.4426950408889634f * (fmaxf(x, 0.f) + log1pf(expf(-fabsf(x)))); }
    const int sc = tid & 31, ss = tid >> 5;
    const size_t rowb = (size_t)b * SEQ;
    const bf16_t* xbase = proj + rowb * INC + C_XR + ch0 + cg * 16;
    const bf16_t* gbase = proj + rowb * INC + C_GR + oc0 + sc;
    bf16_t* ybase = yabc + rowb * YW + Y_A + oc0 + sc;
    u32x4 xr[4][2]; unsigned short gv[8];
#define RG2_LOADX(T0) do { _Pragma("unroll") for (int k = 0; k < 4; ++k) { const int t = (T0) + crow_ - 3 + k; \
        if (t >= 0) { const bf16_t* p = xbase + (size_t)t * INC; xr[k][0] = *(const u32x4*)p; xr[k][1] = *(const u32x4*)(p + 8); } \
        else { xr[k][0] = (u32x4){0u, 0u, 0u, 0u}; xr[k][1] = (u32x4){0u, 0u, 0u, 0u}; } } } while (0)
    RG2_LOADX(0);
    __syncthreads();
    for (int ti = 0; ti < SEQ / TT; ++ti) {
        const int t0 = ti * TT;
        {
            float xc[16];
#pragma unroll
            for (int j = 0; j < 16; ++j) xc[j] = CW[4 * 64 + cg * 16 + j];
#pragma unroll
            for (int k = 0; k < 4; ++k) {
#pragma unroll
                for (int q = 0; q < 2; ++q) { const u32x4 w = xr[k][q]; const unsigned ww[4] = {w.x, w.y, w.z, w.w};
#pragma unroll
                    for (int j = 0; j < 4; ++j) { const int c = q * 8 + 2 * j;
                        xc[c] += CW[k * 64 + cg * 16 + c] * bf2f(ww[j] & 0xffffu); xc[c + 1] += CW[k * 64 + cg * 16 + c + 1] * bf2f(ww[j] >> 16); } } }
            u32x4 o0, o1;
            o0.x = pk2(xc[0], xc[1]); o0.y = pk2(xc[2], xc[3]); o0.z = pk2(xc[4], xc[5]); o0.w = pk2(xc[6], xc[7]);
            o1.x = pk2(xc[8], xc[9]); o1.y = pk2(xc[10], xc[11]); o1.z = pk2(xc[12], xc[13]); o1.w = pk2(xc[14], xc[15]);
            *(LAS u32x4*)(lds + L_XCB + crow_ * XS + cg * 32) = o0; *(LAS u32x4*)(lds + L_XCB + crow_ * XS + cg * 32 + 16) = o1;
            if ((cg >> 1) == hf) { LAS float* d = XCF + crow_ * FS + (cg & 1) * 16;
#pragma unroll
                for (int j = 0; j < 4; ++j) *(LAS f32x4*)(d + 4 * j) = (f32x4){xc[4 * j], xc[4 * j + 1], xc[4 * j + 2], xc[4 * j + 3]}; }
        }
#pragma unroll
        for (int k = 0; k < 8; ++k) gv[k] = gbase[(size_t)(t0 + ss * 8 + k) * INC];
        __syncthreads();
        if (ti + 1 < SEQ / TT) RG2_LOADX(t0 + TT);
        {
            f32x4 ar[2], ai[2];
#pragma unroll
            for (int s = 0; s < 2; ++s) { ar[s] = (f32x4){0.f, 0.f, 0.f, 0.f}; ai[s] = (f32x4){0.f, 0.f, 0.f, 0.f}; }
#pragma unroll
            for (int kk = 0; kk < 2; ++kk) {
                const bf16x8 bwa = *(const LAS bf16x8*)(lds + L_WA + eo * XS + (32 * kk + 8 * g4) * 2);
                const bf16x8 bwx = *(const LAS bf16x8*)(lds + L_WX + eo * XS + (32 * kk + 8 * g4) * 2);
#pragma unroll
                for (int s = 0; s < 2; ++s) {
                    const bf16x8 av = *(const LAS bf16x8*)(lds + L_XCB + (mt * 32 + 16 * s + e16) * XS + (32 * kk + 8 * g4) * 2);
                    ar[s] = __builtin_amdgcn_mfma_f32_16x16x32_bf16(av, bwa, ar[s], 0, 0, 0);
                    ai[s] = __builtin_amdgcn_mfma_f32_16x16x32_bf16(av, bwx, ai[s], 0, 0, 0);
                }
            }
#pragma unroll
            for (int s = 0; s < 2; ++s)
#pragma unroll
                for (int rg = 0; rg < 4; ++rg) {
                    const int tok = mt * 32 + 16 * s + 4 * g4 + rg;
                    const float er = fexp2(-1.4426950408889634f * (ar[s][rg] + gba)) + 1.0f, ei = fexp2(-1.4426950408889634f * (ai[s][rg] + gbx)) + 1.0f;
                    const float pr = frcp(er * ei);
                    const float rgt = ei * pr, igt = er * pr;
                    const float a = fexp2(rgt * gk1);
                    const float om = fmaxf(1.0f - a * a, 0.f);
                    const float u = __builtin_amdgcn_sqrtf(om) * igt * XCF[tok * FS + eo];
                    AV[tok * FS + eo] = a; UV[tok * FS + eo] = u;
                }
        }
        __syncthreads();
        float hl[8], ac[8];
        { float Hh = 0.f, Aa = 1.f;
#pragma unroll
          for (int k = 0; k < 8; ++k) { const float a = AV[(ss * 8 + k) * FS + sc], u = UV[(ss * 8 + k) * FS + sc]; Hh = a * Hh + u; Aa *= a; hl[k] = Hh; ac[k] = Aa; }
          SEGA[ss * 32 + sc] = Aa; SEGH[ss * 32 + sc] = Hh; }
        __syncthreads();
        { float cin = CARRY[(ti & 1) * 32 + sc];
#pragma unroll
          for (int s2 = 0; s2 < 15; ++s2) { const float sa = SEGA[s2 * 32 + sc], sh = SEGH[s2 * 32 + sc]; cin = (s2 < ss) ? sa * cin + sh : cin; }
#pragma unroll
          for (int k = 0; k < 8; ++k) { const float hv = hl[k] + ac[k] * cin; hl[k] = hv;
              ybase[(size_t)(t0 + ss * 8 + k) * YW] = (bf16_t)f2bf(bf2f(gv[k]) * hv); }
          if (ss == 15) CARRY[((ti + 1) & 1) * 32 + sc] = hl[7]; }
    }
    __syncthreads();
#undef RG2_LOADX
}
}
constexpr size_t MiB = 1u << 20;
constexpr size_t WS_CTL = 0, CTL_ZERO_BYTES = 64 * 1024, WS_ROWTOK = 256 * 1024, WS_ROWDST = 400 * 1024, WS_ROWW = 544 * 1024, WS_TILEE = 700 * 1024, WS_NTILES = 702 * 1024;
constexpr size_t WS_MOD = 1 * MiB, WS_CS = 1 * MiB + 512 * 1024, WS_KMEAN = 5 * MiB + 512 * 1024, WS_TOPI = 5 * MiB + 640 * 1024, WS_TOPW = 5 * MiB + 768 * 1024;
constexpr size_t WS_L1W = 6 * MiB, WS_H = 28 * MiB, WS_YABC = 60 * MiB, WS_PROJ = 124 * MiB, WS_XA = 380 * MiB, WS_SPARE = 444 * MiB, WS_END = 488 * MiB;
constexpr size_t WS_HMID_MOE = 138 * MiB, OUT_W2 = 0, OUT_W13A = 44 * MiB, WS_W13B = 444 * MiB, WS_W13C = 6 * MiB, WS_W13D = 124 * MiB, W13_BYTES = 11 * MiB, W2_BYTES = 5 * MiB + 512 * 1024;
constexpr size_t LW_IN = 0, LW_BRA = 16 * MiB, LW_BRB = 18 * MiB, LW_BRC = 19 * MiB, LW_OUT = 20 * MiB, LW_W13 = 22 * MiB, LW_W2 = 33 * MiB;
constexpr int CW_TMO = 0, CW_QUEUE = 64  , CW_BAR = 4096;
constexpr int LDS_MISC = 131072 + 8192, LDS_TOTAL = 147456;


#define XB_TMO      128
#define XB_XCNT(j)  (256  + 64 * (j))
#define XB_XSUB(j)  (1280 + 64 * (j))
#define XB_XGEN(j)  (2304 + 64 * (j))
#define XB_TOP      3328
#define XB_TOPGEN   3392
#define XCD_BAR_WORDS 3456
#define XB_SPIN_CAP (1u << 18)

__device__ __forceinline__ unsigned xb_ld(unsigned* p)              { return __hip_atomic_load(p, __ATOMIC_RELAXED, __HIP_MEMORY_SCOPE_AGENT); }
__device__ __forceinline__ unsigned xb_add(unsigned* p, unsigned v) { return __hip_atomic_fetch_add(p, v, __ATOMIC_RELAXED, __HIP_MEMORY_SCOPE_AGENT); }
__device__ __forceinline__ unsigned xb_xcc_id() { return (unsigned)__builtin_amdgcn_s_getreg((3 << 11) | 20) & 0xFu; }
#define XB_SPIN(cond, bar) do { unsigned _sp = 0; while (cond) { __builtin_amdgcn_s_sleep(1); \
    if ((++_sp & 255u) == 0u) { if (xb_ld(&(bar)[XB_TMO])) break; if (_sp > XB_SPIN_CAP) { atomicAdd(&(bar)[XB_TMO], 1u); break; } } } } while (0)

struct XcdBarrier {
    unsigned* bar; unsigned x;
    volatile LAS unsigned* st;
};

__device__ __forceinline__ XcdBarrier xcd_barrier_post(unsigned* bar, volatile LAS unsigned* st) {
    XcdBarrier b; b.bar = bar; b.x = xb_xcc_id(); b.st = st;
    if (threadIdx.x == 0) (void)xb_add(&bar[XB_XCNT(b.x)], 1u);
    return b;
}
__device__ __forceinline__ void xcd_barrier_complete(unsigned* bar, unsigned x, unsigned& nloc, unsigned& nx) {
    const unsigned G = gridDim.x * gridDim.y * gridDim.z;
    unsigned sum, cnt, mine, sp = 0u;
    for (;;) {
        sum = 0u; cnt = 0u; mine = 0u;
#pragma unroll
        for (unsigned j = 0; j < 16; ++j) { const unsigned c = xb_ld(&bar[XB_XCNT(j)]); sum += c; cnt += (c > 0u) ? 1u : 0u; mine = (j == x) ? c : mine; }
        if (sum == G) break;
        __builtin_amdgcn_s_sleep(1);
        if ((++sp & 255u) == 0u) { if (xb_ld(&bar[XB_TMO])) break; if (sp > XB_SPIN_CAP) { atomicAdd(&bar[XB_TMO], 1u); break; } }
    }
    nloc = mine > 0u ? mine : 1u; nx = cnt > 0u ? cnt : 1u;
}

__device__ __forceinline__ void xcd_barrier(const XcdBarrier& b) {
    asm volatile("s_waitcnt vmcnt(0)" ::: "memory");
    __syncthreads();
    if (threadIdx.x == 0) {
        unsigned* bar = b.bar;
        __builtin_amdgcn_s_waitcnt(0);
        unsigned nloc = b.st[0], nx = b.st[1];
        if (nloc == 0u) { xcd_barrier_complete(bar, b.x, nloc, nx); b.st[0] = nloc; b.st[1] = nx; }
        const unsigned old = xb_add(&bar[XB_XSUB(b.x)], 1u);
        const unsigned gen = old / nloc;
        if (old + 1u == (gen + 1u) * nloc) {
            __builtin_amdgcn_fence(__ATOMIC_RELEASE, "agent");
            asm volatile("s_waitcnt vmcnt(0)" ::: "memory");
            const unsigned og = xb_add(&bar[XB_TOP], 1u);
            const unsigned tg = og / nx;
            if (og + 1u == (tg + 1u) * nx) xb_add(&bar[XB_TOPGEN], 1u);
            else XB_SPIN(xb_ld(&bar[XB_TOPGEN]) == tg, bar);
            __builtin_amdgcn_fence(__ATOMIC_ACQUIRE, "agent");
            xb_add(&bar[XB_XGEN(b.x)], 1u);
            asm volatile("s_waitcnt vmcnt(0)" ::: "memory");
        } else {
            XB_SPIN(xb_ld(&bar[XB_XGEN(b.x)]) == gen, bar);
            __builtin_amdgcn_fence(__ATOMIC_ACQUIRE, "agent");
            asm volatile("s_waitcnt vmcnt(0)" ::: "memory");
        }
    }
    __syncthreads();
}


#ifndef PHMASK
#define PHMASK 0xFFFFF
#endif
#define PH(k) if constexpr ((PHMASK >> (k)) & 1)
#define QOFF 0
__device__ __forceinline__ const float* ldptr(const LAS unsigned long long* PT, int i) {
    const unsigned long long v = PT[i];
    const unsigned lo = __builtin_amdgcn_readfirstlane((unsigned)v), hi = __builtin_amdgcn_readfirstlane((unsigned)(v >> 32));
    return (const float*)(const __attribute__((address_space(1))) float*)(((unsigned long long)hi << 32) | lo);
}
struct CvtD { unsigned long long src, dst; int K, N, ldk, coff, row_off, mode, nunits, pad; };
__device__ __forceinline__ void cvt_unit(const LAS CvtD* cd, int first, int u, LAS float* scr, int wid, int lane) {
    int d = first;
    while (u >= cd[d].nunits) { u -= cd[d].nunits; ++d; }
    const float* W = (const float*)(const __attribute__((address_space(1))) float*)cd[d].src; bf16_t* WT = (bf16_t*)(__attribute__((address_space(1))) bf16_t*)cd[d].dst;
    const int N = cd[d].N, ldk = cd[d].ldk, coff = cd[d].coff, row_off = cd[d].row_off, mode = cd[d].mode;
    LAS unsigned* T = (LAS unsigned*)scr;
    thin::TItem t0, t1, t2;
    thin::titem_load(t0, W, N, 64 * u + wid, lane); thin::titem_load(t1, W, N, 64 * u + wid + 8, lane);
#pragma unroll 1
    for (int i = 0; i < 8; i += 3) { const int it = 64 * u + wid + 8 * i;
        if (i + 2 < 8) thin::titem_load(t2, W, N, it + 16, lane);
        thin::titem_store(t0, N, WT, ldk, coff, row_off, mode, T, it, lane);
        if (i + 3 < 8) thin::titem_load(t0, W, N, it + 24, lane);
        if (i + 1 < 8) thin::titem_store(t1, N, WT, ldk, coff, row_off, mode, T, it + 8, lane);
        if (i + 4 < 8) thin::titem_load(t1, W, N, it + 32, lane);
        if (i + 2 < 8) thin::titem_store(t2, N, WT, ldk, coff, row_off, mode, T, it + 16, lane); }
}
struct Args { const float* in[37]; float* out; unsigned char* ws; };

__device__ __forceinline__ float diff_lambda(const float* lq1, const float* lk1, const float* lq2, const float* lk2, float lam_init, int lane) {
    const float s1 = wave_sum(lq1[lane] * lk1[lane]), s2 = wave_sum(lq2[lane] * lk2[lane]); return expf(s1) - expf(s2) + lam_init; }

constexpr int NQ_RG = 256;
constexpr int NCVT0 = 77, NCVT1 = 198;
__global__ void __launch_bounds__(512, 2) mega_fwd(Args a) {
    extern __shared__ __attribute__((aligned(16))) unsigned char lds_raw[];
    LAS unsigned char* lds = (LAS unsigned char*)lds_raw;
    volatile LAS unsigned* MISC = (volatile LAS unsigned*)(lds + LDS_MISC);
    const int tid0 = threadIdx.x, wid0 = __builtin_amdgcn_readfirstlane(tid0 >> 6);
    const int G = gridDim.x, bid = blockIdx.x;
    if (tid0 < 64) MISC[tid0] = 0u;
    LAS unsigned long long* PT = (LAS unsigned long long*)(lds + LDS_MISC + 256);
    if (tid0 == 0) {
#pragma unroll
        for (int i = 0; i < 37; ++i) PT[i] = (unsigned long long)a.in[i];
    }
    LAS CvtD* CD = (LAS CvtD*)(lds + LDS_MISC + 1024);
    if (tid0 == 64) {
        const unsigned long long wsb = (unsigned long long)a.ws, ob = (unsigned long long)a.out;
#define CVT_PUT(i, SRC, DST, K_, N_, LDK, COFF, MODE) do { CD[i].src = (unsigned long long)(SRC); CD[i].dst = (DST); CD[i].K = (K_); CD[i].N = (N_); CD[i].ldk = (LDK); CD[i].coff = (COFF); CD[i].row_off = 0; CD[i].mode = (MODE); CD[i].nunits = ((K_) >> 6) * ((N_) >> 6) / 64; CD[i].pad = 0; } while (0)
        CVT_PUT(0, a.in[7] + (size_t)D * INC, wsb + WS_L1W + LW_IN, D, INC, D, 0, 0);
        CVT_PUT(1, a.in[25] + (size_t)D * D, wsb + WS_L1W + LW_BRA, D, D, 2048, 0, 0);
        CVT_PUT(2, a.in[26] + (size_t)512 * D, wsb + WS_L1W + LW_BRA, 512, D, 2048, 1024, 0);
        CVT_PUT(3, a.in[27] + (size_t)512 * D, wsb + WS_L1W + LW_BRA, 512, D, 2048, 1536, 0);
        CVT_PUT(4, a.in[28] + (size_t)D * D, wsb + WS_L1W + LW_OUT, D, D, D, 0, 0);
        CVT_PUT(5, a.in[29], ob + LW_W13, D, DFF, D, 0, 1);
        CVT_PUT(6, a.in[30], ob + LW_W13, D, DFF, D, 0, 2);
        CVT_PUT(7, a.in[31], ob + LW_W2, DFF, D, DFF, 0, 0);
#pragma unroll
        for (int e = 0; e < NE; ++e) CVT_PUT(8 + e, a.in[36] + (size_t)e * DFF * D, ob + OUT_W2 + e * W2_BYTES, DFF, D, DFF, 0, 0);
#pragma unroll
        for (int e = 0; e < 5; ++e) { const unsigned long long dst = (e == 0) ? ob + OUT_W13A : wsb + WS_W13B + (e - 1) * W13_BYTES;
            CVT_PUT(16 + 2 * e, a.in[34] + (size_t)e * D * DFF, dst, D, DFF, D, 0, 1); CVT_PUT(17 + 2 * e, a.in[35] + (size_t)e * D * DFF, dst, D, DFF, D, 0, 2); }
#undef CVT_PUT
    }
    __syncthreads();
    XcdBarrier bar = xcd_barrier_post((unsigned*)(a.ws + WS_CTL) + CW_BAR, MISC + 8);
#define F(i) ldptr(PT, (i))
#define PHASE_VARS(lv) \
    unsigned long long ws_u = (unsigned long long)a.ws, out_u = (unsigned long long)a.out; const int l = (lv); int wid = wid0; \
    asm volatile("" : "+s"(ws_u), "+s"(out_u), "+s"(wid)); \
    const int lane = lane_fresh(), tid = wid * 64 + lane; \
    unsigned char* ws = (unsigned char*)(__attribute__((address_space(1))) unsigned char*)ws_u; float* outp = (float*)(__attribute__((address_space(1))) float*)out_u; \
    const int gw = bid * 8 + wid, ngw = G * 8, gtid = bid * 512 + tid, ngt = G * 512; (void)gw; (void)ngw; (void)gtid; (void)ngt; (void)lane; (void)l; (void)tid; \
    char* outb = (char*)outp; (void)outb; \
    float* mod = (float*)(ws + WS_MOD); f32x2* cs = (f32x2*)(ws + WS_CS); float* kmean = (float*)(ws + WS_KMEAN); (void)mod; (void)cs; (void)kmean; \
    bf16_t* H = (bf16_t*)(ws + WS_H); bf16_t* YABC = (bf16_t*)(ws + WS_YABC); bf16_t* PROJ = (bf16_t*)(ws + WS_PROJ); float* XA = (float*)(ws + WS_XA); (void)H; (void)YABC; (void)PROJ; (void)XA; \
    const float* xin = (l == 0) ? F(0) : (const float*)XA; float* x1 = XA; const char* lwb = (l == 0) ? (const char*)outb : (const char*)ws + WS_L1W; \
    const float* modl = mod + (size_t)l * NB * 6 * D; (void)xin; (void)x1; (void)lwb; (void)modl;

    PH(0) { PHASE_VARS(0)
        LAS float* scr = (LAS float*)(lds + wid * 8192);
        thin::transpose_matrix(F(7), D, INC, (bf16_t*)(outb + LW_IN), D, 0, 0, 0, scr, gw, ngw, lane);
        thin::transpose_matrix(F(25), D, D, (bf16_t*)(outb + LW_BRA), 2048, 0, 0, 0, scr, gw, ngw, lane);
        thin::transpose_matrix(F(26), 512, D, (bf16_t*)(outb + LW_BRA), 2048, 1024, 0, 0, scr, gw, ngw, lane);
        thin::transpose_matrix(F(27), 512, D, (bf16_t*)(outb + LW_BRA), 2048, 1536, 0, 0, scr, gw, ngw, lane);
        thin::transpose_matrix(F(28), D, D, (bf16_t*)(outb + LW_OUT), D, 0, 0, 0, scr, gw, ngw, lane);
        __syncthreads();
        thin::mod_body(F(1), F(3), F(4), mod, bid, G, tid, (LAS float*)(lds + 65536));
        thin::rope_body((const int*)F(2), cs, gtid, ngt);
    }
    xcd_barrier(bar);

    {
        PH(1) { PHASE_VARS(0) thin::norm_body(xin, F(5) + l * D, modl + 0 * D, modl + 1 * D, H, gw, ngw, lane); }
        xcd_barrier(bar);
        PH(2) { PHASE_VARS(0) pg8::DenseProb g{H, (const bf16_t*)(lwb + LW_IN), D, D, D, 0}; pg8::StaticOrder S; S.init(M, INC, G, bid);
          pg8::gemm_phase<pg8::DenseProb, epi::Proj, pg8::StaticOrder, true>(lds, g, S, epi::Proj{PROJ, F(8) + l * 3 * D}, wid); }
        xcd_barrier(bar);
        PH(3) { PHASE_VARS(0) for (int u = bid; u < 256; u += G) { const int grp = u & 3;
            qk::unit(u >> 5, (u >> 2) & 7, grp, PROJ, cs, (grp == 0 ? F(16) : grp == 1 ? F(17) : grp == 2 ? F(23) : F(24)) + l * 64, kmean, (LAS char*)lds, wid); } }
        xcd_barrier(bar);
        {
#define POP_Q() do { __syncthreads(); if (tid == 0) MISC[16] = __hip_atomic_fetch_add((unsigned*)(ws + WS_CTL) + CW_QUEUE + 64 * (l + QOFF), 1u, __ATOMIC_RELAXED, __HIP_MEMORY_SCOPE_AGENT); __syncthreads(); q = (int)MISC[16]; } while (0)
            int q; constexpr int NCVT = (0 == 0) ? NCVT0 : NCVT1;
            { PHASE_VARS(0) POP_Q(); }
            PH(5) { PHASE_VARS(0)
              const float lam_init = 0.8f - 0.6f * expf(-0.3f * (float)l);
              const float lam = diff_lambda(F(18) + l * 64, F(19) + l * 64, F(20) + l * 64, F(21) + l * 64, lam_init, lane);
              const float noff = attn::score_shift(F(16) + l * 64, F(17) + l * 64, lane);
#pragma unroll 1
              while (q < 256) { const int i = q;
                attn::diff_unit((i & 31) >> 2, i & 3, 7 - (i >> 5), PROJ, YABC, F(22) + l * 128, lam, 1.0f - lam_init, noff, (LAS char*)lds, wid);
                POP_Q(); } }
            PH(18) { PHASE_VARS(0)
#pragma unroll 1
              while (q < 256 + NCVT) { __syncthreads(); cvt_unit(CD, l == 0 ? 0 : 8, q - 256, (LAS float*)(lds + wid * 8192), wid, lane);
                POP_Q(); } }
            PH(4) { PHASE_VARS(0)
#pragma unroll 1
              while (q < 256 + NCVT + NQ_RG) { const int i = q - 256 - NCVT;
                rg2::unit(i >> 5, (i >> 1) & 15, i & 1, PROJ, YABC, F(9) + l * 4 * D, F(10) + l * D, F(11) + (size_t)l * 16 * 4096, F(12) + l * D, F(13) + (size_t)l * 16 * 4096, F(14) + l * D, F(15) + l * D, (LAS char*)lds, wid);
                POP_Q(); } }
            PH(6) { PHASE_VARS(0)
              const float noff = attn::score_shift(F(23) + l * 64, F(24) + l * 64, lane);
#pragma unroll 1
              while (q < 256 + NCVT + NQ_RG + 512) { const int i = q - NQ_RG - 256 - NCVT;
                attn::moba_unit((i & 63) >> 3, i & 7, 7 - (i >> 6), PROJ, YABC, kmean, noff, (LAS char*)lds, wid);
                POP_Q(); } }
#undef POP_Q
        }
        xcd_barrier(bar);
        PH(7) { PHASE_VARS(0) pg8::StaticOrder S; S.init(M, D, G, bid); pg8::DenseProb g{YABC, (const bf16_t*)(lwb + LW_BRA), 2048, YW, 2048, 0};
          pg8::gemm_phase<pg8::DenseProb, epi::BranchMerge, pg8::StaticOrder, true>(lds, g, S, epi::BranchMerge{PROJ, H, 16, 24}, wid); }
        xcd_barrier(bar);
        PH(8) { PHASE_VARS(0) pg8::DenseProb g{H, (const bf16_t*)(lwb + LW_OUT), D, D, D, 0}; pg8::StaticOrder S; S.init(M, D, G, bid);
          pg8::gemm_phase<pg8::DenseProb, epi::Resid, pg8::StaticOrder, true>(lds, g, S, epi::Resid{xin, x1, modl + 2 * D}, wid); }
        xcd_barrier(bar);
        if (0 == 0) {
            PH(9) { PHASE_VARS(0) thin::norm_body(x1, F(6) + l * D, modl + 3 * D, modl + 4 * D, H, gw, ngw, lane); }
            xcd_barrier(bar);
            PH(10) { PHASE_VARS(0) pg8::DenseProb g{H, (const bf16_t*)(lwb + LW_W13), D, D, D, 0}; pg8::StaticOrder S; S.init(M, DFF2, G, bid);
              pg8::gemm_phase<pg8::DenseProb, epi::SwiGLU, pg8::StaticOrder, true>(lds, g, S, epi::SwiGLU{PROJ}, wid); }
            xcd_barrier(bar);
            PH(11) { PHASE_VARS(0) pg8::DenseProb g{PROJ, (const bf16_t*)(lwb + LW_W2), DFF, DFF, DFF, 0}; pg8::StaticOrder S; S.init(M, D, G, bid);
              pg8::gemm_phase<pg8::DenseProb, epi::Resid, pg8::StaticOrder, true>(lds, g, S, epi::Resid{x1, x1, modl + 5 * D}, wid); }
            xcd_barrier(bar);
        } else {
#define MOE_VARS \
            bf16_t* W2 = (bf16_t*)(outb + OUT_W2); bf16_t* h2 = H; bf16_t* hmid = (bf16_t*)(ws + WS_HMID_MOE); bf16_t* yslot = YABC; \
            int* topi = (int*)(ws + WS_TOPI); float* topw = (float*)(ws + WS_TOPW); int* rowtok = (int*)(ws + WS_ROWTOK); int* rowdst = (int*)(ws + WS_ROWDST); float* roww = (float*)(ws + WS_ROWW); int* tile_e = (int*)(ws + WS_TILEE); int* ntiles = (int*)(ws + WS_NTILES); \
            (void)W2; (void)h2; (void)hmid; (void)yslot; (void)topi; (void)topw; (void)rowtok; (void)rowdst; (void)roww; (void)tile_e; (void)ntiles;
            PH(12) { PHASE_VARS(0) MOE_VARS thin::norm_router_body(x1, F(6) + l * D, modl + 3 * D, modl + 4 * D, h2, F(32), F(33), topi, topw, gw, ngw, lane); }
            xcd_barrier(bar);
            PH(14) { PHASE_VARS(0) MOE_VARS if (bid == 0) moe::assign(topi, topw, rowtok, rowdst, roww, tile_e, ntiles, (LAS int*)lds, tid); }
            PH(13) if (bid != 0) { PHASE_VARS(0) MOE_VARS LAS float* scr = (LAS float*)(lds + wid * 8192); const int gw2 = (bid - 1) * 8 + wid, ngw2 = (G - 1) * 8;
#pragma unroll 1
              for (int e = 5; e < NE; ++e) { bf16_t* dst = (bf16_t*)((e < 7) ? (char*)ws + WS_W13C + (e - 5) * W13_BYTES : (char*)ws + WS_W13D);
                thin::transpose_matrix(F(34) + (size_t)e * D * DFF, D, DFF, dst, D, 0, 0, 1, scr, gw2, ngw2, lane);
                thin::transpose_matrix(F(35) + (size_t)e * D * DFF, D, DFF, dst, D, 0, 0, 2, scr, gw2, ngw2, lane); } }

            xcd_barrier(bar);
            PH(15) { PHASE_VARS(0) MOE_VARS moe::Order S{tile_e, ntiles, DFF2 / 256, 0, 0, 0}; S.dev_init(G, bid);
              pg8::gemm_phase<moe::ProbUp, epi::SwiGLU, moe::Order, true>(lds, moe::ProbUp{h2, (const bf16_t*)(outb + OUT_W13A), (const bf16_t*)(ws + WS_W13B), (const bf16_t*)(ws + WS_W13C), (const bf16_t*)(ws + WS_W13D), rowtok, D, D, D, 0}, S, epi::SwiGLU{hmid}, wid); }
            xcd_barrier(bar);
            PH(16) { PHASE_VARS(0) MOE_VARS moe::Order S{tile_e, ntiles, D / 256, 0, 0, 0}; S.dev_init(G, bid);
              pg8::gemm_phase<moe::ProbDown, epi::MoeDown, moe::Order, true>(lds, moe::ProbDown{hmid, W2, DFF, DFF, DFF, 0}, S, epi::MoeDown{rowdst, roww, yslot}, wid); }
            xcd_barrier(bar);
            PH(17) { PHASE_VARS(0) MOE_VARS thin::moe_combine_body(x1, yslot, modl + 5 * D, outp, gtid, ngt); }
#undef MOE_VARS
        }
    }
    {
        PH(1) { PHASE_VARS(1) thin::norm_body(xin, F(5) + l * D, modl + 0 * D, modl + 1 * D, H, gw, ngw, lane); }
        xcd_barrier(bar);
        PH(2) { PHASE_VARS(1) pg8::DenseProb g{H, (const bf16_t*)(lwb + LW_IN), D, D, D, 0}; pg8::StaticOrder S; S.init(M, INC, G, bid);
          pg8::gemm_phase<pg8::DenseProb, epi::Proj, pg8::StaticOrder, true>(lds, g, S, epi::Proj{PROJ, F(8) + l * 3 * D}, wid); }
        xcd_barrier(bar);
        PH(3) { PHASE_VARS(1) for (int u = bid; u < 256; u += G) { const int grp = u & 3;
            qk::unit(u >> 5, (u >> 2) & 7, grp, PROJ, cs, (grp == 0 ? F(16) : grp == 1 ? F(17) : grp == 2 ? F(23) : F(24)) + l * 64, kmean, (LAS char*)lds, wid); } }
        xcd_barrier(bar);
        {
#define POP_Q() do { __syncthreads(); if (tid == 0) MISC[16] = __hip_atomic_fetch_add((unsigned*)(ws + WS_CTL) + CW_QUEUE + 64 * (l + QOFF), 1u, __ATOMIC_RELAXED, __HIP_MEMORY_SCOPE_AGENT); __syncthreads(); q = (int)MISC[16]; } while (0)
            int q; constexpr int NCVT = (1 == 0) ? NCVT0 : NCVT1;
            { PHASE_VARS(1) POP_Q(); }
            PH(5) { PHASE_VARS(1)
              const float lam_init = 0.8f - 0.6f * expf(-0.3f * (float)l);
              const float lam = diff_lambda(F(18) + l * 64, F(19) + l * 64, F(20) + l * 64, F(21) + l * 64, lam_init, lane);
              const float noff = attn::score_shift(F(16) + l * 64, F(17) + l * 64, lane);
#pragma unroll 1
              while (q < 256) { const int i = q;
                attn::diff_unit((i & 31) >> 2, i & 3, 7 - (i >> 5), PROJ, YABC, F(22) + l * 128, lam, 1.0f - lam_init, noff, (LAS char*)lds, wid);
                POP_Q(); } }
            PH(18) { PHASE_VARS(1)
#pragma unroll 1
              while (q < 256 + NCVT) { __syncthreads(); cvt_unit(CD, l == 0 ? 0 : 8, q - 256, (LAS float*)(lds + wid * 8192), wid, lane);
                POP_Q(); } }
            PH(4) { PHASE_VARS(1)
#pragma unroll 1
              while (q < 256 + NCVT + NQ_RG) { const int i = q - 256 - NCVT;
                rg2::unit(i >> 5, (i >> 1) & 15, i & 1, PROJ, YABC, F(9) + l * 4 * D, F(10) + l * D, F(11) + (size_t)l * 16 * 4096, F(12) + l * D, F(13) + (size_t)l * 16 * 4096, F(14) + l * D, F(15) + l * D, (LAS char*)lds, wid);
                POP_Q(); } }
            PH(6) { PHASE_VARS(1)
              const float noff = attn::score_shift(F(23) + l * 64, F(24) + l * 64, lane);
#pragma unroll 1
              while (q < 256 + NCVT + NQ_RG + 512) { const int i = q - NQ_RG - 256 - NCVT;
                attn::moba_unit((i & 63) >> 3, i & 7, 7 - (i >> 6), PROJ, YABC, kmean, noff, (LAS char*)lds, wid);
                POP_Q(); } }
#undef POP_Q
        }
        xcd_barrier(bar);
        PH(7) { PHASE_VARS(1) pg8::StaticOrder S; S.init(M, D, G, bid); pg8::DenseProb g{YABC, (const bf16_t*)(lwb + LW_BRA), 2048, YW, 2048, 0};
          pg8::gemm_phase<pg8::DenseProb, epi::BranchMerge, pg8::StaticOrder, true>(lds, g, S, epi::BranchMerge{PROJ, H, 16, 24}, wid); }
        xcd_barrier(bar);
        PH(8) { PHASE_VARS(1) pg8::DenseProb g{H, (const bf16_t*)(lwb + LW_OUT), D, D, D, 0}; pg8::StaticOrder S; S.init(M, D, G, bid);
          pg8::gemm_phase<pg8::DenseProb, epi::Resid, pg8::StaticOrder, true>(lds, g, S, epi::Resid{xin, x1, modl + 2 * D}, wid); }
        xcd_barrier(bar);
        if (1 == 0) {
            PH(9) { PHASE_VARS(1) thin::norm_body(x1, F(6) + l * D, modl + 3 * D, modl + 4 * D, H, gw, ngw, lane); }
            xcd_barrier(bar);
            PH(10) { PHASE_VARS(1) pg8::DenseProb g{H, (const bf16_t*)(lwb + LW_W13), D, D, D, 0}; pg8::StaticOrder S; S.init(M, DFF2, G, bid);
              pg8::gemm_phase<pg8::DenseProb, epi::SwiGLU, pg8::StaticOrder, true>(lds, g, S, epi::SwiGLU{PROJ}, wid); }
            xcd_barrier(bar);
            PH(11) { PHASE_VARS(1) pg8::DenseProb g{PROJ, (const bf16_t*)(lwb + LW_W2), DFF, DFF, DFF, 0}; pg8::StaticOrder S; S.init(M, D, G, bid);
              pg8::gemm_phase<pg8::DenseProb, epi::Resid, pg8::StaticOrder, true>(lds, g, S, epi::Resid{x1, x1, modl + 5 * D}, wid); }
            xcd_barrier(bar);
        } else {
#define MOE_VARS \
            bf16_t* W2 = (bf16_t*)(outb + OUT_W2); bf16_t* h2 = H; bf16_t* hmid = (bf16_t*)(ws + WS_HMID_MOE); bf16_t* yslot = YABC; \
            int* topi = (int*)(ws + WS_TOPI); float* topw = (float*)(ws + WS_TOPW); int* rowtok = (int*)(ws + WS_ROWTOK); int* rowdst = (int*)(ws + WS_ROWDST); float* roww = (float*)(ws + WS_ROWW); int* tile_e = (int*)(ws + WS_TILEE); int* ntiles = (int*)(ws + WS_NTILES); \
            (void)W2; (void)h2; (void)hmid; (void)yslot; (void)topi; (void)topw; (void)rowtok; (void)rowdst; (void)roww; (void)tile_e; (void)ntiles;
            PH(12) { PHASE_VARS(1) MOE_VARS thin::norm_router_body(x1, F(6) + l * D, modl + 3 * D, modl + 4 * D, h2, F(32), F(33), topi, topw, gw, ngw, lane); }
            xcd_barrier(bar);
            PH(14) { PHASE_VARS(1) MOE_VARS if (bid == 0) moe::assign(topi, topw, rowtok, rowdst, roww, tile_e, ntiles, (LAS int*)lds, tid); }
            PH(13) if (bid != 0) { PHASE_VARS(1) MOE_VARS LAS float* scr = (LAS float*)(lds + wid * 8192); const int gw2 = (bid - 1) * 8 + wid, ngw2 = (G - 1) * 8;
#pragma unroll 1
              for (int e = 5; e < NE; ++e) { bf16_t* dst = (bf16_t*)((e < 7) ? (char*)ws + WS_W13C + (e - 5) * W13_BYTES : (char*)ws + WS_W13D);
                thin::transpose_matrix(F(34) + (size_t)e * D * DFF, D, DFF, dst, D, 0, 0, 1, scr, gw2, ngw2, lane);
                thin::transpose_matrix(F(35) + (size_t)e * D * DFF, D, DFF, dst, D, 0, 0, 2, scr, gw2, ngw2, lane); } }

            xcd_barrier(bar);
            PH(15) { PHASE_VARS(1) MOE_VARS moe::Order S{tile_e, ntiles, DFF2 / 256, 0, 0, 0}; S.dev_init(G, bid);
              pg8::gemm_phase<moe::ProbUp, epi::SwiGLU, moe::Order, true>(lds, moe::ProbUp{h2, (const bf16_t*)(outb + OUT_W13A), (const bf16_t*)(ws + WS_W13B), (const bf16_t*)(ws + WS_W13C), (const bf16_t*)(ws + WS_W13D), rowtok, D, D, D, 0}, S, epi::SwiGLU{hmid}, wid); }
            xcd_barrier(bar);
            PH(16) { PHASE_VARS(1) MOE_VARS moe::Order S{tile_e, ntiles, D / 256, 0, 0, 0}; S.dev_init(G, bid);
              pg8::gemm_phase<moe::ProbDown, epi::MoeDown, moe::Order, true>(lds, moe::ProbDown{hmid, W2, DFF, DFF, DFF, 0}, S, epi::MoeDown{rowdst, roww, yslot}, wid); }
            xcd_barrier(bar);
            PH(17) { PHASE_VARS(1) MOE_VARS thin::moe_combine_body(x1, yslot, modl + 5 * D, outp, gtid, ngt); }
#undef MOE_VARS
        }
    }
#undef F
#undef PHASE_VARS
}

extern "C" void kernel_launch(void* const* d_in, const int* in_sizes, int n_in, void* d_out, int out_size, void* d_ws, size_t ws_size, hipStream_t stream) {
    static int grid = 0;
    if (grid == 0) {
        if (n_in != 37 || ws_size < WS_END) { fprintf(stderr, "kernel_launch: unexpected n_in %d / ws_size %zu (need %zu)\n", n_in, ws_size, (size_t)WS_END); grid = -1; return; }
        int dev = 0, cus = 0, per_cu = 0;
        if (hipGetDevice(&dev) != hipSuccess || hipDeviceGetAttribute(&cus, hipDeviceAttributeMultiprocessorCount, dev) != hipSuccess) { grid = -1; return; }
        if (hipFuncSetAttribute((const void*)mega_fwd, hipFuncAttributeMaxDynamicSharedMemorySize, LDS_TOTAL) != hipSuccess) { fprintf(stderr, "kernel_launch: hipFuncSetAttribute failed\n"); grid = -1; return; }
        if (hipOccupancyMaxActiveBlocksPerMultiprocessor(&per_cu, (const void*)mega_fwd, 512, LDS_TOTAL) != hipSuccess || per_cu < 1) fprintf(stderr, "kernel_launch: occupancy query says %d\n", per_cu);
        (void)hipGetLastError();
        grid = cus;
    }
    if (grid < 0) return;
    (void)hipMemsetAsync((char*)d_ws + WS_CTL, 0, CTL_ZERO_BYTES, stream);
    Args a{};
    for (int i = 0; i < 37; ++i) a.in[i] = (const float*)d_in[i];
    a.out = (float*)d_out; a.ws = (unsigned char*)d_ws;
    hipLaunchKernelGGL(mega_fwd, dim3(grid), dim3(512), LDS_TOTAL, stream, a);
}
```

```cpp
#include <hip/hip_runtime.h>
#include <stdint.h>
#include <stdio.h>

#define LAS __attribute__((address_space(3)))
typedef unsigned short bf16_t;
typedef short bf16x8 __attribute__((ext_vector_type(8)));
typedef short s16x4 __attribute__((ext_vector_type(4)));
typedef float f32x2 __attribute__((ext_vector_type(2)));
typedef float f32x4 __attribute__((ext_vector_type(4)));
typedef float f32x16 __attribute__((ext_vector_type(16)));
typedef unsigned u32x2 __attribute__((ext_vector_type(2)));
typedef unsigned u32x4 __attribute__((ext_vector_type(4)));

constexpr int D = 1024, NB = 8, SEQ = 2048, M = NB * SEQ, INC = 8192, DFF = 2816, NE = 8, DFF2 = 2 * DFF;
constexpr int C_XR = 0, C_GR = 1024, C_DQ = 2048, C_DK = 2560, C_DV = 3072, C_MQ = 3584, C_MK = 4096, C_MV = 4608, C_GB = 5120;
constexpr int YW = 2048, Y_A = 0, Y_B = 1024, Y_C = 1536;
constexpr float EPS = 1e-6f;
constexpr float QSCALE = 0.125f * 1.4426950408889634f;
constexpr int MOE_MAXROWS = 34816, MOE_MAXTILES = MOE_MAXROWS / 256;

__device__ __forceinline__ float bf2f(unsigned v) { return __uint_as_float(v << 16); }
__device__ __forceinline__ unsigned f2bf(float f) { unsigned u = __float_as_uint(f); return (u + 0x7fffu + ((u >> 16) & 1u)) >> 16; }
__device__ __forceinline__ unsigned pk2(float lo, float hi) { unsigned r; asm volatile("v_cvt_pk_bf16_f32 %0, %1, %2" : "=v"(r) : "v"(lo), "v"(hi)); return r; }
__device__ __forceinline__ float fexp2(float x) { return __builtin_amdgcn_exp2f(x); }
__device__ __forceinline__ float frcp(float x) { return __builtin_amdgcn_rcpf(x); }
__device__ __forceinline__ float sigmoid_f(float x) { return frcp(1.0f + fexp2(-1.4426950408889634f * x)); }
__device__ __forceinline__ float gelu_tanh_f(float x) { return x * sigmoid_f(1.5957691216057308f * (x + 0.044715f * x * x * x)); }
__device__ __forceinline__ float silu_f(float x) { return x * sigmoid_f(x); }
__device__ __forceinline__ float wave_sum(float v) {
#pragma unroll
    for (int o = 1; o < 64; o <<= 1) v += __shfl_xor(v, o);
    return v;
}
__device__ __forceinline__ int lane_fresh() { int l; asm volatile("v_mbcnt_lo_u32_b32 %0, -1, 0\n\tv_mbcnt_hi_u32_b32 %0, -1, %0" : "=v"(l)); return l; }
namespace pg8 {
constexpr int BM = 256, BK = 64, HALF = 128, HTB = HALF * BK * 2  , STAGE_BYTES = 8 * HTB, NXCD = 8, WGM = 8;

__host__ __device__ __forceinline__ int lds_byte(int r, int c) { const int st = (r >> 4) * 2 + (c >> 5), rr = r & 15, cc = c & 31, ob = rr * 64 + cc * 2; return st * 1024 + (ob ^ (((ob >> 9) & 1) << 5)); }
__host__ __device__ __forceinline__ void stage_rc(int b, int& R, int& C) { const int st = b / 1024, sb = b % 1024, swz = sb ^ (((sb >> 9) & 1) << 5); R = (st >> 1) * 16 + swz / 64; C = (st & 1) * 32 + (swz % 64) / 2; }
__host__ __device__ __forceinline__ int perm32(int rho) { const int n = rho >> 4, i = rho & 15; return 8 * (i >> 2) + 4 * n + (i & 3); }

struct Unit { int pm, pn, e, aux; };

struct StaticOrder {
    int nM, nN, nwg, G, c;
    __host__ __device__ void init(int M, int N, int G_, int c_) { nM = M / BM; nN = N / BM; nwg = nM * nN; G = G_; c = c_; }
    __device__ __forceinline__ bool next(int i, Unit& u) const {
        const long L = (long)i * G + c; if (L >= nwg) return false;
        int wgid = (int)L; { const int q = nwg / NXCD, r = nwg % NXCD, xcd = wgid % NXCD, off = wgid / NXCD; wgid = (xcd < r ? xcd * (q + 1) : r * (q + 1) + (xcd - r) * q) + off; }
        const int nig = WGM * nN, gid = wgid / nig, fm = gid * WGM, gsz = (nM - fm) < WGM ? (nM - fm) : WGM;
        u.pm = fm + ((wgid % nig) % gsz); u.pn = (wgid % nig) / gsz; u.e = 0; u.aux = 0; return true;
    }
};

struct RotOrder : StaticOrder {
    __device__ __forceinline__ bool next(int i, Unit& u) const { if (!StaticOrder::next(i, u)) return false; u.pn = (u.pn + 4 * i) % nN; return true; }
};

struct DenseProb {
    static constexpr bool GATHER = false;
    const bf16_t* A; const bf16_t* Bt; int K, lda, ldb, pad;
    __device__ __forceinline__ const char* a_base(const Unit& u) const { return (const char*)A + (size_t)u.pm * BM * lda * 2; }
    __device__ __forceinline__ const char* b_base(const Unit& u) const { return (const char*)Bt + (size_t)u.pn * BM * ldb * 2; }
    __device__ __forceinline__ unsigned a_off(const Unit&, int row, int col) const { return (unsigned)(row * lda + col) * 2u; }
};

template <class Prob, class Epi, class Sched, bool ALIGN_EPI = true>
__device__ __forceinline__ void gemm_phase(LAS unsigned char* lds, const Prob& g, const Sched& S, const Epi& E, int wid) {
    const int lane = lane_fresh(), tid = wid * 64 + lane, wr = wid >> 2, wc = wid & 3, fr = lane & 15, fq = lane >> 4;
    const int K = g.K, nt = K / BK;
    int sR[2], sC[2]; unsigned voffB[2];
#pragma unroll
    for (int i = 0; i < 2; ++i) { int R, C; stage_rc(tid * 16 + i * 8192, R, C); sR[i] = R; sC[i] = C; const int Rb = Epi::PERM ? ((R & ~31) + perm32(R & 31)) : R; voffB[i] = (unsigned)(Rb * g.ldb + C) * 2u; }
    const size_t kstep = (size_t)(BK * 2);
    const size_t hstepB = (size_t)HALF * g.ldb * 2;
    const unsigned ldsw = (unsigned)wid * 1024u;
    const int aoff = lds_byte(wr * 64 + fr, fq * 8), boff = lds_byte(wc * 32 + fr, fq * 8);
#define PG8_SA(b, h) (((b) * 2 + (h)) * HTB)
#define PG8_SB(b, h) ((4 + (b) * 2 + (h)) * HTB)
#define PG8_STAGE(bufoff, gbase, voff) do { _Pragma("unroll") for (int _i = 0; _i < 2; ++_i) \
        __builtin_amdgcn_global_load_lds((const unsigned*)((const char*)(gbase) + (voff)[_i]), (LAS unsigned*)(lds + (bufoff) + ldsw + _i * 8192), 16, 0, 0); } while (0)
#define PG8_LDA(dst, b, h) do { _Pragma("unroll") for (int m = 0; m < 4; ++m) _Pragma("unroll") for (int k = 0; k < 2; ++k) dst[m][k] = *(const LAS bf16x8*)(lds + PG8_SA(b, h) + aoff + m * 2048 + k * 1024); } while (0)
#define PG8_LDB(dst, b, h) do { _Pragma("unroll") for (int n = 0; n < 2; ++n) _Pragma("unroll") for (int k = 0; k < 2; ++k) dst[n][k] = *(const LAS bf16x8*)(lds + PG8_SB(b, h) + boff + n * 2048 + k * 1024); } while (0)
#define PG8_MMA(ai, bj, At, Bt) do { __builtin_amdgcn_s_setprio(1); _Pragma("unroll") for (int m = 0; m < 4; ++m) _Pragma("unroll") for (int n = 0; n < 2; ++n) _Pragma("unroll") for (int k = 0; k < 2; ++k) \
        acc[ai][bj][m][n] = __builtin_amdgcn_mfma_f32_16x16x32_bf16(Bt[n][k], At[m][k], acc[ai][bj][m][n], 0, 0, 0); __builtin_amdgcn_s_setprio(0); } while (0)
#define PG8_WAIT_V(n) asm volatile("s_waitcnt vmcnt(" #n ")" ::: "memory")
#define PG8_WAIT_L(n) asm volatile("s_waitcnt lgkmcnt(" #n ")" ::: "memory")
#define PG8_BAR __builtin_amdgcn_s_barrier()
#define PG8_SCHED __builtin_amdgcn_sched_barrier(0)
    Unit cur, nxt; int ui = 0;
    if (!S.next(0, cur)) return;
    f32x4 acc[2][2][4][2];
#pragma unroll
    for (int a = 0; a < 2; ++a)
#pragma unroll
        for (int b = 0; b < 2; ++b)
#pragma unroll
            for (int m = 0; m < 4; ++m)
#pragma unroll
                for (int n = 0; n < 2; ++n) acc[a][b][m][n] = (f32x4){0.f, 0.f, 0.f, 0.f};
    bf16x8 At[4][2], B0[2][2], B1[2][2];
    unsigned vA[2][2], vN[2][2];
#pragma unroll
    for (int h = 0; h < 2; ++h)
#pragma unroll
        for (int i = 0; i < 2; ++i) { vA[h][i] = g.a_off(cur, h * HALF + sR[i], sC[i]); vN[h][i] = vA[h][i]; }
    const char* cA = g.a_base(cur); const char* cB = g.b_base(cur);
    PG8_STAGE(PG8_SB(0, 0), cB, voffB); PG8_STAGE(PG8_SB(0, 1), cB + hstepB, voffB); PG8_STAGE(PG8_SA(0, 0), cA, vA[0]); PG8_STAGE(PG8_SA(0, 1), cA, vA[1]);
    if (wr == 1) PG8_BAR;
    PG8_WAIT_V(2); PG8_BAR;
    PG8_STAGE(PG8_SB(1, 0), cB + kstep, voffB); PG8_STAGE(PG8_SA(1, 0), cA + kstep, vA[0]); PG8_STAGE(PG8_SB(1, 1), cB + hstepB + kstep, voffB);
    PG8_WAIT_V(6); PG8_BAR;
    for (;;) {
        const bool has_next = S.next(ui + 1, nxt);
        const char* nA = has_next ? g.a_base(nxt) : cA; const char* nB = has_next ? g.b_base(nxt) : cB;
        if (Prob::GATHER) {
#pragma unroll
            for (int h = 0; h < 2; ++h)
#pragma unroll
                for (int i = 0; i < 2; ++i) vN[h][i] = has_next ? g.a_off(nxt, h * HALF + sR[i], sC[i]) : vA[h][i];
        }
        for (int t = 0; t < nt; t += 2) {
            const bool last = (t == nt - 2);
            if constexpr (Epi::KHOOK) { if (t == E.kh1 || t == E.kh2) E.khook(acc, cur, t, wr, wc, fr, fq); }
            const char* a1 = cA + (size_t)(t + 1) * kstep;
            const char* a2 = last ? nA : cA + (size_t)(t + 2) * kstep; const char* b2 = last ? nB : cB + (size_t)(t + 2) * kstep;
            const char* a3 = a2 + kstep; const char* b3 = b2 + kstep;
            unsigned v2[2][2];
#pragma unroll
            for (int h = 0; h < 2; ++h)
#pragma unroll
                for (int i = 0; i < 2; ++i) v2[h][i] = (Prob::GATHER && last) ? vN[h][i] : vA[h][i];
            PG8_LDB(B0, 0, 0); PG8_LDB(B1, 0, 1); PG8_SCHED; PG8_LDA(At, 0, 0); PG8_STAGE(PG8_SA(1, 1), a1, vA[1]);
            PG8_WAIT_V(8); PG8_WAIT_L(0); PG8_BAR; PG8_MMA(0, 0, At, B0); PG8_MMA(0, 1, At, B1); PG8_BAR; PG8_SCHED;
            PG8_LDA(At, 0, 1); PG8_STAGE(PG8_SB(0, 0), b2, voffB); PG8_STAGE(PG8_SB(0, 1), b2 + hstepB, voffB); PG8_STAGE(PG8_SA(0, 0), a2, v2[0]);
            PG8_WAIT_V(8); PG8_WAIT_L(0); PG8_BAR; PG8_MMA(1, 0, At, B0); PG8_MMA(1, 1, At, B1); PG8_BAR; PG8_SCHED;
            PG8_LDB(B0, 1, 0); PG8_LDB(B1, 1, 1); PG8_SCHED; PG8_LDA(At, 1, 0); PG8_STAGE(PG8_SA(0, 1), a2, v2[1]);
            PG8_WAIT_V(8); PG8_WAIT_L(0); PG8_BAR; PG8_MMA(0, 0, At, B0); PG8_MMA(0, 1, At, B1); PG8_BAR; PG8_SCHED;
            PG8_LDA(At, 1, 1); PG8_STAGE(PG8_SB(1, 0), b3, voffB); PG8_STAGE(PG8_SB(1, 1), b3 + hstepB, voffB); PG8_STAGE(PG8_SA(1, 0), a3, v2[0]);
            PG8_WAIT_V(8); PG8_WAIT_L(0); PG8_BAR; PG8_MMA(1, 0, At, B0); PG8_MMA(1, 1, At, B1); PG8_BAR; PG8_SCHED;
        }
        if constexpr (ALIGN_EPI) { if (wr == 0) PG8_BAR; }
        E(acc, cur, wr, wc, fr, fq);
        if (!has_next) break;
#pragma unroll
        for (int a = 0; a < 2; ++a)
#pragma unroll
            for (int b = 0; b < 2; ++b)
#pragma unroll
                for (int m = 0; m < 4; ++m)
#pragma unroll
                    for (int n = 0; n < 2; ++n) acc[a][b][m][n] = (f32x4){0.f, 0.f, 0.f, 0.f};
        cur = nxt; cA = nA; cB = nB; ++ui;
        if (Prob::GATHER) {
#pragma unroll
            for (int h = 0; h < 2; ++h)
#pragma unroll
                for (int i = 0; i < 2; ++i) vA[h][i] = vN[h][i];
        }
        if constexpr (ALIGN_EPI) { if (wr == 1) PG8_BAR; }
    }
    PG8_WAIT_V(0);
    if constexpr (!ALIGN_EPI) { if (wr == 0) PG8_BAR; }
    PG8_BAR;
#undef PG8_SA
#undef PG8_SB
#undef PG8_STAGE
#undef PG8_LDA
#undef PG8_LDB
#undef PG8_MMA
#undef PG8_WAIT_V
#undef PG8_WAIT_L
#undef PG8_BAR
#undef PG8_SCHED
}
}
namespace epi {
using pg8::Unit; using pg8::BM; using pg8::HALF;
typedef const f32x4 (&AccRef)[2][2][4][2];

struct Proj {
    static constexpr bool PERM = true, KHOOK = false;
    bf16_t* O; const float* gate_b;
    __device__ __forceinline__ void operator()(AccRef acc, const Unit& u, int wr, int wc, int fr, int fq) const {
        const int row0 = u.pm * BM + wr * 64 + fr, col0 = u.pn * BM + wc * 32 + 8 * fq;
        const int mode = (u.pn >= 20) ? 2 : ((u.pn >= 4 && u.pn < 8) ? 1 : 0);
        f32x4 bv[2][2];
#pragma unroll
        for (int bj = 0; bj < 2; ++bj)
#pragma unroll
            for (int n = 0; n < 2; ++n) bv[bj][n] = (mode == 2) ? *(const f32x4*)(gate_b + (col0 - C_GB) + bj * HALF + 4 * n) : (f32x4){0.f, 0.f, 0.f, 0.f};
#pragma unroll
        for (int ai = 0; ai < 2; ++ai)
#pragma unroll
            for (int m = 0; m < 4; ++m) { bf16_t* rowp = O + (size_t)(row0 + ai * HALF + m * 16) * INC + col0;
#pragma unroll
                for (int bj = 0; bj < 2; ++bj) { f32x4 v0 = acc[ai][bj][m][0] + bv[bj][0], v1 = acc[ai][bj][m][1] + bv[bj][1];
                    if (mode == 1) {
#pragma unroll
                        for (int j = 0; j < 4; ++j) { v0[j] = gelu_tanh_f(v0[j]); v1[j] = gelu_tanh_f(v1[j]); } }
                    if (mode == 2) {
#pragma unroll
                        for (int j = 0; j < 4; ++j) { v0[j] = sigmoid_f(v0[j]); v1[j] = sigmoid_f(v1[j]); } }
                    u32x4 w; w.x = pk2(v0[0], v0[1]); w.y = pk2(v0[2], v0[3]); w.z = pk2(v1[0], v1[1]); w.w = pk2(v1[2], v1[3]);
                    *(u32x4*)(rowp + bj * HALF) = w; } }
    }
};

template <int STEP> struct Branch {
    static constexpr bool PERM = false, KHOOK = false;
    const bf16_t* proj; float* P; bf16_t* merged;
    __device__ __forceinline__ void operator()(AccRef acc, const Unit& u, int wr, int wc, int fr, int fq) const {
        const int row0 = u.pm * BM + wr * 64 + fr, col0 = u.pn * BM + wc * 32 + 4 * fq;
#pragma unroll
        for (int ai = 0; ai < 2; ++ai)
#pragma unroll
            for (int m = 0; m < 4; ++m) { const size_t row = (size_t)(row0 + ai * HALF + m * 16);
#pragma unroll
                for (int bj = 0; bj < 2; ++bj)
#pragma unroll
                    for (int n = 0; n < 2; ++n) { const int col = col0 + bj * HALF + n * 16;
                        const u32x2 gw = *(const u32x2*)(proj + row * INC + C_GB + STEP * 1024 + col);
                        const f32x4 gv = {bf2f(gw.x & 0xffffu), bf2f(gw.x >> 16), bf2f(gw.y & 0xffffu), bf2f(gw.y >> 16)};
                        f32x4 v = acc[ai][bj][m][n] * gv;
                        float* pp = P + row * D + col;
                        if (STEP >= 1) v += *(const f32x4*)pp;
                        if (STEP <= 1) *(f32x4*)pp = v;
                        else { u32x2 w; w.x = pk2(v[0], v[1]); w.y = pk2(v[2], v[3]); *(u32x2*)(merged + row * D + col) = w; } } }
    }
};

struct Resid {
    static constexpr bool PERM = false, KHOOK = false;
    const float* base; float* out; const float* gate;
    __device__ __forceinline__ void operator()(AccRef acc, const Unit& u, int wr, int wc, int fr, int fq) const {
        const int row0 = u.pm * BM + wr * 64 + fr, col0 = u.pn * BM + wc * 32 + 4 * fq;
        const float* gp = gate + (size_t)((u.pm * BM) / SEQ) * (6 * D) + col0;
        f32x4 gv[2][2];
#pragma unroll
        for (int bj = 0; bj < 2; ++bj)
#pragma unroll
            for (int n = 0; n < 2; ++n) gv[bj][n] = *(const f32x4*)(gp + bj * HALF + n * 16);
#pragma unroll
        for (int ai = 0; ai < 2; ++ai)
#pragma unroll
            for (int m = 0; m < 4; ++m) { const size_t off = (size_t)(row0 + ai * HALF + m * 16) * D + col0;
#pragma unroll
                for (int bj = 0; bj < 2; ++bj)
#pragma unroll
                    for (int n = 0; n < 2; ++n) { const f32x4 bs = *(const f32x4*)(base + off + bj * HALF + n * 16);
                        *(f32x4*)(out + off + bj * HALF + n * 16) = bs + gv[bj][n] * acc[ai][bj][m][n]; } }
    }
};

struct SwiGLU {
    static constexpr bool PERM = true, KHOOK = false;
    bf16_t* O;
    __device__ __forceinline__ void operator()(AccRef acc, const Unit& u, int wr, int wc, int fr, int fq) const {
        const int row0 = u.pm * BM + wr * 64 + fr, col0 = u.pn * HALF + wc * 32 + 8 * fq;
#pragma unroll
        for (int ai = 0; ai < 2; ++ai)
#pragma unroll
            for (int m = 0; m < 4; ++m) { bf16_t* rowp = O + (size_t)(row0 + ai * HALF + m * 16) * DFF + col0;
                f32x4 v0, v1;
#pragma unroll
                for (int j = 0; j < 4; ++j) { v0[j] = silu_f(acc[ai][0][m][0][j]) * acc[ai][1][m][0][j]; v1[j] = silu_f(acc[ai][0][m][1][j]) * acc[ai][1][m][1][j]; }
                u32x4 w; w.x = pk2(v0[0], v0[1]); w.y = pk2(v0[2], v0[3]); w.z = pk2(v1[0], v1[1]); w.w = pk2(v1[2], v1[3]);
                *(u32x4*)rowp = w; }
    }
};

struct MoeDown {
    static constexpr bool PERM = false, KHOOK = false;
    const int* rowdst; const float* roww; bf16_t* yslot;
    __device__ __forceinline__ void operator()(AccRef acc, const Unit& u, int wr, int wc, int fr, int fq) const {
        const int row0 = u.pm * BM + wr * 64 + fr, col0 = u.pn * BM + wc * 32 + 4 * fq;
        int dsts[2][4]; float ws_[2][4];
#pragma unroll
        for (int ai = 0; ai < 2; ++ai)
#pragma unroll
            for (int m = 0; m < 4; ++m) { const int p = row0 + ai * HALF + m * 16; dsts[ai][m] = rowdst[p]; ws_[ai][m] = roww[p]; }
#pragma unroll
        for (int ai = 0; ai < 2; ++ai)
#pragma unroll
            for (int m = 0; m < 4; ++m) { const int dst = dsts[ai][m]; const float w = ws_[ai][m];
                if (dst >= 0) { bf16_t* rowp = yslot + (size_t)dst * D + col0;
#pragma unroll
                    for (int bj = 0; bj < 2; ++bj)
#pragma unroll
                        for (int n = 0; n < 2; ++n) { const f32x4 v = acc[ai][bj][m][n] * w; u32x2 o; o.x = pk2(v[0], v[1]); o.y = pk2(v[2], v[3]); *(u32x2*)(rowp + bj * HALF + n * 16) = o; } } }
    }
};

struct BranchMerge {
    static constexpr bool PERM = true, KHOOK = true;
    const bf16_t* proj; bf16_t* merged; int kh1, kh2;
    typedef f32x4 (&AccMut)[2][2][4][2];
    __device__ __forceinline__ static void unpack8(const u32x4 w, float (&f)[8]) {
        f[0] = bf2f(w.x & 0xffffu); f[1] = bf2f(w.x >> 16); f[2] = bf2f(w.y & 0xffffu); f[3] = bf2f(w.y >> 16); f[4] = bf2f(w.z & 0xffffu); f[5] = bf2f(w.z >> 16); f[6] = bf2f(w.w & 0xffffu); f[7] = bf2f(w.w >> 16); }
    __device__ __forceinline__ void khook(AccMut acc, const Unit& u, int t, int wr, int wc, int fr, int fq) const {
        const int gi = (t == kh1) ? 0 : 1;
        const unsigned off0 = (unsigned)(((u.pm * BM + wr * 64 + fr) * INC + C_GB + gi * 1024 + u.pn * BM + wc * 32 + 8 * fq) * 2);
        const char* pb = (const char*)proj;
#pragma unroll
        for (int ai = 0; ai < 2; ++ai) {
            u32x4 rn[4][2], rd[4][2];
#pragma unroll
            for (int m = 0; m < 4; ++m) { const unsigned off = off0 + (unsigned)((ai * HALF + m * 16) * INC * 2);
#pragma unroll
                for (int bj = 0; bj < 2; ++bj) { rn[m][bj] = *(const u32x4*)(pb + (size_t)(off + bj * HALF * 2)); rd[m][bj] = *(const u32x4*)(pb + (size_t)(off + 2048 + bj * HALF * 2)); } }
#pragma unroll
            for (int m = 0; m < 4; ++m)
#pragma unroll
                for (int bj = 0; bj < 2; ++bj) { float gn[8], gd[8]; unpack8(rn[m][bj], gn); unpack8(rd[m][bj], gd);
#pragma unroll
                    for (int j = 0; j < 4; ++j) { acc[ai][bj][m][0][j] *= gn[j] * frcp(fmaxf(gd[j], 1e-30f)); acc[ai][bj][m][1][j] *= gn[4 + j] * frcp(fmaxf(gd[4 + j], 1e-30f)); } }
            asm volatile("" ::: "memory");
        }
    }
    __device__ __forceinline__ void operator()(AccRef acc, const Unit& u, int wr, int wc, int fr, int fq) const {
        const int row0 = u.pm * BM + wr * 64 + fr, col0 = u.pn * BM + wc * 32 + 8 * fq;
#pragma unroll
        for (int ai = 0; ai < 2; ++ai)
#pragma unroll
            for (int m = 0; m < 4; ++m) { const size_t row = (size_t)(row0 + ai * HALF + m * 16);
#pragma unroll
                for (int bj = 0; bj < 2; ++bj) { float g2[8]; unpack8(*(const u32x4*)(proj + row * INC + C_GB + 2048 + col0 + bj * HALF), g2);
                    const f32x4 v0 = acc[ai][bj][m][0], v1 = acc[ai][bj][m][1];
                    u32x4 w; w.x = pk2(v0[0] * g2[0], v0[1] * g2[1]); w.y = pk2(v0[2] * g2[2], v0[3] * g2[3]); w.z = pk2(v1[0] * g2[4], v1[1] * g2[5]); w.w = pk2(v1[2] * g2[6], v1[3] * g2[7]);
                    *(u32x4*)(merged + row * D + col0 + bj * HALF) = w; } }
    }
};
}
namespace attn {
constexpr int NSLOT = 4, SLOT_K = 8192, SLOT128 = SLOT_K + 16384, SLOT64 = SLOT_K + 8192, LDS_BYTES = NSLOT * SLOT128;
constexpr float NEGF = -1e30f;
__device__ __forceinline__ int crow(int r, int hi) { return (r & 3) + 8 * (r >> 2) + 4 * hi; }
__device__ __forceinline__ float swapmax(float m) { auto rr = __builtin_amdgcn_permlane32_swap(__float_as_uint(m), __float_as_uint(m), false, false); return fmaxf(__uint_as_float(rr[0]), __uint_as_float(rr[1])); }
__device__ __forceinline__ float swapsum(float m) { auto rr = __builtin_amdgcn_permlane32_swap(__float_as_uint(m), __float_as_uint(m), false, false); return __uint_as_float(rr[0]) + __uint_as_float(rr[1]); }
typedef short v4i16_t __attribute__((ext_vector_type(4)));
__device__ __forceinline__ s16x4 vtr(const LAS char* p) { return __builtin_bit_cast(s16x4, __builtin_amdgcn_ds_read_tr16_b64_v4i16((LAS v4i16_t*)p)); }

__device__ __forceinline__ void qk_tile(f32x16& sA, f32x16& sB, const LAS char* Kt, const bf16x8 (&qf)[4], int r, int h, float noff) {
    const LAS char* kb = Kt + h * 1024 + r * 16;
#pragma unroll
    for (int j = 0; j < 16; ++j) { sA[j] = noff; sB[j] = noff; }
    bf16x8 kf[8];
#pragma unroll
    for (int ks = 0; ks < 4; ++ks) { kf[2 * ks] = *(const LAS bf16x8*)(kb + ks * 2048); kf[2 * ks + 1] = *(const LAS bf16x8*)(kb + ks * 2048 + 512); }
    __builtin_amdgcn_sched_barrier(0);
#pragma unroll
    for (int ks = 0; ks < 4; ++ks) {
        sA = __builtin_amdgcn_mfma_f32_32x32x16_bf16(kf[2 * ks], qf[ks], sA, 0, 0, 0);
        sB = __builtin_amdgcn_mfma_f32_32x32x16_bf16(kf[2 * ks + 1], qf[ks], sB, 0, 0, 0);
    }
}
template <int NDB>
__device__ __forceinline__ void pv_tile(f32x16 (&o)[NDB], const LAS char* Vt, const bf16x8 (&pf)[4], int lane) {
    const int h = lane >> 5, q = (lane & 15) >> 2, p = lane & 3, g1 = (lane >> 4) & 1;
    const LAS char* vb = Vt + (4 * h + q) * 64 + (16 * g1 + 4 * p) * 2;
#pragma unroll
    for (int kb = 0; kb < 2; ++kb) {
        bf16x8 vf[2][NDB];
#pragma unroll
        for (int s = 0; s < 2; ++s)
#pragma unroll
            for (int db = 0; db < NDB; ++db) { const int r0 = kb * 32 + 16 * s;
                const s16x4 lo = vtr(vb + r0 * 64 + db * 4096), hi = vtr(vb + (r0 + 8) * 64 + db * 4096);
                vf[s][db] = (bf16x8){lo[0], lo[1], lo[2], lo[3], hi[0], hi[1], hi[2], hi[3]}; }
        __builtin_amdgcn_sched_barrier(0);
#pragma unroll
        for (int s = 0; s < 2; ++s)
#pragma unroll
            for (int db = 0; db < NDB; ++db) o[db] = __builtin_amdgcn_mfma_f32_32x32x16_bf16(pf[kb * 2 + s], vf[s][db], o[db], 0, 0, 0);
    }
}
template <int NDB>
__device__ __forceinline__ void softmax_pv(f32x16& sA, f32x16& sB, f32x16 (&o)[NDB], float& lsum, const LAS char* Vt, int lane) {
    float rs0 = 0.f, rs1 = 0.f;
#pragma unroll
    for (int j = 0; j < 16; ++j) { sA[j] = fexp2(sA[j]); sB[j] = fexp2(sB[j]); rs0 += sA[j]; rs1 += sB[j]; }
    lsum += rs0 + rs1;
    bf16x8 pf[4];
    { u32x4 w;
      w.x = pk2(sA[0], sA[1]); w.y = pk2(sA[2], sA[3]); w.z = pk2(sA[4], sA[5]); w.w = pk2(sA[6], sA[7]); pf[0] = __builtin_bit_cast(bf16x8, w);
      w.x = pk2(sA[8], sA[9]); w.y = pk2(sA[10], sA[11]); w.z = pk2(sA[12], sA[13]); w.w = pk2(sA[14], sA[15]); pf[1] = __builtin_bit_cast(bf16x8, w);
      w.x = pk2(sB[0], sB[1]); w.y = pk2(sB[2], sB[3]); w.z = pk2(sB[4], sB[5]); w.w = pk2(sB[6], sB[7]); pf[2] = __builtin_bit_cast(bf16x8, w);
      w.x = pk2(sB[8], sB[9]); w.y = pk2(sB[10], sB[11]); w.z = pk2(sB[12], sB[13]); w.w = pk2(sB[14], sB[15]); pf[3] = __builtin_bit_cast(bf16x8, w); }
    pv_tile<NDB>(o, Vt, pf, lane);
}
__device__ __forceinline__ float score_shift(const float* gq, const float* gk, int lane) {
    float mq = fabsf(gq[lane]), mk = fabsf(gk[lane]);
#pragma unroll
    for (int o = 1; o < 64; o <<= 1) { mq = fmaxf(mq, __shfl_xor(mq, o)); mk = fmaxf(mk, __shfl_xor(mk, o)); }
    const float bound = QSCALE * 64.0f * mq * mk;
    return -fmaxf(0.f, bound - 24.0f);
}

template <int DV>
__device__ __forceinline__ void dma_tile(const bf16_t* Kg, const bf16_t* Vg, int key0, LAS char* slot, int wid, int lane) {
    __builtin_amdgcn_global_load_lds((const unsigned*)(Kg + (size_t)(key0 + lane) * INC + wid * 8), (LAS unsigned*)(slot + wid * 1024), 16, 0, 0);
#pragma unroll
    for (int i = 0; i < DV / 64; ++i) { const int p = wid + 8 * i, db = p >> 2, rg = p & 3;
        __builtin_amdgcn_global_load_lds((const unsigned*)(Vg + (size_t)(key0 + 16 * rg + (lane >> 2)) * INC + db * 32 + (lane & 3) * 8), (LAS unsigned*)(slot + SLOT_K + p * 1024), 16, 0, 0); }
}
template <int OPS> __device__ __forceinline__ void ring_wait(int ahead) {
    if (ahead >= 2) asm volatile("s_waitcnt vmcnt(%0) lgkmcnt(0)\n\ts_barrier" :: "n"(2 * OPS) : "memory");
    else if (ahead == 1) asm volatile("s_waitcnt vmcnt(%0) lgkmcnt(0)\n\ts_barrier" :: "n"(OPS) : "memory");
    else asm volatile("s_waitcnt vmcnt(0) lgkmcnt(0)\n\ts_barrier" ::: "memory");
}
template <int DV>
__device__ __forceinline__ void causal_pass(f32x16 (&o)[DV / 32], float& lsum, const bf16x8 (&qf)[4], const bf16_t* Kg, const bf16_t* Vg,
                                            int ntiles, int qw0, float noff, LAS char* lds, int tid) {
    constexpr int SLOT = SLOT_K + DV * 128, OPS = 1 + DV / 64;
    const int lane = tid & 63, r = lane & 31, h = lane >> 5, wid = __builtin_amdgcn_readfirstlane(tid >> 6);
    asm volatile("s_waitcnt vmcnt(0) lgkmcnt(0)\n\ts_barrier" ::: "memory");
#pragma unroll
    for (int t = 0; t < 3; ++t) if (t < ntiles) dma_tile<DV>(Kg, Vg, t * 64, lds + t * SLOT, wid, lane);
    __builtin_amdgcn_s_waitcnt(0);
    for (int t = 0; t < ntiles; ++t) {
        ring_wait<OPS>(ntiles - 1 - t);
        if (t + 3 < ntiles) dma_tile<DV>(Kg, Vg, (t + 3) * 64, lds + ((t + 3) & 3) * SLOT, wid, lane);
        const LAS char* slot = lds + (t & 3) * SLOT;
        const int key0 = t * 64;
        if (key0 <= qw0 + 31) {
            f32x16 sA, sB;
            qk_tile(sA, sB, slot, qf, r, h, noff);
            if (key0 + 63 > qw0) {
                const int qpos = qw0 + r;
#pragma unroll
                for (int j = 0; j < 16; ++j) { const int kp = key0 + crow(j, h); if (kp > qpos) sA[j] = NEGF; if (kp + 32 > qpos) sB[j] = NEGF; }
            }
            softmax_pv<DV / 32>(sA, sB, o, lsum, slot + SLOT_K, lane);
        }
    }
}

__device__ __forceinline__ void diff_unit(int b, int hd, int qt, const bf16_t* proj, bf16_t* yabc, const float* subln, float lam, float one_m_laminit, float noff, LAS char* lds, int wid) {
    const int lane = lane_fresh(), tid = wid * 64 + lane, r = lane & 31, h = lane >> 5;
    const int qw0 = qt * 256 + wid * 32;
    const size_t rowb = (size_t)b * SEQ;
    const int ntiles = 4 * (qt + 1);
    unsigned o0p[4][8];
#pragma unroll
    for (int j = 0; j < 2; ++j) {
        const bf16_t* qp = proj + (rowb + qw0 + r) * INC + C_DQ + (hd * 2 + j) * 64 + h * 8;
        bf16x8 qf[4];
#pragma unroll
        for (int ks = 0; ks < 4; ++ks) qf[ks] = *(const bf16x8*)(qp + ks * 16);
        f32x16 o[4];
#pragma unroll
        for (int db = 0; db < 4; ++db)
#pragma unroll
            for (int i = 0; i < 16; ++i) o[db][i] = 0.f;
        float lsum = 0.f;
        causal_pass<128>(o, lsum, qf, proj + rowb * INC + C_DK + (hd * 2 + j) * 64, proj + rowb * INC + C_DV + hd * 128, ntiles, qw0, noff, lds, tid);
        const float il = frcp(swapsum(lsum));
        if (j == 0) {
#pragma unroll
            for (int i = 0; i < 16; i += 2) { const float a0 = __shfl(il, crow(i, h)), a1 = __shfl(il, crow(i + 1, h));
#pragma unroll
                for (int db = 0; db < 4; ++db) o0p[db][i >> 1] = pk2(o[db][i] * a0, o[db][i + 1] * a1); }
        } else {
#pragma unroll
            for (int i = 0; i < 16; ++i) { const float a = __shfl(il, crow(i, h)) * lam;
                float ss = 0.f; float cv[4];
#pragma unroll
                for (int db = 0; db < 4; ++db) { const unsigned w = o0p[db][i >> 1]; const float x0 = (i & 1) ? bf2f(w >> 16) : bf2f(w & 0xffffu); const float c = x0 - o[db][i] * a; cv[db] = c; ss += c * c; }
                ss += __shfl_xor(ss, 1); ss += __shfl_xor(ss, 2); ss += __shfl_xor(ss, 4); ss += __shfl_xor(ss, 8); ss += __shfl_xor(ss, 16);
                const float rn = rsqrtf(ss * (1.0f / 128.0f) + EPS) * one_m_laminit;
                bf16_t* yp = yabc + (rowb + qw0 + crow(i, h)) * YW + Y_B + hd * 128 + r;
#pragma unroll
                for (int db = 0; db < 4; ++db) yp[db * 32] = (bf16_t)f2bf(cv[db] * rn * subln[db * 32 + r]);
            }
        }
    }
}

__device__ __forceinline__ void moba_unit(int b, int hd, int cur, const bf16_t* proj, bf16_t* yabc, const float* kmean, float noff, LAS char* lds, int wid) {
    const int lane = lane_fresh(), tid = wid * 64 + lane, r = lane & 31, h = lane >> 5;
    const int qw0 = cur * 256 + wid * 32;
    const size_t rowb = (size_t)b * SEQ;
    const bf16_t* qp = proj + (rowb + qw0 + r) * INC + C_MQ + hd * 64 + h * 8;
    bf16x8 qf[4];
#pragma unroll
    for (int ks = 0; ks < 4; ++ks) qf[ks] = *(const bf16x8*)(qp + ks * 16);
    unsigned selmask = 0u;
    if (cur > 0) {
        float gate[8];
#pragma unroll
        for (int n = 0; n < 8; ++n) {
            float g = 0.f;
            if (n < cur) {
                const f32x4* km = (const f32x4*)(kmean + ((size_t)((b * 8 + hd) * 8 + n)) * 64 + h * 8);
#pragma unroll
                for (int ks = 0; ks < 4; ++ks) { const f32x4 k0 = km[ks * 4], k1 = km[ks * 4 + 1];
                    g += bf2f((unsigned)(unsigned short)qf[ks][0]) * k0.x + bf2f((unsigned)(unsigned short)qf[ks][1]) * k0.y + bf2f((unsigned)(unsigned short)qf[ks][2]) * k0.z + bf2f((unsigned)(unsigned short)qf[ks][3]) * k0.w
                       + bf2f((unsigned)(unsigned short)qf[ks][4]) * k1.x + bf2f((unsigned)(unsigned short)qf[ks][5]) * k1.y + bf2f((unsigned)(unsigned short)qf[ks][6]) * k1.z + bf2f((unsigned)(unsigned short)qf[ks][7]) * k1.w; }
                g = swapsum(g);
            } else g = -3.0e38f;
            gate[n] = g;
        }
        const int nsel = cur < 3 ? cur : 3;
        for (int s = 0; s < nsel; ++s) {
            float best = -3.0e38f; int bi = 0;
#pragma unroll
            for (int n = 0; n < 8; ++n) { const bool tk = (n < cur) && !((selmask >> n) & 1u) && (gate[n] > best); if (tk) { best = gate[n]; bi = n; } }
            selmask |= 1u << bi;
        }
    }
    f32x16 o[2];
#pragma unroll
    for (int db = 0; db < 2; ++db)
#pragma unroll
        for (int i = 0; i < 16; ++i) o[db][i] = 0.f;
    float lsum = 0.f;
    const bf16_t* Kg = proj + rowb * INC + C_MK + hd * 64; const bf16_t* Vg = proj + rowb * INC + C_MV + hd * 64;
    const int ntiles = 4 * (cur + 1);
#define MOBA_KEY0(T) ((((T) < 4) ? cur : (((T) >> 2) - 1)) * 256 + ((T) & 3) * 64)
    const int widu = wid;
    asm volatile("s_waitcnt vmcnt(0) lgkmcnt(0)\n\ts_barrier" ::: "memory");
#pragma unroll
    for (int t = 0; t < 3; ++t) dma_tile<64>(Kg, Vg, MOBA_KEY0(t), lds + t * SLOT64, widu, lane);
    __builtin_amdgcn_s_waitcnt(0);
    for (int t = 0; t < ntiles; ++t) {
        ring_wait<2>(ntiles - 1 - t);
        if (t + 3 < ntiles) dma_tile<64>(Kg, Vg, MOBA_KEY0(t + 3), lds + ((t + 3) & 3) * SLOT64, widu, lane);
        const LAS char* slot = lds + (t & 3) * SLOT64;
        const int blk = (t < 4) ? cur : (t >> 2) - 1;
        const int key0 = blk * 256 + (t & 3) * 64;
        const bool own = (t < 4);
        const bool lane_on = own ? true : (((selmask >> blk) & 1u) != 0u);
        const bool wave_on = own ? (key0 <= qw0 + 31) : (__any(lane_on) != 0);
        if (wave_on) {
            f32x16 sA, sB;
            qk_tile(sA, sB, slot, qf, r, h, noff);
            if (own) {
                if (key0 + 63 > qw0) {
                    const int qpos = qw0 + r;
#pragma unroll
                    for (int j = 0; j < 16; ++j) { const int kp = key0 + crow(j, h); if (kp > qpos) sA[j] = NEGF; if (kp + 32 > qpos) sB[j] = NEGF; }
                }
            } else if (!lane_on) {
#pragma unroll
                for (int j = 0; j < 16; ++j) { sA[j] = NEGF; sB[j] = NEGF; }
            }
            softmax_pv<2>(sA, sB, o, lsum, slot + SLOT_K, lane);
        }
    }
#undef MOBA_KEY0
    const float il = frcp(swapsum(lsum));
#pragma unroll
    for (int i = 0; i < 16; ++i) { const float a = __shfl(il, crow(i, h));
        bf16_t* yp = yabc + (rowb + qw0 + crow(i, h)) * YW + Y_C + hd * 64 + r;
#pragma unroll
        for (int db = 0; db < 2; ++db) yp[db * 32] = (bf16_t)f2bf(o[db][i] * a); }
}
}
namespace thin {
struct TItem { f32x4 v[8][2]; };
__device__ __forceinline__ void titem_load(TItem& it, const float* W, int N, int item, int lane) {
    const int nblk = N >> 6, kb = item / nblk, nb = item - kb * nblk;
    const float* p = W + (size_t)(kb * 64 + 2 * (lane >> 4)) * N + nb * 64 + 4 * (lane & 15);
#pragma unroll
    for (int i = 0; i < 8; ++i) { it.v[i][0] = *(const f32x4*)(p + (size_t)(8 * i) * N); it.v[i][1] = *(const f32x4*)(p + (size_t)(8 * i + 1) * N); }
}
__device__ __forceinline__ void titem_store(const TItem& it, int N, bf16_t* WT, int ldk, int coff, int row_off, int mode, LAS unsigned* T, int item, int lane) {
    const int nblk = N >> 6, kb = item / nblk, nb = item - kb * nblk, k0 = kb * 64, n0 = nb * 64;
    const int kp = lane >> 4, np = lane & 15;
#pragma unroll
    for (int i = 0; i < 8; ++i) { const int col = (kp + 4 * i) ^ ((np & 7) << 2);
#pragma unroll
        for (int j = 0; j < 4; ++j) T[(4 * np + j) * 32 + col] = pk2(it.v[i][0][j], it.v[i][1][j]); }
    asm volatile("s_waitcnt lgkmcnt(0)" ::: "memory");
    const int c = lane & 7;
#pragma unroll
    for (int j = 0; j < 8; ++j) { const int n = (lane >> 3) + 8 * j;
        const u32x4 o = *(const LAS u32x4*)(T + n * 32 + 4 * (c ^ ((n >> 2) & 7)));
        const int nn = n0 + n; const int row = row_off + (mode == 0 ? nn : ((nn >> 7) * 256 + (mode == 2 ? 128 : 0) + (nn & 127)));
        const bf16_t* dstp = WT + (size_t)row * ldk + coff + k0 + 8 * c;
        asm volatile("global_store_dwordx4 %0, %1, off\n\ts_nop 2" :: "v"(dstp), "v"(o) : "memory"); }
    asm volatile("s_waitcnt lgkmcnt(0)" ::: "memory");
}
__device__ __forceinline__ void transpose_matrix(const float* W, int K, int N, bf16_t* WT, int ldk, int coff, int row_off, int mode, LAS float* scr, int gw, int ngw, int lane) {
    const int nitems = (K >> 6) * (N >> 6);
    LAS unsigned* T = (LAS unsigned*)scr;
    TItem cur;
    int it = gw;
    if (it < nitems) titem_load(cur, W, N, it, lane);
    while (it < nitems) {
        const int nx = it + ngw;
        TItem nxt;
        if (nx < nitems) titem_load(nxt, W, N, nx, lane);
        titem_store(cur, N, WT, ldk, coff, row_off, mode, T, it, lane);
        cur = nxt; it = nx;
    }
}

__device__ __forceinline__ void mod_body(const float* c, const float* ada_w, const float* ada_b, float* mod, int bid, int G, int tid, LAS float* red) {
    for (int cb = bid; cb < (2 * 6 * D) / 48; cb += G) {
        const int kg = tid / 48, jj = tid - kg * 48;
        const int idx = cb * 48 + jj, l = idx / (6 * D), j = idx - l * (6 * D);
        float acc[NB];
#pragma unroll
        for (int b = 0; b < NB; ++b) acc[b] = 0.f;
        if (kg < 8) {
            const float* w = ada_w + (size_t)l * D * 6 * D + (size_t)(kg * 128) * 6 * D + j;
#pragma unroll 16
            for (int k = 0; k < 128; ++k) { const float wv = w[(size_t)k * 6 * D];
#pragma unroll
                for (int b = 0; b < NB; ++b) acc[b] += c[b * D + kg * 128 + k] * wv; }
#pragma unroll
            for (int b = 0; b < NB; ++b) red[(kg * 48 + jj) * NB + b] = acc[b];
        }
        __syncthreads();
        if (tid < 48 * NB) { const int j2 = tid >> 3, b = tid & 7; float s = 0.f;
#pragma unroll
            for (int g = 0; g < 8; ++g) s += red[(g * 48 + j2) * NB + b];
            const int idx2 = cb * 48 + j2, l2 = idx2 / (6 * D), jo = idx2 - l2 * (6 * D);
            mod[((size_t)l2 * NB + b) * 6 * D + jo] = s + ada_b[l2 * 6 * D + jo]; }
        __syncthreads();
    }
}
__device__ __forceinline__ void rope_body(const int* positions, f32x2* cs, int gtid, int ngt) {
    for (int idx = gtid; idx < M * 32; idx += ngt) {
        const int tok = idx >> 5, i = idx & 31;
        const float inv = 1.0f / powf(10000.0f, (float)(2 * i) / 64.0f);
        const float ang = (float)positions[tok] * inv;
        float s, c; sincosf(ang, &s, &c);
        cs[idx] = (f32x2){c, s};
    }
}
template <int R>
__device__ __forceinline__ void norm_rows(const float* xrow, const float* g, const float* shift, const float* scale, bf16_t* orow, int lane, f32x4 (&y)[R][4]) {
    f32x4 v[R][4]; float ss[R];
#pragma unroll
    for (int r = 0; r < R; ++r) { const f32x4* xr = (const f32x4*)(xrow + (size_t)r * D) + lane;
#pragma unroll
        for (int j = 0; j < 4; ++j) v[r][j] = xr[64 * j]; }
#pragma unroll
    for (int r = 0; r < R; ++r) { float s = 0.f;
#pragma unroll
        for (int j = 0; j < 4; ++j) s += (v[r][j].x * v[r][j].x + v[r][j].y * v[r][j].y) + (v[r][j].z * v[r][j].z + v[r][j].w * v[r][j].w);
        ss[r] = s; }
#pragma unroll
    for (int o = 1; o < 64; o <<= 1) {
#pragma unroll
        for (int r = 0; r < R; ++r) ss[r] += __shfl_xor(ss[r], o); }
#pragma unroll
    for (int j = 0; j < 4; ++j) { const int col = 4 * lane + 256 * j;
        const f32x4 gg = *(const f32x4*)(g + col), sc = *(const f32x4*)(scale + col), sh = *(const f32x4*)(shift + col);
        const f32x4 gs = gg * (sc + 1.0f);
#pragma unroll
        for (int r = 0; r < R; ++r) { const float rn = rsqrtf(ss[r] * (1.0f / D) + EPS);
            y[r][j] = v[r][j] * rn * gs + sh;
            u32x2 w; w.x = pk2(y[r][j].x, y[r][j].y); w.y = pk2(y[r][j].z, y[r][j].w); ((u32x2*)(orow + (size_t)r * D) + lane)[64 * j] = w; } }
}
__device__ __forceinline__ void norm_body(const float* x, const float* g, const float* shift, const float* scale, bf16_t* out, int gw, int ngw, int lane) {
    for (int m = gw * 4; m < M; m += ngw * 4) { const int b = m / SEQ; f32x4 y[4][4]; norm_rows<4>(x + (size_t)m * D, g, shift + b * 6 * D, scale + b * 6 * D, out + (size_t)m * D, lane, y); }
}
__device__ __forceinline__ void norm_router_body(const float* x, const float* g, const float* shift, const float* scale, bf16_t* out,
                                                 const float* rw, const float* rb, int* topi, float* topw, int gw, int ngw, int lane) {
    for (int m0 = gw * 2; m0 < M; m0 += ngw * 2) { const int b = m0 / SEQ; f32x4 y[2][4];
        norm_rows<2>(x + (size_t)m0 * D, g, shift + b * 6 * D, scale + b * 6 * D, out + (size_t)m0 * D, lane, y);
        float lg[2][NE];
#pragma unroll
        for (int r = 0; r < 2; ++r)
#pragma unroll
            for (int e = 0; e < NE; ++e) lg[r][e] = 0.f;
#pragma unroll
        for (int j = 0; j < 4; ++j)
#pragma unroll
            for (int q = 0; q < 4; ++q) { const int col = 4 * lane + 256 * j + q; const f32x4 w0 = *(const f32x4*)(rw + col * NE), w1 = *(const f32x4*)(rw + col * NE + 4);
#pragma unroll
                for (int r = 0; r < 2; ++r) { const float hv = y[r][j][q];
                    lg[r][0] += hv * w0.x; lg[r][1] += hv * w0.y; lg[r][2] += hv * w0.z; lg[r][3] += hv * w0.w; lg[r][4] += hv * w1.x; lg[r][5] += hv * w1.y; lg[r][6] += hv * w1.z; lg[r][7] += hv * w1.w; } }
#pragma unroll
        for (int o = 1; o < 64; o <<= 1) {
#pragma unroll
            for (int r = 0; r < 2; ++r)
#pragma unroll
                for (int e = 0; e < NE; ++e) lg[r][e] += __shfl_xor(lg[r][e], o); }
#pragma unroll
        for (int r = 0; r < 2; ++r) { const int m = m0 + r;
#pragma unroll
            for (int e = 0; e < NE; ++e) lg[r][e] += rb[e];
            int i0 = 0; float v0 = lg[r][0];
#pragma unroll
            for (int e = 1; e < NE; ++e) if (lg[r][e] > v0) { v0 = lg[r][e]; i0 = e; }
            int i1 = -1; float v1 = -3.0e38f;
#pragma unroll
            for (int e = 0; e < NE; ++e) if (e != i0 && lg[r][e] > v1) { v1 = lg[r][e]; i1 = e; }
            const float w1v = 1.0f / (1.0f + expf(v0 - v1)), w0v = 1.0f - w1v;
            if (lane == 0) { topi[2 * m] = i0; topi[2 * m + 1] = i1; topw[2 * m] = w0v; topw[2 * m + 1] = w1v; } }
    }
}
__device__ __forceinline__ void qknorm_body(bf16_t* proj, const f32x2* cs, const float* dqn, const float* dkn, const float* mqn, const float* mkn, int gtid, int ngt) {
    for (long idx = gtid; idx < (long)M * 32 * 32; idx += ngt) {
        const int i = (int)(idx & 31); const long pair = idx >> 5; const int hh = (int)(pair & 31); const int tok = (int)(pair >> 5);
        const int grp = hh >> 3, hi = hh & 7;
        const int cb = (grp == 0 ? C_DQ : grp == 1 ? C_DK : grp == 2 ? C_MQ : C_MK) + hi * 64;
        const float* gn = grp == 0 ? dqn : grp == 1 ? dkn : grp == 2 ? mqn : mkn;
        bf16_t* p = proj + (size_t)tok * INC + cb;
        const float x1 = bf2f(p[i]), x2 = bf2f(p[i + 32]);
        float ss = x1 * x1 + x2 * x2;
        ss += __shfl_xor(ss, 1); ss += __shfl_xor(ss, 2); ss += __shfl_xor(ss, 4); ss += __shfl_xor(ss, 8); ss += __shfl_xor(ss, 16);
        const float rn = rsqrtf(ss * (1.0f / 64.0f) + EPS);
        const float y1 = x1 * rn * gn[i], y2 = x2 * rn * gn[i + 32];
        const f32x2 c = cs[(size_t)tok * 32 + i];
        float o1 = y1 * c.x - y2 * c.y, o2 = y2 * c.x + y1 * c.y;
        if ((grp & 1) == 0) { o1 *= QSCALE; o2 *= QSCALE; }
        p[i] = (bf16_t)f2bf(o1); p[i + 32] = (bf16_t)f2bf(o2);
    }
}
__device__ __forceinline__ void kmean_body(const bf16_t* proj, float* kmean, int gw, int ngw, int lane) {
    for (int it = gw; it < NB * 8 * 8; it += ngw) { const int blk = it & 7, hd = (it >> 3) & 7, b = it >> 6;
        const bf16_t* p = proj + ((size_t)b * SEQ + blk * 256) * INC + C_MK + hd * 64 + lane;
        float s = 0.f;
        for (int t = 0; t < 256; ++t) s += bf2f(p[(size_t)t * INC]);
        kmean[(size_t)it * 64 + lane] = s * (1.0f / 256.0f); }
}
__device__ __forceinline__ void moe_combine_body(const float* x1, const bf16_t* yslot, const float* gate, float* out, int gtid, int ngt) {
    for (long idx0 = gtid; idx0 < (long)M * D / 4; idx0 += 4L * ngt) {
        f32x4 xv[4], gv[4]; u32x2 a[4], c[4];
#pragma unroll
        for (int u = 0; u < 4; ++u) { const long idx = idx0 + (long)u * ngt; const int m = (int)(idx >> 8), c4 = (int)(idx & 255) * 4; const int b = m / SEQ;
            xv[u] = *(const f32x4*)(x1 + (size_t)m * D + c4); gv[u] = *(const f32x4*)(gate + b * 6 * D + c4);
            a[u] = *(const u32x2*)(yslot + (size_t)m * D + c4); c[u] = *(const u32x2*)(yslot + ((size_t)M + m) * D + c4); }
#pragma unroll
        for (int u = 0; u < 4; ++u) { const long idx = idx0 + (long)u * ngt; const int m = (int)(idx >> 8), c4 = (int)(idx & 255) * 4;
            const f32x4 y = {bf2f(a[u].x & 0xffffu) + bf2f(c[u].x & 0xffffu), bf2f(a[u].x >> 16) + bf2f(c[u].x >> 16), bf2f(a[u].y & 0xffffu) + bf2f(c[u].y & 0xffffu), bf2f(a[u].y >> 16) + bf2f(c[u].y >> 16)};
            *(f32x4*)(out + (size_t)m * D + c4) = xv[u] + gv[u] * y; }
    }
}
}
namespace qk {
constexpr int LDS_BYTES = 8 * 64 * 8 * 4;
__device__ __forceinline__ void unit(int b, int blk, int grp, bf16_t* proj, const f32x2* cs, const float* gn, float* kmean, LAS char* lds, int wid) {
    const int lane = lane_fresh(), tid = wid * 64 + lane;
    const int hd = lane >> 3, half = (lane >> 2) & 1, j = lane & 3;
    const int cb = (grp == 0 ? C_DQ : grp == 1 ? C_DK : grp == 2 ? C_MQ : C_MK) + hd * 64 + half * 32 + 8 * j;
    float gnv[8];
#pragma unroll
    for (int e = 0; e < 8; ++e) gnv[e] = gn[half * 32 + 8 * j + e];
    const float qs = ((grp & 1) == 0) ? QSCALE : 1.0f;
    const float sgn = half ? 1.0f : -1.0f;
    float ksum[8];
#pragma unroll
    for (int e = 0; e < 8; ++e) ksum[e] = 0.f;
    for (int i0 = 0; i0 < 32; i0 += 4) {
        u32x4 raw[4]; f32x4 cq[4][4];
#pragma unroll
        for (int u = 0; u < 4; ++u) { const size_t tok = (size_t)b * SEQ + blk * 256 + wid + 8 * (i0 + u);
            raw[u] = *(const u32x4*)(proj + tok * INC + cb);
            const f32x4* cp = (const f32x4*)(cs + tok * 32 + 8 * j);
            cq[u][0] = cp[0]; cq[u][1] = cp[1]; cq[u][2] = cp[2]; cq[u][3] = cp[3]; }
#pragma unroll
        for (int u = 0; u < 4; ++u) { const size_t tok = (size_t)b * SEQ + blk * 256 + wid + 8 * (i0 + u);
            float x[8] = {bf2f(raw[u].x & 0xffffu), bf2f(raw[u].x >> 16), bf2f(raw[u].y & 0xffffu), bf2f(raw[u].y >> 16), bf2f(raw[u].z & 0xffffu), bf2f(raw[u].z >> 16), bf2f(raw[u].w & 0xffffu), bf2f(raw[u].w >> 16)};
            float ss = 0.f;
#pragma unroll
            for (int e = 0; e < 8; ++e) ss += x[e] * x[e];
            ss += __shfl_xor(ss, 1); ss += __shfl_xor(ss, 2); ss += __shfl_xor(ss, 4);
            const float rn = rsqrtf(ss * (1.0f / 64.0f) + EPS);
            const float cc[8] = {cq[u][0].x, cq[u][0].z, cq[u][1].x, cq[u][1].z, cq[u][2].x, cq[u][2].z, cq[u][3].x, cq[u][3].z}, sn[8] = {cq[u][0].y, cq[u][0].w, cq[u][1].y, cq[u][1].w, cq[u][2].y, cq[u][2].w, cq[u][3].y, cq[u][3].w};
            float o[8];
#pragma unroll
            for (int e = 0; e < 8; ++e) { const float y = x[e] * rn * gnv[e]; const float py = __shfl_xor(y, 4); o[e] = (y * cc[e] + sgn * py * sn[e]) * qs; }
            u32x4 w; w.x = pk2(o[0], o[1]); w.y = pk2(o[2], o[3]); w.z = pk2(o[4], o[5]); w.w = pk2(o[6], o[7]);
            *(u32x4*)(proj + tok * INC + cb) = w;
            if (grp == 3) { ksum[0] += bf2f(w.x & 0xffffu); ksum[1] += bf2f(w.x >> 16); ksum[2] += bf2f(w.y & 0xffffu); ksum[3] += bf2f(w.y >> 16);
                            ksum[4] += bf2f(w.z & 0xffffu); ksum[5] += bf2f(w.z >> 16); ksum[6] += bf2f(w.w & 0xffffu); ksum[7] += bf2f(w.w >> 16); }
        }
    }
    if (grp == 3) {
        LAS float* red = (LAS float*)lds;
        __syncthreads();
#pragma unroll
        for (int e = 0; e < 8; ++e) red[(wid * 64 + lane) * 8 + e] = ksum[e];
        __syncthreads();
        { const int ln = tid >> 3, e = tid & 7; float s = 0.f;
#pragma unroll
          for (int w = 0; w < 8; ++w) s += red[(w * 64 + ln) * 8 + e];
          const int h2 = ln >> 3, hf = (ln >> 2) & 1, jj = ln & 3;
          kmean[((size_t)((b * 8 + h2) * 8 + blk)) * 64 + hf * 32 + 8 * jj + e] = s * (1.0f / 256.0f); }
        __syncthreads();
    }
}
}
namespace rglru {
constexpr int TT = 32;
constexpr int LDS_WA = 0, LDS_WX = 16384, LDS_XC = 32768, LDS_A = LDS_XC + TT * 65 * 4, LDS_U = LDS_A + TT * 64 * 4, LDS_BYTES = LDS_U + TT * 64 * 4;
__device__ __forceinline__ void unit(int b, int n, const bf16_t* proj, bf16_t* yabc, const float* conv_w, const float* conv_b, const float* wa, const float* ba,
                                     const float* wx, const float* bx, const float* lam, LAS char* lds) {
    int tid_l = threadIdx.x; asm volatile("" : "+v"(tid_l));
    const int tid = tid_l;
    LAS float* Wa = (LAS float*)(lds + LDS_WA); LAS float* Wx = (LAS float*)(lds + LDS_WX); LAS float* XC = (LAS float*)(lds + LDS_XC);
    LAS float* AV = (LAS float*)(lds + LDS_A); LAS float* UV = (LAS float*)(lds + LDS_U);
    __syncthreads();
    for (int i = tid; i < 4096; i += 512) { Wa[i] = wa[(size_t)n * 4096 + i]; Wx[i] = wx[(size_t)n * 4096 + i]; }
    const int cc = tid & 63, ct = tid >> 6;
    const int ch = n * 64 + cc;
    const float cw0 = conv_w[0 * D + ch], cw1 = conv_w[1 * D + ch], cw2 = conv_w[2 * D + ch], cw3 = conv_w[3 * D + ch], cb = conv_b[ch];
    const int gt = tid >> 4, eq = tid & 15;
    float gba[4], gbx[4], gsp[4];
#pragma unroll
    for (int j = 0; j < 4; ++j) { const int e = n * 64 + eq * 4 + j; gba[j] = ba[e]; gbx[j] = bx[e]; const float x = -lam[e]; gsp[j] = fmaxf(x, 0.f) + log1pf(expf(-fabsf(x))); }
    float hstate = 0.f;
    const size_t rowb = (size_t)b * SEQ;
    __syncthreads();
    for (int t0 = 0; t0 < SEQ; t0 += TT) {
#pragma unroll
        for (int i = 0; i < 4; ++i) { const int tt = ct + 8 * i, t = t0 + tt;
            const bf16_t* p = proj + (rowb + t) * INC + C_XR + ch;
            float acc = cb + cw3 * bf2f(p[0]);
            if (t >= 1) acc += cw2 * bf2f(*(p - INC));
            if (t >= 2) acc += cw1 * bf2f(*(p - 2 * INC));
            if (t >= 3) acc += cw0 * bf2f(*(p - 3 * INC));
            XC[tt * 65 + cc] = acc; }
        __syncthreads();
        { f32x4 ar = {0.f, 0.f, 0.f, 0.f}, ai = {0.f, 0.f, 0.f, 0.f};
#pragma unroll 8
          for (int d = 0; d < 64; ++d) { const float xv = XC[gt * 65 + d]; ar += *(const LAS f32x4*)(Wa + d * 64 + eq * 4) * xv; ai += *(const LAS f32x4*)(Wx + d * 64 + eq * 4) * xv; }
#pragma unroll
          for (int j = 0; j < 4; ++j) { const int e = eq * 4 + j;
              const float rg = 1.0f / (1.0f + expf(-(ar[j] + gba[j]))), ig = 1.0f / (1.0f + expf(-(ai[j] + gbx[j])));
              const float log_a = -8.0f * rg * gsp[j]; const float a = expf(log_a); const float mult = sqrtf(-expm1f(2.0f * log_a));
              AV[gt * 64 + e] = a; UV[gt * 64 + e] = mult * ig * XC[gt * 65 + e]; } }
        __syncthreads();
        if (tid < 64) {
            for (int tt = 0; tt < TT; ++tt) { hstate = AV[tt * 64 + tid] * hstate + UV[tt * 64 + tid];
                const size_t row = rowb + t0 + tt;
                const float g = bf2f(proj[row * INC + C_GR + n * 64 + tid]);
                yabc[row * YW + Y_A + n * 64 + tid] = (bf16_t)f2bf(g * hstate); }
        }
        __syncthreads();
    }
}
}

namespace moe {
__device__ __forceinline__ void assign(const int* topi, const float* topw, int* rowtok, int* rowdst, float* roww, int* tile_e, int* ntiles, LAS int* sm, int tid) {
    typedef int i32x4 __attribute__((ext_vector_type(4)));
    const int nthr = 512, per = M / nthr, t0 = tid * per;
    int cnt[NE];
#pragma unroll
    for (int e = 0; e < NE; ++e) cnt[e] = 0;
    { i32x4 a = *(const i32x4*)(topi + 2 * t0), b = *(const i32x4*)(topi + 2 * t0 + 4);
#pragma unroll 1
      for (int i = 0; i < 8; ++i) { i32x4 na = a, nb = b;
        if (i < 7) { na = *(const i32x4*)(topi + 2 * t0 + 8 * (i + 1)); nb = *(const i32x4*)(topi + 2 * t0 + 8 * (i + 1) + 4); }
#pragma unroll
        for (int q = 0; q < 4; ++q)
#pragma unroll
            for (int e = 0; e < NE; ++e) cnt[e] += (a[q] == e) + (b[q] == e);
        a = na; b = nb; } }
#pragma unroll
    for (int e = 0; e < NE; ++e) sm[e * nthr + tid] = cnt[e];
    __syncthreads();
    { const int e = tid >> 6, ln = tid & 63;
      int v[8], s = 0;
#pragma unroll
      for (int i = 0; i < 8; ++i) { v[i] = sm[e * nthr + 8 * ln + i]; s += v[i]; }
      int incl = s;
#pragma unroll
      for (int o = 1; o < 64; o <<= 1) { const int up = __shfl_up(incl, o); if (ln >= o) incl += up; }
      int run = incl - s;
#pragma unroll
      for (int i = 0; i < 8; ++i) { sm[e * nthr + 8 * ln + i] = run; run += v[i]; }
      if (ln == 63) sm[NE * nthr + e] = incl; }
    __syncthreads();
    if (tid == 0) { int p = 0, nt = 0;
        for (int e = 0; e < NE; ++e) { const int tot = sm[NE * nthr + e]; sm[NE * nthr + 8 + e] = p; const int nte = (tot + 255) >> 8; for (int i = 0; i < nte; ++i) tile_e[nt++] = e; p += nte * 256; }
        *ntiles = nt; }
    __syncthreads();
    for (int e = 0; e < NE; ++e) { const int tot = sm[NE * nthr + e], base = sm[NE * nthr + 8 + e], padded = ((tot + 255) >> 8) << 8;
        for (int i = tot + tid; i < padded; i += nthr) { rowtok[base + i] = 0; rowdst[base + i] = -1; roww[base + i] = 0.f; } }
    int pos[NE];
#pragma unroll
    for (int e = 0; e < NE; ++e) pos[e] = sm[NE * nthr + 8 + e] + sm[e * nthr + tid];
    { i32x4 a = *(const i32x4*)(topi + 2 * t0), b = *(const i32x4*)(topi + 2 * t0 + 4); f32x4 wa = *(const f32x4*)(topw + 2 * t0), wb = *(const f32x4*)(topw + 2 * t0 + 4);
#pragma unroll 1
      for (int i = 0; i < 8; ++i) { i32x4 na = a, nb = b; f32x4 nwa = wa, nwb = wb;
        if (i < 7) { na = *(const i32x4*)(topi + 2 * t0 + 8 * (i + 1)); nb = *(const i32x4*)(topi + 2 * t0 + 8 * (i + 1) + 4); nwa = *(const f32x4*)(topw + 2 * t0 + 8 * (i + 1)); nwb = *(const f32x4*)(topw + 2 * t0 + 8 * (i + 1) + 4); }
#pragma unroll
        for (int q = 0; q < 8; ++q) { const int ek = (q < 4) ? a[q & 3] : b[q & 3]; const float wv = (q < 4) ? wa[q & 3] : wb[q & 3]; const int t = t0 + 4 * i + (q >> 1), k = q & 1; int p = 0;
#pragma unroll
            for (int e = 0; e < NE; ++e) { if (ek == e) { p = pos[e]; pos[e] = p + 1; } }
            rowtok[p] = t; rowdst[p] = k * M + t; roww[p] = wv; }
        a = na; b = nb; wa = nwa; wb = nwb; } }
}
struct Order {
    const int* tile_e; const int* ntiles_p; int nN, G, c, ntiles;
    __device__ __forceinline__ void dev_init(int G_, int c_) { G = G_; c = c_; ntiles = *ntiles_p; }
    __device__ __forceinline__ bool next(int i, pg8::Unit& u) const { const int L = i * G + c; if (L >= ntiles * nN) return false; u.pm = L / nN; u.pn = L % nN; u.e = tile_e[u.pm]; u.aux = 0; return true; }
};
struct ProbUp {
    static constexpr bool GATHER = true;
    const bf16_t* A; const bf16_t* Ba; const bf16_t* Bb; const bf16_t* Bc; const bf16_t* Bd; const int* rowtok; int K, lda, ldb, pad;
    __device__ __forceinline__ const char* a_base(const pg8::Unit&) const { return (const char*)A; }
    __device__ __forceinline__ const char* b_base(const pg8::Unit& u) const {
        const char* base = (u.e == 0) ? (const char*)Ba : (u.e < 5) ? (const char*)Bb + (size_t)(u.e - 1) * DFF2 * ldb * 2 : (u.e < 7) ? (const char*)Bc + (size_t)(u.e - 5) * DFF2 * ldb * 2 : (const char*)Bd;
        return base + (size_t)u.pn * 256 * ldb * 2; }
    __device__ __forceinline__ unsigned a_off(const pg8::Unit& u, int row, int col) const { return (unsigned)(rowtok[u.pm * 256 + row] * lda + col) * 2u; }
};
struct ProbDown {
    static constexpr bool GATHER = false;
    const bf16_t* A; const bf16_t* Bt; int K, lda, ldb, pad;
    __device__ __forceinline__ const char* a_base(const pg8::Unit& u) const { return (const char*)A + (size_t)u.pm * 256 * lda * 2; }
    __device__ __forceinline__ const char* b_base(const pg8::Unit& u) const { return (const char*)Bt + ((size_t)u.e * D + (size_t)u.pn * 256) * ldb * 2; }
    __device__ __forceinline__ unsigned a_off(const pg8::Unit&, int row, int col) const { return (unsigned)(row * lda + col) * 2u; }
};
}
namespace rg2 {
constexpr int TT = 128, XS = 144  , FS = 36  ;
constexpr int L_XCB = 0, L_XCF = L_XCB + TT * XS, L_AV = L_XCF + TT * FS * 4, L_UV = L_AV + TT * FS * 4, L_WA = L_UV + TT * FS * 4, L_WX = L_WA + 32 * XS,
              L_CW = L_WX + 32 * XS, L_SEGA = L_CW + 5 * 64 * 4, L_SEGH = L_SEGA + 16 * 32 * 4, L_CARRY = L_SEGH + 16 * 32 * 4, LDS_BYTES = L_CARRY + 2 * 32 * 4;
__device__ __forceinline__ void unit(int b, int n, int hf, const bf16_t* proj, bf16_t* yabc, const float* conv_w, const float* conv_b, const float* wa, const float* ba,
                                     const float* wx, const float* bx, const float* lam, LAS char* lds, int wid) {
    const int lane = lane_fresh(), tid = wid * 64 + lane;
    LAS float* XCF = (LAS float*)(lds + L_XCF); LAS float* AV = (LAS float*)(lds + L_AV); LAS float* UV = (LAS float*)(lds + L_UV);
    LAS float* CW = (LAS float*)(lds + L_CW); LAS float* SEGA = (LAS float*)(lds + L_SEGA); LAS float* SEGH = (LAS float*)(lds + L_SEGH); LAS float* CARRY = (LAS float*)(lds + L_CARRY);
    const int ch0 = n * 64;
    const int oc0 = ch0 + hf * 32;
    __syncthreads();
    for (int i = tid; i < 2048; i += 512) { const int d = i >> 5, e = i & 31;
        *(LAS bf16_t*)(lds + L_WA + e * XS + d * 2) = (bf16_t)f2bf(wa[(size_t)n * 4096 + d * 64 + hf * 32 + e]);
        *(LAS bf16_t*)(lds + L_WX + e * XS + d * 2) = (bf16_t)f2bf(wx[(size_t)n * 4096 + d * 64 + hf * 32 + e]); }
    if (tid < 320) { const int k = tid >> 6, c = tid & 63; CW[tid] = (k < 4) ? conv_w[k * D + ch0 + c] : conv_b[ch0 + c]; }
    if (tid < 64) CARRY[tid] = 0.f;
    const int crow_ = tid >> 2, cg = tid & 3;
    const int mt = wid & 3, chh = wid >> 2;
    const int g4 = lane >> 4, e16 = lane & 15;
    const int eo = chh * 16 + e16;
    const float gba = ba[oc0 + eo], gbx = bx[oc0 + eo];
    float gk1; { const float x = -lam[oc0 + eo]; gk1 = -8.0f * 1.4426950408889634f * (fmaxf(x, 0.f) + log1pf(expf(-fabsf(x)))); }
    const int sc = tid & 31, ss = tid >> 5;
    const size_t rowb = (size_t)b * SEQ;
    const bf16_t* xbase = proj + rowb * INC + C_XR + ch0 + cg * 16;
    const bf16_t* gbase = proj + rowb * INC + C_GR + oc0 + sc;
    bf16_t* ybase = yabc + rowb * YW + Y_A + oc0 + sc;
    u32x4 xr[4][2]; unsigned short gv[8];
#define RG2_LOADX(T0) do { _Pragma("unroll") for (int k = 0; k < 4; ++k) { const int t = (T0) + crow_ - 3 + k; \
        if (t >= 0) { const bf16_t* p = xbase + (size_t)t * INC; xr[k][0] = *(const u32x4*)p; xr[k][1] = *(const u32x4*)(p + 8); } \
        else { xr[k][0] = (u32x4){0u, 0u, 0u, 0u}; xr[k][1] = (u32x4){0u, 0u, 0u, 0u}; } } } while (0)
    RG2_LOADX(0);
    __syncthreads();
    for (int ti = 0; ti < SEQ / TT; ++ti) {
        const int t0 = ti * TT;
        {
            float xc[16];
#pragma unroll
            for (int j = 0; j < 16; ++j) xc[j] = CW[4 * 64 + cg * 16 + j];
#pragma unroll
            for (int k = 0; k < 4; ++k) {
#pragma unroll
                for (int q = 0; q < 2; ++q) { const u32x4 w = xr[k][q]; const unsigned ww[4] = {w.x, w.y, w.z, w.w};
#pragma unroll
                    for (int j = 0; j < 4; ++j) { const int c = q * 8 + 2 * j;
                        xc[c] += CW[k * 64 + cg * 16 + c] * bf2f(ww[j] & 0xffffu); xc[c + 1] += CW[k * 64 + cg * 16 + c + 1] * bf2f(ww[j] >> 16); } } }
            u32x4 o0, o1;
            o0.x = pk2(xc[0], xc[1]); o0.y = pk2(xc[2], xc[3]); o0.z = pk2(xc[4], xc[5]); o0.w = pk2(xc[6], xc[7]);
            o1.x = pk2(xc[8], xc[9]); o1.y = pk2(xc[10], xc[11]); o1.z = pk2(xc[12], xc[13]); o1.w = pk2(xc[14], xc[15]);
            *(LAS u32x4*)(lds + L_XCB + crow_ * XS + cg * 32) = o0; *(LAS u32x4*)(lds + L_XCB + crow_ * XS + cg * 32 + 16) = o1;
            if ((cg >> 1) == hf) { LAS float* d = XCF + crow_ * FS + (cg & 1) * 16;
#pragma unroll
                for (int j = 0; j < 4; ++j) *(LAS f32x4*)(d + 4 * j) = (f32x4){xc[4 * j], xc[4 * j + 1], xc[4 * j + 2], xc[4 * j + 3]}; }
        }
#pragma unroll
        for (int k = 0; k < 8; ++k) gv[k] = gbase[(size_t)(t0 + ss * 8 + k) * INC];
        __syncthreads();
        if (ti + 1 < SEQ / TT) RG2_LOADX(t0 + TT);
        {
            f32x4 ar[2], ai[2];
#pragma unroll
            for (int s = 0; s < 2; ++s) { ar[s] = (f32x4){0.f, 0.f, 0.f, 0.f}; ai[s] = (f32x4){0.f, 0.f, 0.f, 0.f}; }
#pragma unroll
            for (int kk = 0; kk < 2; ++kk) {
                const bf16x8 bwa = *(const LAS bf16x8*)(lds + L_WA + eo * XS + (32 * kk + 8 * g4) * 2);
                const bf16x8 bwx = *(const LAS bf16x8*)(lds + L_WX + eo * XS + (32 * kk + 8 * g4) * 2);
#pragma unroll
                for (int s = 0; s < 2; ++s) {
                    const bf16x8 av = *(const LAS bf16x8*)(lds + L_XCB + (mt * 32 + 16 * s + e16) * XS + (32 * kk + 8 * g4) * 2);
                    ar[s] = __builtin_amdgcn_mfma_f32_16x16x32_bf16(av, bwa, ar[s], 0, 0, 0);
                    ai[s] = __builtin_amdgcn_mfma_f32_16x16x32_bf16(av, bwx, ai[s], 0, 0, 0);
                }
            }
#pragma unroll
            for (int s = 0; s < 2; ++s)
#pragma unroll
                for (int rg = 0; rg < 4; ++rg) {
                    const int tok = mt * 32 + 16 * s + 4 * g4 + rg;
                    const float er = fexp2(-1.4426950408889634f * (ar[s][rg] + gba)) + 1.0f, ei = fexp2(-1.4426950408889634f * (ai[s][rg] + gbx)) + 1.0f;
                    const float pr = frcp(er * ei);
                    const float rgt = ei * pr, igt = er * pr;
                    const float a = fexp2(rgt * gk1);
                    const float om = fmaxf(1.0f - a * a, 0.f);
                    const float u = __builtin_amdgcn_sqrtf(om) * igt * XCF[tok * FS + eo];
                    AV[tok * FS + eo] = a; UV[tok * FS + eo] = u;
                }
        }
        __syncthreads();
        float hl[8], ac[8];
        { float Hh = 0.f, Aa = 1.f;
#pragma unroll
          for (int k = 0; k < 8; ++k) { const float a = AV[(ss * 8 + k) * FS + sc], u = UV[(ss * 8 + k) * FS + sc]; Hh = a * Hh + u; Aa *= a; hl[k] = Hh; ac[k] = Aa; }
          SEGA[ss * 32 + sc] = Aa; SEGH[ss * 32 + sc] = Hh; }
        __syncthreads();
        { float cin = CARRY[(ti & 1) * 32 + sc];
#pragma unroll
          for (int s2 = 0; s2 < 15; ++s2) { const float sa = SEGA[s2 * 32 + sc], sh = SEGH[s2 * 32 + sc]; cin = (s2 < ss) ? sa * cin + sh : cin; }
#pragma unroll
          for (int k = 0; k < 8; ++k) { const float hv = hl[k] + ac[k] * cin; hl[k] = hv;
              ybase[(size_t)(t0 + ss * 8 + k) * YW] = (bf16_t)f2bf(bf2f(gv[k]) * hv); }
          if (ss == 15) CARRY[((ti + 1) & 1) * 32 + sc] = hl[7]; }
    }
    __syncthreads();
#undef RG2_LOADX
}
}
constexpr size_t MiB = 1u << 20;
constexpr size_t WS_CTL = 0, CTL_ZERO_BYTES = 64 * 1024, WS_ROWTOK = 256 * 1024, WS_ROWDST = 400 * 1024, WS_ROWW = 544 * 1024, WS_TILEE = 700 * 1024, WS_NTILES = 702 * 1024;
constexpr size_t WS_MOD = 1 * MiB, WS_CS = 1 * MiB + 512 * 1024, WS_KMEAN = 5 * MiB + 512 * 1024, WS_TOPI = 5 * MiB + 640 * 1024, WS_TOPW = 5 * MiB + 768 * 1024;
constexpr size_t WS_L1W = 6 * MiB, WS_H = 28 * MiB, WS_YABC = 60 * MiB, WS_PROJ = 124 * MiB, WS_XA = 380 * MiB, WS_SPARE = 444 * MiB, WS_END = 488 * MiB;
constexpr size_t WS_HMID_MOE = 138 * MiB, OUT_W2 = 0, OUT_W13A = 44 * MiB, WS_W13B = 444 * MiB, WS_W13C = 6 * MiB, WS_W13D = 124 * MiB, W13_BYTES = 11 * MiB, W2_BYTES = 5 * MiB + 512 * 1024;
constexpr size_t LW_IN = 0, LW_BRA = 16 * MiB, LW_BRB = 18 * MiB, LW_BRC = 19 * MiB, LW_OUT = 20 * MiB, LW_W13 = 22 * MiB, LW_W2 = 33 * MiB;
constexpr int CW_TMO = 0, CW_QUEUE = 64  , CW_BAR = 4096;
constexpr int LDS_MISC = 131072 + 8192, LDS_TOTAL = 147456;


#define XB_TMO      128
#define XB_XCNT(j)  (256  + 64 * (j))
#define XB_XSUB(j)  (1280 + 64 * (j))
#define XB_XGEN(j)  (2304 + 64 * (j))
#define XB_TOP      3328
#define XB_TOPGEN   3392
#define XCD_BAR_WORDS 3456
#define XB_SPIN_CAP (1u << 18)

__device__ __forceinline__ unsigned xb_ld(unsigned* p)              { return __hip_atomic_load(p, __ATOMIC_RELAXED, __HIP_MEMORY_SCOPE_AGENT); }
__device__ __forceinline__ unsigned xb_add(unsigned* p, unsigned v) { return __hip_atomic_fetch_add(p, v, __ATOMIC_RELAXED, __HIP_MEMORY_SCOPE_AGENT); }
__device__ __forceinline__ unsigned xb_xcc_id() { return (unsigned)__builtin_amdgcn_s_getreg((3 << 11) | 20) & 0xFu; }
#define XB_SPIN(cond, bar) do { unsigned _sp = 0; while (cond) { __builtin_amdgcn_s_sleep(1); \
    if ((++_sp & 255u) == 0u) { if (xb_ld(&(bar)[XB_TMO])) break; if (_sp > XB_SPIN_CAP) { atomicAdd(&(bar)[XB_TMO], 1u); break; } } } } while (0)

struct XcdBarrier {
    unsigned* bar; unsigned x;
    volatile LAS unsigned* st;
};

__device__ __forceinline__ XcdBarrier xcd_barrier_post(unsigned* bar, volatile LAS unsigned* st) {
    XcdBarrier b; b.bar = bar; b.x = xb_xcc_id(); b.st = st;
    if (threadIdx.x == 0) (void)xb_add(&bar[XB_XCNT(b.x)], 1u);
    return b;
}
__device__ __forceinline__ void xcd_barrier_complete(unsigned* bar, unsigned x, unsigned& nloc, unsigned& nx) {
    const unsigned G = gridDim.x * gridDim.y * gridDim.z;
    unsigned sum, cnt, mine, sp = 0u;
    for (;;) {
        sum = 0u; cnt = 0u; mine = 0u;
#pragma unroll
        for (unsigned j = 0; j < 16; ++j) { const unsigned c = xb_ld(&bar[XB_XCNT(j)]); sum += c; cnt += (c > 0u) ? 1u : 0u; mine = (j == x) ? c : mine; }
        if (sum == G) break;
        __builtin_amdgcn_s_sleep(1);
        if ((++sp & 255u) == 0u) { if (xb_ld(&bar[XB_TMO])) break; if (sp > XB_SPIN_CAP) { atomicAdd(&bar[XB_TMO], 1u); break; } }
    }
    nloc = mine > 0u ? mine : 1u; nx = cnt > 0u ? cnt : 1u;
}

__device__ __forceinline__ void xcd_barrier(const XcdBarrier& b) {
    asm volatile("s_waitcnt vmcnt(0)" ::: "memory");
    __syncthreads();
    if (threadIdx.x == 0) {
        unsigned* bar = b.bar;
        __builtin_amdgcn_s_waitcnt(0);
        unsigned nloc = b.st[0], nx = b.st[1];
        if (nloc == 0u) { xcd_barrier_complete(bar, b.x, nloc, nx); b.st[0] = nloc; b.st[1] = nx; }
        const unsigned old = xb_add(&bar[XB_XSUB(b.x)], 1u);
        const unsigned gen = old / nloc;
        if (old + 1u == (gen + 1u) * nloc) {
            __builtin_amdgcn_fence(__ATOMIC_RELEASE, "agent");
            asm volatile("s_waitcnt vmcnt(0)" ::: "memory");
            const unsigned og = xb_add(&bar[XB_TOP], 1u);
            const unsigned tg = og / nx;
            if (og + 1u == (tg + 1u) * nx) xb_add(&bar[XB_TOPGEN], 1u);
            else XB_SPIN(xb_ld(&bar[XB_TOPGEN]) == tg, bar);
            __builtin_amdgcn_fence(__ATOMIC_ACQUIRE, "agent");
            xb_add(&bar[XB_XGEN(b.x)], 1u);
            asm volatile("s_waitcnt vmcnt(0)" ::: "memory");
        } else {
            XB_SPIN(xb_ld(&bar[XB_XGEN(b.x)]) == gen, bar);
            __builtin_amdgcn_fence(__ATOMIC_ACQUIRE, "agent");
            asm volatile("s_waitcnt vmcnt(0)" ::: "memory");
        }
    }
    __syncthreads();
}


#ifndef PHMASK
#define PHMASK 0xFFFFF
#endif
#define PH(k) if constexpr ((PHMASK >> (k)) & 1)
#define QOFF 0
__device__ __forceinline__ const float* ldptr(const LAS unsigned long long* PT, int i) {
    const unsigned long long v = PT[i];
    const unsigned lo = __builtin_amdgcn_readfirstlane((unsigned)v), hi = __builtin_amdgcn_readfirstlane((unsigned)(v >> 32));
    return (const float*)(const __attribute__((address_space(1))) float*)(((unsigned long long)hi << 32) | lo);
}
struct CvtD { unsigned long long src, dst; int K, N, ldk, coff, row_off, mode, nunits, pad; };
__device__ __forceinline__ void cvt_unit(const LAS CvtD* cd, int first, int u, LAS float* scr, int wid, int lane) {
    int d = first;
    while (u >= cd[d].nunits) { u -= cd[d].nunits; ++d; }
    const float* W = (const float*)(const __attribute__((address_space(1))) float*)cd[d].src; bf16_t* WT = (bf16_t*)(__attribute__((address_space(1))) bf16_t*)cd[d].dst;
    const int N = cd[d].N, ldk = cd[d].ldk, coff = cd[d].coff, row_off = cd[d].row_off, mode = cd[d].mode;
    LAS unsigned* T = (LAS unsigned*)scr;
    thin::TItem t0, t1, t2;
    thin::titem_load(t0, W, N, 64 * u + wid, lane); thin::titem_load(t1, W, N, 64 * u + wid + 8, lane);
#pragma unroll 1
    for (int i = 0; i < 8; i += 3) { const int it = 64 * u + wid + 8 * i;
        if (i + 2 < 8) thin::titem_load(t2, W, N, it + 16, lane);
        thin::titem_store(t0, N, WT, ldk, coff, row_off, mode, T, it, lane);
        if (i + 3 < 8) thin::titem_load(t0, W, N, it + 24, lane);
        if (i + 1 < 8) thin::titem_store(t1, N, WT, ldk, coff, row_off, mode, T, it + 8, lane);
        if (i + 4 < 8) thin::titem_load(t1, W, N, it + 32, lane);
        if (i + 2 < 8) thin::titem_store(t2, N, WT, ldk, coff, row_off, mode, T, it + 16, lane); }
}
struct Args { const float* in[37]; float* out; unsigned char* ws; };

__device__ __forceinline__ float diff_lambda(const float* lq1, const float* lk1, const float* lq2, const float* lk2, float lam_init, int lane) {
    const float s1 = wave_sum(lq1[lane] * lk1[lane]), s2 = wave_sum(lq2[lane] * lk2[lane]); return expf(s1) - expf(s2) + lam_init; }

constexpr int NQ_RG = 256;
constexpr int NCVT0 = 77, NCVT1 = 198;
__global__ void __launch_bounds__(512, 2) mega_fwd(Args a) {
    extern __shared__ __attribute__((aligned(16))) unsigned char lds_raw[];
    LAS unsigned char* lds = (LAS unsigned char*)lds_raw;
    volatile LAS unsigned* MISC = (volatile LAS unsigned*)(lds + LDS_MISC);
    const int tid0 = threadIdx.x, wid0 = __builtin_amdgcn_readfirstlane(tid0 >> 6);
    const int G = gridDim.x, bid = blockIdx.x;
    if (tid0 < 64) MISC[tid0] = 0u;
    LAS unsigned long long* PT = (LAS unsigned long long*)(lds + LDS_MISC + 256);
    if (tid0 == 0) {
#pragma unroll
        for (int i = 0; i < 37; ++i) PT[i] = (unsigned long long)a.in[i];
    }
    LAS CvtD* CD = (LAS CvtD*)(lds + LDS_MISC + 1024);
    if (tid0 == 64) {
        const unsigned long long wsb = (unsigned long long)a.ws, ob = (unsigned long long)a.out;
#define CVT_PUT(i, SRC, DST, K_, N_, LDK, COFF, MODE) do { CD[i].src = (unsigned long long)(SRC); CD[i].dst = (DST); CD[i].K = (K_); CD[i].N = (N_); CD[i].ldk = (LDK); CD[i].coff = (COFF); CD[i].row_off = 0; CD[i].mode = (MODE); CD[i].nunits = ((K_) >> 6) * ((N_) >> 6) / 64; CD[i].pad = 0; } while (0)
        CVT_PUT(0, a.in[7] + (size_t)D * INC, wsb + WS_L1W + LW_IN, D, INC, D, 0, 0);
        CVT_PUT(1, a.in[25] + (size_t)D * D, wsb + WS_L1W + LW_BRA, D, D, 2048, 0, 0);
        CVT_PUT(2, a.in[26] + (size_t)512 * D, wsb + WS_L1W + LW_BRA, 512, D, 2048, 1024, 0);
        CVT_PUT(3, a.in[27] + (size_t)512 * D, wsb + WS_L1W + LW_BRA, 512, D, 2048, 1536, 0);
        CVT_PUT(4, a.in[28] + (size_t)D * D, wsb + WS_L1W + LW_OUT, D, D, D, 0, 0);
        CVT_PUT(5, a.in[29], ob + LW_W13, D, DFF, D, 0, 1);
        CVT_PUT(6, a.in[30], ob + LW_W13, D, DFF, D, 0, 2);
        CVT_PUT(7, a.in[31], ob + LW_W2, DFF, D, DFF, 0, 0);
#pragma unroll
        for (int e = 0; e < NE; ++e) CVT_PUT(8 + e, a.in[36] + (size_t)e * DFF * D, ob + OUT_W2 + e * W2_BYTES, DFF, D, DFF, 0, 0);
#pragma unroll
        for (int e = 0; e < 5; ++e) { const unsigned long long dst = (e == 0) ? ob + OUT_W13A : wsb + WS_W13B + (e - 1) * W13_BYTES;
            CVT_PUT(16 + 2 * e, a.in[34] + (size_t)e * D * DFF, dst, D, DFF, D, 0, 1); CVT_PUT(17 + 2 * e, a.in[35] + (size_t)e * D * DFF, dst, D, DFF, D, 0, 2); }
#undef CVT_PUT
    }
    __syncthreads();
    XcdBarrier bar = xcd_barrier_post((unsigned*)(a.ws + WS_CTL) + CW_BAR, MISC + 8);
#define F(i) ldptr(PT, (i))
#define PHASE_VARS(lv) \
    unsigned long long ws_u = (unsigned long long)a.ws, out_u = (unsigned long long)a.out; const int l = (lv); int wid = wid0; \
    asm volatile("" : "+s"(ws_u), "+s"(out_u), "+s"(wid)); \
    const int lane = lane_fresh(), tid = wid * 64 + lane; \
    unsigned char* ws = (unsigned char*)(__attribute__((address_space(1))) unsigned char*)ws_u; float* outp = (float*)(__attribute__((address_space(1))) float*)out_u; \
    const int gw = bid * 8 + wid, ngw = G * 8, gtid = bid * 512 + tid, ngt = G * 512; (void)gw; (void)ngw; (void)gtid; (void)ngt; (void)lane; (void)l; (void)tid; \
    char* outb = (char*)outp; (void)outb; \
    float* mod = (float*)(ws + WS_MOD); f32x2* cs = (f32x2*)(ws + WS_CS); float* kmean = (float*)(ws + WS_KMEAN); (void)mod; (void)cs; (void)kmean; \
    bf16_t* H = (bf16_t*)(ws + WS_H); bf16_t* YABC = (bf16_t*)(ws + WS_YABC); bf16_t* PROJ = (bf16_t*)(ws + WS_PROJ); float* XA = (float*)(ws + WS_XA); (void)H; (void)YABC; (void)PROJ; (void)XA; \
    const float* xin = (l == 0) ? F(0) : (const float*)XA; float* x1 = XA; const char* lwb = (l == 0) ? (const char*)outb : (const char*)ws + WS_L1W; \
    const float* modl = mod + (size_t)l * NB * 6 * D; (void)xin; (void)x1; (void)lwb; (void)modl;

    PH(0) { PHASE_VARS(0)
        LAS float* scr = (LAS float*)(lds + wid * 8192);
        thin::transpose_matrix(F(7), D, INC, (bf16_t*)(outb + LW_IN), D, 0, 0, 0, scr, gw, ngw, lane);
        thin::transpose_matrix(F(25), D, D, (bf16_t*)(outb + LW_BRA), 2048, 0, 0, 0, scr, gw, ngw, lane);
        thin::transpose_matrix(F(26), 512, D, (bf16_t*)(outb + LW_BRA), 2048, 1024, 0, 0, scr, gw, ngw, lane);
        thin::transpose_matrix(F(27), 512, D, (bf16_t*)(outb + LW_BRA), 2048, 1536, 0, 0, scr, gw, ngw, lane);
        thin::transpose_matrix(F(28), D, D, (bf16_t*)(outb + LW_OUT), D, 0, 0, 0, scr, gw, ngw, lane);
        __syncthreads();
        thin::mod_body(F(1), F(3), F(4), mod, bid, G, tid, (LAS float*)(lds + 65536));
        thin::rope_body((const int*)F(2), cs, gtid, ngt);
    }
    xcd_barrier(bar);

    {
        PH(1) { PHASE_VARS(0) thin::norm_body(xin, F(5) + l * D, modl + 0 * D, modl + 1 * D, H, gw, ngw, lane); }
        xcd_barrier(bar);
        PH(2) { PHASE_VARS(0) pg8::DenseProb g{H, (const bf16_t*)(lwb + LW_IN), D, D, D, 0}; pg8::StaticOrder S; S.init(M, INC, G, bid);
          pg8::gemm_phase<pg8::DenseProb, epi::Proj, pg8::StaticOrder, true>(lds, g, S, epi::Proj{PROJ, F(8) + l * 3 * D}, wid); }
        xcd_barrier(bar);
        PH(3) { PHASE_VARS(0) for (int u = bid; u < 256; u += G) { const int grp = u & 3;
            qk::unit(u >> 5, (u >> 2) & 7, grp, PROJ, cs, (grp == 0 ? F(16) : grp == 1 ? F(17) : grp == 2 ? F(23) : F(24)) + l * 64, kmean, (LAS char*)lds, wid); } }
        xcd_barrier(bar);
        {
#define POP_Q() do { __syncthreads(); if (tid == 0) MISC[16] = __hip_atomic_fetch_add((unsigned*)(ws + WS_CTL) + CW_QUEUE + 64 * (l + QOFF), 1u, __ATOMIC_RELAXED, __HIP_MEMORY_SCOPE_AGENT); __syncthreads(); q = (int)MISC[16]; } while (0)
#define POP_ISSUE() do { if (tid == 0) qn = __hip_atomic_fetch_add((unsigned*)(ws + WS_CTL) + CW_QUEUE + 64 * (l + QOFF), 1u, __ATOMIC_RELAXED, __HIP_MEMORY_SCOPE_AGENT); } while (0)
#define POP_TAKE() do { __syncthreads(); if (tid == 0) MISC[16] = qn; __syncthreads(); q = (int)MISC[16]; } while (0)
            int q; constexpr int NCVT = (0 == 0) ? NCVT0 : NCVT1;
            { PHASE_VARS(0) POP_Q(); }
            PH(5) { PHASE_VARS(0)
              const float lam_init = 0.8f - 0.6f * expf(-0.3f * (float)l);
              const float lam = diff_lambda(F(18) + l * 64, F(19) + l * 64, F(20) + l * 64, F(21) + l * 64, lam_init, lane);
              const float noff = attn::score_shift(F(16) + l * 64, F(17) + l * 64, lane);
#pragma unroll 1
              while (q < 256) { const int i = q; unsigned qn = 0u; POP_ISSUE();
                attn::diff_unit((i & 31) >> 2, i & 3, 7 - (i >> 5), PROJ, YABC, F(22) + l * 128, lam, 1.0f - lam_init, noff, (LAS char*)lds, wid);
                POP_TAKE(); } }
            PH(18) { PHASE_VARS(0)
#pragma unroll 1
              while (q < 256 + NCVT) { unsigned qn = 0u; POP_ISSUE(); __syncthreads(); cvt_unit(CD, l == 0 ? 0 : 8, q - 256, (LAS float*)(lds + wid * 8192), wid, lane);
                POP_TAKE(); } }
            PH(4) { PHASE_VARS(0)
#pragma unroll 1
              while (q < 256 + NCVT + NQ_RG) { const int i = q - 256 - NCVT; unsigned qn = 0u; POP_ISSUE();
                rg2::unit(i >> 5, (i >> 1) & 15, i & 1, PROJ, YABC, F(9) + l * 4 * D, F(10) + l * D, F(11) + (size_t)l * 16 * 4096, F(12) + l * D, F(13) + (size_t)l * 16 * 4096, F(14) + l * D, F(15) + l * D, (LAS char*)lds, wid);
                POP_TAKE(); } }
            PH(6) { PHASE_VARS(0)
              const float noff = attn::score_shift(F(23) + l * 64, F(24) + l * 64, lane);
#pragma unroll 1
              while (q < 256 + NCVT + NQ_RG + 512) { const int i = q - NQ_RG - 256 - NCVT; unsigned qn = 0u; POP_ISSUE();
                attn::moba_unit((i & 63) >> 3, i & 7, 7 - (i >> 6), PROJ, YABC, kmean, noff, (LAS char*)lds, wid);
                POP_TAKE(); } }
#undef POP_Q
#undef POP_ISSUE
#undef POP_TAKE
        }
        xcd_barrier(bar);
        PH(7) { PHASE_VARS(0) pg8::StaticOrder S; S.init(M, D, G, bid); pg8::DenseProb g{YABC, (const bf16_t*)(lwb + LW_BRA), 2048, YW, 2048, 0};
          pg8::gemm_phase<pg8::DenseProb, epi::BranchMerge, pg8::StaticOrder, true>(lds, g, S, epi::BranchMerge{PROJ, H, 16, 24}, wid); }
        xcd_barrier(bar);
        PH(8) { PHASE_VARS(0) pg8::DenseProb g{H, (const bf16_t*)(lwb + LW_OUT), D, D, D, 0}; pg8::StaticOrder S; S.init(M, D, G, bid);
          pg8::gemm_phase<pg8::DenseProb, epi::Resid, pg8::StaticOrder, true>(lds, g, S, epi::Resid{xin, x1, modl + 2 * D}, wid); }
        xcd_barrier(bar);
        if (0 == 0) {
            PH(9) { PHASE_VARS(0) thin::norm_body(x1, F(6) + l * D, modl + 3 * D, modl + 4 * D, H, gw, ngw, lane); }
            xcd_barrier(bar);
            PH(10) { PHASE_VARS(0) pg8::DenseProb g{H, (const bf16_t*)(lwb + LW_W13), D, D, D, 0}; pg8::StaticOrder S; S.init(M, DFF2, G, bid);
              pg8::gemm_phase<pg8::DenseProb, epi::SwiGLU, pg8::StaticOrder, true>(lds, g, S, epi::SwiGLU{PROJ}, wid); }
            xcd_barrier(bar);
            PH(11) { PHASE_VARS(0) pg8::DenseProb g{PROJ, (const bf16_t*)(lwb + LW_W2), DFF, DFF, DFF, 0}; pg8::StaticOrder S; S.init(M, D, G, bid);
              pg8::gemm_phase<pg8::DenseProb, epi::Resid, pg8::StaticOrder, true>(lds, g, S, epi::Resid{x1, x1, modl + 5 * D}, wid); }
            xcd_barrier(bar);
        } else {
#define MOE_VARS \
            bf16_t* W2 = (bf16_t*)(outb + OUT_W2); bf16_t* h2 = H; bf16_t* hmid = (bf16_t*)(ws + WS_HMID_MOE); bf16_t* yslot = YABC; \
            int* topi = (int*)(ws + WS_TOPI); float* topw = (float*)(ws + WS_TOPW); int* rowtok = (int*)(ws + WS_ROWTOK); int* rowdst = (int*)(ws + WS_ROWDST); float* roww = (float*)(ws + WS_ROWW); int* tile_e = (int*)(ws + WS_TILEE); int* ntiles = (int*)(ws + WS_NTILES); \
            (void)W2; (void)h2; (void)hmid; (void)yslot; (void)topi; (void)topw; (void)rowtok; (void)rowdst; (void)roww; (void)tile_e; (void)ntiles;
            PH(12) { PHASE_VARS(0) MOE_VARS thin::norm_router_body(x1, F(6) + l * D, modl + 3 * D, modl + 4 * D, h2, F(32), F(33), topi, topw, gw, ngw, lane); }
            xcd_barrier(bar);
            PH(14) { PHASE_VARS(0) MOE_VARS if (bid == 0) moe::assign(topi, topw, rowtok, rowdst, roww, tile_e, ntiles, (LAS int*)lds, tid); }
            PH(13) if (bid != 0) { PHASE_VARS(0) MOE_VARS LAS float* scr = (LAS float*)(lds + wid * 8192); const int gw2 = (bid - 1) * 8 + wid, ngw2 = (G - 1) * 8;
#pragma unroll 1
              for (int e = 5; e < NE; ++e) { bf16_t* dst = (bf16_t*)((e < 7) ? (char*)ws + WS_W13C + (e - 5) * W13_BYTES : (char*)ws + WS_W13D);
                thin::transpose_matrix(F(34) + (size_t)e * D * DFF, D, DFF, dst, D, 0, 0, 1, scr, gw2, ngw2, lane);
                thin::transpose_matrix(F(35) + (size_t)e * D * DFF, D, DFF, dst, D, 0, 0, 2, scr, gw2, ngw2, lane); } }

            xcd_barrier(bar);
            PH(15) { PHASE_VARS(0) MOE_VARS moe::Order S{tile_e, ntiles, DFF2 / 256, 0, 0, 0}; S.dev_init(G, bid);
              pg8::gemm_phase<moe::ProbUp, epi::SwiGLU, moe::Order, true>(lds, moe::ProbUp{h2, (const bf16_t*)(outb + OUT_W13A), (const bf16_t*)(ws + WS_W13B), (const bf16_t*)(ws + WS_W13C), (const bf16_t*)(ws + WS_W13D), rowtok, D, D, D, 0}, S, epi::SwiGLU{hmid}, wid); }
            xcd_barrier(bar);
            PH(16) { PHASE_VARS(0) MOE_VARS moe::Order S{tile_e, ntiles, D / 256, 0, 0, 0}; S.dev_init(G, bid);
              pg8::gemm_phase<moe::ProbDown, epi::MoeDown, moe::Order, true>(lds, moe::ProbDown{hmid, W2, DFF, DFF, DFF, 0}, S, epi::MoeDown{rowdst, roww, yslot}, wid); }
            xcd_barrier(bar);
            PH(17) { PHASE_VARS(0) MOE_VARS thin::moe_combine_body(x1, yslot, modl + 5 * D, outp, gtid, ngt); }
#undef MOE_VARS
        }
    }
    {
        PH(1) { PHASE_VARS(1) thin::norm_body(xin, F(5) + l * D, modl + 0 * D, modl + 1 * D, H, gw, ngw, lane); }
        xcd_barrier(bar);
        PH(2) { PHASE_VARS(1) pg8::DenseProb g{H, (const bf16_t*)(lwb + LW_IN), D, D, D, 0}; pg8::StaticOrder S; S.init(M, INC, G, bid);
          pg8::gemm_phase<pg8::DenseProb, epi::Proj, pg8::StaticOrder, true>(lds, g, S, epi::Proj{PROJ, F(8) + l * 3 * D}, wid); }
        xcd_barrier(bar);
        PH(3) { PHASE_VARS(1) for (int u = bid; u < 256; u += G) { const int grp = u & 3;
            qk::unit(u >> 5, (u >> 2) & 7, grp, PROJ, cs, (grp == 0 ? F(16) : grp == 1 ? F(17) : grp == 2 ? F(23) : F(24)) + l * 64, kmean, (LAS char*)lds, wid); } }
        xcd_barrier(bar);
        {
#define POP_Q() do { __syncthreads(); if (tid == 0) MISC[16] = __hip_atomic_fetch_add((unsigned*)(ws + WS_CTL) + CW_QUEUE + 64 * (l + QOFF), 1u, __ATOMIC_RELAXED, __HIP_MEMORY_SCOPE_AGENT); __syncthreads(); q = (int)MISC[16]; } while (0)
#define POP_ISSUE() do { if (tid == 0) qn = __hip_atomic_fetch_add((unsigned*)(ws + WS_CTL) + CW_QUEUE + 64 * (l + QOFF), 1u, __ATOMIC_RELAXED, __HIP_MEMORY_SCOPE_AGENT); } while (0)
#define POP_TAKE() do { __syncthreads(); if (tid == 0) MISC[16] = qn; __syncthreads(); q = (int)MISC[16]; } while (0)
            int q; constexpr int NCVT = (1 == 0) ? NCVT0 : NCVT1;
            { PHASE_VARS(1) POP_Q(); }
            PH(5) { PHASE_VARS(1)
              const float lam_init = 0.8f - 0.6f * expf(-0.3f * (float)l);
              const float lam = diff_lambda(F(18) + l * 64, F(19) + l * 64, F(20) + l * 64, F(21) + l * 64, lam_init, lane);
              const float noff = attn::score_shift(F(16) + l * 64, F(17) + l * 64, lane);
#pragma unroll 1
              while (q < 256) { const int i = q; unsigned qn = 0u; POP_ISSUE();
                attn::diff_unit((i & 31) >> 2, i & 3, 7 - (i >> 5), PROJ, YABC, F(22) + l * 128, lam, 1.0f - lam_init, noff, (LAS char*)lds, wid);
                POP_TAKE(); } }
            PH(18) { PHASE_VARS(1)
#pragma unroll 1
              while (q < 256 + NCVT) { unsigned qn = 0u; POP_ISSUE(); __syncthreads(); cvt_unit(CD, l == 0 ? 0 : 8, q - 256, (LAS float*)(lds + wid * 8192), wid, lane);
                POP_TAKE(); } }
            PH(4) { PHASE_VARS(1)
#pragma unroll 1
              while (q < 256 + NCVT + NQ_RG) { const int i = q - 256 - NCVT; unsigned qn = 0u; POP_ISSUE();
                rg2::unit(i >> 5, (i >> 1) & 15, i & 1, PROJ, YABC, F(9) + l * 4 * D, F(10) + l * D, F(11) + (size_t)l * 16 * 4096, F(12) + l * D, F(13) + (size_t)l * 16 * 4096, F(14) + l * D, F(15) + l * D, (LAS char*)lds, wid);
                POP_TAKE(); } }
            PH(6) { PHASE_VARS(1)
              const float noff = attn::score_shift(F(23) + l * 64, F(24) + l * 64, lane);
#pragma unroll 1
              while (q < 256 + NCVT + NQ_RG + 512) { const int i = q - NQ_RG - 256 - NCVT; unsigned qn = 0u; POP_ISSUE();
                attn::moba_unit((i & 63) >> 3, i & 7, 7 - (i >> 6), PROJ, YABC, kmean, noff, (LAS char*)lds, wid);
                POP_TAKE(); } }
#undef POP_Q
#undef POP_ISSUE
#undef POP_TAKE
        }
        xcd_barrier(bar);
        PH(7) { PHASE_VARS(1) pg8::StaticOrder S; S.init(M, D, G, bid); pg8::DenseProb g{YABC, (const bf16_t*)(lwb + LW_BRA), 2048, YW, 2048, 0};
          pg8::gemm_phase<pg8::DenseProb, epi::BranchMerge, pg8::StaticOrder, true>(lds, g, S, epi::BranchMerge{PROJ, H, 16, 24}, wid); }
        xcd_barrier(bar);
        PH(8) { PHASE_VARS(1) pg8::DenseProb g{H, (const bf16_t*)(lwb + LW_OUT), D, D, D, 0}; pg8::StaticOrder S; S.init(M, D, G, bid);
          pg8::gemm_phase<pg8::DenseProb, epi::Resid, pg8::StaticOrder, true>(lds, g, S, epi::Resid{xin, x1, modl + 2 * D}, wid); }
        xcd_barrier(bar);
        if (1 == 0) {
            PH(9) { PHASE_VARS(1) thin::norm_body(x1, F(6) + l * D, modl + 3 * D, modl + 4 * D, H, gw, ngw, lane); }
            xcd_barrier(bar);
            PH(10) { PHASE_VARS(1) pg8::DenseProb g{H, (const bf16_t*)(lwb + LW_W13), D, D, D, 0}; pg8::StaticOrder S; S.init(M, DFF2, G, bid);
              pg8::gemm_phase<pg8::DenseProb, epi::SwiGLU, pg8::StaticOrder, true>(lds, g, S, epi::SwiGLU{PROJ}, wid); }
            xcd_barrier(bar);
            PH(11) { PHASE_VARS(1) pg8::DenseProb g{PROJ, (const bf16_t*)(lwb + LW_W2), DFF, DFF, DFF, 0}; pg8::StaticOrder S; S.init(M, D, G, bid);
              pg8::gemm_phase<pg8::DenseProb, epi::Resid, pg8::StaticOrder, true>(lds, g, S, epi::Resid{x1, x1, modl + 5 * D}, wid); }
            xcd_barrier(bar);
        } else {
#define MOE_VARS \
            bf16_t* W2 = (bf16_t*)(outb + OUT_W2); bf16_t* h2 = H; bf16_t* hmid = (bf16_t*)(ws + WS_HMID_MOE); bf16_t* yslot = YABC; \
            int* topi = (int*)(ws + WS_TOPI); float* topw = (float*)(ws + WS_TOPW); int* rowtok = (int*)(ws + WS_ROWTOK); int* rowdst = (int*)(ws + WS_ROWDST); float* roww = (float*)(ws + WS_ROWW); int* tile_e = (int*)(ws + WS_TILEE); int* ntiles = (int*)(ws + WS_NTILES); \
            (void)W2; (void)h2; (void)hmid; (void)yslot; (void)topi; (void)topw; (void)rowtok; (void)rowdst; (void)roww; (void)tile_e; (void)ntiles;
            PH(12) { PHASE_VARS(1) MOE_VARS thin::norm_router_body(x1, F(6) + l * D, modl + 3 * D, modl + 4 * D, h2, F(32), F(33), topi, topw, gw, ngw, lane); }
            xcd_barrier(bar);
            PH(14) { PHASE_VARS(1) MOE_VARS if (bid == 0) moe::assign(topi, topw, rowtok, rowdst, roww, tile_e, ntiles, (LAS int*)lds, tid); }
            PH(13) if (bid != 0) { PHASE_VARS(1) MOE_VARS LAS float* scr = (LAS float*)(lds + wid * 8192); const int gw2 = (bid - 1) * 8 + wid, ngw2 = (G - 1) * 8;
#pragma unroll 1
              for (int e = 5; e < NE; ++e) { bf16_t* dst = (bf16_t*)((e < 7) ? (char*)ws + WS_W13C + (e - 5) * W13_BYTES : (char*)ws + WS_W13D);
                thin::transpose_matrix(F(34) + (size_t)e * D * DFF, D, DFF, dst, D, 0, 0, 1, scr, gw2, ngw2, lane);
                thin::transpose_matrix(F(35) + (size_t)e * D * DFF, D, DFF, dst, D, 0, 0, 2, scr, gw2, ngw2, lane); } }

            xcd_barrier(bar);
            PH(15) { PHASE_VARS(1) MOE_VARS moe::Order S{tile_e, ntiles, DFF2 / 256, 0, 0, 0}; S.dev_init(G, bid);
              pg8::gemm_phase<moe::ProbUp, epi::SwiGLU, moe::Order, true>(lds, moe::ProbUp{h2, (const bf16_t*)(outb + OUT_W13A), (const bf16_t*)(ws + WS_W13B), (const bf16_t*)(ws + WS_W13C), (const bf16_t*)(ws + WS_W13D), rowtok, D, D, D, 0}, S, epi::SwiGLU{hmid}, wid); }
            xcd_barrier(bar);
            PH(16) { PHASE_VARS(1) MOE_VARS moe::Order S{tile_e, ntiles, D / 256, 0, 0, 0}; S.dev_init(G, bid);
              pg8::gemm_phase<moe::ProbDown, epi::MoeDown, moe::Order, true>(lds, moe::ProbDown{hmid, W2, DFF, DFF, DFF, 0}, S, epi::MoeDown{rowdst, roww, yslot}, wid); }
            xcd_barrier(bar);
            PH(17) { PHASE_VARS(1) MOE_VARS thin::moe_combine_body(x1, yslot, modl + 5 * D, outp, gtid, ngt); }
#undef MOE_VARS
        }
    }
#undef F
#undef PHASE_VARS
}

extern "C" void kernel_launch(void* const* d_in, const int* in_sizes, int n_in, void* d_out, int out_size, void* d_ws, size_t ws_size, hipStream_t stream) {
    static int grid = 0;
    if (grid == 0) {
        if (n_in != 37 || ws_size < WS_END) { fprintf(stderr, "kernel_launch: unexpected n_in %d / ws_size %zu (need %zu)\n", n_in, ws_size, (size_t)WS_END); grid = -1; return; }
        int dev = 0, cus = 0, per_cu = 0;
        if (hipGetDevice(&dev) != hipSuccess || hipDeviceGetAttribute(&cus, hipDeviceAttributeMultiprocessorCount, dev) != hipSuccess) { grid = -1; return; }
        if (hipFuncSetAttribute((const void*)mega_fwd, hipFuncAttributeMaxDynamicSharedMemorySize, LDS_TOTAL) != hipSuccess) { fprintf(stderr, "kernel_launch: hipFuncSetAttribute failed\n"); grid = -1; return; }
        if (hipOccupancyMaxActiveBlocksPerMultiprocessor(&per_cu, (const void*)mega_fwd, 512, LDS_TOTAL) != hipSuccess || per_cu < 1) fprintf(stderr, "kernel_launch: occupancy query says %d\n", per_cu);
        (void)hipGetLastError();
        grid = cus;
    }
    if (grid < 0) return;
    (void)hipMemsetAsync((char*)d_ws + WS_CTL, 0, CTL_ZERO_BYTES, stream);
    Args a{};
    for (int i = 0; i < 37; ++i) a.in[i] = (const float*)d_in[i];
    a.out = (float*)d_out; a.ws = (unsigned char*)d_ws;
    hipLaunchKernelGGL(mega_fwd, dim3(grid), dim3(512), LDS_TOTAL, stream, a);
}
```

```cpp
#include <hip/hip_runtime.h>
#include <stdint.h>
#include <stdio.h>

#define LAS __attribute__((address_space(3)))
typedef unsigned short bf16_t;
typedef short bf16x8 __attribute__((ext_vector_type(8)));
typedef short s16x4 __attribute__((ext_vector_type(4)));
typedef float f32x2 __attribute__((ext_vector_type(2)));
typedef float f32x4 __attribute__((ext_vector_type(4)));
typedef float f32x16 __attribute__((ext_vector_type(16)));
typedef unsigned u32x2 __attribute__((ext_vector_type(2)));
typedef unsigned u32x4 __attribute__((ext_vector_type(4)));

constexpr int D = 1024, NB = 8, SEQ = 2048, M = NB * SEQ, INC = 8192, DFF = 2816, NE = 8, DFF2 = 2 * DFF;
constexpr int PP = 5120;
constexpr int C_XR = 0, C_GR = 1024, C_DQ = 2048, C_DK = 2560, C_DV = 3072, C_MQ = 3584, C_MK = 4096, C_MV = 4608, C_GB = 5120;
constexpr int YW = 2048, Y_A = 0, Y_B = 1024, Y_C = 1536;
constexpr float EPS = 1e-6f;
constexpr float QSCALE = 0.125f * 1.4426950408889634f;
constexpr int MOE_MAXROWS = 34816, MOE_MAXTILES = MOE_MAXROWS / 256;

__device__ __forceinline__ float bf2f(unsigned v) { return __uint_as_float(v << 16); }
__device__ __forceinline__ unsigned f2bf(float f) { unsigned u = __float_as_uint(f); return (u + 0x7fffu + ((u >> 16) & 1u)) >> 16; }
__device__ __forceinline__ unsigned pk2(float lo, float hi) { unsigned r; asm volatile("v_cvt_pk_bf16_f32 %0, %1, %2" : "=v"(r) : "v"(lo), "v"(hi)); return r; }
__device__ __forceinline__ float fexp2(float x) { return __builtin_amdgcn_exp2f(x); }
__device__ __forceinline__ float frcp(float x) { return __builtin_amdgcn_rcpf(x); }
__device__ __forceinline__ float sigmoid_f(float x) { return frcp(1.0f + fexp2(-1.4426950408889634f * x)); }
__device__ __forceinline__ float gelu_tanh_f(float x) { return x * sigmoid_f(1.5957691216057308f * (x + 0.044715f * x * x * x)); }
__device__ __forceinline__ float silu_f(float x) { return x * sigmoid_f(x); }
__device__ __forceinline__ float wave_sum(float v) {
#pragma unroll
    for (int o = 1; o < 64; o <<= 1) v += __shfl_xor(v, o);
    return v;
}
__device__ __forceinline__ int lane_fresh() { int l; asm volatile("v_mbcnt_lo_u32_b32 %0, -1, 0\n\tv_mbcnt_hi_u32_b32 %0, -1, %0" : "=v"(l)); return l; }
namespace pg8 {
constexpr int BM = 256, BK = 64, HALF = 128, HTB = HALF * BK * 2  , STAGE_BYTES = 8 * HTB, NXCD = 8, WGM = 8;

__host__ __device__ __forceinline__ int lds_byte(int r, int c) { const int st = (r >> 4) * 2 + (c >> 5), rr = r & 15, cc = c & 31, ob = rr * 64 + cc * 2; return st * 1024 + (ob ^ (((ob >> 9) & 1) << 5)); }
__host__ __device__ __forceinline__ void stage_rc(int b, int& R, int& C) { const int st = b / 1024, sb = b % 1024, swz = sb ^ (((sb >> 9) & 1) << 5); R = (st >> 1) * 16 + swz / 64; C = (st & 1) * 32 + (swz % 64) / 2; }
__host__ __device__ __forceinline__ int perm32(int rho) { const int n = rho >> 4, i = rho & 15; return 8 * (i >> 2) + 4 * n + (i & 3); }

struct Unit { int pm, pn, e, aux; };

struct StaticOrder {
    int nM, nN, nwg, G, c;
    __host__ __device__ void init(int M, int N, int G_, int c_) { nM = M / BM; nN = N / BM; nwg = nM * nN; G = G_; c = c_; }
    __device__ __forceinline__ bool next(int i, Unit& u) const {
        const long L = (long)i * G + c; if (L >= nwg) return false;
        int wgid = (int)L; { const int q = nwg / NXCD, r = nwg % NXCD, xcd = wgid % NXCD, off = wgid / NXCD; wgid = (xcd < r ? xcd * (q + 1) : r * (q + 1) + (xcd - r) * q) + off; }
        const int nig = WGM * nN, gid = wgid / nig, fm = gid * WGM, gsz = (nM - fm) < WGM ? (nM - fm) : WGM;
        u.pm = fm + ((wgid % nig) % gsz); u.pn = (wgid % nig) / gsz; u.e = 0; u.aux = 0; return true;
    }
};

struct RotOrder : StaticOrder {
    __device__ __forceinline__ bool next(int i, Unit& u) const { if (!StaticOrder::next(i, u)) return false; u.pn = (u.pn + 4 * i) % nN; return true; }
};

struct DenseProb {
    static constexpr bool GATHER = false;
    const bf16_t* A; const bf16_t* Bt; int K, lda, ldb, pad;
    __device__ __forceinline__ const char* a_base(const Unit& u) const { return (const char*)A + (size_t)u.pm * BM * lda * 2; }
    __device__ __forceinline__ const char* b_base(const Unit& u) const { return (const char*)Bt + (size_t)u.pn * BM * ldb * 2; }
    __device__ __forceinline__ unsigned a_off(const Unit&, int row, int col) const { return (unsigned)(row * lda + col) * 2u; }
};

template <class Prob, class Epi, class Sched, bool ALIGN_EPI = true>
__device__ __forceinline__ void gemm_phase(LAS unsigned char* lds, const Prob& g, const Sched& S, const Epi& E, int wid) {
    const int lane = lane_fresh(), tid = wid * 64 + lane, wr = wid >> 2, wc = wid & 3, fr = lane & 15, fq = lane >> 4;
    const int K = g.K, nt = K / BK;
    int sR[2], sC[2]; unsigned voffB[2];
#pragma unroll
    for (int i = 0; i < 2; ++i) { int R, C; stage_rc(tid * 16 + i * 8192, R, C); sR[i] = R; sC[i] = C; const int Rb = Epi::PERM ? ((R & ~31) + perm32(R & 31)) : R; voffB[i] = (unsigned)(Rb * g.ldb + C) * 2u; }
    const size_t kstep = (size_t)(BK * 2);
    const size_t hstepB = (size_t)HALF * g.ldb * 2;
    const unsigned ldsw = (unsigned)wid * 1024u;
    const int aoff = lds_byte(wr * 64 + fr, fq * 8), boff = lds_byte(wc * 32 + fr, fq * 8);
#define PG8_SA(b, h) (((b) * 2 + (h)) * HTB)
#define PG8_SB(b, h) ((4 + (b) * 2 + (h)) * HTB)
#define PG8_STAGE(bufoff, gbase, voff) do { _Pragma("unroll") for (int _i = 0; _i < 2; ++_i) \
        __builtin_amdgcn_global_load_lds((const unsigned*)((const char*)(gbase) + (voff)[_i]), (LAS unsigned*)(lds + (bufoff) + ldsw + _i * 8192), 16, 0, 0); } while (0)
#define PG8_LDA(dst, b, h) do { _Pragma("unroll") for (int m = 0; m < 4; ++m) _Pragma("unroll") for (int k = 0; k < 2; ++k) dst[m][k] = *(const LAS bf16x8*)(lds + PG8_SA(b, h) + aoff + m * 2048 + k * 1024); } while (0)
#define PG8_LDB(dst, b, h) do { _Pragma("unroll") for (int n = 0; n < 2; ++n) _Pragma("unroll") for (int k = 0; k < 2; ++k) dst[n][k] = *(const LAS bf16x8*)(lds + PG8_SB(b, h) + boff + n * 2048 + k * 1024); } while (0)
#define PG8_MMA(ai, bj, At, Bt) do { __builtin_amdgcn_s_setprio(1); _Pragma("unroll") for (int m = 0; m < 4; ++m) _Pragma("unroll") for (int n = 0; n < 2; ++n) _Pragma("unroll") for (int k = 0; k < 2; ++k) \
        acc[ai][bj][m][n] = __builtin_amdgcn_mfma_f32_16x16x32_bf16(Bt[n][k], At[m][k], acc[ai][bj][m][n], 0, 0, 0); __builtin_amdgcn_s_setprio(0); } while (0)
#define PG8_WAIT_V(n) asm volatile("s_waitcnt vmcnt(" #n ")" ::: "memory")
#define PG8_WAIT_L(n) asm volatile("s_waitcnt lgkmcnt(" #n ")" ::: "memory")
#define PG8_BAR __builtin_amdgcn_s_barrier()
#define PG8_SCHED __builtin_amdgcn_sched_barrier(0)
    Unit cur, nxt; int ui = 0;
    if (!S.next(0, cur)) return;
    f32x4 acc[2][2][4][2];
#pragma unroll
    for (int a = 0; a < 2; ++a)
#pragma unroll
        for (int b = 0; b < 2; ++b)
#pragma unroll
            for (int m = 0; m < 4; ++m)
#pragma unroll
                for (int n = 0; n < 2; ++n) acc[a][b][m][n] = (f32x4){0.f, 0.f, 0.f, 0.f};
    bf16x8 At[4][2], B0[2][2], B1[2][2];
    unsigned vA[2][2], vN[2][2];
#pragma unroll
    for (int h = 0; h < 2; ++h)
#pragma unroll
        for (int i = 0; i < 2; ++i) { vA[h][i] = g.a_off(cur, h * HALF + sR[i], sC[i]); vN[h][i] = vA[h][i]; }
    const char* cA = g.a_base(cur); const char* cB = g.b_base(cur);
    PG8_STAGE(PG8_SB(0, 0), cB, voffB); PG8_STAGE(PG8_SB(0, 1), cB + hstepB, voffB); PG8_STAGE(PG8_SA(0, 0), cA, vA[0]); PG8_STAGE(PG8_SA(0, 1), cA, vA[1]);
    if (wr == 1) PG8_BAR;
    PG8_WAIT_V(2); PG8_BAR;
    PG8_STAGE(PG8_SB(1, 0), cB + kstep, voffB); PG8_STAGE(PG8_SA(1, 0), cA + kstep, vA[0]); PG8_STAGE(PG8_SB(1, 1), cB + hstepB + kstep, voffB);
    PG8_WAIT_V(6); PG8_BAR;
    for (;;) {
        const bool has_next = S.next(ui + 1, nxt);
        const char* nA = has_next ? g.a_base(nxt) : cA; const char* nB = has_next ? g.b_base(nxt) : cB;
        if (Prob::GATHER) {
#pragma unroll
            for (int h = 0; h < 2; ++h)
#pragma unroll
                for (int i = 0; i < 2; ++i) vN[h][i] = has_next ? g.a_off(nxt, h * HALF + sR[i], sC[i]) : vA[h][i];
        }
        for (int t = 0; t < nt; t += 2) {
            const bool last = (t == nt - 2);
            if constexpr (Epi::KHOOK) { if (t == E.kh1 || t == E.kh2) E.khook(acc, cur, t, wr, wc, fr, fq); }
            const char* a1 = cA + (size_t)(t + 1) * kstep;
            const char* a2 = last ? nA : cA + (size_t)(t + 2) * kstep; const char* b2 = last ? nB : cB + (size_t)(t + 2) * kstep;
            const char* a3 = a2 + kstep; const char* b3 = b2 + kstep;
            unsigned v2[2][2];
#pragma unroll
            for (int h = 0; h < 2; ++h)
#pragma unroll
                for (int i = 0; i < 2; ++i) v2[h][i] = (Prob::GATHER && last) ? vN[h][i] : vA[h][i];
            PG8_LDB(B0, 0, 0); PG8_LDB(B1, 0, 1); PG8_SCHED; PG8_LDA(At, 0, 0); PG8_STAGE(PG8_SA(1, 1), a1, vA[1]);
            PG8_WAIT_V(8); PG8_WAIT_L(0); PG8_BAR; PG8_MMA(0, 0, At, B0); PG8_MMA(0, 1, At, B1); PG8_BAR; PG8_SCHED;
            PG8_LDA(At, 0, 1); PG8_STAGE(PG8_SB(0, 0), b2, voffB); PG8_STAGE(PG8_SB(0, 1), b2 + hstepB, voffB); PG8_STAGE(PG8_SA(0, 0), a2, v2[0]);
            PG8_WAIT_V(8); PG8_WAIT_L(0); PG8_BAR; PG8_MMA(1, 0, At, B0); PG8_MMA(1, 1, At, B1); PG8_BAR; PG8_SCHED;
            PG8_LDB(B0, 1, 0); PG8_LDB(B1, 1, 1); PG8_SCHED; PG8_LDA(At, 1, 0); PG8_STAGE(PG8_SA(0, 1), a2, v2[1]);
            PG8_WAIT_V(8); PG8_WAIT_L(0); PG8_BAR; PG8_MMA(0, 0, At, B0); PG8_MMA(0, 1, At, B1); PG8_BAR; PG8_SCHED;
            PG8_LDA(At, 1, 1); PG8_STAGE(PG8_SB(1, 0), b3, voffB); PG8_STAGE(PG8_SB(1, 1), b3 + hstepB, voffB); PG8_STAGE(PG8_SA(1, 0), a3, v2[0]);
            PG8_WAIT_V(8); PG8_WAIT_L(0); PG8_BAR; PG8_MMA(1, 0, At, B0); PG8_MMA(1, 1, At, B1); PG8_BAR; PG8_SCHED;
        }
        if constexpr (ALIGN_EPI) { if (wr == 0) PG8_BAR; }
        E(acc, cur, wr, wc, fr, fq);
        if (!has_next) break;
#pragma unroll
        for (int a = 0; a < 2; ++a)
#pragma unroll
            for (int b = 0; b < 2; ++b)
#pragma unroll
                for (int m = 0; m < 4; ++m)
#pragma unroll
                    for (int n = 0; n < 2; ++n) acc[a][b][m][n] = (f32x4){0.f, 0.f, 0.f, 0.f};
        cur = nxt; cA = nA; cB = nB; ++ui;
        if (Prob::GATHER) {
#pragma unroll
            for (int h = 0; h < 2; ++h)
#pragma unroll
                for (int i = 0; i < 2; ++i) vA[h][i] = vN[h][i];
        }
        if constexpr (ALIGN_EPI) { if (wr == 1) PG8_BAR; }
    }
    PG8_WAIT_V(0);
    if constexpr (!ALIGN_EPI) { if (wr == 0) PG8_BAR; }
    PG8_BAR;
#undef PG8_SA
#undef PG8_SB
#undef PG8_STAGE
#undef PG8_LDA
#undef PG8_LDB
#undef PG8_MMA
#undef PG8_WAIT_V
#undef PG8_WAIT_L
#undef PG8_BAR
#undef PG8_SCHED
}
}
namespace epi {
using pg8::Unit; using pg8::BM; using pg8::HALF;
typedef const f32x4 (&AccRef)[2][2][4][2];

struct Proj {
    static constexpr bool PERM = true, KHOOK = false;
    bf16_t* O; const float* gate_b; bf16_t* GT;
    __device__ __forceinline__ void operator()(AccRef acc, const Unit& u, int wr, int wc, int fr, int fq) const {
        const int row0 = u.pm * BM + wr * 64 + fr, col0 = u.pn * BM + wc * 32 + 8 * fq;
        const int mode = (u.pn >= 20) ? 2 : ((u.pn >= 4 && u.pn < 8) ? 1 : 0);
        f32x4 bv[2][2];
#pragma unroll
        for (int bj = 0; bj < 2; ++bj)
#pragma unroll
            for (int n = 0; n < 2; ++n) bv[bj][n] = (mode == 2) ? *(const f32x4*)(gate_b + (col0 - C_GB) + bj * HALF + 4 * n) : (f32x4){0.f, 0.f, 0.f, 0.f};
#pragma unroll
        for (int ai = 0; ai < 2; ++ai)
#pragma unroll
            for (int m = 0; m < 4; ++m) { bf16_t* rowp = O + (size_t)(row0 + ai * HALF + m * 16) * PP + col0;
#pragma unroll
                for (int bj = 0; bj < 2; ++bj) { f32x4 v0 = acc[ai][bj][m][0] + bv[bj][0], v1 = acc[ai][bj][m][1] + bv[bj][1];
                    if (mode == 1) {
#pragma unroll
                        for (int j = 0; j < 4; ++j) { v0[j] = gelu_tanh_f(v0[j]); v1[j] = gelu_tanh_f(v1[j]); } }
                    if (mode == 2) {
#pragma unroll
                        for (int j = 0; j < 4; ++j) { v0[j] = sigmoid_f(v0[j]); v1[j] = sigmoid_f(v1[j]); } }
                    u32x4 w; w.x = pk2(v0[0], v0[1]); w.y = pk2(v0[2], v0[3]); w.z = pk2(v1[0], v1[1]); w.w = pk2(v1[2], v1[3]);
                    if (mode == 2) { const int gp = u.pn - 20; const size_t piece = ((((size_t)u.pm * 3 + (gp >> 2)) * 4 + (gp & 3)) * 16 + (ai * 4 + m) * 2 + bj) * 512 + (wr * 4 + wc) * 64 + fq * 16 + fr;
                        *(u32x4*)(GT + piece * 8) = w; }
                    else *(u32x4*)(rowp + bj * HALF) = w; } }
    }
};

struct Resid {
    static constexpr bool PERM = false, KHOOK = false;
    const float* base; float* out; const float* gate;
    __device__ __forceinline__ void operator()(AccRef acc, const Unit& u, int wr, int wc, int fr, int fq) const {
        const int row0 = u.pm * BM + wr * 64 + fr, col0 = u.pn * BM + wc * 32 + 4 * fq;
        const float* gp = gate + (size_t)((u.pm * BM) / SEQ) * (6 * D) + col0;
        f32x4 gv[2][2];
#pragma unroll
        for (int bj = 0; bj < 2; ++bj)
#pragma unroll
            for (int n = 0; n < 2; ++n) gv[bj][n] = *(const f32x4*)(gp + bj * HALF + n * 16);
#pragma unroll
        for (int ai = 0; ai < 2; ++ai)
#pragma unroll
            for (int m = 0; m < 4; ++m) { const size_t off = (size_t)(row0 + ai * HALF + m * 16) * D + col0;
#pragma unroll
                for (int bj = 0; bj < 2; ++bj)
#pragma unroll
                    for (int n = 0; n < 2; ++n) { const f32x4 bs = *(const f32x4*)(base + off + bj * HALF + n * 16);
                        *(f32x4*)(out + off + bj * HALF + n * 16) = bs + gv[bj][n] * acc[ai][bj][m][n]; } }
    }
};

struct SwiGLU {
    static constexpr bool PERM = true, KHOOK = false;
    bf16_t* O;
    __device__ __forceinline__ void operator()(AccRef acc, const Unit& u, int wr, int wc, int fr, int fq) const {
        const int row0 = u.pm * BM + wr * 64 + fr, col0 = u.pn * HALF + wc * 32 + 8 * fq;
#pragma unroll
        for (int ai = 0; ai < 2; ++ai)
#pragma unroll
            for (int m = 0; m < 4; ++m) { bf16_t* rowp = O + (size_t)(row0 + ai * HALF + m * 16) * DFF + col0;
                f32x4 v0, v1;
#pragma unroll
                for (int j = 0; j < 4; ++j) { v0[j] = silu_f(acc[ai][0][m][0][j]) * acc[ai][1][m][0][j]; v1[j] = silu_f(acc[ai][0][m][1][j]) * acc[ai][1][m][1][j]; }
                u32x4 w; w.x = pk2(v0[0], v0[1]); w.y = pk2(v0[2], v0[3]); w.z = pk2(v1[0], v1[1]); w.w = pk2(v1[2], v1[3]);
                *(u32x4*)rowp = w; }
    }
};

struct MoeDown {
    static constexpr bool PERM = false, KHOOK = false;
    const int* rowdst; const float* roww; bf16_t* yslot;
    __device__ __forceinline__ void operator()(AccRef acc, const Unit& u, int wr, int wc, int fr, int fq) const {
        const int row0 = u.pm * BM + wr * 64 + fr, col0 = u.pn * BM + wc * 32 + 4 * fq;
        int dsts[2][4]; float ws_[2][4];
#pragma unroll
        for (int ai = 0; ai < 2; ++ai)
#pragma unroll
            for (int m = 0; m < 4; ++m) { const int p = row0 + ai * HALF + m * 16; dsts[ai][m] = rowdst[p]; ws_[ai][m] = roww[p]; }
#pragma unroll
        for (int ai = 0; ai < 2; ++ai)
#pragma unroll
            for (int m = 0; m < 4; ++m) { const int dst = dsts[ai][m]; const float w = ws_[ai][m];
                if (dst >= 0) { bf16_t* rowp = yslot + (size_t)dst * D + col0;
#pragma unroll
                    for (int bj = 0; bj < 2; ++bj)
#pragma unroll
                        for (int n = 0; n < 2; ++n) { const f32x4 v = acc[ai][bj][m][n] * w; u32x2 o; o.x = pk2(v[0], v[1]); o.y = pk2(v[2], v[3]); *(u32x2*)(rowp + bj * HALF + n * 16) = o; } } }
    }
};

struct BranchMerge {
    static constexpr bool PERM = true, KHOOK = true;
    const bf16_t* GT; bf16_t* merged; int kh1, kh2;
    typedef f32x4 (&AccMut)[2][2][4][2];
    __device__ __forceinline__ static void unpack8(const u32x4 w, float (&f)[8]) {
        f[0] = bf2f(w.x & 0xffffu); f[1] = bf2f(w.x >> 16); f[2] = bf2f(w.y & 0xffffu); f[3] = bf2f(w.y >> 16); f[4] = bf2f(w.z & 0xffffu); f[5] = bf2f(w.z >> 16); f[6] = bf2f(w.w & 0xffffu); f[7] = bf2f(w.w >> 16); }
    __device__ __forceinline__ const u32x4* gate_piece(const Unit& u, int g, int wr, int wc, int fr, int fq) const {
        return (const u32x4*)GT + ((((size_t)u.pm * 3 + g) * 4 + u.pn) * 16) * 512 + (wr * 4 + wc) * 64 + fq * 16 + fr; }
    __device__ __forceinline__ void khook(AccMut acc, const Unit& u, int t, int wr, int wc, int fr, int fq) const {
        const int gi = (t == kh1) ? 0 : 1;
        const u32x4* pn_ = gate_piece(u, gi, wr, wc, fr, fq); const u32x4* pd_ = gate_piece(u, gi + 1, wr, wc, fr, fq);
#pragma unroll
        for (int ai = 0; ai < 2; ++ai) {
            u32x4 rn[4][2], rd[4][2];
#pragma unroll
            for (int m = 0; m < 4; ++m)
#pragma unroll
                for (int bj = 0; bj < 2; ++bj) { rn[m][bj] = pn_[((ai * 4 + m) * 2 + bj) * 512]; rd[m][bj] = pd_[((ai * 4 + m) * 2 + bj) * 512]; }
#pragma unroll
            for (int m = 0; m < 4; ++m)
#pragma unroll
                for (int bj = 0; bj < 2; ++bj) { float gn[8], gd[8]; unpack8(rn[m][bj], gn); unpack8(rd[m][bj], gd);
#pragma unroll
                    for (int j = 0; j < 4; ++j) { acc[ai][bj][m][0][j] *= gn[j] * frcp(fmaxf(gd[j], 1e-30f)); acc[ai][bj][m][1][j] *= gn[4 + j] * frcp(fmaxf(gd[4 + j], 1e-30f)); } }
            asm volatile("" ::: "memory");
        }
    }
    __device__ __forceinline__ void operator()(AccRef acc, const Unit& u, int wr, int wc, int fr, int fq) const {
        const int row0 = u.pm * BM + wr * 64 + fr, col0 = u.pn * BM + wc * 32 + 8 * fq;
#pragma unroll
        for (int ai = 0; ai < 2; ++ai)
#pragma unroll
            for (int m = 0; m < 4; ++m) { const size_t row = (size_t)(row0 + ai * HALF + m * 16);
#pragma unroll
                for (int bj = 0; bj < 2; ++bj) { float g2[8]; unpack8(gate_piece(u, 2, wr, wc, fr, fq)[((ai * 4 + m) * 2 + bj) * 512], g2);
                    const f32x4 v0 = acc[ai][bj][m][0], v1 = acc[ai][bj][m][1];
                    u32x4 w; w.x = pk2(v0[0] * g2[0], v0[1] * g2[1]); w.y = pk2(v0[2] * g2[2], v0[3] * g2[3]); w.z = pk2(v1[0] * g2[4], v1[1] * g2[5]); w.w = pk2(v1[2] * g2[6], v1[3] * g2[7]);
                    *(u32x4*)(merged + row * D + col0 + bj * HALF) = w; } }
    }
};
}
namespace attn {
constexpr int NSLOT = 4, SLOT_K = 8192, SLOT128 = SLOT_K + 16384, SLOT64 = SLOT_K + 8192, LDS_BYTES = NSLOT * SLOT128;
constexpr float NEGF = -1e30f;
__device__ __forceinline__ int crow(int r, int hi) { return (r & 3) + 8 * (r >> 2) + 4 * hi; }
__device__ __forceinline__ float swapmax(float m) { auto rr = __builtin_amdgcn_permlane32_swap(__float_as_uint(m), __float_as_uint(m), false, false); return fmaxf(__uint_as_float(rr[0]), __uint_as_float(rr[1])); }
__device__ __forceinline__ float swapsum(float m) { auto rr = __builtin_amdgcn_permlane32_swap(__float_as_uint(m), __float_as_uint(m), false, false); return __uint_as_float(rr[0]) + __uint_as_float(rr[1]); }
typedef short v4i16_t __attribute__((ext_vector_type(4)));
__device__ __forceinline__ s16x4 vtr(const LAS char* p) { return __builtin_bit_cast(s16x4, __builtin_amdgcn_ds_read_tr16_b64_v4i16((LAS v4i16_t*)p)); }

__device__ __forceinline__ void qk_tile(f32x16& sA, f32x16& sB, const LAS char* Kt, const bf16x8 (&qf)[4], int r, int h, float noff) {
    const LAS char* kb = Kt + h * 1024 + r * 16;
#pragma unroll
    for (int j = 0; j < 16; ++j) { sA[j] = noff; sB[j] = noff; }
    bf16x8 kf[8];
#pragma unroll
    for (int ks = 0; ks < 4; ++ks) { kf[2 * ks] = *(const LAS bf16x8*)(kb + ks * 2048); kf[2 * ks + 1] = *(const LAS bf16x8*)(kb + ks * 2048 + 512); }
    __builtin_amdgcn_sched_barrier(0);
#pragma unroll
    for (int ks = 0; ks < 4; ++ks) {
        sA = __builtin_amdgcn_mfma_f32_32x32x16_bf16(kf[2 * ks], qf[ks], sA, 0, 0, 0);
        sB = __builtin_amdgcn_mfma_f32_32x32x16_bf16(kf[2 * ks + 1], qf[ks], sB, 0, 0, 0);
    }
}
template <int NDB>
__device__ __forceinline__ void pv_tile(f32x16 (&o)[NDB], const LAS char* Vt, const bf16x8 (&pf)[4], int lane) {
    const int h = lane >> 5, q = (lane & 15) >> 2, p = lane & 3, g1 = (lane >> 4) & 1;
    const LAS char* vb = Vt + (4 * h + q) * 64 + (16 * g1 + 4 * p) * 2;
#pragma unroll
    for (int kb = 0; kb < 2; ++kb) {
        bf16x8 vf[2][NDB];
#pragma unroll
        for (int s = 0; s < 2; ++s)
#pragma unroll
            for (int db = 0; db < NDB; ++db) { const int r0 = kb * 32 + 16 * s;
                const s16x4 lo = vtr(vb + r0 * 64 + db * 4096), hi = vtr(vb + (r0 + 8) * 64 + db * 4096);
                vf[s][db] = (bf16x8){lo[0], lo[1], lo[2], lo[3], hi[0], hi[1], hi[2], hi[3]}; }
        __builtin_amdgcn_sched_barrier(0);
#pragma unroll
        for (int s = 0; s < 2; ++s)
#pragma unroll
            for (int db = 0; db < NDB; ++db) o[db] = __builtin_amdgcn_mfma_f32_32x32x16_bf16(pf[kb * 2 + s], vf[s][db], o[db], 0, 0, 0);
    }
}
template <int NDB>
__device__ __forceinline__ void softmax_pv(f32x16& sA, f32x16& sB, f32x16 (&o)[NDB], float& lsum, const LAS char* Vt, int lane) {
    float rs0 = 0.f, rs1 = 0.f;
#pragma unroll
    for (int j = 0; j < 16; ++j) { sA[j] = fexp2(sA[j]); sB[j] = fexp2(sB[j]); rs0 += sA[j]; rs1 += sB[j]; }
    lsum += rs0 + rs1;
    bf16x8 pf[4];
    { u32x4 w;
      w.x = pk2(sA[0], sA[1]); w.y = pk2(sA[2], sA[3]); w.z = pk2(sA[4], sA[5]); w.w = pk2(sA[6], sA[7]); pf[0] = __builtin_bit_cast(bf16x8, w);
      w.x = pk2(sA[8], sA[9]); w.y = pk2(sA[10], sA[11]); w.z = pk2(sA[12], sA[13]); w.w = pk2(sA[14], sA[15]); pf[1] = __builtin_bit_cast(bf16x8, w);
      w.x = pk2(sB[0], sB[1]); w.y = pk2(sB[2], sB[3]); w.z = pk2(sB[4], sB[5]); w.w = pk2(sB[6], sB[7]); pf[2] = __builtin_bit_cast(bf16x8, w);
      w.x = pk2(sB[8], sB[9]); w.y = pk2(sB[10], sB[11]); w.z = pk2(sB[12], sB[13]); w.w = pk2(sB[14], sB[15]); pf[3] = __builtin_bit_cast(bf16x8, w); }
    pv_tile<NDB>(o, Vt, pf, lane);
}
__device__ __forceinline__ float score_shift(const float* gq, const float* gk, int lane) {
    float mq = fabsf(gq[lane]), mk = fabsf(gk[lane]);
#pragma unroll
    for (int o = 1; o < 64; o <<= 1) { mq = fmaxf(mq, __shfl_xor(mq, o)); mk = fmaxf(mk, __shfl_xor(mk, o)); }
    const float bound = QSCALE * 64.0f * mq * mk;
    return -fmaxf(0.f, bound - 24.0f);
}

template <int DV>
__device__ __forceinline__ void dma_tile(const bf16_t* Kg, const bf16_t* Vg, int key0, LAS char* slot, int wid, int lane) {
    __builtin_amdgcn_global_load_lds((const unsigned*)(Kg + (size_t)(key0 + lane) * PP + wid * 8), (LAS unsigned*)(slot + wid * 1024), 16, 0, 0);
#pragma unroll
    for (int i = 0; i < DV / 64; ++i) { const int p = wid + 8 * i, db = p >> 2, rg = p & 3;
        __builtin_amdgcn_global_load_lds((const unsigned*)(Vg + (size_t)(key0 + 16 * rg + (lane >> 2)) * PP + db * 32 + (lane & 3) * 8), (LAS unsigned*)(slot + SLOT_K + p * 1024), 16, 0, 0); }
}
template <int OPS> __device__ __forceinline__ void ring_wait(int ahead) {
    if (ahead >= 2) asm volatile("s_waitcnt vmcnt(%0) lgkmcnt(0)\n\ts_barrier" :: "n"(2 * OPS) : "memory");
    else if (ahead == 1) asm volatile("s_waitcnt vmcnt(%0) lgkmcnt(0)\n\ts_barrier" :: "n"(OPS) : "memory");
    else asm volatile("s_waitcnt vmcnt(0) lgkmcnt(0)\n\ts_barrier" ::: "memory");
}
template <int DV>
__device__ __forceinline__ void causal_pass(f32x16 (&o)[DV / 32], float& lsum, const bf16x8 (&qf)[4], const bf16_t* Kg, const bf16_t* Vg,
                                            int ntiles, int qw0, float noff, LAS char* lds, int tid) {
    constexpr int SLOT = SLOT_K + DV * 128, OPS = 1 + DV / 64;
    const int lane = tid & 63, r = lane & 31, h = lane >> 5, wid = __builtin_amdgcn_readfirstlane(tid >> 6);
    asm volatile("s_waitcnt vmcnt(0) lgkmcnt(0)\n\ts_barrier" ::: "memory");
#pragma unroll
    for (int t = 0; t < 3; ++t) if (t < ntiles) dma_tile<DV>(Kg, Vg, t * 64, lds + t * SLOT, wid, lane);
    __builtin_amdgcn_s_waitcnt(0);
    for (int t = 0; t < ntiles; ++t) {
        ring_wait<OPS>(ntiles - 1 - t);
        if (t + 3 < ntiles) dma_tile<DV>(Kg, Vg, (t + 3) * 64, lds + ((t + 3) & 3) * SLOT, wid, lane);
        const LAS char* slot = lds + (t & 3) * SLOT;
        const int key0 = t * 64;
        if (key0 <= qw0 + 31) {
            f32x16 sA, sB;
            qk_tile(sA, sB, slot, qf, r, h, noff);
            if (key0 + 63 > qw0) {
                const int qpos = qw0 + r;
#pragma unroll
                for (int j = 0; j < 16; ++j) { const int kp = key0 + crow(j, h); if (kp > qpos) sA[j] = NEGF; if (kp + 32 > qpos) sB[j] = NEGF; }
            }
            softmax_pv<DV / 32>(sA, sB, o, lsum, slot + SLOT_K, lane);
        }
    }
}

__device__ __forceinline__ void diff_unit(int b, int hd, int qt, const bf16_t* proj, bf16_t* yabc, const float* subln, float lam, float one_m_laminit, float noff, LAS char* lds, int wid) {
    const int lane = lane_fresh(), tid = wid * 64 + lane, r = lane & 31, h = lane >> 5;
    const int qw0 = qt * 256 + wid * 32;
    const size_t rowb = (size_t)b * SEQ;
    const int ntiles = 4 * (qt + 1);
    unsigned o0p[4][8];
#pragma unroll
    for (int j = 0; j < 2; ++j) {
        const bf16_t* qp = proj + (rowb + qw0 + r) * PP + C_DQ + (hd * 2 + j) * 64 + h * 8;
        bf16x8 qf[4];
#pragma unroll
        for (int ks = 0; ks < 4; ++ks) qf[ks] = *(const bf16x8*)(qp + ks * 16);
        f32x16 o[4];
#pragma unroll
        for (int db = 0; db < 4; ++db)
#pragma unroll
            for (int i = 0; i < 16; ++i) o[db][i] = 0.f;
        float lsum = 0.f;
        causal_pass<128>(o, lsum, qf, proj + rowb * PP + C_DK + (hd * 2 + j) * 64, proj + rowb * PP + C_DV + hd * 128, ntiles, qw0, noff, lds, tid);
        const float il = frcp(swapsum(lsum));
        if (j == 0) {
#pragma unroll
            for (int i = 0; i < 16; i += 2) { const float a0 = __shfl(il, crow(i, h)), a1 = __shfl(il, crow(i + 1, h));
#pragma unroll
                for (int db = 0; db < 4; ++db) o0p[db][i >> 1] = pk2(o[db][i] * a0, o[db][i + 1] * a1); }
        } else {
#pragma unroll
            for (int i = 0; i < 16; ++i) { const float a = __shfl(il, crow(i, h)) * lam;
                float ss = 0.f; float cv[4];
#pragma unroll
                for (int db = 0; db < 4; ++db) { const unsigned w = o0p[db][i >> 1]; const float x0 = (i & 1) ? bf2f(w >> 16) : bf2f(w & 0xffffu); const float c = x0 - o[db][i] * a; cv[db] = c; ss += c * c; }
                ss += __shfl_xor(ss, 1); ss += __shfl_xor(ss, 2); ss += __shfl_xor(ss, 4); ss += __shfl_xor(ss, 8); ss += __shfl_xor(ss, 16);
                const float rn = rsqrtf(ss * (1.0f / 128.0f) + EPS) * one_m_laminit;
                bf16_t* yp = yabc + (rowb + qw0 + crow(i, h)) * YW + Y_B + hd * 128 + r;
#pragma unroll
                for (int db = 0; db < 4; ++db) yp[db * 32] = (bf16_t)f2bf(cv[db] * rn * subln[db * 32 + r]);
            }
        }
    }
}

__device__ __forceinline__ void moba_unit(int b, int hd, int cur, const bf16_t* proj, bf16_t* yabc, const float* kmean, float noff, LAS char* lds, int wid) {
    const int lane = lane_fresh(), tid = wid * 64 + lane, r = lane & 31, h = lane >> 5;
    const int qw0 = cur * 256 + wid * 32;
    const size_t rowb = (size_t)b * SEQ;
    const bf16_t* qp = proj + (rowb + qw0 + r) * PP + C_MQ + hd * 64 + h * 8;
    bf16x8 qf[4];
#pragma unroll
    for (int ks = 0; ks < 4; ++ks) qf[ks] = *(const bf16x8*)(qp + ks * 16);
    unsigned selmask = 0u;
    if (cur > 0) {
        float gate[8];
        float qv[4][8];
#pragma unroll
        for (int ks = 0; ks < 4; ++ks)
#pragma unroll
            for (int j = 0; j < 8; ++j) qv[ks][j] = bf2f((unsigned)(unsigned short)qf[ks][j]);
#pragma unroll
        for (int nb = 0; nb < 8; nb += 4) {
            f32x4 kmv[4][8];
#pragma unroll
            for (int n = 0; n < 4; ++n) { const f32x4* km = (const f32x4*)(kmean + ((size_t)((b * 8 + hd) * 8 + nb + n)) * 64 + h * 8);
#pragma unroll
                for (int ks = 0; ks < 4; ++ks) { kmv[n][2 * ks] = km[ks * 4]; kmv[n][2 * ks + 1] = km[ks * 4 + 1]; } }
#pragma unroll
            for (int n = 0; n < 4; ++n) { float g = 0.f;
#pragma unroll
                for (int ks = 0; ks < 4; ++ks) { const f32x4 k0 = kmv[n][2 * ks], k1 = kmv[n][2 * ks + 1];
                    g += qv[ks][0] * k0.x + qv[ks][1] * k0.y + qv[ks][2] * k0.z + qv[ks][3] * k0.w + qv[ks][4] * k1.x + qv[ks][5] * k1.y + qv[ks][6] * k1.z + qv[ks][7] * k1.w; }
                g = swapsum(g);
                gate[nb + n] = (nb + n < cur) ? g : -3.0e38f; }
        }
        const int nsel = cur < 3 ? cur : 3;
        for (int s = 0; s < nsel; ++s) {
            float best = -3.0e38f; int bi = 0;
#pragma unroll
            for (int n = 0; n < 8; ++n) { const bool tk = (n < cur) && !((selmask >> n) & 1u) && (gate[n] > best); if (tk) { best = gate[n]; bi = n; } }
            selmask |= 1u << bi;
        }
    }
    f32x16 o[2];
#pragma unroll
    for (int db = 0; db < 2; ++db)
#pragma unroll
        for (int i = 0; i < 16; ++i) o[db][i] = 0.f;
    float lsum = 0.f;
    const bf16_t* Kg = proj + rowb * PP + C_MK + hd * 64; const bf16_t* Vg = proj + rowb * PP + C_MV + hd * 64;
    const int ntiles = 4 * (cur + 1);
#define MOBA_KEY0(T) ((((T) < 4) ? cur : (((T) >> 2) - 1)) * 256 + ((T) & 3) * 64)
    const int widu = wid;
    asm volatile("s_waitcnt vmcnt(0) lgkmcnt(0)\n\ts_barrier" ::: "memory");
#pragma unroll
    for (int t = 0; t < 3; ++t) dma_tile<64>(Kg, Vg, MOBA_KEY0(t), lds + t * SLOT64, widu, lane);
    __builtin_amdgcn_s_waitcnt(0);
    for (int t = 0; t < ntiles; ++t) {
        ring_wait<2>(ntiles - 1 - t);
        if (t + 3 < ntiles) dma_tile<64>(Kg, Vg, MOBA_KEY0(t + 3), lds + ((t + 3) & 3) * SLOT64, widu, lane);
        const LAS char* slot = lds + (t & 3) * SLOT64;
        const int blk = (t < 4) ? cur : (t >> 2) - 1;
        const int key0 = blk * 256 + (t & 3) * 64;
        const bool own = (t < 4);
        const bool lane_on = own ? true : (((selmask >> blk) & 1u) != 0u);
        const bool wave_on = own ? (key0 <= qw0 + 31) : (__any(lane_on) != 0);
        if (wave_on) {
            f32x16 sA, sB;
            qk_tile(sA, sB, slot, qf, r, h, noff);
            if (own) {
                if (key0 + 63 > qw0) {
                    const int qpos = qw0 + r;
#pragma unroll
                    for (int j = 0; j < 16; ++j) { const int kp = key0 + crow(j, h); if (kp > qpos) sA[j] = NEGF; if (kp + 32 > qpos) sB[j] = NEGF; }
                }
            } else if (!lane_on) {
#pragma unroll
                for (int j = 0; j < 16; ++j) { sA[j] = NEGF; sB[j] = NEGF; }
            }
            softmax_pv<2>(sA, sB, o, lsum, slot + SLOT_K, lane);
        }
    }
#undef MOBA_KEY0
    const float il = frcp(swapsum(lsum));
#pragma unroll
    for (int i = 0; i < 16; ++i) { const float a = __shfl(il, crow(i, h));
        bf16_t* yp = yabc + (rowb + qw0 + crow(i, h)) * YW + Y_C + hd * 64 + r;
#pragma unroll
        for (int db = 0; db < 2; ++db) yp[db * 32] = (bf16_t)f2bf(o[db][i] * a); }
}
}
namespace thin {
struct TItem { f32x4 v[8][2]; };
__device__ __forceinline__ void titem_load(TItem& it, const float* W, int N, int item, int lane) {
    const int nblk = N >> 6, kb = item / nblk, nb = item - kb * nblk;
    const float* p = W + (size_t)(kb * 64 + 2 * (lane >> 4)) * N + nb * 64 + 4 * (lane & 15);
#pragma unroll
    for (int i = 0; i < 8; ++i) { it.v[i][0] = *(const f32x4*)(p + (size_t)(8 * i) * N); it.v[i][1] = *(const f32x4*)(p + (size_t)(8 * i + 1) * N); }
}
__device__ __forceinline__ void titem_store(const TItem& it, int N, bf16_t* WT, int ldk, int coff, int row_off, int mode, LAS unsigned* T, int item, int lane) {
    const int nblk = N >> 6, kb = item / nblk, nb = item - kb * nblk, k0 = kb * 64, n0 = nb * 64;
    const int kp = lane >> 4, np = lane & 15;
#pragma unroll
    for (int i = 0; i < 8; ++i) { const int col = (kp + 4 * i) ^ ((np & 7) << 2);
#pragma unroll
        for (int j = 0; j < 4; ++j) T[(4 * np + j) * 32 + col] = pk2(it.v[i][0][j], it.v[i][1][j]); }
    asm volatile("s_waitcnt lgkmcnt(0)" ::: "memory");
    const int c = lane & 7;
#pragma unroll
    for (int j = 0; j < 8; ++j) { const int n = (lane >> 3) + 8 * j;
        const u32x4 o = *(const LAS u32x4*)(T + n * 32 + 4 * (c ^ ((n >> 2) & 7)));
        const int nn = n0 + n; const int row = row_off + (mode == 0 ? nn : ((nn >> 7) * 256 + (mode == 2 ? 128 : 0) + (nn & 127)));
        const bf16_t* dstp = WT + (size_t)row * ldk + coff + k0 + 8 * c;
        asm volatile("global_store_dwordx4 %0, %1, off\n\ts_nop 2" :: "v"(dstp), "v"(o) : "memory"); }
    asm volatile("s_waitcnt lgkmcnt(0)" ::: "memory");
}
__device__ __forceinline__ void transpose_matrix(const float* W, int K, int N, bf16_t* WT, int ldk, int coff, int row_off, int mode, LAS float* scr, int gw, int ngw, int lane) {
    const int nitems = (K >> 6) * (N >> 6);
    LAS unsigned* T = (LAS unsigned*)scr;
    TItem cur;
    int it = gw;
    if (it < nitems) titem_load(cur, W, N, it, lane);
    while (it < nitems) {
        const int nx = it + ngw;
        TItem nxt;
        if (nx < nitems) titem_load(nxt, W, N, nx, lane);
        titem_store(cur, N, WT, ldk, coff, row_off, mode, T, it, lane);
        cur = nxt; it = nx;
    }
}

__device__ __forceinline__ void mod_body(const float* c, const float* ada_w, const float* ada_b, float* mod, int bid, int G, int tid, LAS float* red) {
    for (int cb = bid; cb < (2 * 6 * D) / 48; cb += G) {
        const int kg = tid / 48, jj = tid - kg * 48;
        const int idx = cb * 48 + jj, l = idx / (6 * D), j = idx - l * (6 * D);
        float acc[NB];
#pragma unroll
        for (int b = 0; b < NB; ++b) acc[b] = 0.f;
        if (kg < 8) {
            const float* w = ada_w + (size_t)l * D * 6 * D + (size_t)(kg * 128) * 6 * D + j;
#pragma unroll 16
            for (int k = 0; k < 128; ++k) { const float wv = w[(size_t)k * 6 * D];
#pragma unroll
                for (int b = 0; b < NB; ++b) acc[b] += c[b * D + kg * 128 + k] * wv; }
#pragma unroll
            for (int b = 0; b < NB; ++b) red[(kg * 48 + jj) * NB + b] = acc[b];
        }
        __syncthreads();
        if (tid < 48 * NB) { const int j2 = tid >> 3, b = tid & 7; float s = 0.f;
#pragma unroll
            for (int g = 0; g < 8; ++g) s += red[(g * 48 + j2) * NB + b];
            const int idx2 = cb * 48 + j2, l2 = idx2 / (6 * D), jo = idx2 - l2 * (6 * D);
            mod[((size_t)l2 * NB + b) * 6 * D + jo] = s + ada_b[l2 * 6 * D + jo]; }
        __syncthreads();
    }
}
__device__ __forceinline__ void rope_body(const int* positions, f32x2* cs, int gtid, int ngt) {
    for (int idx = gtid; idx < M * 32; idx += ngt) {
        const int tok = idx >> 5, i = idx & 31;
        const float inv = 1.0f / powf(10000.0f, (float)(2 * i) / 64.0f);
        const float ang = (float)positions[tok] * inv;
        float s, c; sincosf(ang, &s, &c);
        cs[idx] = (f32x2){c, s};
    }
}
template <int R>
__device__ __forceinline__ void norm_rows(const float* xrow, const float* g, const float* shift, const float* scale, bf16_t* orow, int lane, f32x4 (&y)[R][4]) {
    f32x4 v[R][4]; float ss[R];
#pragma unroll
    for (int r = 0; r < R; ++r) { const f32x4* xr = (const f32x4*)(xrow + (size_t)r * D) + lane;
#pragma unroll
        for (int j = 0; j < 4; ++j) v[r][j] = xr[64 * j]; }
#pragma unroll
    for (int r = 0; r < R; ++r) { float s = 0.f;
#pragma unroll
        for (int j = 0; j < 4; ++j) s += (v[r][j].x * v[r][j].x + v[r][j].y * v[r][j].y) + (v[r][j].z * v[r][j].z + v[r][j].w * v[r][j].w);
        ss[r] = s; }
#pragma unroll
    for (int o = 1; o < 64; o <<= 1) {
#pragma unroll
        for (int r = 0; r < R; ++r) ss[r] += __shfl_xor(ss[r], o); }
#pragma unroll
    for (int j = 0; j < 4; ++j) { const int col = 4 * lane + 256 * j;
        const f32x4 gg = *(const f32x4*)(g + col), sc = *(const f32x4*)(scale + col), sh = *(const f32x4*)(shift + col);
        const f32x4 gs = gg * (sc + 1.0f);
#pragma unroll
        for (int r = 0; r < R; ++r) { const float rn = rsqrtf(ss[r] * (1.0f / D) + EPS);
            y[r][j] = v[r][j] * rn * gs + sh;
            u32x2 w; w.x = pk2(y[r][j].x, y[r][j].y); w.y = pk2(y[r][j].z, y[r][j].w); ((u32x2*)(orow + (size_t)r * D) + lane)[64 * j] = w; } }
}
__device__ __forceinline__ void norm_body(const float* x, const float* g, const float* shift, const float* scale, bf16_t* out, int gw, int ngw, int lane) {
    for (int m = gw * 8; m < M; m += ngw * 8) { const int b = m / SEQ; f32x4 y[8][4]; norm_rows<8>(x + (size_t)m * D, g, shift + b * 6 * D, scale + b * 6 * D, out + (size_t)m * D, lane, y); }
}
__device__ __forceinline__ void norm_router_body(const float* x, const float* g, const float* shift, const float* scale, bf16_t* out,
                                                 const float* rw, const float* rb, int* topi, float* topw, int gw, int ngw, int lane) {
    for (int m0 = gw * 2; m0 < M; m0 += ngw * 2) { const int b = m0 / SEQ; f32x4 y[2][4];
        norm_rows<2>(x + (size_t)m0 * D, g, shift + b * 6 * D, scale + b * 6 * D, out + (size_t)m0 * D, lane, y);
        float lg[2][NE];
#pragma unroll
        for (int r = 0; r < 2; ++r)
#pragma unroll
            for (int e = 0; e < NE; ++e) lg[r][e] = 0.f;
#pragma unroll
        for (int j = 0; j < 4; ++j)
#pragma unroll
            for (int q = 0; q < 4; ++q) { const int col = 4 * lane + 256 * j + q; const f32x4 w0 = *(const f32x4*)(rw + col * NE), w1 = *(const f32x4*)(rw + col * NE + 4);
#pragma unroll
                for (int r = 0; r < 2; ++r) { const float hv = y[r][j][q];
                    lg[r][0] += hv * w0.x; lg[r][1] += hv * w0.y; lg[r][2] += hv * w0.z; lg[r][3] += hv * w0.w; lg[r][4] += hv * w1.x; lg[r][5] += hv * w1.y; lg[r][6] += hv * w1.z; lg[r][7] += hv * w1.w; } }
#pragma unroll
        for (int o = 1; o < 64; o <<= 1) {
#pragma unroll
            for (int r = 0; r < 2; ++r)
#pragma unroll
                for (int e = 0; e < NE; ++e) lg[r][e] += __shfl_xor(lg[r][e], o); }
#pragma unroll
        for (int r = 0; r < 2; ++r) { const int m = m0 + r;
#pragma unroll
            for (int e = 0; e < NE; ++e) lg[r][e] += rb[e];
            int i0 = 0; float v0 = lg[r][0];
#pragma unroll
            for (int e = 1; e < NE; ++e) if (lg[r][e] > v0) { v0 = lg[r][e]; i0 = e; }
            int i1 = -1; float v1 = -3.0e38f;
#pragma unroll
            for (int e = 0; e < NE; ++e) if (e != i0 && lg[r][e] > v1) { v1 = lg[r][e]; i1 = e; }
            const float w1v = 1.0f / (1.0f + expf(v0 - v1)), w0v = 1.0f - w1v;
            if (lane == 0) { topi[2 * m] = i0; topi[2 * m + 1] = i1; topw[2 * m] = w0v; topw[2 * m + 1] = w1v; } }
    }
}
__device__ __forceinline__ void qknorm_body(bf16_t* proj, const f32x2* cs, const float* dqn, const float* dkn, const float* mqn, const float* mkn, int gtid, int ngt) {
    for (long idx = gtid; idx < (long)M * 32 * 32; idx += ngt) {
        const int i = (int)(idx & 31); const long pair = idx >> 5; const int hh = (int)(pair & 31); const int tok = (int)(pair >> 5);
        const int grp = hh >> 3, hi = hh & 7;
        const int cb = (grp == 0 ? C_DQ : grp == 1 ? C_DK : grp == 2 ? C_MQ : C_MK) + hi * 64;
        const float* gn = grp == 0 ? dqn : grp == 1 ? dkn : grp == 2 ? mqn : mkn;
        bf16_t* p = proj + (size_t)tok * INC + cb;
        const float x1 = bf2f(p[i]), x2 = bf2f(p[i + 32]);
        float ss = x1 * x1 + x2 * x2;
        ss += __shfl_xor(ss, 1); ss += __shfl_xor(ss, 2); ss += __shfl_xor(ss, 4); ss += __shfl_xor(ss, 8); ss += __shfl_xor(ss, 16);
        const float rn = rsqrtf(ss * (1.0f / 64.0f) + EPS);
        const float y1 = x1 * rn * gn[i], y2 = x2 * rn * gn[i + 32];
        const f32x2 c = cs[(size_t)tok * 32 + i];
        float o1 = y1 * c.x - y2 * c.y, o2 = y2 * c.x + y1 * c.y;
        if ((grp & 1) == 0) { o1 *= QSCALE; o2 *= QSCALE; }
        p[i] = (bf16_t)f2bf(o1); p[i + 32] = (bf16_t)f2bf(o2);
    }
}
__device__ __forceinline__ void kmean_body(const bf16_t* proj, float* kmean, int gw, int ngw, int lane) {
    for (int it = gw; it < NB * 8 * 8; it += ngw) { const int blk = it & 7, hd = (it >> 3) & 7, b = it >> 6;
        const bf16_t* p = proj + ((size_t)b * SEQ + blk * 256) * INC + C_MK + hd * 64 + lane;
        float s = 0.f;
        for (int t = 0; t < 256; ++t) s += bf2f(p[(size_t)t * INC]);
        kmean[(size_t)it * 64 + lane] = s * (1.0f / 256.0f); }
}
__device__ __forceinline__ void moe_combine_body(const float* x1, const bf16_t* yslot, const float* gate, float* out, int gtid, int ngt) {
    for (long idx0 = gtid; idx0 < (long)M * D / 4; idx0 += 4L * ngt) {
        f32x4 xv[4], gv[4]; u32x2 a[4], c[4];
#pragma unroll
        for (int u = 0; u < 4; ++u) { const long idx = idx0 + (long)u * ngt; const int m = (int)(idx >> 8), c4 = (int)(idx & 255) * 4; const int b = m / SEQ;
            xv[u] = *(const f32x4*)(x1 + (size_t)m * D + c4); gv[u] = *(const f32x4*)(gate + b * 6 * D + c4);
            a[u] = *(const u32x2*)(yslot + (size_t)m * D + c4); c[u] = *(const u32x2*)(yslot + ((size_t)M + m) * D + c4); }
#pragma unroll
        for (int u = 0; u < 4; ++u) { const long idx = idx0 + (long)u * ngt; const int m = (int)(idx >> 8), c4 = (int)(idx & 255) * 4;
            const f32x4 y = {bf2f(a[u].x & 0xffffu) + bf2f(c[u].x & 0xffffu), bf2f(a[u].x >> 16) + bf2f(c[u].x >> 16), bf2f(a[u].y & 0xffffu) + bf2f(c[u].y & 0xffffu), bf2f(a[u].y >> 16) + bf2f(c[u].y >> 16)};
            *(f32x4*)(out + (size_t)m * D + c4) = xv[u] + gv[u] * y; }
    }
}
}
namespace qk {
constexpr int LDS_BYTES = 8 * 64 * 8 * 4;
__device__ __forceinline__ void unit(int b, int blk, int grp, bf16_t* proj, const f32x2* cs, const float* gn, float* kmean, LAS char* lds, int wid) {
    const int lane = lane_fresh(), tid = wid * 64 + lane;
    const int hd = lane >> 3, half = (lane >> 2) & 1, j = lane & 3;
    const int cb = (grp == 0 ? C_DQ : grp == 1 ? C_DK : grp == 2 ? C_MQ : C_MK) + hd * 64 + half * 32 + 8 * j;
    float gnv[8];
#pragma unroll
    for (int e = 0; e < 8; ++e) gnv[e] = gn[half * 32 + 8 * j + e];
    const float qs = ((grp & 1) == 0) ? QSCALE : 1.0f;
    const float sgn = half ? 1.0f : -1.0f;
    float ksum[8];
#pragma unroll
    for (int e = 0; e < 8; ++e) ksum[e] = 0.f;
    for (int i0 = 0; i0 < 32; i0 += 4) {
        u32x4 raw[4]; f32x4 cq[4][4];
#pragma unroll
        for (int u = 0; u < 4; ++u) { const size_t tok = (size_t)b * SEQ + blk * 256 + wid + 8 * (i0 + u);
            raw[u] = *(const u32x4*)(proj + tok * PP + cb);
            const f32x4* cp = (const f32x4*)(cs + tok * 32 + 8 * j);
            cq[u][0] = cp[0]; cq[u][1] = cp[1]; cq[u][2] = cp[2]; cq[u][3] = cp[3]; }
#pragma unroll
        for (int u = 0; u < 4; ++u) { const size_t tok = (size_t)b * SEQ + blk * 256 + wid + 8 * (i0 + u);
            float x[8] = {bf2f(raw[u].x & 0xffffu), bf2f(raw[u].x >> 16), bf2f(raw[u].y & 0xffffu), bf2f(raw[u].y >> 16), bf2f(raw[u].z & 0xffffu), bf2f(raw[u].z >> 16), bf2f(raw[u].w & 0xffffu), bf2f(raw[u].w >> 16)};
            float ss = 0.f;
#pragma unroll
            for (int e = 0; e < 8; ++e) ss += x[e] * x[e];
            ss += __shfl_xor(ss, 1); ss += __shfl_xor(ss, 2); ss += __shfl_xor(ss, 4);
            const float rn = rsqrtf(ss * (1.0f / 64.0f) + EPS);
            const float cc[8] = {cq[u][0].x, cq[u][0].z, cq[u][1].x, cq[u][1].z, cq[u][2].x, cq[u][2].z, cq[u][3].x, cq[u][3].z}, sn[8] = {cq[u][0].y, cq[u][0].w, cq[u][1].y, cq[u][1].w, cq[u][2].y, cq[u][2].w, cq[u][3].y, cq[u][3].w};
            float o[8];
#pragma unroll
            for (int e = 0; e < 8; ++e) { const float y = x[e] * rn * gnv[e]; const float py = __shfl_xor(y, 4); o[e] = (y * cc[e] + sgn * py * sn[e]) * qs; }
            u32x4 w; w.x = pk2(o[0], o[1]); w.y = pk2(o[2], o[3]); w.z = pk2(o[4], o[5]); w.w = pk2(o[6], o[7]);
            *(u32x4*)(proj + tok * PP + cb) = w;
            if (grp == 3) { ksum[0] += bf2f(w.x & 0xffffu); ksum[1] += bf2f(w.x >> 16); ksum[2] += bf2f(w.y & 0xffffu); ksum[3] += bf2f(w.y >> 16);
                            ksum[4] += bf2f(w.z & 0xffffu); ksum[5] += bf2f(w.z >> 16); ksum[6] += bf2f(w.w & 0xffffu); ksum[7] += bf2f(w.w >> 16); }
        }
    }
    if (grp == 3) {
        LAS float* red = (LAS float*)lds;
        __syncthreads();
#pragma unroll
        for (int e = 0; e < 8; ++e) red[(wid * 64 + lane) * 8 + e] = ksum[e];
        __syncthreads();
        { const int ln = tid >> 3, e = tid & 7; float s = 0.f;
#pragma unroll
          for (int w = 0; w < 8; ++w) s += red[(w * 64 + ln) * 8 + e];
          const int h2 = ln >> 3, hf = (ln >> 2) & 1, jj = ln & 3;
          kmean[((size_t)((b * 8 + h2) * 8 + blk)) * 64 + hf * 32 + 8 * jj + e] = s * (1.0f / 256.0f); }
        __syncthreads();
    }
}
}
namespace rglru {
constexpr int TT = 32;
constexpr int LDS_WA = 0, LDS_WX = 16384, LDS_XC = 32768, LDS_A = LDS_XC + TT * 65 * 4, LDS_U = LDS_A + TT * 64 * 4, LDS_BYTES = LDS_U + TT * 64 * 4;
__device__ __forceinline__ void unit(int b, int n, const bf16_t* proj, bf16_t* yabc, const float* conv_w, const float* conv_b, const float* wa, const float* ba,
                                     const float* wx, const float* bx, const float* lam, LAS char* lds) {
    int tid_l = threadIdx.x; asm volatile("" : "+v"(tid_l));
    const int tid = tid_l;
    LAS float* Wa = (LAS float*)(lds + LDS_WA); LAS float* Wx = (LAS float*)(lds + LDS_WX); LAS float* XC = (LAS float*)(lds + LDS_XC);
    LAS float* AV = (LAS float*)(lds + LDS_A); LAS float* UV = (LAS float*)(lds + LDS_U);
    __syncthreads();
    for (int i = tid; i < 4096; i += 512) { Wa[i] = wa[(size_t)n * 4096 + i]; Wx[i] = wx[(size_t)n * 4096 + i]; }
    const int cc = tid & 63, ct = tid >> 6;
    const int ch = n * 64 + cc;
    const float cw0 = conv_w[0 * D + ch], cw1 = conv_w[1 * D + ch], cw2 = conv_w[2 * D + ch], cw3 = conv_w[3 * D + ch], cb = conv_b[ch];
    const int gt = tid >> 4, eq = tid & 15;
    float gba[4], gbx[4], gsp[4];
#pragma unroll
    for (int j = 0; j < 4; ++j) { const int e = n * 64 + eq * 4 + j; gba[j] = ba[e]; gbx[j] = bx[e]; const float x = -lam[e]; gsp[j] = fmaxf(x, 0.f) + log1pf(expf(-fabsf(x))); }
    float hstate = 0.f;
    const size_t rowb = (size_t)b * SEQ;
    __syncthreads();
    for (int t0 = 0; t0 < SEQ; t0 += TT) {
#pragma unroll
        for (int i = 0; i < 4; ++i) { const int tt = ct + 8 * i, t = t0 + tt;
            const bf16_t* p = proj + (rowb + t) * INC + C_XR + ch;
            float acc = cb + cw3 * bf2f(p[0]);
            if (t >= 1) acc += cw2 * bf2f(*(p - INC));
            if (t >= 2) acc += cw1 * bf2f(*(p - 2 * INC));
            if (t >= 3) acc += cw0 * bf2f(*(p - 3 * INC));
            XC[tt * 65 + cc] = acc; }
        __syncthreads();
        { f32x4 ar = {0.f, 0.f, 0.f, 0.f}, ai = {0.f, 0.f, 0.f, 0.f};
#pragma unroll 8
          for (int d = 0; d < 64; ++d) { const float xv = XC[gt * 65 + d]; ar += *(const LAS f32x4*)(Wa + d * 64 + eq * 4) * xv; ai += *(const LAS f32x4*)(Wx + d * 64 + eq * 4) * xv; }
#pragma unroll
          for (int j = 0; j < 4; ++j) { const int e = eq * 4 + j;
              const float rg = 1.0f / (1.0f + expf(-(ar[j] + gba[j]))), ig = 1.0f / (1.0f + expf(-(ai[j] + gbx[j])));
              const float log_a = -8.0f * rg * gsp[j]; const float a = expf(log_a); const float mult = sqrtf(-expm1f(2.0f * log_a));
              AV[gt * 64 + e] = a; UV[gt * 64 + e] = mult * ig * XC[gt * 65 + e]; } }
        __syncthreads();
        if (tid < 64) {
            for (int tt = 0; tt < TT; ++tt) { hstate = AV[tt * 64 + tid] * hstate + UV[tt * 64 + tid];
                const size_t row = rowb + t0 + tt;
                const float g = bf2f(proj[row * INC + C_GR + n * 64 + tid]);
                yabc[row * YW + Y_A + n * 64 + tid] = (bf16_t)f2bf(g * hstate); }
        }
        __syncthreads();
    }
}
}

namespace moe {
__device__ __forceinline__ void assign(const int* topi, const float* topw, int* rowtok, int* rowdst, float* roww, int* tile_e, int* ntiles, LAS int* sm, int tid) {
    typedef int i32x4 __attribute__((ext_vector_type(4)));
    const int nthr = 512, per = M / nthr, t0 = tid * per;
    int cnt[NE];
#pragma unroll
    for (int e = 0; e < NE; ++e) cnt[e] = 0;
    { i32x4 a = *(const i32x4*)(topi + 2 * t0), b = *(const i32x4*)(topi + 2 * t0 + 4);
#pragma unroll 1
      for (int i = 0; i < 8; ++i) { i32x4 na = a, nb = b;
        if (i < 7) { na = *(const i32x4*)(topi + 2 * t0 + 8 * (i + 1)); nb = *(const i32x4*)(topi + 2 * t0 + 8 * (i + 1) + 4); }
#pragma unroll
        for (int q = 0; q < 4; ++q)
#pragma unroll
            for (int e = 0; e < NE; ++e) cnt[e] += (a[q] == e) + (b[q] == e);
        a = na; b = nb; } }
#pragma unroll
    for (int e = 0; e < NE; ++e) sm[e * nthr + tid] = cnt[e];
    __syncthreads();
    { const int e = tid >> 6, ln = tid & 63;
      int v[8], s = 0;
#pragma unroll
      for (int i = 0; i < 8; ++i) { v[i] = sm[e * nthr + 8 * ln + i]; s += v[i]; }
      int incl = s;
#pragma unroll
      for (int o = 1; o < 64; o <<= 1) { const int up = __shfl_up(incl, o); if (ln >= o) incl += up; }
      int run = incl - s;
#pragma unroll
      for (int i = 0; i < 8; ++i) { sm[e * nthr + 8 * ln + i] = run; run += v[i]; }
      if (ln == 63) sm[NE * nthr + e] = incl; }
    __syncthreads();
    if (tid == 0) { int p = 0, nt = 0;
        for (int e = 0; e < NE; ++e) { const int tot = sm[NE * nthr + e]; sm[NE * nthr + 8 + e] = p; const int nte = (tot + 255) >> 8; for (int i = 0; i < nte; ++i) tile_e[nt++] = e; p += nte * 256; }
        *ntiles = nt; }
    __syncthreads();
    for (int e = 0; e < NE; ++e) { const int tot = sm[NE * nthr + e], base = sm[NE * nthr + 8 + e], padded = ((tot + 255) >> 8) << 8;
        for (int i = tot + tid; i < padded; i += nthr) { rowtok[base + i] = 0; rowdst[base + i] = -1; roww[base + i] = 0.f; } }
    int pos[NE];
#pragma unroll
    for (int e = 0; e < NE; ++e) pos[e] = sm[NE * nthr + 8 + e] + sm[e * nthr + tid];
    { i32x4 a = *(const i32x4*)(topi + 2 * t0), b = *(const i32x4*)(topi + 2 * t0 + 4); f32x4 wa = *(const f32x4*)(topw + 2 * t0), wb = *(const f32x4*)(topw + 2 * t0 + 4);
#pragma unroll 1
      for (int i = 0; i < 8; ++i) { i32x4 na = a, nb = b; f32x4 nwa = wa, nwb = wb;
        if (i < 7) { na = *(const i32x4*)(topi + 2 * t0 + 8 * (i + 1)); nb = *(const i32x4*)(topi + 2 * t0 + 8 * (i + 1) + 4); nwa = *(const f32x4*)(topw + 2 * t0 + 8 * (i + 1)); nwb = *(const f32x4*)(topw + 2 * t0 + 8 * (i + 1) + 4); }
#pragma unroll
        for (int q = 0; q < 8; ++q) { const int ek = (q < 4) ? a[q & 3] : b[q & 3]; const float wv = (q < 4) ? wa[q & 3] : wb[q & 3]; const int t = t0 + 4 * i + (q >> 1), k = q & 1; int p = 0;
#pragma unroll
            for (int e = 0; e < NE; ++e) { if (ek == e) { p = pos[e]; pos[e] = p + 1; } }
            rowtok[p] = t; rowdst[p] = k * M + t; roww[p] = wv; }
        a = na; b = nb; wa = nwa; wb = nwb; } }
}
struct Order {
    const int* tile_e; const int* ntiles_p; int nN, G, c, ntiles;
    __device__ __forceinline__ void dev_init(int G_, int c_) { G = G_; c = c_; ntiles = *ntiles_p; }
    __device__ __forceinline__ bool next(int i, pg8::Unit& u) const { const int L = i * G + c; if (L >= ntiles * nN) return false; u.pm = L / nN; u.pn = L % nN; u.e = tile_e[u.pm]; u.aux = 0; return true; }
};
struct ProbUp {
    static constexpr bool GATHER = true;
    const bf16_t* A; const bf16_t* Ba; const bf16_t* Bb; const bf16_t* Bc; const bf16_t* Bd; const int* rowtok; int K, lda, ldb, pad;
    __device__ __forceinline__ const char* a_base(const pg8::Unit&) const { return (const char*)A; }
    __device__ __forceinline__ const char* b_base(const pg8::Unit& u) const {
        const char* base = (u.e == 0) ? (const char*)Ba : (u.e < 5) ? (const char*)Bb + (size_t)(u.e - 1) * DFF2 * ldb * 2 : (u.e < 7) ? (const char*)Bc + (size_t)(u.e - 5) * DFF2 * ldb * 2 : (const char*)Bd;
        return base + (size_t)u.pn * 256 * ldb * 2; }
    __device__ __forceinline__ unsigned a_off(const pg8::Unit& u, int row, int col) const { return (unsigned)(rowtok[u.pm * 256 + row] * lda + col) * 2u; }
};
struct ProbDown {
    static constexpr bool GATHER = false;
    const bf16_t* A; const bf16_t* Bt; int K, lda, ldb, pad;
    __device__ __forceinline__ const char* a_base(const pg8::Unit& u) const { return (const char*)A + (size_t)u.pm * 256 * lda * 2; }
    __device__ __forceinline__ const char* b_base(const pg8::Unit& u) const { return (const char*)Bt + ((size_t)u.e * D + (size_t)u.pn * 256) * ldb * 2; }
    __device__ __forceinline__ unsigned a_off(const pg8::Unit&, int row, int col) const { return (unsigned)(row * lda + col) * 2u; }
};
}
namespace rg2 {
constexpr int TT = 128, XS = 144  , FS = 36  ;
constexpr int L_XCB = 0, L_XCF = L_XCB + TT * XS, L_AV = L_XCF + TT * FS * 4, L_UV = L_AV + TT * FS * 4, L_WA = L_UV + TT * FS * 4, L_WX = L_WA + 32 * XS,
              L_CW = L_WX + 32 * XS, L_SEGA = L_CW + 5 * 64 * 4, L_SEGH = L_SEGA + 16 * 32 * 4, L_CARRY = L_SEGH + 16 * 32 * 4, LDS_BYTES = L_CARRY + 2 * 32 * 4;
__device__ __forceinline__ void unit(int b, int n, int hf, const bf16_t* proj, bf16_t* yabc, const float* conv_w, const float* conv_b, const float* wa, const float* ba,
                                     const float* wx, const float* bx, const float* lam, LAS char* lds, int wid) {
    const int lane = lane_fresh(), tid = wid * 64 + lane;
    LAS float* XCF = (LAS float*)(lds + L_XCF); LAS float* AV = (LAS float*)(lds + L_AV); LAS float* UV = (LAS float*)(lds + L_UV);
    LAS float* CW = (LAS float*)(lds + L_CW); LAS float* SEGA = (LAS float*)(lds + L_SEGA); LAS float* SEGH = (LAS float*)(lds + L_SEGH); LAS float* CARRY = (LAS float*)(lds + L_CARRY);
    const int ch0 = n * 64;
    const int oc0 = ch0 + hf * 32;
    __syncthreads();
    for (int i = tid; i < 2048; i += 512) { const int d = i >> 5, e = i & 31;
        *(LAS bf16_t*)(lds + L_WA + e * XS + d * 2) = (bf16_t)f2bf(wa[(size_t)n * 4096 + d * 64 + hf * 32 + e]);
        *(LAS bf16_t*)(lds + L_WX + e * XS + d * 2) = (bf16_t)f2bf(wx[(size_t)n * 4096 + d * 64 + hf * 32 + e]); }
    if (tid < 320) { const int k = tid >> 6, c = tid & 63; CW[tid] = (k < 4) ? conv_w[k * D + ch0 + c] : conv_b[ch0 + c]; }
    if (tid < 64) CARRY[tid] = 0.f;
    const int crow_ = tid >> 2, cg = tid & 3;
    const int mt = wid & 3, chh = wid >> 2;
    const int g4 = lane >> 4, e16 = lane & 15;
    const int eo = chh * 16 + e16;
    const float gba = ba[oc0 + eo], gbx = bx[oc0 + eo];
    float gk1; { const float x = -lam[oc0 + eo]; gk1 = -8.0f * 1.4426950408889634f * (fmaxf(x, 0.f) + log1pf(expf(-fabsf(x)))); }
    const int sc = tid & 31, ss = tid >> 5;
    const size_t rowb = (size_t)b * SEQ;
    const bf16_t* xbase = proj + rowb * PP + C_XR + ch0 + cg * 16;
    const bf16_t* gbase = proj + rowb * PP + C_GR + oc0 + sc;
    bf16_t* ybase = yabc + rowb * YW + Y_A + oc0 + sc;
    u32x4 xr[4][2]; unsigned short gv[8];
#define RG2_LOADX(T0) do { _Pragma("unroll") for (int k = 0; k < 4; ++k) { const int t = (T0) + crow_ - 3 + k; \
        if (t >= 0) { const bf16_t* p = xbase + (size_t)t * PP; xr[k][0] = *(const u32x4*)p; xr[k][1] = *(const u32x4*)(p + 8); } \
        else { xr[k][0] = (u32x4){0u, 0u, 0u, 0u}; xr[k][1] = (u32x4){0u, 0u, 0u, 0u}; } } } while (0)
    RG2_LOADX(0);
    __syncthreads();
    for (int ti = 0; ti < SEQ / TT; ++ti) {
        const int t0 = ti * TT;
        {
            float xc[16];
#pragma unroll
            for (int j = 0; j < 16; ++j) xc[j] = CW[4 * 64 + cg * 16 + j];
#pragma unroll
            for (int k = 0; k < 4; ++k) {
#pragma unroll
                for (int q = 0; q < 2; ++q) { const u32x4 w = xr[k][q]; const unsigned ww[4] = {w.x, w.y, w.z, w.w};
#pragma unroll
                    for (int j = 0; j < 4; ++j) { const int c = q * 8 + 2 * j;
                        xc[c] += CW[k * 64 + cg * 16 + c] * bf2f(ww[j] & 0xffffu); xc[c + 1] += CW[k * 64 + cg * 16 + c + 1] * bf2f(ww[j] >> 16); } } }
            u32x4 o0, o1;
            o0.x = pk2(xc[0], xc[1]); o0.y = pk2(xc[2], xc[3]); o0.z = pk2(xc[4], xc[5]); o0.w = pk2(xc[6], xc[7]);
            o1.x = pk2(xc[8], xc[9]); o1.y = pk2(xc[10], xc[11]); o1.z = pk2(xc[12], xc[13]); o1.w = pk2(xc[14], xc[15]);
            *(LAS u32x4*)(lds + L_XCB + crow_ * XS + cg * 32) = o0; *(LAS u32x4*)(lds + L_XCB + crow_ * XS + cg * 32 + 16) = o1;
            if ((cg >> 1) == hf) { LAS float* d = XCF + crow_ * FS + (cg & 1) * 16;
#pragma unroll
                for (int j = 0; j < 4; ++j) *(LAS f32x4*)(d + 4 * j) = (f32x4){xc[4 * j], xc[4 * j + 1], xc[4 * j + 2], xc[4 * j + 3]}; }
        }
#pragma unroll
        for (int k = 0; k < 8; ++k) gv[k] = gbase[(size_t)(t0 + ss * 8 + k) * PP];
        __syncthreads();
        if (ti + 1 < SEQ / TT) RG2_LOADX(t0 + TT);
        {
            f32x4 ar[2], ai[2];
#pragma unroll
            for (int s = 0; s < 2; ++s) { ar[s] = (f32x4){0.f, 0.f, 0.f, 0.f}; ai[s] = (f32x4){0.f, 0.f, 0.f, 0.f}; }
#pragma unroll
            for (int kk = 0; kk < 2; ++kk) {
                const bf16x8 bwa = *(const LAS bf16x8*)(lds + L_WA + eo * XS + (32 * kk + 8 * g4) * 2);
                const bf16x8 bwx = *(const LAS bf16x8*)(lds + L_WX + eo * XS + (32 * kk + 8 * g4) * 2);
#pragma unroll
                for (int s = 0; s < 2; ++s) {
                    const bf16x8 av = *(const LAS bf16x8*)(lds + L_XCB + (mt * 32 + 16 * s + e16) * XS + (32 * kk + 8 * g4) * 2);
                    ar[s] = __builtin_amdgcn_mfma_f32_16x16x32_bf16(av, bwa, ar[s], 0, 0, 0);
                    ai[s] = __builtin_amdgcn_mfma_f32_16x16x32_bf16(av, bwx, ai[s], 0, 0, 0);
                }
            }
#pragma unroll
            for (int s = 0; s < 2; ++s)
#pragma unroll
                for (int rg = 0; rg < 4; ++rg) {
                    const int tok = mt * 32 + 16 * s + 4 * g4 + rg;
                    const float er = fexp2(-1.4426950408889634f * (ar[s][rg] + gba)) + 1.0f, ei = fexp2(-1.4426950408889634f * (ai[s][rg] + gbx)) + 1.0f;
                    const float pr = frcp(er * ei);
                    const float rgt = ei * pr, igt = er * pr;
                    const float a = fexp2(rgt * gk1);
                    const float om = fmaxf(1.0f - a * a, 0.f);
                    const float u = __builtin_amdgcn_sqrtf(om) * igt * XCF[tok * FS + eo];
                    AV[tok * FS + eo] = a; UV[tok * FS + eo] = u;
                }
        }
        __syncthreads();
        float hl[8], ac[8];
        { float Hh = 0.f, Aa = 1.f;
#pragma unroll
          for (int k = 0; k < 8; ++k) { const float a = AV[(ss * 8 + k) * FS + sc], u = UV[(ss * 8 + k) * FS + sc]; Hh = a * Hh + u; Aa *= a; hl[k] = Hh; ac[k] = Aa; }
          SEGA[ss * 32 + sc] = Aa; SEGH[ss * 32 + sc] = Hh; }
        __syncthreads();
        { float cin = CARRY[(ti & 1) * 32 + sc];
#pragma unroll
          for (int s2 = 0; s2 < 15; ++s2) { const float sa = SEGA[s2 * 32 + sc], sh = SEGH[s2 * 32 + sc]; cin = (s2 < ss) ? sa * cin + sh : cin; }
#pragma unroll
          for (int k = 0; k < 8; ++k) { const float hv = hl[k] + ac[k] * cin; hl[k] = hv;
              ybase[(size_t)(t0 + ss * 8 + k) * YW] = (bf16_t)f2bf(bf2f(gv[k]) * hv); }
          if (ss == 15) CARRY[((ti + 1) & 1) * 32 + sc] = hl[7]; }
    }
    __syncthreads();
#undef RG2_LOADX
}
}
constexpr size_t MiB = 1u << 20;
constexpr size_t WS_CTL = 0, CTL_ZERO_BYTES = 64 * 1024, WS_ROWTOK = 256 * 1024, WS_ROWDST = 400 * 1024, WS_ROWW = 544 * 1024, WS_TILEE = 700 * 1024, WS_NTILES = 702 * 1024;
constexpr size_t WS_MOD = 1 * MiB, WS_CS = 1 * MiB + 512 * 1024, WS_KMEAN = 5 * MiB + 512 * 1024, WS_TOPI = 5 * MiB + 640 * 1024, WS_TOPW = 5 * MiB + 768 * 1024;
constexpr size_t WS_L1W = 6 * MiB, WS_H = 28 * MiB, WS_YABC = 60 * MiB, WS_PROJ = 124 * MiB, WS_XA = 380 * MiB, WS_SPARE = 444 * MiB, WS_END = 488 * MiB;
constexpr size_t WS_HMID_MOE = 138 * MiB, OUT_W2 = 0, OUT_W13A = 44 * MiB, WS_W13B = 444 * MiB, WS_W13C = 6 * MiB, WS_W13D = 124 * MiB, W13_BYTES = 11 * MiB, W2_BYTES = 5 * MiB + 512 * 1024;
constexpr size_t LW_IN = 0, LW_BRA = 16 * MiB, LW_BRB = 18 * MiB, LW_BRC = 19 * MiB, LW_OUT = 20 * MiB, LW_W13 = 22 * MiB, LW_W2 = 33 * MiB;
constexpr int CW_TMO = 0, CW_QUEUE = 64  , CW_BAR = 4096;
constexpr int LDS_MISC = 131072 + 8192, LDS_TOTAL = 147456;


#define XB_TMO      128
#define XB_XCNT(j)  (256  + 64 * (j))
#define XB_XSUB(j)  (1280 + 64 * (j))
#define XB_XGEN(j)  (2304 + 64 * (j))
#define XB_TOP      3328
#define XB_TOPGEN   3392
#define XCD_BAR_WORDS 3456
#define XB_SPIN_CAP (1u << 18)

__device__ __forceinline__ unsigned xb_ld(unsigned* p)              { return __hip_atomic_load(p, __ATOMIC_RELAXED, __HIP_MEMORY_SCOPE_AGENT); }
__device__ __forceinline__ unsigned xb_add(unsigned* p, unsigned v) { return __hip_atomic_fetch_add(p, v, __ATOMIC_RELAXED, __HIP_MEMORY_SCOPE_AGENT); }
__device__ __forceinline__ unsigned xb_xcc_id() { return (unsigned)__builtin_amdgcn_s_getreg((3 << 11) | 20) & 0xFu; }
#define XB_SPIN(cond, bar) do { unsigned _sp = 0; while (cond) { __builtin_amdgcn_s_sleep(1); \
    if ((++_sp & 255u) == 0u) { if (xb_ld(&(bar)[XB_TMO])) break; if (_sp > XB_SPIN_CAP) { atomicAdd(&(bar)[XB_TMO], 1u); break; } } } } while (0)

struct XcdBarrier {
    unsigned* bar; unsigned x;
    volatile LAS unsigned* st;
};

__device__ __forceinline__ XcdBarrier xcd_barrier_post(unsigned* bar, volatile LAS unsigned* st) {
    XcdBarrier b; b.bar = bar; b.x = xb_xcc_id(); b.st = st;
    if (threadIdx.x == 0) (void)xb_add(&bar[XB_XCNT(b.x)], 1u);
    return b;
}
__device__ __forceinline__ void xcd_barrier_complete(unsigned* bar, unsigned x, unsigned& nloc, unsigned& nx) {
    const unsigned G = gridDim.x * gridDim.y * gridDim.z;
    unsigned sum, cnt, mine, sp = 0u;
    for (;;) {
        sum = 0u; cnt = 0u; mine = 0u;
#pragma unroll
        for (unsigned j = 0; j < 16; ++j) { const unsigned c = xb_ld(&bar[XB_XCNT(j)]); sum += c; cnt += (c > 0u) ? 1u : 0u; mine = (j == x) ? c : mine; }
        if (sum == G) break;
        __builtin_amdgcn_s_sleep(1);
        if ((++sp & 255u) == 0u) { if (xb_ld(&bar[XB_TMO])) break; if (sp > XB_SPIN_CAP) { atomicAdd(&bar[XB_TMO], 1u); break; } }
    }
    nloc = mine > 0u ? mine : 1u; nx = cnt > 0u ? cnt : 1u;
}

__device__ __forceinline__ void xcd_barrier(const XcdBarrier& b) {
    asm volatile("s_waitcnt vmcnt(0)" ::: "memory");
    __syncthreads();
    if (threadIdx.x == 0) {
        unsigned* bar = b.bar;
        __builtin_amdgcn_s_waitcnt(0);
        unsigned nloc = b.st[0], nx = b.st[1];
        if (nloc == 0u) { xcd_barrier_complete(bar, b.x, nloc, nx); b.st[0] = nloc; b.st[1] = nx; }
        const unsigned old = xb_add(&bar[XB_XSUB(b.x)], 1u);
        const unsigned gen = old / nloc;
        if (old + 1u == (gen + 1u) * nloc) {
            __builtin_amdgcn_fence(__ATOMIC_RELEASE, "agent");
            asm volatile("s_waitcnt vmcnt(0)" ::: "memory");
            const unsigned og = xb_add(&bar[XB_TOP], 1u);
            const unsigned tg = og / nx;
            if (og + 1u == (tg + 1u) * nx) xb_add(&bar[XB_TOPGEN], 1u);
            else XB_SPIN(xb_ld(&bar[XB_TOPGEN]) == tg, bar);
            __builtin_amdgcn_fence(__ATOMIC_ACQUIRE, "agent");
            xb_add(&bar[XB_XGEN(b.x)], 1u);
            asm volatile("s_waitcnt vmcnt(0)" ::: "memory");
        } else {
            XB_SPIN(xb_ld(&bar[XB_XGEN(b.x)]) == gen, bar);
            __builtin_amdgcn_fence(__ATOMIC_ACQUIRE, "agent");
            asm volatile("s_waitcnt vmcnt(0)" ::: "memory");
        }
    }
    __syncthreads();
}


#ifndef PHMASK
#define PHMASK 0xFFFFF
#endif
#define PH(k) if constexpr ((PHMASK >> (k)) & 1)
#define QOFF 0
__device__ __forceinline__ const float* ldptr(const LAS unsigned long long* PT, int i) {
    const unsigned long long v = PT[i];
    const unsigned lo = __builtin_amdgcn_readfirstlane((unsigned)v), hi = __builtin_amdgcn_readfirstlane((unsigned)(v >> 32));
    return (const float*)(const __attribute__((address_space(1))) float*)(((unsigned long long)hi << 32) | lo);
}
struct CvtD { unsigned long long src, dst; int K, N, ldk, coff, row_off, mode, nunits, pad; };
__device__ __forceinline__ void cvt_unit(const LAS CvtD* cd, int first, int u, LAS float* scr, int wid, int lane) {
    int d = first;
    while (u >= cd[d].nunits) { u -= cd[d].nunits; ++d; }
    const float* W = (const float*)(const __attribute__((address_space(1))) float*)cd[d].src; bf16_t* WT = (bf16_t*)(__attribute__((address_space(1))) bf16_t*)cd[d].dst;
    const int N = cd[d].N, ldk = cd[d].ldk, coff = cd[d].coff, row_off = cd[d].row_off, mode = cd[d].mode;
    LAS unsigned* T = (LAS unsigned*)scr;
    thin::TItem t0, t1, t2;
    thin::titem_load(t0, W, N, 64 * u + wid, lane); thin::titem_load(t1, W, N, 64 * u + wid + 8, lane);
#pragma unroll 1
    for (int i = 0; i < 8; i += 3) { const int it = 64 * u + wid + 8 * i;
        if (i + 2 < 8) thin::titem_load(t2, W, N, it + 16, lane);
        thin::titem_store(t0, N, WT, ldk, coff, row_off, mode, T, it, lane);
        if (i + 3 < 8) thin::titem_load(t0, W, N, it + 24, lane);
        if (i + 1 < 8) thin::titem_store(t1, N, WT, ldk, coff, row_off, mode, T, it + 8, lane);
        if (i + 4 < 8) thin::titem_load(t1, W, N, it + 32, lane);
        if (i + 2 < 8) thin::titem_store(t2, N, WT, ldk, coff, row_off, mode, T, it + 16, lane); }
}
__device__ __forceinline__ void cvt_find(const LAS CvtD* cd, int first, int it, int& d, int& loc) { d = first; while (it >= cd[d].nunits * 64) { it -= cd[d].nunits * 64; ++d; } loc = it; }
__device__ __forceinline__ void cvt_flat(const LAS CvtD* cd, int first, int total, LAS float* scr, int gw, int ngw, int lane) {
    LAS unsigned* T = (LAS unsigned*)scr;
    int it = gw; if (it >= total) return;
    int d, loc; cvt_find(cd, first, it, d, loc);
    thin::TItem cur; thin::titem_load(cur, (const float*)(const __attribute__((address_space(1))) float*)cd[d].src, cd[d].N, loc, lane);
#pragma unroll 1
    while (it < total) {
        const int nx = it + ngw; int d2 = d, loc2 = loc;
        thin::TItem nxt;
        if (nx < total) { cvt_find(cd, first, nx, d2, loc2); thin::titem_load(nxt, (const float*)(const __attribute__((address_space(1))) float*)cd[d2].src, cd[d2].N, loc2, lane); }
        thin::titem_store(cur, cd[d].N, (bf16_t*)(__attribute__((address_space(1))) bf16_t*)cd[d].dst, cd[d].ldk, cd[d].coff, cd[d].row_off, cd[d].mode, T, loc, lane);
        cur = nxt; it = nx; d = d2; loc = loc2;
    }
}
struct Args { const float* in[37]; float* out; unsigned char* ws; };

__device__ __forceinline__ float diff_lambda(const float* lq1, const float* lk1, const float* lq2, const float* lk2, float lam_init, int lane) {
    const float s1 = wave_sum(lq1[lane] * lk1[lane]), s2 = wave_sum(lq2[lane] * lk2[lane]); return expf(s1) - expf(s2) + lam_init; }

constexpr int NQ_RG = 256;
constexpr int NCVT0 = 77, NCVT1 = 198;
__global__ void __launch_bounds__(512, 2) mega_fwd(Args a) {
    extern __shared__ __attribute__((aligned(16))) unsigned char lds_raw[];
    LAS unsigned char* lds = (LAS unsigned char*)lds_raw;
    volatile LAS unsigned* MISC = (volatile LAS unsigned*)(lds + LDS_MISC);
    const int tid0 = threadIdx.x, wid0 = __builtin_amdgcn_readfirstlane(tid0 >> 6);
    const int G = gridDim.x, bid = blockIdx.x;
    if (tid0 < 64) MISC[tid0] = 0u;
    LAS unsigned long long* PT = (LAS unsigned long long*)(lds + LDS_MISC + 256);
    if (tid0 == 0) {
#pragma unroll
        for (int i = 0; i < 37; ++i) PT[i] = (unsigned long long)a.in[i];
    }
    LAS CvtD* CD = (LAS CvtD*)(lds + LDS_MISC + 1024);
    if (tid0 == 64) {
        const unsigned long long wsb = (unsigned long long)a.ws, ob = (unsigned long long)a.out;
#define CVT_PUT(i, SRC, DST, K_, N_, LDK, COFF, MODE) do { CD[i].src = (unsigned long long)(SRC); CD[i].dst = (DST); CD[i].K = (K_); CD[i].N = (N_); CD[i].ldk = (LDK); CD[i].coff = (COFF); CD[i].row_off = 0; CD[i].mode = (MODE); CD[i].nunits = ((K_) >> 6) * ((N_) >> 6) / 64; CD[i].pad = 0; } while (0)
        CVT_PUT(0, a.in[7] + (size_t)D * INC, wsb + WS_L1W + LW_IN, D, INC, D, 0, 0);
        CVT_PUT(1, a.in[25] + (size_t)D * D, wsb + WS_L1W + LW_BRA, D, D, 2048, 0, 0);
        CVT_PUT(2, a.in[26] + (size_t)512 * D, wsb + WS_L1W + LW_BRA, 512, D, 2048, 1024, 0);
        CVT_PUT(3, a.in[27] + (size_t)512 * D, wsb + WS_L1W + LW_BRA, 512, D, 2048, 1536, 0);
        CVT_PUT(4, a.in[28] + (size_t)D * D, wsb + WS_L1W + LW_OUT, D, D, D, 0, 0);
        CVT_PUT(5, a.in[29], ob + LW_W13, D, DFF, D, 0, 1);
        CVT_PUT(6, a.in[30], ob + LW_W13, D, DFF, D, 0, 2);
        CVT_PUT(7, a.in[31], ob + LW_W2, DFF, D, DFF, 0, 0);
#pragma unroll
        for (int e = 0; e < NE; ++e) CVT_PUT(8 + e, a.in[36] + (size_t)e * DFF * D, ob + OUT_W2 + e * W2_BYTES, DFF, D, DFF, 0, 0);
#pragma unroll
        for (int e = 0; e < 5; ++e) { const unsigned long long dst = (e == 0) ? ob + OUT_W13A : wsb + WS_W13B + (e - 1) * W13_BYTES;
            CVT_PUT(16 + 2 * e, a.in[34] + (size_t)e * D * DFF, dst, D, DFF, D, 0, 1); CVT_PUT(17 + 2 * e, a.in[35] + (size_t)e * D * DFF, dst, D, DFF, D, 0, 2); }
        CVT_PUT(26, a.in[7], ob + LW_IN, D, INC, D, 0, 0);
        CVT_PUT(27, a.in[25], ob + LW_BRA, D, D, 2048, 0, 0);
        CVT_PUT(28, a.in[26], ob + LW_BRA, 512, D, 2048, 1024, 0);
        CVT_PUT(29, a.in[27], ob + LW_BRA, 512, D, 2048, 1536, 0);
        CVT_PUT(30, a.in[28], ob + LW_OUT, D, D, D, 0, 0);
#pragma unroll
        for (int e = 5; e < NE; ++e) { const unsigned long long dst = (e < 7) ? wsb + WS_W13C + (e - 5) * W13_BYTES : wsb + WS_W13D;
            CVT_PUT(31 + 2 * (e - 5), a.in[34] + (size_t)e * D * DFF, dst, D, DFF, D, 0, 1); CVT_PUT(32 + 2 * (e - 5), a.in[35] + (size_t)e * D * DFF, dst, D, DFF, D, 0, 2); }
#undef CVT_PUT
    }
    __syncthreads();
    XcdBarrier bar = xcd_barrier_post((unsigned*)(a.ws + WS_CTL) + CW_BAR, MISC + 8);
#define F(i) ldptr(PT, (i))
#define PHASE_VARS(lv) \
    unsigned long long ws_u = (unsigned long long)a.ws, out_u = (unsigned long long)a.out; const int l = (lv); int wid = wid0; \
    asm volatile("" : "+s"(ws_u), "+s"(out_u), "+s"(wid)); \
    const int lane = lane_fresh(), tid = wid * 64 + lane; \
    unsigned char* ws = (unsigned char*)(__attribute__((address_space(1))) unsigned char*)ws_u; float* outp = (float*)(__attribute__((address_space(1))) float*)out_u; \
    const int gw = bid * 8 + wid, ngw = G * 8, gtid = bid * 512 + tid, ngt = G * 512; (void)gw; (void)ngw; (void)gtid; (void)ngt; (void)lane; (void)l; (void)tid; \
    char* outb = (char*)outp; (void)outb; \
    float* mod = (float*)(ws + WS_MOD); f32x2* cs = (f32x2*)(ws + WS_CS); float* kmean = (float*)(ws + WS_KMEAN); (void)mod; (void)cs; (void)kmean; \
    bf16_t* H = (bf16_t*)(ws + WS_H); bf16_t* YABC = (bf16_t*)(ws + WS_YABC); bf16_t* PROJ = (bf16_t*)(ws + WS_PROJ); bf16_t* GATES = (bf16_t*)(ws + WS_PROJ + (size_t)M * PP * 2); (void)GATES; float* XA = (float*)(ws + WS_XA); (void)H; (void)YABC; (void)PROJ; (void)XA; \
    const float* xin = (l == 0) ? F(0) : (const float*)XA; float* x1 = XA; const char* lwb = (l == 0) ? (const char*)outb : (const char*)ws + WS_L1W; \
    const float* modl = mod + (size_t)l * NB * 6 * D; (void)xin; (void)x1; (void)lwb; (void)modl;

    PH(0) { PHASE_VARS(0)
        LAS float* scr = (LAS float*)(lds + wid * 8192);
        cvt_flat(CD, 26, 2816, scr, gw, ngw, lane);
        __syncthreads();
        thin::mod_body(F(1), F(3), F(4), mod, bid, G, tid, (LAS float*)(lds + 65536));
        thin::rope_body((const int*)F(2), cs, gtid, ngt);
    }
    xcd_barrier(bar);

    {
        PH(1) { PHASE_VARS(0) thin::norm_body(xin, F(5) + l * D, modl + 0 * D, modl + 1 * D, H, gw, ngw, lane); }
        xcd_barrier(bar);
        PH(2) { PHASE_VARS(0) pg8::DenseProb g{H, (const bf16_t*)(lwb + LW_IN), D, D, D, 0}; pg8::StaticOrder S; S.init(M, INC, G, bid);
          pg8::gemm_phase<pg8::DenseProb, epi::Proj, pg8::StaticOrder, true>(lds, g, S, epi::Proj{PROJ, F(8) + l * 3 * D, GATES}, wid); }
        xcd_barrier(bar);
        PH(3) { PHASE_VARS(0) for (int u = bid; u < 256; u += G) { const int grp = u & 3;
            qk::unit(u >> 5, (u >> 2) & 7, grp, PROJ, cs, (grp == 0 ? F(16) : grp == 1 ? F(17) : grp == 2 ? F(23) : F(24)) + l * 64, kmean, (LAS char*)lds, wid); } }
        xcd_barrier(bar);
        {
#define POP_Q() do { __syncthreads(); if (tid == 0) MISC[16] = __hip_atomic_fetch_add((unsigned*)(ws + WS_CTL) + CW_QUEUE + 64 * (l + QOFF), 1u, __ATOMIC_RELAXED, __HIP_MEMORY_SCOPE_AGENT); __syncthreads(); q = (int)MISC[16]; } while (0)
#define POP_ISSUE() do { if (tid == 0) qn = __hip_atomic_fetch_add((unsigned*)(ws + WS_CTL) + CW_QUEUE + 64 * (l + QOFF), 1u, __ATOMIC_RELAXED, __HIP_MEMORY_SCOPE_AGENT); } while (0)
#define POP_TAKE() do { __syncthreads(); if (tid == 0) MISC[16] = qn; __syncthreads(); q = (int)MISC[16]; } while (0)
            int q; constexpr int NCVT = (0 == 0) ? NCVT0 : NCVT1;
            { PHASE_VARS(0) POP_Q(); }
            PH(5) { PHASE_VARS(0)
              const float lam_init = 0.8f - 0.6f * expf(-0.3f * (float)l);
              const float lam = diff_lambda(F(18) + l * 64, F(19) + l * 64, F(20) + l * 64, F(21) + l * 64, lam_init, lane);
              const float noff = attn::score_shift(F(16) + l * 64, F(17) + l * 64, lane);
#pragma unroll 1
              while (q < 256) { const int i = q; unsigned qn = 0u; POP_ISSUE();
                attn::diff_unit((i & 31) >> 2, i & 3, 7 - (i >> 5), PROJ, YABC, F(22) + l * 128, lam, 1.0f - lam_init, noff, (LAS char*)lds, wid);
                POP_TAKE(); } }
            PH(18) { PHASE_VARS(0)
#pragma unroll 1
              while (q < 256 + NCVT) { unsigned qn = 0u; POP_ISSUE(); __syncthreads(); cvt_unit(CD, l == 0 ? 0 : 8, q - 256, (LAS float*)(lds + wid * 8192), wid, lane);
                POP_TAKE(); } }
            PH(4) { PHASE_VARS(0)
#pragma unroll 1
              while (q < 256 + NCVT + NQ_RG) { const int i = q - 256 - NCVT; unsigned qn = 0u; POP_ISSUE();
                rg2::unit(i >> 5, (i >> 1) & 15, i & 1, PROJ, YABC, F(9) + l * 4 * D, F(10) + l * D, F(11) + (size_t)l * 16 * 4096, F(12) + l * D, F(13) + (size_t)l * 16 * 4096, F(14) + l * D, F(15) + l * D, (LAS char*)lds, wid);
                POP_TAKE(); } }
            PH(6) { PHASE_VARS(0)
              const float noff = attn::score_shift(F(23) + l * 64, F(24) + l * 64, lane);
#pragma unroll 1
              while (q < 256 + NCVT + NQ_RG + 512) { const int i = q - NQ_RG - 256 - NCVT; unsigned qn = 0u; POP_ISSUE();
                attn::moba_unit((i & 63) >> 3, i & 7, 7 - (i >> 6), PROJ, YABC, kmean, noff, (LAS char*)lds, wid);
                POP_TAKE(); } }
#undef POP_Q
#undef POP_ISSUE
#undef POP_TAKE
        }
        xcd_barrier(bar);
        PH(7) { PHASE_VARS(0) pg8::StaticOrder S; S.init(M, D, G, bid); pg8::DenseProb g{YABC, (const bf16_t*)(lwb + LW_BRA), 2048, YW, 2048, 0};
          pg8::gemm_phase<pg8::DenseProb, epi::BranchMerge, pg8::StaticOrder, true>(lds, g, S, epi::BranchMerge{GATES, H, 16, 24}, wid); }
        xcd_barrier(bar);
        PH(8) { PHASE_VARS(0) pg8::DenseProb g{H, (const bf16_t*)(lwb + LW_OUT), D, D, D, 0}; pg8::StaticOrder S; S.init(M, D, G, bid);
          pg8::gemm_phase<pg8::DenseProb, epi::Resid, pg8::StaticOrder, true>(lds, g, S, epi::Resid{xin, x1, modl + 2 * D}, wid); }
        xcd_barrier(bar);
        if (0 == 0) {
            PH(9) { PHASE_VARS(0) thin::norm_body(x1, F(6) + l * D, modl + 3 * D, modl + 4 * D, H, gw, ngw, lane); }
            xcd_barrier(bar);
            PH(10) { PHASE_VARS(0) pg8::DenseProb g{H, (const bf16_t*)(lwb + LW_W13), D, D, D, 0}; pg8::StaticOrder S; S.init(M, DFF2, G, bid);
              pg8::gemm_phase<pg8::DenseProb, epi::SwiGLU, pg8::StaticOrder, true>(lds, g, S, epi::SwiGLU{PROJ}, wid); }
            xcd_barrier(bar);
            PH(11) { PHASE_VARS(0) pg8::DenseProb g{PROJ, (const bf16_t*)(lwb + LW_W2), DFF, DFF, DFF, 0}; pg8::StaticOrder S; S.init(M, D, G, bid);
              pg8::gemm_phase<pg8::DenseProb, epi::Resid, pg8::StaticOrder, true>(lds, g, S, epi::Resid{x1, x1, modl + 5 * D}, wid); }
            xcd_barrier(bar);
        } else {
#define MOE_VARS \
            bf16_t* W2 = (bf16_t*)(outb + OUT_W2); bf16_t* h2 = H; bf16_t* hmid = (bf16_t*)(ws + WS_HMID_MOE); bf16_t* yslot = YABC; \
            int* topi = (int*)(ws + WS_TOPI); float* topw = (float*)(ws + WS_TOPW); int* rowtok = (int*)(ws + WS_ROWTOK); int* rowdst = (int*)(ws + WS_ROWDST); float* roww = (float*)(ws + WS_ROWW); int* tile_e = (int*)(ws + WS_TILEE); int* ntiles = (int*)(ws + WS_NTILES); \
            (void)W2; (void)h2; (void)hmid; (void)yslot; (void)topi; (void)topw; (void)rowtok; (void)rowdst; (void)roww; (void)tile_e; (void)ntiles;
            PH(12) { PHASE_VARS(0) MOE_VARS thin::norm_router_body(x1, F(6) + l * D, modl + 3 * D, modl + 4 * D, h2, F(32), F(33), topi, topw, gw, ngw, lane); }
            xcd_barrier(bar);
            PH(14) { PHASE_VARS(0) MOE_VARS if (bid == 0) moe::assign(topi, topw, rowtok, rowdst, roww, tile_e, ntiles, (LAS int*)lds, tid); }
            PH(13) if (bid != 0) { PHASE_VARS(0) MOE_VARS LAS float* scr = (LAS float*)(lds + wid * 8192); const int gw2 = (bid - 1) * 8 + wid, ngw2 = (G - 1) * 8;
              cvt_flat(CD, 31, 4224, scr, gw2, ngw2, lane); }

            xcd_barrier(bar);
            PH(15) { PHASE_VARS(0) MOE_VARS moe::Order S{tile_e, ntiles, DFF2 / 256, 0, 0, 0}; S.dev_init(G, bid);
              pg8::gemm_phase<moe::ProbUp, epi::SwiGLU, moe::Order, true>(lds, moe::ProbUp{h2, (const bf16_t*)(outb + OUT_W13A), (const bf16_t*)(ws + WS_W13B), (const bf16_t*)(ws + WS_W13C), (const bf16_t*)(ws + WS_W13D), rowtok, D, D, D, 0}, S, epi::SwiGLU{hmid}, wid); }
            xcd_barrier(bar);
            PH(16) { PHASE_VARS(0) MOE_VARS moe::Order S{tile_e, ntiles, D / 256, 0, 0, 0}; S.dev_init(G, bid);
              pg8::gemm_phase<moe::ProbDown, epi::MoeDown, moe::Order, true>(lds, moe::ProbDown{hmid, W2, DFF, DFF, DFF, 0}, S, epi::MoeDown{rowdst, roww, yslot}, wid); }
            xcd_barrier(bar);
            PH(17) { PHASE_VARS(0) MOE_VARS thin::moe_combine_body(x1, yslot, modl + 5 * D, outp, gtid, ngt); }
#undef MOE_VARS
        }
    }
    {
        PH(1) { PHASE_VARS(1) thin::norm_body(xin, F(5) + l * D, modl + 0 * D, modl + 1 * D, H, gw, ngw, lane); }
        xcd_barrier(bar);
        PH(2) { PHASE_VARS(1) pg8::DenseProb g{H, (const bf16_t*)(lwb + LW_IN), D, D, D, 0}; pg8::StaticOrder S; S.init(M, INC, G, bid);
          pg8::gemm_phase<pg8::DenseProb, epi::Proj, pg8::StaticOrder, true>(lds, g, S, epi::Proj{PROJ, F(8) + l * 3 * D, GATES}, wid); }
        xcd_barrier(bar);
        PH(3) { PHASE_VARS(1) for (int u = bid; u < 256; u += G) { const int grp = u & 3;
            qk::unit(u >> 5, (u >> 2) & 7, grp, PROJ, cs, (grp == 0 ? F(16) : grp == 1 ? F(17) : grp == 2 ? F(23) : F(24)) + l * 64, kmean, (LAS char*)lds, wid); } }
        xcd_barrier(bar);
        {
#define POP_Q() do { __syncthreads(); if (tid == 0) MISC[16] = __hip_atomic_fetch_add((unsigned*)(ws + WS_CTL) + CW_QUEUE + 64 * (l + QOFF), 1u, __ATOMIC_RELAXED, __HIP_MEMORY_SCOPE_AGENT); __syncthreads(); q = (int)MISC[16]; } while (0)
#define POP_ISSUE() do { if (tid == 0) qn = __hip_atomic_fetch_add((unsigned*)(ws + WS_CTL) + CW_QUEUE + 64 * (l + QOFF), 1u, __ATOMIC_RELAXED, __HIP_MEMORY_SCOPE_AGENT); } while (0)
#define POP_TAKE() do { __syncthreads(); if (tid == 0) MISC[16] = qn; __syncthreads(); q = (int)MISC[16]; } while (0)
            int q; constexpr int NCVT = (1 == 0) ? NCVT0 : NCVT1;
            { PHASE_VARS(1) POP_Q(); }
            PH(5) { PHASE_VARS(1)
              const float lam_init = 0.8f - 0.6f * expf(-0.3f * (float)l);
              const float lam = diff_lambda(F(18) + l * 64, F(19) + l * 64, F(20) + l * 64, F(21) + l * 64, lam_init, lane);
              const float noff = attn::score_shift(F(16) + l * 64, F(17) + l * 64, lane);
#pragma unroll 1
              while (q < 256) { const int i = q; unsigned qn = 0u; POP_ISSUE();
                attn::diff_unit((i & 31) >> 2, i & 3, 7 - (i >> 5), PROJ, YABC, F(22) + l * 128, lam, 1.0f - lam_init, noff, (LAS char*)lds, wid);
                POP_TAKE(); } }
            PH(18) { PHASE_VARS(1)
#pragma unroll 1
              while (q < 256 + NCVT) { unsigned qn = 0u; POP_ISSUE(); __syncthreads(); cvt_unit(CD, l == 0 ? 0 : 8, q - 256, (LAS float*)(lds + wid * 8192), wid, lane);
                POP_TAKE(); } }
            PH(4) { PHASE_VARS(1)
#pragma unroll 1
              while (q < 256 + NCVT + NQ_RG) { const int i = q - 256 - NCVT; unsigned qn = 0u; POP_ISSUE();
                rg2::unit(i >> 5, (i >> 1) & 15, i & 1, PROJ, YABC, F(9) + l * 4 * D, F(10) + l * D, F(11) + (size_t)l * 16 * 4096, F(12) + l * D, F(13) + (size_t)l * 16 * 4096, F(14) + l * D, F(15) + l * D, (LAS char*)lds, wid);
                POP_TAKE(); } }
            PH(6) { PHASE_VARS(1)
              const float noff = attn::score_shift(F(23) + l * 64, F(24) + l * 64, lane);
#pragma unroll 1
              while (q < 256 + NCVT + NQ_RG + 512) { const int i = q - NQ_RG - 256 - NCVT; unsigned qn = 0u; POP_ISSUE();
                attn::moba_unit((i & 63) >> 3, i & 7, 7 - (i >> 6), PROJ, YABC, kmean, noff, (LAS char*)lds, wid);
                POP_TAKE(); } }
#undef POP_Q
#undef POP_ISSUE
#undef POP_TAKE
        }
        xcd_barrier(bar);
        PH(7) { PHASE_VARS(1) pg8::StaticOrder S; S.init(M, D, G, bid); pg8::DenseProb g{YABC, (const bf16_t*)(lwb + LW_BRA), 2048, YW, 2048, 0};
          pg8::gemm_phase<pg8::DenseProb, epi::BranchMerge, pg8::StaticOrder, true>(lds, g, S, epi::BranchMerge{GATES, H, 16, 24}, wid); }
        xcd_barrier(bar);
        PH(8) { PHASE_VARS(1) pg8::DenseProb g{H, (const bf16_t*)(lwb + LW_OUT), D, D, D, 0}; pg8::StaticOrder S; S.init(M, D, G, bid);
          pg8::gemm_phase<pg8::DenseProb, epi::Resid, pg8::StaticOrder, true>(lds, g, S, epi::Resid{xin, x1, modl + 2 * D}, wid); }
        xcd_barrier(bar);
        if (1 == 0) {
            PH(9) { PHASE_VARS(1) thin::norm_body(x1, F(6) + l * D, modl + 3 * D, modl + 4 * D, H, gw, ngw, lane); }
            xcd_barrier(bar);
            PH(10) { PHASE_VARS(1) pg8::DenseProb g{H, (const bf16_t*)(lwb + LW_W13), D, D, D, 0}; pg8::StaticOrder S; S.init(M, DFF2, G, bid);
              pg8::gemm_phase<pg8::DenseProb, epi::SwiGLU, pg8::StaticOrder, true>(lds, g, S, epi::SwiGLU{PROJ}, wid); }
            xcd_barrier(bar);
            PH(11) { PHASE_VARS(1) pg8::DenseProb g{PROJ, (const bf16_t*)(lwb + LW_W2), DFF, DFF, DFF, 0}; pg8::StaticOrder S; S.init(M, D, G, bid);
              pg8::gemm_phase<pg8::DenseProb, epi::Resid, pg8::StaticOrder, true>(lds, g, S, epi::Resid{x1, x1, modl + 5 * D}, wid); }
            xcd_barrier(bar);
        } else {
#define MOE_VARS \
            bf16_t* W2 = (bf16_t*)(outb + OUT_W2); bf16_t* h2 = H; bf16_t* hmid = (bf16_t*)(ws + WS_HMID_MOE); bf16_t* yslot = YABC; \
            int* topi = (int*)(ws + WS_TOPI); float* topw = (float*)(ws + WS_TOPW); int* rowtok = (int*)(ws + WS_ROWTOK); int* rowdst = (int*)(ws + WS_ROWDST); float* roww = (float*)(ws + WS_ROWW); int* tile_e = (int*)(ws + WS_TILEE); int* ntiles = (int*)(ws + WS_NTILES); \
            (void)W2; (void)h2; (void)hmid; (void)yslot; (void)topi; (void)topw; (void)rowtok; (void)rowdst; (void)roww; (void)tile_e; (void)ntiles;
            PH(12) { PHASE_VARS(1) MOE_VARS thin::norm_router_body(x1, F(6) + l * D, modl + 3 * D, modl + 4 * D, h2, F(32), F(33), topi, topw, gw, ngw, lane); }
            xcd_barrier(bar);
            PH(14) { PHASE_VARS(1) MOE_VARS if (bid == 0) moe::assign(topi, topw, rowtok, rowdst, roww, tile_e, ntiles, (LAS int*)lds, tid); }
            PH(13) if (bid != 0) { PHASE_VARS(1) MOE_VARS LAS float* scr = (LAS float*)(lds + wid * 8192); const int gw2 = (bid - 1) * 8 + wid, ngw2 = (G - 1) * 8;
              cvt_flat(CD, 31, 4224, scr, gw2, ngw2, lane); }

            xcd_barrier(bar);
            PH(15) { PHASE_VARS(1) MOE_VARS moe::Order S{tile_e, ntiles, DFF2 / 256, 0, 0, 0}; S.dev_init(G, bid);
              pg8::gemm_phase<moe::ProbUp, epi::SwiGLU, moe::Order, true>(lds, moe::ProbUp{h2, (const bf16_t*)(outb + OUT_W13A), (const bf16_t*)(ws + WS_W13B), (const bf16_t*)(ws + WS_W13C), (const bf16_t*)(ws + WS_W13D), rowtok, D, D, D, 0}, S, epi::SwiGLU{hmid}, wid); }
            xcd_barrier(bar);
            PH(16) { PHASE_VARS(1) MOE_VARS moe::Order S{tile_e, ntiles, D / 256, 0, 0, 0}; S.dev_init(G, bid);
              pg8::gemm_phase<moe::ProbDown, epi::MoeDown, moe::Order, true>(lds, moe::ProbDown{hmid, W2, DFF, DFF, DFF, 0}, S, epi::MoeDown{rowdst, roww, yslot}, wid); }
            xcd_barrier(bar);
            PH(17) { PHASE_VARS(1) MOE_VARS thin::moe_combine_body(x1, yslot, modl + 5 * D, outp, gtid, ngt); }
#undef MOE_VARS
        }
    }
#undef F
#undef PHASE_VARS
}

extern "C" void kernel_launch(void* const* d_in, const int* in_sizes, int n_in, void* d_out, int out_size, void* d_ws, size_t ws_size, hipStream_t stream) {
    static int grid = 0;
    if (grid == 0) {
        if (n_in != 37 || ws_size < WS_END) { fprintf(stderr, "kernel_launch: unexpected n_in %d / ws_size %zu (need %zu)\n", n_in, ws_size, (size_t)WS_END); grid = -1; return; }
        int dev = 0, cus = 0, per_cu = 0;
        if (hipGetDevice(&dev) != hipSuccess || hipDeviceGetAttribute(&cus, hipDeviceAttributeMultiprocessorCount, dev) != hipSuccess) { grid = -1; return; }
        if (hipFuncSetAttribute((const void*)mega_fwd, hipFuncAttributeMaxDynamicSharedMemorySize, LDS_TOTAL) != hipSuccess) { fprintf(stderr, "kernel_launch: hipFuncSetAttribute failed\n"); grid = -1; return; }
        if (hipOccupancyMaxActiveBlocksPerMultiprocessor(&per_cu, (const void*)mega_fwd, 512, LDS_TOTAL) != hipSuccess || per_cu < 1) fprintf(stderr, "kernel_launch: occupancy query says %d\n", per_cu);
        (void)hipGetLastError();
        grid = cus;
    }
    if (grid < 0) return;
    (void)hipMemsetAsync((char*)d_ws + WS_CTL, 0, CTL_ZERO_BYTES, stream);
    Args a{};
    for (int i = 0; i < 37; ++i) a.in[i] = (const float*)d_in[i];
    a.out = (float*)d_out; a.ws = (unsigned char*)d_ws;
    hipLaunchKernelGGL(mega_fwd, dim3(grid), dim3(512), LDS_TOTAL, stream, a);
}
```

```cpp
#include <hip/hip_runtime.h>
#include <stdint.h>
#include <stdio.h>

#define LAS __attribute__((address_space(3)))
typedef unsigned short bf16_t;
typedef short bf16x8 __attribute__((ext_vector_type(8)));
typedef short s16x4 __attribute__((ext_vector_type(4)));
typedef float f32x2 __attribute__((ext_vector_type(2)));
typedef float f32x4 __attribute__((ext_vector_type(4)));
typedef float f32x16 __attribute__((ext_vector_type(16)));
typedef unsigned u32x2 __attribute__((ext_vector_type(2)));
typedef unsigned u32x4 __attribute__((ext_vector_type(4)));

constexpr int D = 1024, NB = 8, SEQ = 2048, M = NB * SEQ, INC = 8192, DFF = 2816, NE = 8, DFF2 = 2 * DFF;
constexpr int PP = 5120;
constexpr int C_XR = 0, C_GR = 1024, C_DQ = 2048, C_DK = 2560, C_DV = 3072, C_MQ = 3584, C_MK = 4096, C_MV = 4608, C_GB = 5120;
constexpr int YW = 2048, Y_A = 0, Y_B = 1024, Y_C = 1536;
constexpr float EPS = 1e-6f;
constexpr float QSCALE = 0.125f * 1.4426950408889634f;
constexpr int MOE_MAXROWS = 34816, MOE_MAXTILES = MOE_MAXROWS / 256;

__device__ __forceinline__ float bf2f(unsigned v) { return __uint_as_float(v << 16); }
__device__ __forceinline__ unsigned f2bf(float f) { unsigned u = __float_as_uint(f); return (u + 0x7fffu + ((u >> 16) & 1u)) >> 16; }
__device__ __forceinline__ unsigned pk2(float lo, float hi) { unsigned r; asm volatile("v_cvt_pk_bf16_f32 %0, %1, %2" : "=v"(r) : "v"(lo), "v"(hi)); return r; }
__device__ __forceinline__ float fexp2(float x) { return __builtin_amdgcn_exp2f(x); }
__device__ __forceinline__ float frcp(float x) { return __builtin_amdgcn_rcpf(x); }
__device__ __forceinline__ float sigmoid_f(float x) { return frcp(1.0f + fexp2(-1.4426950408889634f * x)); }
__device__ __forceinline__ float gelu_tanh_f(float x) { return x * sigmoid_f(1.5957691216057308f * (x + 0.044715f * x * x * x)); }
__device__ __forceinline__ float silu_f(float x) { return x * sigmoid_f(x); }
__device__ __forceinline__ float wave_sum(float v) {
#pragma unroll
    for (int o = 1; o < 64; o <<= 1) v += __shfl_xor(v, o);
    return v;
}
__device__ __forceinline__ int lane_fresh() { int l; asm volatile("v_mbcnt_lo_u32_b32 %0, -1, 0\n\tv_mbcnt_hi_u32_b32 %0, -1, %0" : "=v"(l)); return l; }
namespace pg8 {
constexpr int BM = 256, BK = 64, HALF = 128, HTB = HALF * BK * 2  , STAGE_BYTES = 8 * HTB, NXCD = 8, WGM = 8;

__host__ __device__ __forceinline__ int lds_byte(int r, int c) { const int st = (r >> 4) * 2 + (c >> 5), rr = r & 15, cc = c & 31, ob = rr * 64 + cc * 2; return st * 1024 + (ob ^ (((ob >> 9) & 1) << 5)); }
__host__ __device__ __forceinline__ void stage_rc(int b, int& R, int& C) { const int st = b / 1024, sb = b % 1024, swz = sb ^ (((sb >> 9) & 1) << 5); R = (st >> 1) * 16 + swz / 64; C = (st & 1) * 32 + (swz % 64) / 2; }
__host__ __device__ __forceinline__ int perm32(int rho) { const int n = rho >> 4, i = rho & 15; return 8 * (i >> 2) + 4 * n + (i & 3); }

struct Unit { int pm, pn, e, aux; };

struct StaticOrder {
    int nM, nN, nwg, G, c;
    __host__ __device__ void init(int M, int N, int G_, int c_) { nM = M / BM; nN = N / BM; nwg = nM * nN; G = G_; c = c_; }
    __device__ __forceinline__ bool next(int i, Unit& u) const {
        const long L = (long)i * G + c; if (L >= nwg) return false;
        int wgid = (int)L; { const int q = nwg / NXCD, r = nwg % NXCD, xcd = wgid % NXCD, off = wgid / NXCD; wgid = (xcd < r ? xcd * (q + 1) : r * (q + 1) + (xcd - r) * q) + off; }
        const int nig = WGM * nN, gid = wgid / nig, fm = gid * WGM, gsz = (nM - fm) < WGM ? (nM - fm) : WGM;
        u.pm = fm + ((wgid % nig) % gsz); u.pn = (wgid % nig) / gsz; u.e = 0; u.aux = 0; return true;
    }
};

struct RotOrder : StaticOrder {
    __device__ __forceinline__ bool next(int i, Unit& u) const { if (!StaticOrder::next(i, u)) return false; u.pn = (u.pn + 4 * i) % nN; return true; }
};

struct DenseProb {
    static constexpr bool GATHER = false;
    const bf16_t* A; const bf16_t* Bt; int K, lda, ldb, pad;
    __device__ __forceinline__ const char* a_base(const Unit& u) const { return (const char*)A + (size_t)u.pm * BM * lda * 2; }
    __device__ __forceinline__ const char* b_base(const Unit& u) const { return (const char*)Bt + (size_t)u.pn * BM * ldb * 2; }
    __device__ __forceinline__ unsigned a_off(const Unit&, int row, int col) const { return (unsigned)(row * lda + col) * 2u; }
};

template <class Prob, class Epi, class Sched, bool ALIGN_EPI = true>
__device__ __forceinline__ void gemm_phase(LAS unsigned char* lds, const Prob& g, const Sched& S, const Epi& E, int wid) {
    const int lane = lane_fresh(), tid = wid * 64 + lane, wr = wid >> 2, wc = wid & 3, fr = lane & 15, fq = lane >> 4;
    const int K = g.K, nt = K / BK;
    int sR[2], sC[2]; unsigned voffB[2];
#pragma unroll
    for (int i = 0; i < 2; ++i) { int R, C; stage_rc(tid * 16 + i * 8192, R, C); sR[i] = R; sC[i] = C; const int Rb = Epi::PERM ? ((R & ~31) + perm32(R & 31)) : R; voffB[i] = (unsigned)(Rb * g.ldb + C) * 2u; }
    const size_t kstep = (size_t)(BK * 2);
    const size_t hstepB = (size_t)HALF * g.ldb * 2;
    const unsigned ldsw = (unsigned)wid * 1024u;
    const int aoff = lds_byte(wr * 64 + fr, fq * 8), boff = lds_byte(wc * 32 + fr, fq * 8);
#define PG8_SA(b, h) (((b) * 2 + (h)) * HTB)
#define PG8_SB(b, h) ((4 + (b) * 2 + (h)) * HTB)
#define PG8_STAGE(bufoff, gbase, voff) do { _Pragma("unroll") for (int _i = 0; _i < 2; ++_i) \
        __builtin_amdgcn_global_load_lds((const unsigned*)((const char*)(gbase) + (voff)[_i]), (LAS unsigned*)(lds + (bufoff) + ldsw + _i * 8192), 16, 0, 0); } while (0)
#define PG8_LDA(dst, b, h) do { _Pragma("unroll") for (int m = 0; m < 4; ++m) _Pragma("unroll") for (int k = 0; k < 2; ++k) dst[m][k] = *(const LAS bf16x8*)(lds + PG8_SA(b, h) + aoff + m * 2048 + k * 1024); } while (0)
#define PG8_LDB(dst, b, h) do { _Pragma("unroll") for (int n = 0; n < 2; ++n) _Pragma("unroll") for (int k = 0; k < 2; ++k) dst[n][k] = *(const LAS bf16x8*)(lds + PG8_SB(b, h) + boff + n * 2048 + k * 1024); } while (0)
#define PG8_MMA(ai, bj, At, Bt) do { __builtin_amdgcn_s_setprio(1); _Pragma("unroll") for (int m = 0; m < 4; ++m) _Pragma("unroll") for (int n = 0; n < 2; ++n) _Pragma("unroll") for (int k = 0; k < 2; ++k) \
        acc[ai][bj][m][n] = __builtin_amdgcn_mfma_f32_16x16x32_bf16(Bt[n][k], At[m][k], acc[ai][bj][m][n], 0, 0, 0); __builtin_amdgcn_s_setprio(0); } while (0)
#define PG8_WAIT_V(n) asm volatile("s_waitcnt vmcnt(" #n ")" ::: "memory")
#define PG8_WAIT_L(n) asm volatile("s_waitcnt lgkmcnt(" #n ")" ::: "memory")
#define PG8_BAR __builtin_amdgcn_s_barrier()
#define PG8_SCHED __builtin_amdgcn_sched_barrier(0)
    Unit cur, nxt; int ui = 0;
    if (!S.next(0, cur)) return;
    f32x4 acc[2][2][4][2];
#pragma unroll
    for (int a = 0; a < 2; ++a)
#pragma unroll
        for (int b = 0; b < 2; ++b)
#pragma unroll
            for (int m = 0; m < 4; ++m)
#pragma unroll
                for (int n = 0; n < 2; ++n) acc[a][b][m][n] = (f32x4){0.f, 0.f, 0.f, 0.f};
    bf16x8 At[4][2], B0[2][2], B1[2][2];
    unsigned vA[2][2], vN[2][2];
#pragma unroll
    for (int h = 0; h < 2; ++h)
#pragma unroll
        for (int i = 0; i < 2; ++i) { vA[h][i] = g.a_off(cur, h * HALF + sR[i], sC[i]); vN[h][i] = vA[h][i]; }
    const char* cA = g.a_base(cur); const char* cB = g.b_base(cur);
    PG8_STAGE(PG8_SB(0, 0), cB, voffB); PG8_STAGE(PG8_SB(0, 1), cB + hstepB, voffB); PG8_STAGE(PG8_SA(0, 0), cA, vA[0]); PG8_STAGE(PG8_SA(0, 1), cA, vA[1]);
    if (wr == 1) PG8_BAR;
    PG8_WAIT_V(2); PG8_BAR;
    PG8_STAGE(PG8_SB(1, 0), cB + kstep, voffB); PG8_STAGE(PG8_SA(1, 0), cA + kstep, vA[0]); PG8_STAGE(PG8_SB(1, 1), cB + hstepB + kstep, voffB);
    PG8_WAIT_V(6); PG8_BAR;
    for (;;) {
        const bool has_next = S.next(ui + 1, nxt);
        const char* nA = has_next ? g.a_base(nxt) : cA; const char* nB = has_next ? g.b_base(nxt) : cB;
        if (Prob::GATHER) {
#pragma unroll
            for (int h = 0; h < 2; ++h)
#pragma unroll
                for (int i = 0; i < 2; ++i) vN[h][i] = has_next ? g.a_off(nxt, h * HALF + sR[i], sC[i]) : vA[h][i];
        }
        for (int t = 0; t < nt; t += 2) {
            const bool last = (t == nt - 2);
            if constexpr (Epi::KHOOK) { if (t == E.kh1 || t == E.kh2) E.khook(acc, cur, t, wr, wc, fr, fq); }
            const char* a1 = cA + (size_t)(t + 1) * kstep;
            const char* a2 = last ? nA : cA + (size_t)(t + 2) * kstep; const char* b2 = last ? nB : cB + (size_t)(t + 2) * kstep;
            const char* a3 = a2 + kstep; const char* b3 = b2 + kstep;
            unsigned v2[2][2];
#pragma unroll
            for (int h = 0; h < 2; ++h)
#pragma unroll
                for (int i = 0; i < 2; ++i) v2[h][i] = (Prob::GATHER && last) ? vN[h][i] : vA[h][i];
            PG8_LDB(B0, 0, 0); PG8_LDB(B1, 0, 1); PG8_SCHED; PG8_LDA(At, 0, 0); PG8_STAGE(PG8_SA(1, 1), a1, vA[1]);
            PG8_WAIT_V(8); PG8_WAIT_L(0); PG8_BAR; PG8_MMA(0, 0, At, B0); PG8_MMA(0, 1, At, B1); PG8_BAR; PG8_SCHED;
            PG8_LDA(At, 0, 1); PG8_STAGE(PG8_SB(0, 0), b2, voffB); PG8_STAGE(PG8_SB(0, 1), b2 + hstepB, voffB); PG8_STAGE(PG8_SA(0, 0), a2, v2[0]);
            PG8_WAIT_V(8); PG8_WAIT_L(0); PG8_BAR; PG8_MMA(1, 0, At, B0); PG8_MMA(1, 1, At, B1); PG8_BAR; PG8_SCHED;
            PG8_LDB(B0, 1, 0); PG8_LDB(B1, 1, 1); PG8_SCHED; PG8_LDA(At, 1, 0); PG8_STAGE(PG8_SA(0, 1), a2, v2[1]);
            PG8_WAIT_V(8); PG8_WAIT_L(0); PG8_BAR; PG8_MMA(0, 0, At, B0); PG8_MMA(0, 1, At, B1); PG8_BAR; PG8_SCHED;
            PG8_LDA(At, 1, 1); PG8_STAGE(PG8_SB(1, 0), b3, voffB); PG8_STAGE(PG8_SB(1, 1), b3 + hstepB, voffB); PG8_STAGE(PG8_SA(1, 0), a3, v2[0]);
            PG8_WAIT_V(8); PG8_WAIT_L(0); PG8_BAR; PG8_MMA(1, 0, At, B0); PG8_MMA(1, 1, At, B1); PG8_BAR; PG8_SCHED;
        }
        if constexpr (ALIGN_EPI) { if (wr == 0) PG8_BAR; }
        E(acc, cur, wr, wc, fr, fq);
        if (!has_next) break;
#pragma unroll
        for (int a = 0; a < 2; ++a)
#pragma unroll
            for (int b = 0; b < 2; ++b)
#pragma unroll
                for (int m = 0; m < 4; ++m)
#pragma unroll
                    for (int n = 0; n < 2; ++n) acc[a][b][m][n] = (f32x4){0.f, 0.f, 0.f, 0.f};
        cur = nxt; cA = nA; cB = nB; ++ui;
        if (Prob::GATHER) {
#pragma unroll
            for (int h = 0; h < 2; ++h)
#pragma unroll
                for (int i = 0; i < 2; ++i) vA[h][i] = vN[h][i];
        }
        if constexpr (ALIGN_EPI) { if (wr == 1) PG8_BAR; }
    }
    PG8_WAIT_V(0);
    if constexpr (!ALIGN_EPI) { if (wr == 0) PG8_BAR; }
    PG8_BAR;
#undef PG8_SA
#undef PG8_SB
#undef PG8_STAGE
#undef PG8_LDA
#undef PG8_LDB
#undef PG8_MMA
#undef PG8_WAIT_V
#undef PG8_WAIT_L
#undef PG8_BAR
#undef PG8_SCHED
}
}
namespace epi {
using pg8::Unit; using pg8::BM; using pg8::HALF;
typedef const f32x4 (&AccRef)[2][2][4][2];

struct Proj {
    static constexpr bool PERM = true, KHOOK = false;
    bf16_t* O; const float* gate_b; bf16_t* GT; const f32x2* cs; const float* dqn; const float* dkn; const float* mqn; const float* mkn; float* kmean;
    __device__ __forceinline__ void qk_tile(AccRef acc, const Unit& u, int wr, int wc, int fr, int fq) const {
        const int grp = (u.pn < 10) ? 0 : (u.pn < 12) ? 1 : (u.pn < 16) ? 2 : 3;
        const float* gn = grp == 0 ? dqn : grp == 1 ? dkn : grp == 2 ? mqn : mkn;
        const float qs = ((grp & 1) == 0) ? QSCALE : 1.0f;
        const int c0 = 8 * fq;
        float g1[8], g2[8];
#pragma unroll
        for (int k = 0; k < 8; ++k) { g1[k] = gn[c0 + k]; g2[k] = gn[32 + c0 + k]; }
        float ks1[8], ks2[8];
#pragma unroll
        for (int k = 0; k < 8; ++k) { ks1[k] = 0.f; ks2[k] = 0.f; }
        const int row0 = u.pm * BM + wr * 64 + fr, colb = u.pn * BM + 64 * wc + c0;
#pragma unroll
        for (int ai = 0; ai < 2; ++ai)
#pragma unroll
            for (int m = 0; m < 4; ++m) { const int row = row0 + ai * HALF + m * 16;
                const f32x4* cp = (const f32x4*)(cs + (size_t)row * 32 + c0);
                const f32x4 q0 = cp[0], q1 = cp[1], q2 = cp[2], q3 = cp[3];
                const float cc[8] = {q0.x, q0.z, q1.x, q1.z, q2.x, q2.z, q3.x, q3.z}, sn[8] = {q0.y, q0.w, q1.y, q1.w, q2.y, q2.w, q3.y, q3.w};
                float x1[8], x2[8];
#pragma unroll
                for (int j = 0; j < 4; ++j) { x1[j] = acc[ai][0][m][0][j]; x1[4 + j] = acc[ai][0][m][1][j]; x2[j] = acc[ai][1][m][0][j]; x2[4 + j] = acc[ai][1][m][1][j]; }
                float ss = 0.f;
#pragma unroll
                for (int k = 0; k < 8; ++k) ss += x1[k] * x1[k] + x2[k] * x2[k];
                ss += __shfl_xor(ss, 16); ss += __shfl_xor(ss, 32);
                const float rn = rsqrtf(ss * (1.0f / 64.0f) + EPS);
                float o1[8], o2[8];
#pragma unroll
                for (int k = 0; k < 8; ++k) { const float y1 = x1[k] * rn * g1[k], y2 = x2[k] * rn * g2[k]; o1[k] = (y1 * cc[k] - y2 * sn[k]) * qs; o2[k] = (y2 * cc[k] + y1 * sn[k]) * qs; }
                u32x4 w1, w2;
                w1.x = pk2(o1[0], o1[1]); w1.y = pk2(o1[2], o1[3]); w1.z = pk2(o1[4], o1[5]); w1.w = pk2(o1[6], o1[7]);
                w2.x = pk2(o2[0], o2[1]); w2.y = pk2(o2[2], o2[3]); w2.z = pk2(o2[4], o2[5]); w2.w = pk2(o2[6], o2[7]);
                bf16_t* rowp = O + (size_t)row * PP + colb;
                *(u32x4*)rowp = w1; *(u32x4*)(rowp + 32) = w2;
                if (grp == 3) {
                    ks1[0] += bf2f(w1.x & 0xffffu); ks1[1] += bf2f(w1.x >> 16); ks1[2] += bf2f(w1.y & 0xffffu); ks1[3] += bf2f(w1.y >> 16); ks1[4] += bf2f(w1.z & 0xffffu); ks1[5] += bf2f(w1.z >> 16); ks1[6] += bf2f(w1.w & 0xffffu); ks1[7] += bf2f(w1.w >> 16);
                    ks2[0] += bf2f(w2.x & 0xffffu); ks2[1] += bf2f(w2.x >> 16); ks2[2] += bf2f(w2.y & 0xffffu); ks2[3] += bf2f(w2.y >> 16); ks2[4] += bf2f(w2.z & 0xffffu); ks2[5] += bf2f(w2.z >> 16); ks2[6] += bf2f(w2.w & 0xffffu); ks2[7] += bf2f(w2.w >> 16); }
                if (m & 1) asm volatile("" ::: "memory");
            }
        if (grp == 3) {
#pragma unroll
            for (int k = 0; k < 8; ++k) {
#pragma unroll
                for (int o = 1; o < 16; o <<= 1) { ks1[k] += __shfl_xor(ks1[k], o); ks2[k] += __shfl_xor(ks2[k], o); } }
            if (fr == 0) { const int b = u.pm >> 3, blk = u.pm & 7, hd = (u.pn - 16) * 4 + wc;
                float* kp = kmean + ((size_t)((b * 8 + hd) * 8 + blk)) * 64 + c0;
#pragma unroll
                for (int k = 0; k < 8; ++k) { atomicAdd(kp + k, ks1[k] * (1.0f / 256.0f)); atomicAdd(kp + 32 + k, ks2[k] * (1.0f / 256.0f)); } }
        }
    }
    __device__ __forceinline__ void operator()(AccRef acc, const Unit& u, int wr, int wc, int fr, int fq) const {
        const int row0 = u.pm * BM + wr * 64 + fr, col0 = u.pn * BM + wc * 32 + 8 * fq;
        const int mode = (u.pn >= 20) ? 2 : ((u.pn >= 4 && u.pn < 8) ? 1 : 0);
        const bool qkt = (u.pn >= 8 && u.pn < 12) || (u.pn >= 14 && u.pn < 18);
        if (qkt) { qk_tile(acc, u, wr, wc, fr, fq); return; }
        f32x4 bv[2][2];
#pragma unroll
        for (int bj = 0; bj < 2; ++bj)
#pragma unroll
            for (int n = 0; n < 2; ++n) bv[bj][n] = (mode == 2) ? *(const f32x4*)(gate_b + (col0 - C_GB) + bj * HALF + 4 * n) : (f32x4){0.f, 0.f, 0.f, 0.f};
#pragma unroll
        for (int ai = 0; ai < 2; ++ai)
#pragma unroll
            for (int m = 0; m < 4; ++m) { bf16_t* rowp = O + (size_t)(row0 + ai * HALF + m * 16) * PP + col0;
#pragma unroll
                for (int bj = 0; bj < 2; ++bj) { f32x4 v0 = acc[ai][bj][m][0] + bv[bj][0], v1 = acc[ai][bj][m][1] + bv[bj][1];
                    if (mode == 1) {
#pragma unroll
                        for (int j = 0; j < 4; ++j) { v0[j] = gelu_tanh_f(v0[j]); v1[j] = gelu_tanh_f(v1[j]); } }
                    if (mode == 2) {
#pragma unroll
                        for (int j = 0; j < 4; ++j) { v0[j] = sigmoid_f(v0[j]); v1[j] = sigmoid_f(v1[j]); } }
                    u32x4 w; w.x = pk2(v0[0], v0[1]); w.y = pk2(v0[2], v0[3]); w.z = pk2(v1[0], v1[1]); w.w = pk2(v1[2], v1[3]);
                    if (mode == 2) { const int gp = u.pn - 20; const size_t piece = ((((size_t)u.pm * 3 + (gp >> 2)) * 4 + (gp & 3)) * 16 + (ai * 4 + m) * 2 + bj) * 512 + (wr * 4 + wc) * 64 + fq * 16 + fr;
                        *(u32x4*)(GT + piece * 8) = w; }
                    else *(u32x4*)(rowp + bj * HALF) = w; } }
    }
};

struct Resid {
    static constexpr bool PERM = false, KHOOK = false;
    const float* base; float* out; const float* gate;
    __device__ __forceinline__ void operator()(AccRef acc, const Unit& u, int wr, int wc, int fr, int fq) const {
        const int row0 = u.pm * BM + wr * 64 + fr, col0 = u.pn * BM + wc * 32 + 4 * fq;
        const float* gp = gate + (size_t)((u.pm * BM) / SEQ) * (6 * D) + col0;
        f32x4 gv[2][2];
#pragma unroll
        for (int bj = 0; bj < 2; ++bj)
#pragma unroll
            for (int n = 0; n < 2; ++n) gv[bj][n] = *(const f32x4*)(gp + bj * HALF + n * 16);
#pragma unroll
        for (int ai = 0; ai < 2; ++ai)
#pragma unroll
            for (int m = 0; m < 4; ++m) { const size_t off = (size_t)(row0 + ai * HALF + m * 16) * D + col0;
#pragma unroll
                for (int bj = 0; bj < 2; ++bj)
#pragma unroll
                    for (int n = 0; n < 2; ++n) { const f32x4 bs = *(const f32x4*)(base + off + bj * HALF + n * 16);
                        *(f32x4*)(out + off + bj * HALF + n * 16) = bs + gv[bj][n] * acc[ai][bj][m][n]; } }
    }
};

struct SwiGLU {
    static constexpr bool PERM = true, KHOOK = false;
    bf16_t* O;
    __device__ __forceinline__ void operator()(AccRef acc, const Unit& u, int wr, int wc, int fr, int fq) const {
        const int row0 = u.pm * BM + wr * 64 + fr, col0 = u.pn * HALF + wc * 32 + 8 * fq;
#pragma unroll
        for (int ai = 0; ai < 2; ++ai)
#pragma unroll
            for (int m = 0; m < 4; ++m) { bf16_t* rowp = O + (size_t)(row0 + ai * HALF + m * 16) * DFF + col0;
                f32x4 v0, v1;
#pragma unroll
                for (int j = 0; j < 4; ++j) { v0[j] = silu_f(acc[ai][0][m][0][j]) * acc[ai][1][m][0][j]; v1[j] = silu_f(acc[ai][0][m][1][j]) * acc[ai][1][m][1][j]; }
                u32x4 w; w.x = pk2(v0[0], v0[1]); w.y = pk2(v0[2], v0[3]); w.z = pk2(v1[0], v1[1]); w.w = pk2(v1[2], v1[3]);
                *(u32x4*)rowp = w; }
    }
};

struct MoeDown {
    static constexpr bool PERM = false, KHOOK = false;
    const int* rowdst; const float* roww; bf16_t* yslot;
    __device__ __forceinline__ void operator()(AccRef acc, const Unit& u, int wr, int wc, int fr, int fq) const {
        const int row0 = u.pm * BM + wr * 64 + fr, col0 = u.pn * BM + wc * 32 + 4 * fq;
        int dsts[2][4]; float ws_[2][4];
#pragma unroll
        for (int ai = 0; ai < 2; ++ai)
#pragma unroll
            for (int m = 0; m < 4; ++m) { const int p = row0 + ai * HALF + m * 16; dsts[ai][m] = rowdst[p]; ws_[ai][m] = roww[p]; }
#pragma unroll
        for (int ai = 0; ai < 2; ++ai)
#pragma unroll
            for (int m = 0; m < 4; ++m) { const int dst = dsts[ai][m]; const float w = ws_[ai][m];
                if (dst >= 0) { bf16_t* rowp = yslot + (size_t)dst * D + col0;
#pragma unroll
                    for (int bj = 0; bj < 2; ++bj)
#pragma unroll
                        for (int n = 0; n < 2; ++n) { const f32x4 v = acc[ai][bj][m][n] * w; u32x2 o; o.x = pk2(v[0], v[1]); o.y = pk2(v[2], v[3]); *(u32x2*)(rowp + bj * HALF + n * 16) = o; } } }
    }
};

struct MoeDownTail {
    static constexpr bool PERM = false, KHOOK = false;
    const float* roww; bf16_t* ypart;
    __device__ __forceinline__ void operator()(AccRef acc, const Unit& u, int wr, int wc, int fr, int fq) const {
        const int row0 = u.pm * BM + wr * 64 + fr, col0 = u.pn * BM + wc * 32 + 4 * fq;
        float ws_[2][4];
#pragma unroll
        for (int ai = 0; ai < 2; ++ai)
#pragma unroll
            for (int m = 0; m < 4; ++m) ws_[ai][m] = roww[row0 + ai * HALF + m * 16];
#pragma unroll
        for (int ai = 0; ai < 2; ++ai)
#pragma unroll
            for (int m = 0; m < 4; ++m) { const int p = row0 + ai * HALF + m * 16 - 256 * 128; const float w = ws_[ai][m];
                bf16_t* rowp = ypart + ((size_t)u.aux * 2048 + p) * D + col0;
#pragma unroll
                for (int bj = 0; bj < 2; ++bj)
#pragma unroll
                    for (int n = 0; n < 2; ++n) { const f32x4 v = acc[ai][bj][m][n] * w; u32x2 o; o.x = pk2(v[0], v[1]); o.y = pk2(v[2], v[3]); *(u32x2*)(rowp + bj * HALF + n * 16) = o; } }
    }
};

struct BranchMerge {
    static constexpr bool PERM = true, KHOOK = true;
    const bf16_t* GT; bf16_t* merged; int kh1, kh2;
    typedef f32x4 (&AccMut)[2][2][4][2];
    __device__ __forceinline__ static void unpack8(const u32x4 w, float (&f)[8]) {
        f[0] = bf2f(w.x & 0xffffu); f[1] = bf2f(w.x >> 16); f[2] = bf2f(w.y & 0xffffu); f[3] = bf2f(w.y >> 16); f[4] = bf2f(w.z & 0xffffu); f[5] = bf2f(w.z >> 16); f[6] = bf2f(w.w & 0xffffu); f[7] = bf2f(w.w >> 16); }
    __device__ __forceinline__ const u32x4* gate_piece(const Unit& u, int g, int wr, int wc, int fr, int fq) const {
        return (const u32x4*)GT + ((((size_t)u.pm * 3 + g) * 4 + u.pn) * 16) * 512 + (wr * 4 + wc) * 64 + fq * 16 + fr; }
    __device__ __forceinline__ void khook(AccMut acc, const Unit& u, int t, int wr, int wc, int fr, int fq) const {
        const int gi = (t == kh1) ? 0 : 1;
        const u32x4* pn_ = gate_piece(u, gi, wr, wc, fr, fq); const u32x4* pd_ = gate_piece(u, gi + 1, wr, wc, fr, fq);
#pragma unroll
        for (int ai = 0; ai < 2; ++ai) {
            u32x4 rn[4][2], rd[4][2];
#pragma unroll
            for (int m = 0; m < 4; ++m)
#pragma unroll
                for (int bj = 0; bj < 2; ++bj) { rn[m][bj] = pn_[((ai * 4 + m) * 2 + bj) * 512]; rd[m][bj] = pd_[((ai * 4 + m) * 2 + bj) * 512]; }
#pragma unroll
            for (int m = 0; m < 4; ++m)
#pragma unroll
                for (int bj = 0; bj < 2; ++bj) { float gn[8], gd[8]; unpack8(rn[m][bj], gn); unpack8(rd[m][bj], gd);
#pragma unroll
                    for (int j = 0; j < 4; ++j) { acc[ai][bj][m][0][j] *= gn[j] * frcp(fmaxf(gd[j], 1e-30f)); acc[ai][bj][m][1][j] *= gn[4 + j] * frcp(fmaxf(gd[4 + j], 1e-30f)); } }
            asm volatile("" ::: "memory");
        }
    }
    __device__ __forceinline__ void operator()(AccRef acc, const Unit& u, int wr, int wc, int fr, int fq) const {
        const int row0 = u.pm * BM + wr * 64 + fr, col0 = u.pn * BM + wc * 32 + 8 * fq;
#pragma unroll
        for (int ai = 0; ai < 2; ++ai)
#pragma unroll
            for (int m = 0; m < 4; ++m) { const size_t row = (size_t)(row0 + ai * HALF + m * 16);
#pragma unroll
                for (int bj = 0; bj < 2; ++bj) { float g2[8]; unpack8(gate_piece(u, 2, wr, wc, fr, fq)[((ai * 4 + m) * 2 + bj) * 512], g2);
                    const f32x4 v0 = acc[ai][bj][m][0], v1 = acc[ai][bj][m][1];
                    u32x4 w; w.x = pk2(v0[0] * g2[0], v0[1] * g2[1]); w.y = pk2(v0[2] * g2[2], v0[3] * g2[3]); w.z = pk2(v1[0] * g2[4], v1[1] * g2[5]); w.w = pk2(v1[2] * g2[6], v1[3] * g2[7]);
                    *(u32x4*)(merged + row * D + col0 + bj * HALF) = w; } }
    }
};
}
namespace attn {
constexpr int NSLOT = 4, SLOT_K = 8192, SLOT128 = SLOT_K + 16384, SLOT64 = SLOT_K + 8192, LDS_BYTES = NSLOT * SLOT128;
constexpr float NEGF = -1e30f;
__device__ __forceinline__ int crow(int r, int hi) { return (r & 3) + 8 * (r >> 2) + 4 * hi; }
__device__ __forceinline__ float swapmax(float m) { auto rr = __builtin_amdgcn_permlane32_swap(__float_as_uint(m), __float_as_uint(m), false, false); return fmaxf(__uint_as_float(rr[0]), __uint_as_float(rr[1])); }
__device__ __forceinline__ float swapsum(float m) { auto rr = __builtin_amdgcn_permlane32_swap(__float_as_uint(m), __float_as_uint(m), false, false); return __uint_as_float(rr[0]) + __uint_as_float(rr[1]); }
typedef short v4i16_t __attribute__((ext_vector_type(4)));
__device__ __forceinline__ s16x4 vtr(const LAS char* p) { return __builtin_bit_cast(s16x4, __builtin_amdgcn_ds_read_tr16_b64_v4i16((LAS v4i16_t*)p)); }

__device__ __forceinline__ void qk_tile(f32x16& sA, f32x16& sB, const LAS char* Kt, const bf16x8 (&qf)[4], int r, int h, float noff) {
    const LAS char* kb = Kt + h * 1024 + r * 16;
#pragma unroll
    for (int j = 0; j < 16; ++j) { sA[j] = noff; sB[j] = noff; }
    bf16x8 kf[8];
#pragma unroll
    for (int ks = 0; ks < 4; ++ks) { kf[2 * ks] = *(const LAS bf16x8*)(kb + ks * 2048); kf[2 * ks + 1] = *(const LAS bf16x8*)(kb + ks * 2048 + 512); }
    __builtin_amdgcn_sched_barrier(0);
#pragma unroll
    for (int ks = 0; ks < 4; ++ks) {
        sA = __builtin_amdgcn_mfma_f32_32x32x16_bf16(kf[2 * ks], qf[ks], sA, 0, 0, 0);
        sB = __builtin_amdgcn_mfma_f32_32x32x16_bf16(kf[2 * ks + 1], qf[ks], sB, 0, 0, 0);
    }
}
template <int NDB>
__device__ __forceinline__ void pv_tile(f32x16 (&o)[NDB], const LAS char* Vt, const bf16x8 (&pf)[4], int lane) {
    const int h = lane >> 5, q = (lane & 15) >> 2, p = lane & 3, g1 = (lane >> 4) & 1;
    const LAS char* vb = Vt + (4 * h + q) * 64 + (16 * g1 + 4 * p) * 2;
#pragma unroll
    for (int kb = 0; kb < 2; ++kb) {
        bf16x8 vf[2][NDB];
#pragma unroll
        for (int s = 0; s < 2; ++s)
#pragma unroll
            for (int db = 0; db < NDB; ++db) { const int r0 = kb * 32 + 16 * s;
                const s16x4 lo = vtr(vb + r0 * 64 + db * 4096), hi = vtr(vb + (r0 + 8) * 64 + db * 4096);
                vf[s][db] = (bf16x8){lo[0], lo[1], lo[2], lo[3], hi[0], hi[1], hi[2], hi[3]}; }
        __builtin_amdgcn_sched_barrier(0);
#pragma unroll
        for (int s = 0; s < 2; ++s)
#pragma unroll
            for (int db = 0; db < NDB; ++db) o[db] = __builtin_amdgcn_mfma_f32_32x32x16_bf16(pf[kb * 2 + s], vf[s][db], o[db], 0, 0, 0);
    }
}
template <int NDB>
__device__ __forceinline__ void softmax_pv(f32x16& sA, f32x16& sB, f32x16 (&o)[NDB], float& lsum, const LAS char* Vt, int lane) {
    float rs0 = 0.f, rs1 = 0.f;
#pragma unroll
    for (int j = 0; j < 16; ++j) { sA[j] = fexp2(sA[j]); sB[j] = fexp2(sB[j]); rs0 += sA[j]; rs1 += sB[j]; }
    lsum += rs0 + rs1;
    bf16x8 pf[4];
    { u32x4 w;
      w.x = pk2(sA[0], sA[1]); w.y = pk2(sA[2], sA[3]); w.z = pk2(sA[4], sA[5]); w.w = pk2(sA[6], sA[7]); pf[0] = __builtin_bit_cast(bf16x8, w);
      w.x = pk2(sA[8], sA[9]); w.y = pk2(sA[10], sA[11]); w.z = pk2(sA[12], sA[13]); w.w = pk2(sA[14], sA[15]); pf[1] = __builtin_bit_cast(bf16x8, w);
      w.x = pk2(sB[0], sB[1]); w.y = pk2(sB[2], sB[3]); w.z = pk2(sB[4], sB[5]); w.w = pk2(sB[6], sB[7]); pf[2] = __builtin_bit_cast(bf16x8, w);
      w.x = pk2(sB[8], sB[9]); w.y = pk2(sB[10], sB[11]); w.z = pk2(sB[12], sB[13]); w.w = pk2(sB[14], sB[15]); pf[3] = __builtin_bit_cast(bf16x8, w); }
    pv_tile<NDB>(o, Vt, pf, lane);
}
__device__ __forceinline__ float score_shift(const float* gq, const float* gk, int lane) {
    float mq = fabsf(gq[lane]), mk = fabsf(gk[lane]);
#pragma unroll
    for (int o = 1; o < 64; o <<= 1) { mq = fmaxf(mq, __shfl_xor(mq, o)); mk = fmaxf(mk, __shfl_xor(mk, o)); }
    const float bound = QSCALE * 64.0f * mq * mk;
    return -fmaxf(0.f, bound - 24.0f);
}

template <int DV>
__device__ __forceinline__ void dma_tile(const bf16_t* Kg, const bf16_t* Vg, int key0, LAS char* slot, int wid, int lane) {
    __builtin_amdgcn_global_load_lds((const unsigned*)(Kg + (size_t)(key0 + lane) * PP + wid * 8), (LAS unsigned*)(slot + wid * 1024), 16, 0, 0);
#pragma unroll
    for (int i = 0; i < DV / 64; ++i) { const int p = wid + 8 * i, db = p >> 2, rg = p & 3;
        __builtin_amdgcn_global_load_lds((const unsigned*)(Vg + (size_t)(key0 + 16 * rg + (lane >> 2)) * PP + db * 32 + (lane & 3) * 8), (LAS unsigned*)(slot + SLOT_K + p * 1024), 16, 0, 0); }
}
template <int OPS> __device__ __forceinline__ void ring_wait(int ahead) {
    if (ahead >= 2) asm volatile("s_waitcnt vmcnt(%0) lgkmcnt(0)\n\ts_barrier" :: "n"(2 * OPS) : "memory");
    else if (ahead == 1) asm volatile("s_waitcnt vmcnt(%0) lgkmcnt(0)\n\ts_barrier" :: "n"(OPS) : "memory");
    else asm volatile("s_waitcnt vmcnt(0) lgkmcnt(0)\n\ts_barrier" ::: "memory");
}
template <int DV>
__device__ __forceinline__ void causal_pass(f32x16 (&o)[DV / 32], float& lsum, const bf16x8 (&qf)[4], const bf16_t* Kg, const bf16_t* Vg,
                                            int ntiles, int qw0, float noff, LAS char* lds, int tid) {
    constexpr int SLOT = SLOT_K + DV * 128, OPS = 1 + DV / 64;
    const int lane = tid & 63, r = lane & 31, h = lane >> 5, wid = __builtin_amdgcn_readfirstlane(tid >> 6);
    asm volatile("s_waitcnt vmcnt(0) lgkmcnt(0)\n\ts_barrier" ::: "memory");
#pragma unroll
    for (int t = 0; t < 3; ++t) if (t < ntiles) dma_tile<DV>(Kg, Vg, t * 64, lds + t * SLOT, wid, lane);
    __builtin_amdgcn_s_waitcnt(0);
    for (int t = 0; t < ntiles; ++t) {
        ring_wait<OPS>(ntiles - 1 - t);
        if (t + 3 < ntiles) dma_tile<DV>(Kg, Vg, (t + 3) * 64, lds + ((t + 3) & 3) * SLOT, wid, lane);
        const LAS char* slot = lds + (t & 3) * SLOT;
        const int key0 = t * 64;
        if (key0 <= qw0 + 31) {
            f32x16 sA, sB;
            qk_tile(sA, sB, slot, qf, r, h, noff);
            if (key0 + 63 > qw0) {
                const int qpos = qw0 + r;
#pragma unroll
                for (int j = 0; j < 16; ++j) { const int kp = key0 + crow(j, h); if (kp > qpos) sA[j] = NEGF; if (kp + 32 > qpos) sB[j] = NEGF; }
            }
            softmax_pv<DV / 32>(sA, sB, o, lsum, slot + SLOT_K, lane);
        }
    }
}

__device__ __forceinline__ void diff_unit(int b, int hd, int qt, const bf16_t* proj, bf16_t* yabc, const float* subln, float lam, float one_m_laminit, float noff, LAS char* lds, int wid) {
    const int lane = lane_fresh(), tid = wid * 64 + lane, r = lane & 31, h = lane >> 5;
    const int qw0 = qt * 256 + wid * 32;
    const size_t rowb = (size_t)b * SEQ;
    const int ntiles = 4 * (qt + 1);
    unsigned o0p[4][8];
#pragma unroll
    for (int j = 0; j < 2; ++j) {
        const bf16_t* qp = proj + (rowb + qw0 + r) * PP + C_DQ + (hd * 2 + j) * 64 + h * 8;
        bf16x8 qf[4];
#pragma unroll
        for (int ks = 0; ks < 4; ++ks) qf[ks] = *(const bf16x8*)(qp + ks * 16);
        f32x16 o[4];
#pragma unroll
        for (int db = 0; db < 4; ++db)
#pragma unroll
            for (int i = 0; i < 16; ++i) o[db][i] = 0.f;
        float lsum = 0.f;
        causal_pass<128>(o, lsum, qf, proj + rowb * PP + C_DK + (hd * 2 + j) * 64, proj + rowb * PP + C_DV + hd * 128, ntiles, qw0, noff, lds, tid);
        const float il = frcp(swapsum(lsum));
        if (j == 0) {
#pragma unroll
            for (int i = 0; i < 16; i += 2) { const float a0 = __shfl(il, crow(i, h)), a1 = __shfl(il, crow(i + 1, h));
#pragma unroll
                for (int db = 0; db < 4; ++db) o0p[db][i >> 1] = pk2(o[db][i] * a0, o[db][i + 1] * a1); }
        } else {
#pragma unroll
            for (int i = 0; i < 16; ++i) { const float a = __shfl(il, crow(i, h)) * lam;
                float ss = 0.f; float cv[4];
#pragma unroll
                for (int db = 0; db < 4; ++db) { const unsigned w = o0p[db][i >> 1]; const float x0 = (i & 1) ? bf2f(w >> 16) : bf2f(w & 0xffffu); const float c = x0 - o[db][i] * a; cv[db] = c; ss += c * c; }
                ss += __shfl_xor(ss, 1); ss += __shfl_xor(ss, 2); ss += __shfl_xor(ss, 4); ss += __shfl_xor(ss, 8); ss += __shfl_xor(ss, 16);
                const float rn = rsqrtf(ss * (1.0f / 128.0f) + EPS) * one_m_laminit;
                bf16_t* yp = yabc + (rowb + qw0 + crow(i, h)) * YW + Y_B + hd * 128 + r;
#pragma unroll
                for (int db = 0; db < 4; ++db) yp[db * 32] = (bf16_t)f2bf(cv[db] * rn * subln[db * 32 + r]);
            }
        }
    }
}

__device__ __forceinline__ void moba_unit(int b, int hd, int cur, const bf16_t* proj, bf16_t* yabc, const float* kmean, float noff, LAS char* lds, int wid) {
    const int lane = lane_fresh(), tid = wid * 64 + lane, r = lane & 31, h = lane >> 5;
    const int qw0 = cur * 256 + wid * 32;
    const size_t rowb = (size_t)b * SEQ;
    const bf16_t* qp = proj + (rowb + qw0 + r) * PP + C_MQ + hd * 64 + h * 8;
    bf16x8 qf[4];
#pragma unroll
    for (int ks = 0; ks < 4; ++ks) qf[ks] = *(const bf16x8*)(qp + ks * 16);
    unsigned selmask = 0u;
    if (cur > 0) {
        float gate[8];
        float qv[4][8];
#pragma unroll
        for (int ks = 0; ks < 4; ++ks)
#pragma unroll
            for (int j = 0; j < 8; ++j) qv[ks][j] = bf2f((unsigned)(unsigned short)qf[ks][j]);
#pragma unroll
        for (int nb = 0; nb < 8; nb += 4) {
            f32x4 kmv[4][8];
#pragma unroll
            for (int n = 0; n < 4; ++n) { const f32x4* km = (const f32x4*)(kmean + ((size_t)((b * 8 + hd) * 8 + nb + n)) * 64 + h * 8);
#pragma unroll
                for (int ks = 0; ks < 4; ++ks) { kmv[n][2 * ks] = km[ks * 4]; kmv[n][2 * ks + 1] = km[ks * 4 + 1]; } }
#pragma unroll
            for (int n = 0; n < 4; ++n) { float g = 0.f;
#pragma unroll
                for (int ks = 0; ks < 4; ++ks) { const f32x4 k0 = kmv[n][2 * ks], k1 = kmv[n][2 * ks + 1];
                    g += qv[ks][0] * k0.x + qv[ks][1] * k0.y + qv[ks][2] * k0.z + qv[ks][3] * k0.w + qv[ks][4] * k1.x + qv[ks][5] * k1.y + qv[ks][6] * k1.z + qv[ks][7] * k1.w; }
                g = swapsum(g);
                gate[nb + n] = (nb + n < cur) ? g : -3.0e38f; }
        }
        const int nsel = cur < 3 ? cur : 3;
        for (int s = 0; s < nsel; ++s) {
            float best = -3.0e38f; int bi = 0;
#pragma unroll
            for (int n = 0; n < 8; ++n) { const bool tk = (n < cur) && !((selmask >> n) & 1u) && (gate[n] > best); if (tk) { best = gate[n]; bi = n; } }
            selmask |= 1u << bi;
        }
    }
    f32x16 o[2];
#pragma unroll
    for (int db = 0; db < 2; ++db)
#pragma unroll
        for (int i = 0; i < 16; ++i) o[db][i] = 0.f;
    float lsum = 0.f;
    const bf16_t* Kg = proj + rowb * PP + C_MK + hd * 64; const bf16_t* Vg = proj + rowb * PP + C_MV + hd * 64;
    const int ntiles = 4 * (cur + 1);
#define MOBA_KEY0(T) ((((T) < 4) ? cur : (((T) >> 2) - 1)) * 256 + ((T) & 3) * 64)
    const int widu = wid;
    asm volatile("s_waitcnt vmcnt(0) lgkmcnt(0)\n\ts_barrier" ::: "memory");
#pragma unroll
    for (int t = 0; t < 3; ++t) dma_tile<64>(Kg, Vg, MOBA_KEY0(t), lds + t * SLOT64, widu, lane);
    __builtin_amdgcn_s_waitcnt(0);
    for (int t = 0; t < ntiles; ++t) {
        ring_wait<2>(ntiles - 1 - t);
        if (t + 3 < ntiles) dma_tile<64>(Kg, Vg, MOBA_KEY0(t + 3), lds + ((t + 3) & 3) * SLOT64, widu, lane);
        const LAS char* slot = lds + (t & 3) * SLOT64;
        const int blk = (t < 4) ? cur : (t >> 2) - 1;
        const int key0 = blk * 256 + (t & 3) * 64;
        const bool own = (t < 4);
        const bool lane_on = own ? true : (((selmask >> blk) & 1u) != 0u);
        const bool wave_on = own ? (key0 <= qw0 + 31) : (__any(lane_on) != 0);
        if (wave_on) {
            f32x16 sA, sB;
            qk_tile(sA, sB, slot, qf, r, h, noff);
            if (own) {
                if (key0 + 63 > qw0) {
                    const int qpos = qw0 + r;
#pragma unroll
                    for (int j = 0; j < 16; ++j) { const int kp = key0 + crow(j, h); if (kp > qpos) sA[j] = NEGF; if (kp + 32 > qpos) sB[j] = NEGF; }
                }
            } else if (!lane_on) {
#pragma unroll
                for (int j = 0; j < 16; ++j) { sA[j] = NEGF; sB[j] = NEGF; }
            }
            softmax_pv<2>(sA, sB, o, lsum, slot + SLOT_K, lane);
        }
    }
#undef MOBA_KEY0
    const float il = frcp(swapsum(lsum));
#pragma unroll
    for (int i = 0; i < 16; ++i) { const float a = __shfl(il, crow(i, h));
        bf16_t* yp = yabc + (rowb + qw0 + crow(i, h)) * YW + Y_C + hd * 64 + r;
#pragma unroll
        for (int db = 0; db < 2; ++db) yp[db * 32] = (bf16_t)f2bf(o[db][i] * a); }
}
}
namespace thin {
struct TItem { f32x4 v[8][2]; };
__device__ __forceinline__ void titem_load(TItem& it, const float* W, int N, int item, int lane) {
    const int nblk = N >> 6, kb = item / nblk, nb = item - kb * nblk;
    const float* p = W + (size_t)(kb * 64 + 2 * (lane >> 4)) * N + nb * 64 + 4 * (lane & 15);
#pragma unroll
    for (int i = 0; i < 8; ++i) { it.v[i][0] = *(const f32x4*)(p + (size_t)(8 * i) * N); it.v[i][1] = *(const f32x4*)(p + (size_t)(8 * i + 1) * N); }
}
__device__ __forceinline__ void titem_store(const TItem& it, int N, bf16_t* WT, int ldk, int coff, int row_off, int mode, LAS unsigned* T, int item, int lane) {
    const int nblk = N >> 6, kb = item / nblk, nb = item - kb * nblk, k0 = kb * 64, n0 = nb * 64;
    const int kp = lane >> 4, np = lane & 15;
#pragma unroll
    for (int i = 0; i < 8; ++i) { const int col = (kp + 4 * i) ^ ((np & 7) << 2);
#pragma unroll
        for (int j = 0; j < 4; ++j) T[(4 * np + j) * 32 + col] = pk2(it.v[i][0][j], it.v[i][1][j]); }
    asm volatile("s_waitcnt lgkmcnt(0)" ::: "memory");
    const int c = lane & 7;
#pragma unroll
    for (int j = 0; j < 8; ++j) { const int n = (lane >> 3) + 8 * j;
        const u32x4 o = *(const LAS u32x4*)(T + n * 32 + 4 * (c ^ ((n >> 2) & 7)));
        const int nn = n0 + n;
        const bool qk = (mode == 3) && ((nn >= 2048 && nn < 3072) || (nn >= 3584 && nn < 4608));
        const int row = row_off + (qk ? ((nn & ~255) + 128 * ((nn >> 5) & 1) + 32 * ((nn >> 6) & 3) + (nn & 31)) : (mode == 0 || mode == 3) ? nn : ((nn >> 7) * 256 + (mode == 2 ? 128 : 0) + (nn & 127)));
        const bf16_t* dstp = WT + (size_t)row * ldk + coff + k0 + 8 * c;
        asm volatile("global_store_dwordx4 %0, %1, off\n\ts_nop 2" :: "v"(dstp), "v"(o) : "memory"); }
    asm volatile("s_waitcnt lgkmcnt(0)" ::: "memory");
}
__device__ __forceinline__ void transpose_matrix(const float* W, int K, int N, bf16_t* WT, int ldk, int coff, int row_off, int mode, LAS float* scr, int gw, int ngw, int lane) {
    const int nitems = (K >> 6) * (N >> 6);
    LAS unsigned* T = (LAS unsigned*)scr;
    TItem cur;
    int it = gw;
    if (it < nitems) titem_load(cur, W, N, it, lane);
    while (it < nitems) {
        const int nx = it + ngw;
        TItem nxt;
        if (nx < nitems) titem_load(nxt, W, N, nx, lane);
        titem_store(cur, N, WT, ldk, coff, row_off, mode, T, it, lane);
        cur = nxt; it = nx;
    }
}

__device__ __forceinline__ void mod_body(const float* c, const float* ada_w, const float* ada_b, float* mod, int bid, int G, int tid, LAS float* red) {
    for (int cb = bid; cb < (2 * 6 * D) / 48; cb += G) {
        const int kg = tid / 48, jj = tid - kg * 48;
        const int idx = cb * 48 + jj, l = idx / (6 * D), j = idx - l * (6 * D);
        float acc[NB];
#pragma unroll
        for (int b = 0; b < NB; ++b) acc[b] = 0.f;
        if (kg < 8) {
            const float* w = ada_w + (size_t)l * D * 6 * D + (size_t)(kg * 128) * 6 * D + j;
#pragma unroll 16
            for (int k = 0; k < 128; ++k) { const float wv = w[(size_t)k * 6 * D];
#pragma unroll
                for (int b = 0; b < NB; ++b) acc[b] += c[b * D + kg * 128 + k] * wv; }
#pragma unroll
            for (int b = 0; b < NB; ++b) red[(kg * 48 + jj) * NB + b] = acc[b];
        }
        __syncthreads();
        if (tid < 48 * NB) { const int j2 = tid >> 3, b = tid & 7; float s = 0.f;
#pragma unroll
            for (int g = 0; g < 8; ++g) s += red[(g * 48 + j2) * NB + b];
            const int idx2 = cb * 48 + j2, l2 = idx2 / (6 * D), jo = idx2 - l2 * (6 * D);
            mod[((size_t)l2 * NB + b) * 6 * D + jo] = s + ada_b[l2 * 6 * D + jo]; }
        __syncthreads();
    }
}
__device__ __forceinline__ void rope_body(const int* positions, f32x2* cs, int gtid, int ngt) {
    for (int idx = gtid; idx < M * 32; idx += ngt) {
        const int tok = idx >> 5, i = idx & 31;
        const float inv = 1.0f / powf(10000.0f, (float)(2 * i) / 64.0f);
        const float ang = (float)positions[tok] * inv;
        float s, c; sincosf(ang, &s, &c);
        cs[idx] = (f32x2){c, s};
    }
}
template <int R>
__device__ __forceinline__ void norm_rows(const float* xrow, const float* g, const float* shift, const float* scale, bf16_t* orow, int lane, f32x4 (&y)[R][4]) {
    f32x4 v[R][4]; float ss[R];
#pragma unroll
    for (int r = 0; r < R; ++r) { const f32x4* xr = (const f32x4*)(xrow + (size_t)r * D) + lane;
#pragma unroll
        for (int j = 0; j < 4; ++j) v[r][j] = xr[64 * j]; }
#pragma unroll
    for (int r = 0; r < R; ++r) { float s = 0.f;
#pragma unroll
        for (int j = 0; j < 4; ++j) s += (v[r][j].x * v[r][j].x + v[r][j].y * v[r][j].y) + (v[r][j].z * v[r][j].z + v[r][j].w * v[r][j].w);
        ss[r] = s; }
#pragma unroll
    for (int o = 1; o < 64; o <<= 1) {
#pragma unroll
        for (int r = 0; r < R; ++r) ss[r] += __shfl_xor(ss[r], o); }
#pragma unroll
    for (int j = 0; j < 4; ++j) { const int col = 4 * lane + 256 * j;
        const f32x4 gg = *(const f32x4*)(g + col), sc = *(const f32x4*)(scale + col), sh = *(const f32x4*)(shift + col);
        const f32x4 gs = gg * (sc + 1.0f);
#pragma unroll
        for (int r = 0; r < R; ++r) { const float rn = rsqrtf(ss[r] * (1.0f / D) + EPS);
            y[r][j] = v[r][j] * rn * gs + sh;
            u32x2 w; w.x = pk2(y[r][j].x, y[r][j].y); w.y = pk2(y[r][j].z, y[r][j].w); ((u32x2*)(orow + (size_t)r * D) + lane)[64 * j] = w; } }
}
__device__ __forceinline__ void norm_body(const float* x, const float* g, const float* shift, const float* scale, bf16_t* out, int gw, int ngw, int lane) {
    for (int m = gw * 8; m < M; m += ngw * 8) { const int b = m / SEQ; f32x4 y[8][4]; norm_rows<8>(x + (size_t)m * D, g, shift + b * 6 * D, scale + b * 6 * D, out + (size_t)m * D, lane, y); }
}
__device__ __forceinline__ void norm_router_body(const float* x, const float* g, const float* shift, const float* scale, bf16_t* out,
                                                 const float* rw, const float* rb, int* topi, float* topw, int gw, int ngw, int lane) {
    for (int m0 = gw * 2; m0 < M; m0 += ngw * 2) { const int b = m0 / SEQ; f32x4 y[2][4];
        norm_rows<2>(x + (size_t)m0 * D, g, shift + b * 6 * D, scale + b * 6 * D, out + (size_t)m0 * D, lane, y);
        float lg[2][NE];
#pragma unroll
        for (int r = 0; r < 2; ++r)
#pragma unroll
            for (int e = 0; e < NE; ++e) lg[r][e] = 0.f;
#pragma unroll
        for (int j = 0; j < 4; ++j)
#pragma unroll
            for (int q = 0; q < 4; ++q) { const int col = 4 * lane + 256 * j + q; const f32x4 w0 = *(const f32x4*)(rw + col * NE), w1 = *(const f32x4*)(rw + col * NE + 4);
#pragma unroll
                for (int r = 0; r < 2; ++r) { const float hv = y[r][j][q];
                    lg[r][0] += hv * w0.x; lg[r][1] += hv * w0.y; lg[r][2] += hv * w0.z; lg[r][3] += hv * w0.w; lg[r][4] += hv * w1.x; lg[r][5] += hv * w1.y; lg[r][6] += hv * w1.z; lg[r][7] += hv * w1.w; } }
#pragma unroll
        for (int o = 1; o < 64; o <<= 1) {
#pragma unroll
            for (int r = 0; r < 2; ++r)
#pragma unroll
                for (int e = 0; e < NE; ++e) lg[r][e] += __shfl_xor(lg[r][e], o); }
#pragma unroll
        for (int r = 0; r < 2; ++r) { const int m = m0 + r;
#pragma unroll
            for (int e = 0; e < NE; ++e) lg[r][e] += rb[e];
            int i0 = 0; float v0 = lg[r][0];
#pragma unroll
            for (int e = 1; e < NE; ++e) if (lg[r][e] > v0) { v0 = lg[r][e]; i0 = e; }
            int i1 = -1; float v1 = -3.0e38f;
#pragma unroll
            for (int e = 0; e < NE; ++e) if (e != i0 && lg[r][e] > v1) { v1 = lg[r][e]; i1 = e; }
            const float w1v = 1.0f / (1.0f + expf(v0 - v1)), w0v = 1.0f - w1v;
            if (lane == 0) { topi[2 * m] = i0; topi[2 * m + 1] = i1; topw[2 * m] = w0v; topw[2 * m + 1] = w1v; } }
    }
}
__device__ __forceinline__ void qknorm_body(bf16_t* proj, const f32x2* cs, const float* dqn, const float* dkn, const float* mqn, const float* mkn, int gtid, int ngt) {
    for (long idx = gtid; idx < (long)M * 32 * 32; idx += ngt) {
        const int i = (int)(idx & 31); const long pair = idx >> 5; const int hh = (int)(pair & 31); const int tok = (int)(pair >> 5);
        const int grp = hh >> 3, hi = hh & 7;
        const int cb = (grp == 0 ? C_DQ : grp == 1 ? C_DK : grp == 2 ? C_MQ : C_MK) + hi * 64;
        const float* gn = grp == 0 ? dqn : grp == 1 ? dkn : grp == 2 ? mqn : mkn;
        bf16_t* p = proj + (size_t)tok * INC + cb;
        const float x1 = bf2f(p[i]), x2 = bf2f(p[i + 32]);
        float ss = x1 * x1 + x2 * x2;
        ss += __shfl_xor(ss, 1); ss += __shfl_xor(ss, 2); ss += __shfl_xor(ss, 4); ss += __shfl_xor(ss, 8); ss += __shfl_xor(ss, 16);
        const float rn = rsqrtf(ss * (1.0f / 64.0f) + EPS);
        const float y1 = x1 * rn * gn[i], y2 = x2 * rn * gn[i + 32];
        const f32x2 c = cs[(size_t)tok * 32 + i];
        float o1 = y1 * c.x - y2 * c.y, o2 = y2 * c.x + y1 * c.y;
        if ((grp & 1) == 0) { o1 *= QSCALE; o2 *= QSCALE; }
        p[i] = (bf16_t)f2bf(o1); p[i + 32] = (bf16_t)f2bf(o2);
    }
}
__device__ __forceinline__ void kmean_body(const bf16_t* proj, float* kmean, int gw, int ngw, int lane) {
    for (int it = gw; it < NB * 8 * 8; it += ngw) { const int blk = it & 7, hd = (it >> 3) & 7, b = it >> 6;
        const bf16_t* p = proj + ((size_t)b * SEQ + blk * 256) * INC + C_MK + hd * 64 + lane;
        float s = 0.f;
        for (int t = 0; t < 256; ++t) s += bf2f(p[(size_t)t * INC]);
        kmean[(size_t)it * 64 + lane] = s * (1.0f / 256.0f); }
}
__device__ __forceinline__ void moe_combine_body(const float* x1, const bf16_t* yslot, const bf16_t* ypart, const int* tokpos, const float* gate, float* out, int gtid, int ngt) {
    for (long idx0 = gtid; idx0 < (long)M * D / 4; idx0 += 4L * ngt) {
        f32x4 xv[4], gv[4]; u32x2 a[4], c[4], a2[4], c2[4]; int pa[4], pc[4];
#pragma unroll
        for (int u = 0; u < 4; ++u) { const long idx = idx0 + (long)u * ngt; const int m = (int)(idx >> 8); pa[u] = tokpos[m]; pc[u] = tokpos[M + m]; }
#pragma unroll
        for (int u = 0; u < 4; ++u) { const long idx = idx0 + (long)u * ngt; const int m = (int)(idx >> 8), c4 = (int)(idx & 255) * 4; const int b = m / SEQ;
            xv[u] = *(const f32x4*)(x1 + (size_t)m * D + c4); gv[u] = *(const f32x4*)(gate + b * 6 * D + c4);
            const bool ta = pa[u] >= 32768, tc = pc[u] >= 32768;
            a[u] = *(const u32x2*)(ta ? ypart + (size_t)(pa[u] - 32768) * D + c4 : yslot + (size_t)m * D + c4);
            c[u] = *(const u32x2*)(tc ? ypart + (size_t)(pc[u] - 32768) * D + c4 : yslot + ((size_t)M + m) * D + c4);
            a2[u] = ta ? *(const u32x2*)(ypart + (size_t)(2048 + pa[u] - 32768) * D + c4) : (u32x2){0u, 0u};
            c2[u] = tc ? *(const u32x2*)(ypart + (size_t)(2048 + pc[u] - 32768) * D + c4) : (u32x2){0u, 0u}; }
#pragma unroll
        for (int u = 0; u < 4; ++u) { const long idx = idx0 + (long)u * ngt; const int m = (int)(idx >> 8), c4 = (int)(idx & 255) * 4;
            const f32x4 y = {(bf2f(a[u].x & 0xffffu) + bf2f(a2[u].x & 0xffffu)) + (bf2f(c[u].x & 0xffffu) + bf2f(c2[u].x & 0xffffu)), (bf2f(a[u].x >> 16) + bf2f(a2[u].x >> 16)) + (bf2f(c[u].x >> 16) + bf2f(c2[u].x >> 16)),
                             (bf2f(a[u].y & 0xffffu) + bf2f(a2[u].y & 0xffffu)) + (bf2f(c[u].y & 0xffffu) + bf2f(c2[u].y & 0xffffu)), (bf2f(a[u].y >> 16) + bf2f(a2[u].y >> 16)) + (bf2f(c[u].y >> 16) + bf2f(c2[u].y >> 16))};
            *(f32x4*)(out + (size_t)m * D + c4) = xv[u] + gv[u] * y; }
    }
}
}
namespace qk {
constexpr int LDS_BYTES = 8 * 64 * 8 * 4;
__device__ __forceinline__ void unit(int b, int blk, int grp, bf16_t* proj, const f32x2* cs, const float* gn, float* kmean, LAS char* lds, int wid) {
    const int lane = lane_fresh(), tid = wid * 64 + lane;
    const int hd = lane >> 3, half = (lane >> 2) & 1, j = lane & 3;
    const int cb = (grp == 0 ? C_DQ : grp == 1 ? C_DK : grp == 2 ? C_MQ : C_MK) + hd * 64 + half * 32 + 8 * j;
    float gnv[8];
#pragma unroll
    for (int e = 0; e < 8; ++e) gnv[e] = gn[half * 32 + 8 * j + e];
    const float qs = ((grp & 1) == 0) ? QSCALE : 1.0f;
    const float sgn = half ? 1.0f : -1.0f;
    float ksum[8];
#pragma unroll
    for (int e = 0; e < 8; ++e) ksum[e] = 0.f;
    for (int i0 = 0; i0 < 32; i0 += 4) {
        u32x4 raw[4]; f32x4 cq[4][4];
#pragma unroll
        for (int u = 0; u < 4; ++u) { const size_t tok = (size_t)b * SEQ + blk * 256 + wid + 8 * (i0 + u);
            raw[u] = *(const u32x4*)(proj + tok * PP + cb);
            const f32x4* cp = (const f32x4*)(cs + tok * 32 + 8 * j);
            cq[u][0] = cp[0]; cq[u][1] = cp[1]; cq[u][2] = cp[2]; cq[u][3] = cp[3]; }
#pragma unroll
        for (int u = 0; u < 4; ++u) { const size_t tok = (size_t)b * SEQ + blk * 256 + wid + 8 * (i0 + u);
            float x[8] = {bf2f(raw[u].x & 0xffffu), bf2f(raw[u].x >> 16), bf2f(raw[u].y & 0xffffu), bf2f(raw[u].y >> 16), bf2f(raw[u].z & 0xffffu), bf2f(raw[u].z >> 16), bf2f(raw[u].w & 0xffffu), bf2f(raw[u].w >> 16)};
            float ss = 0.f;
#pragma unroll
            for (int e = 0; e < 8; ++e) ss += x[e] * x[e];
            ss += __shfl_xor(ss, 1); ss += __shfl_xor(ss, 2); ss += __shfl_xor(ss, 4);
            const float rn = rsqrtf(ss * (1.0f / 64.0f) + EPS);
            const float cc[8] = {cq[u][0].x, cq[u][0].z, cq[u][1].x, cq[u][1].z, cq[u][2].x, cq[u][2].z, cq[u][3].x, cq[u][3].z}, sn[8] = {cq[u][0].y, cq[u][0].w, cq[u][1].y, cq[u][1].w, cq[u][2].y, cq[u][2].w, cq[u][3].y, cq[u][3].w};
            float o[8];
#pragma unroll
            for (int e = 0; e < 8; ++e) { const float y = x[e] * rn * gnv[e]; const float py = __shfl_xor(y, 4); o[e] = (y * cc[e] + sgn * py * sn[e]) * qs; }
            u32x4 w; w.x = pk2(o[0], o[1]); w.y = pk2(o[2], o[3]); w.z = pk2(o[4], o[5]); w.w = pk2(o[6], o[7]);
            *(u32x4*)(proj + tok * PP + cb) = w;
            if (grp == 3) { ksum[0] += bf2f(w.x & 0xffffu); ksum[1] += bf2f(w.x >> 16); ksum[2] += bf2f(w.y & 0xffffu); ksum[3] += bf2f(w.y >> 16);
                            ksum[4] += bf2f(w.z & 0xffffu); ksum[5] += bf2f(w.z >> 16); ksum[6] += bf2f(w.w & 0xffffu); ksum[7] += bf2f(w.w >> 16); }
        }
    }
    if (grp == 3) {
        LAS float* red = (LAS float*)lds;
        __syncthreads();
#pragma unroll
        for (int e = 0; e < 8; ++e) red[(wid * 64 + lane) * 8 + e] = ksum[e];
        __syncthreads();
        { const int ln = tid >> 3, e = tid & 7; float s = 0.f;
#pragma unroll
          for (int w = 0; w < 8; ++w) s += red[(w * 64 + ln) * 8 + e];
          const int h2 = ln >> 3, hf = (ln >> 2) & 1, jj = ln & 3;
          kmean[((size_t)((b * 8 + h2) * 8 + blk)) * 64 + hf * 32 + 8 * jj + e] = s * (1.0f / 256.0f); }
        __syncthreads();
    }
}
}
namespace rglru {
constexpr int TT = 32;
constexpr int LDS_WA = 0, LDS_WX = 16384, LDS_XC = 32768, LDS_A = LDS_XC + TT * 65 * 4, LDS_U = LDS_A + TT * 64 * 4, LDS_BYTES = LDS_U + TT * 64 * 4;
__device__ __forceinline__ void unit(int b, int n, const bf16_t* proj, bf16_t* yabc, const float* conv_w, const float* conv_b, const float* wa, const float* ba,
                                     const float* wx, const float* bx, const float* lam, LAS char* lds) {
    int tid_l = threadIdx.x; asm volatile("" : "+v"(tid_l));
    const int tid = tid_l;
    LAS float* Wa = (LAS float*)(lds + LDS_WA); LAS float* Wx = (LAS float*)(lds + LDS_WX); LAS float* XC = (LAS float*)(lds + LDS_XC);
    LAS float* AV = (LAS float*)(lds + LDS_A); LAS float* UV = (LAS float*)(lds + LDS_U);
    __syncthreads();
    for (int i = tid; i < 4096; i += 512) { Wa[i] = wa[(size_t)n * 4096 + i]; Wx[i] = wx[(size_t)n * 4096 + i]; }
    const int cc = tid & 63, ct = tid >> 6;
    const int ch = n * 64 + cc;
    const float cw0 = conv_w[0 * D + ch], cw1 = conv_w[1 * D + ch], cw2 = conv_w[2 * D + ch], cw3 = conv_w[3 * D + ch], cb = conv_b[ch];
    const int gt = tid >> 4, eq = tid & 15;
    float gba[4], gbx[4], gsp[4];
#pragma unroll
    for (int j = 0; j < 4; ++j) { const int e = n * 64 + eq * 4 + j; gba[j] = ba[e]; gbx[j] = bx[e]; const float x = -lam[e]; gsp[j] = fmaxf(x, 0.f) + log1pf(expf(-fabsf(x))); }
    float hstate = 0.f;
    const size_t rowb = (size_t)b * SEQ;
    __syncthreads();
    for (int t0 = 0; t0 < SEQ; t0 += TT) {
#pragma unroll
        for (int i = 0; i < 4; ++i) { const int tt = ct + 8 * i, t = t0 + tt;
            const bf16_t* p = proj + (rowb + t) * INC + C_XR + ch;
            float acc = cb + cw3 * bf2f(p[0]);
            if (t >= 1) acc += cw2 * bf2f(*(p - INC));
            if (t >= 2) acc += cw1 * bf2f(*(p - 2 * INC));
            if (t >= 3) acc += cw0 * bf2f(*(p - 3 * INC));
            XC[tt * 65 + cc] = acc; }
        __syncthreads();
        { f32x4 ar = {0.f, 0.f, 0.f, 0.f}, ai = {0.f, 0.f, 0.f, 0.f};
#pragma unroll 8
          for (int d = 0; d < 64; ++d) { const float xv = XC[gt * 65 + d]; ar += *(const LAS f32x4*)(Wa + d * 64 + eq * 4) * xv; ai += *(const LAS f32x4*)(Wx + d * 64 + eq * 4) * xv; }
#pragma unroll
          for (int j = 0; j < 4; ++j) { const int e = eq * 4 + j;
              const float rg = 1.0f / (1.0f + expf(-(ar[j] + gba[j]))), ig = 1.0f / (1.0f + expf(-(ai[j] + gbx[j])));
              const float log_a = -8.0f * rg * gsp[j]; const float a = expf(log_a); const float mult = sqrtf(-expm1f(2.0f * log_a));
              AV[gt * 64 + e] = a; UV[gt * 64 + e] = mult * ig * XC[gt * 65 + e]; } }
        __syncthreads();
        if (tid < 64) {
            for (int tt = 0; tt < TT; ++tt) { hstate = AV[tt * 64 + tid] * hstate + UV[tt * 64 + tid];
                const size_t row = rowb + t0 + tt;
                const float g = bf2f(proj[row * INC + C_GR + n * 64 + tid]);
                yabc[row * YW + Y_A + n * 64 + tid] = (bf16_t)f2bf(g * hstate); }
        }
        __syncthreads();
    }
}
}

namespace moe {
__device__ __forceinline__ void assign(const int* topi, const float* topw, int* rowtok, int* rowdst, float* roww, int* tile_e, int* ntiles, int* tokpos, LAS int* sm, int tid) {
    typedef int i32x4 __attribute__((ext_vector_type(4)));
    const int nthr = 512, per = M / nthr, t0 = tid * per;
    int cnt[NE];
#pragma unroll
    for (int e = 0; e < NE; ++e) cnt[e] = 0;
    { i32x4 a = *(const i32x4*)(topi + 2 * t0), b = *(const i32x4*)(topi + 2 * t0 + 4);
#pragma unroll 1
      for (int i = 0; i < 8; ++i) { i32x4 na = a, nb = b;
        if (i < 7) { na = *(const i32x4*)(topi + 2 * t0 + 8 * (i + 1)); nb = *(const i32x4*)(topi + 2 * t0 + 8 * (i + 1) + 4); }
#pragma unroll
        for (int q = 0; q < 4; ++q)
#pragma unroll
            for (int e = 0; e < NE; ++e) cnt[e] += (a[q] == e) + (b[q] == e);
        a = na; b = nb; } }
#pragma unroll
    for (int e = 0; e < NE; ++e) sm[e * nthr + tid] = cnt[e];
    __syncthreads();
    { const int e = tid >> 6, ln = tid & 63;
      int v[8], s = 0;
#pragma unroll
      for (int i = 0; i < 8; ++i) { v[i] = sm[e * nthr + 8 * ln + i]; s += v[i]; }
      int incl = s;
#pragma unroll
      for (int o = 1; o < 64; o <<= 1) { const int up = __shfl_up(incl, o); if (ln >= o) incl += up; }
      int run = incl - s;
#pragma unroll
      for (int i = 0; i < 8; ++i) { sm[e * nthr + 8 * ln + i] = run; run += v[i]; }
      if (ln == 63) sm[NE * nthr + e] = incl; }
    __syncthreads();
    if (tid == 0) { int p = 0, nt = 0;
        for (int e = 0; e < NE; ++e) { const int tot = sm[NE * nthr + e]; sm[NE * nthr + 8 + e] = p; const int nte = (tot + 255) >> 8; for (int i = 0; i < nte; ++i) tile_e[nt++] = e; p += nte * 256; }
        *ntiles = nt; }
    __syncthreads();
    for (int e = 0; e < NE; ++e) { const int tot = sm[NE * nthr + e], base = sm[NE * nthr + 8 + e], padded = ((tot + 255) >> 8) << 8;
        for (int i = tot + tid; i < padded; i += nthr) { rowtok[base + i] = 0; rowdst[base + i] = -1; roww[base + i] = 0.f; } }
    int pos[NE];
#pragma unroll
    for (int e = 0; e < NE; ++e) pos[e] = sm[NE * nthr + 8 + e] + sm[e * nthr + tid];
    { i32x4 a = *(const i32x4*)(topi + 2 * t0), b = *(const i32x4*)(topi + 2 * t0 + 4); f32x4 wa = *(const f32x4*)(topw + 2 * t0), wb = *(const f32x4*)(topw + 2 * t0 + 4);
#pragma unroll 1
      for (int i = 0; i < 8; ++i) { i32x4 na = a, nb = b; f32x4 nwa = wa, nwb = wb;
        if (i < 7) { na = *(const i32x4*)(topi + 2 * t0 + 8 * (i + 1)); nb = *(const i32x4*)(topi + 2 * t0 + 8 * (i + 1) + 4); nwa = *(const f32x4*)(topw + 2 * t0 + 8 * (i + 1)); nwb = *(const f32x4*)(topw + 2 * t0 + 8 * (i + 1) + 4); }
#pragma unroll
        for (int q = 0; q < 8; ++q) { const int ek = (q < 4) ? a[q & 3] : b[q & 3]; const float wv = (q < 4) ? wa[q & 3] : wb[q & 3]; const int t = t0 + 4 * i + (q >> 1), k = q & 1; int p = 0;
#pragma unroll
            for (int e = 0; e < NE; ++e) { if (ek == e) { p = pos[e]; pos[e] = p + 1; } }
            rowtok[p] = t; rowdst[p] = k * M + t; roww[p] = wv; tokpos[k * M + t] = p; }
        a = na; b = nb; wa = nwa; wb = nwb; } }
}
constexpr int MAIN_TILES = 128, KSPLIT = DFF / 2;
struct OrderCap {
    const int* tile_e; const int* ntiles_p; int nN, G, c, ntiles;
    __device__ __forceinline__ void dev_init(int G_, int c_) { G = G_; c = c_; const int t = *ntiles_p; ntiles = t < MAIN_TILES ? t : MAIN_TILES; }
    __device__ __forceinline__ bool next(int i, pg8::Unit& u) const { const int L = i * G + c; if (L >= ntiles * nN) return false; u.pm = L / nN; u.pn = L % nN; u.e = tile_e[u.pm]; u.aux = 0; return true; }
};
struct OrderTail {
    const int* tile_e; const int* ntiles_p; int G, c, nunits, pad;
    __device__ __forceinline__ void dev_init(int G_, int c_) { G = G_; c = c_; const int t = *ntiles_p; nunits = t > MAIN_TILES ? (t - MAIN_TILES) * 8 : 0; }
    __device__ __forceinline__ bool next(int i, pg8::Unit& u) const { const int L = i * G + c; if (L >= nunits) return false; u.pm = MAIN_TILES + (L >> 3); u.pn = (L >> 1) & 3; u.aux = L & 1; u.e = tile_e[u.pm]; return true; }
};
struct Order {
    const int* tile_e; const int* ntiles_p; int nN, G, c, ntiles;
    __device__ __forceinline__ void dev_init(int G_, int c_) { G = G_; c = c_; ntiles = *ntiles_p; }
    __device__ __forceinline__ bool next(int i, pg8::Unit& u) const { const int L = i * G + c; if (L >= ntiles * nN) return false; u.pm = L / nN; u.pn = L % nN; u.e = tile_e[u.pm]; u.aux = 0; return true; }
};
struct ProbUp {
    static constexpr bool GATHER = true;
    const bf16_t* A; const bf16_t* Ba; const bf16_t* Bb; const bf16_t* Bc; const bf16_t* Bd; const int* rowtok; int K, lda, ldb, pad;
    __device__ __forceinline__ const char* a_base(const pg8::Unit&) const { return (const char*)A; }
    __device__ __forceinline__ const char* b_base(const pg8::Unit& u) const {
        const char* base = (u.e == 0) ? (const char*)Ba : (u.e < 5) ? (const char*)Bb + (size_t)(u.e - 1) * DFF2 * ldb * 2 : (u.e < 7) ? (const char*)Bc + (size_t)(u.e - 5) * DFF2 * ldb * 2 : (const char*)Bd;
        return base + (size_t)u.pn * 256 * ldb * 2; }
    __device__ __forceinline__ unsigned a_off(const pg8::Unit& u, int row, int col) const { return (unsigned)(rowtok[u.pm * 256 + row] * lda + col) * 2u; }
};
struct ProbDown {
    static constexpr bool GATHER = false;
    const bf16_t* A; const bf16_t* Bt; int K, lda, ldb, pad;
    __device__ __forceinline__ const char* a_base(const pg8::Unit& u) const { return (const char*)A + (size_t)u.pm * 256 * lda * 2; }
    __device__ __forceinline__ const char* b_base(const pg8::Unit& u) const { return (const char*)Bt + ((size_t)u.e * D + (size_t)u.pn * 256) * ldb * 2; }
    __device__ __forceinline__ unsigned a_off(const pg8::Unit&, int row, int col) const { return (unsigned)(row * lda + col) * 2u; }
};
struct ProbDownK {
    static constexpr bool GATHER = false;
    const bf16_t* A; const bf16_t* Bt; int K, lda, ldb, pad;
    __device__ __forceinline__ const char* a_base(const pg8::Unit& u) const { return (const char*)A + ((size_t)u.pm * 256 * lda + (size_t)u.aux * KSPLIT) * 2; }
    __device__ __forceinline__ const char* b_base(const pg8::Unit& u) const { return (const char*)Bt + (((size_t)u.e * D + (size_t)u.pn * 256) * ldb + (size_t)u.aux * KSPLIT) * 2; }
    __device__ __forceinline__ unsigned a_off(const pg8::Unit&, int row, int col) const { return (unsigned)(row * lda + col) * 2u; }
};
}
namespace rg2 {
constexpr int TT = 128, XS = 144  , FS = 36  ;
constexpr int L_XCB = 0, L_XCF = L_XCB + TT * XS, L_AV = L_XCF + TT * FS * 4, L_UV = L_AV + TT * FS * 4, L_WA = L_UV + TT * FS * 4, L_WX = L_WA + 32 * XS,
              L_CW = L_WX + 32 * XS, L_SEGA = L_CW + 5 * 64 * 4, L_SEGH = L_SEGA + 16 * 32 * 4, L_CARRY = L_SEGH + 16 * 32 * 4, LDS_BYTES = L_CARRY + 2 * 32 * 4;
__device__ __forceinline__ void unit(int b, int n, int hf, const bf16_t* proj, bf16_t* yabc, const float* conv_w, const float* conv_b, const float* wa, const float* ba,
                                     const float* wx, const float* bx, const float* lam, LAS char* lds, int wid) {
    const int lane = lane_fresh(), tid = wid * 64 + lane;
    LAS float* XCF = (LAS float*)(lds + L_XCF); LAS float* AV = (LAS float*)(lds + L_AV); LAS float* UV = (LAS float*)(lds + L_UV);
    LAS float* CW = (LAS float*)(lds + L_CW); LAS float* SEGA = (LAS float*)(lds + L_SEGA); LAS float* SEGH = (LAS float*)(lds + L_SEGH); LAS float* CARRY = (LAS float*)(lds + L_CARRY);
    const int ch0 = n * 64;
    const int oc0 = ch0 + hf * 32;
    __syncthreads();
    for (int i = tid; i < 2048; i += 512) { const int d = i >> 5, e = i & 31;
        *(LAS bf16_t*)(lds + L_WA + e * XS + d * 2) = (bf16_t)f2bf(wa[(size_t)n * 4096 + d * 64 + hf * 32 + e]);
        *(LAS bf16_t*)(lds + L_WX + e * XS + d * 2) = (bf16_t)f2bf(wx[(size_t)n * 4096 + d * 64 + hf * 32 + e]); }
    if (tid < 320) { const int k = tid >> 6, c = tid & 63; CW[tid] = (k < 4) ? conv_w[k * D + ch0 + c] : conv_b[ch0 + c]; }
    if (tid < 64) CARRY[tid] = 0.f;
    const int crow_ = tid >> 2, cg = tid & 3;
    const int mt = wid & 3, chh = wid >> 2;
    const int g4 = lane >> 4, e16 = lane & 15;
    const int eo = chh * 16 + e16;
    const float gba = ba[oc0 + eo], gbx = bx[oc0 + eo];
    float gk1; { const float x = -lam[oc0 + eo]; gk1 = -8.0f * 1.4426950408889634f * (fmaxf(x, 0.f) + log1pf(expf(-fabsf(x)))); }
    const int sc = tid & 31, ss = tid >> 5;
    const size_t rowb = (size_t)b * SEQ;
    const bf16_t* xbase = proj + rowb * PP + C_XR + ch0 + cg * 16;
    const bf16_t* gbase = proj + rowb * PP + C_GR + oc0 + sc;
    bf16_t* ybase = yabc + rowb * YW + Y_A + oc0 + sc;
    u32x4 xr[4][2]; unsigned short gv[8];
#define RG2_LOADX(T0) do { _Pragma("unroll") for (int k = 0; k < 4; ++k) { const int t = (T0) + crow_ - 3 + k; \
        if (t >= 0) { const bf16_t* p = xbase + (size_t)t * PP; xr[k][0] = *(const u32x4*)p; xr[k][1] = *(const u32x4*)(p + 8); } \
        else { xr[k][0] = (u32x4){0u, 0u, 0u, 0u}; xr[k][1] = (u32x4){0u, 0u, 0u, 0u}; } } } while (0)
    RG2_LOADX(0);
    __syncthreads();
    for (int ti = 0; ti < SEQ / TT; ++ti) {
        const int t0 = ti * TT;
        {
            float xc[16];
#pragma unroll
            for (int j = 0; j < 16; ++j) xc[j] = CW[4 * 64 + cg * 16 + j];
#pragma unroll
            for (int k = 0; k < 4; ++k) {
#pragma unroll
                for (int q = 0; q < 2; ++q) { const u32x4 w = xr[k][q]; const unsigned ww[4] = {w.x, w.y, w.z, w.w};
#pragma unroll
                    for (int j = 0; j < 4; ++j) { const int c = q * 8 + 2 * j;
                        xc[c] += CW[k * 64 + cg * 16 + c] * bf2f(ww[j] & 0xffffu); xc[c + 1] += CW[k * 64 + cg * 16 + c + 1] * bf2f(ww[j] >> 16); } } }
            u32x4 o0, o1;
            o0.x = pk2(xc[0], xc[1]); o0.y = pk2(xc[2], xc[3]); o0.z = pk2(xc[4], xc[5]); o0.w = pk2(xc[6], xc[7]);
            o1.x = pk2(xc[8], xc[9]); o1.y = pk2(xc[10], xc[11]); o1.z = pk2(xc[12], xc[13]); o1.w = pk2(xc[14], xc[15]);
            *(LAS u32x4*)(lds + L_XCB + crow_ * XS + cg * 32) = o0; *(LAS u32x4*)(lds + L_XCB + crow_ * XS + cg * 32 + 16) = o1;
            if ((cg >> 1) == hf) { LAS float* d = XCF + crow_ * FS + (cg & 1) * 16;
#pragma unroll
                for (int j = 0; j < 4; ++j) *(LAS f32x4*)(d + 4 * j) = (f32x4){xc[4 * j], xc[4 * j + 1], xc[4 * j + 2], xc[4 * j + 3]}; }
        }
#pragma unroll
        for (int k = 0; k < 8; ++k) gv[k] = gbase[(size_t)(t0 + ss * 8 + k) * PP];
        __syncthreads();
        if (ti + 1 < SEQ / TT) RG2_LOADX(t0 + TT);
        {
            f32x4 ar[2], ai[2];
#pragma unroll
            for (int s = 0; s < 2; ++s) { ar[s] = (f32x4){0.f, 0.f, 0.f, 0.f}; ai[s] = (f32x4){0.f, 0.f, 0.f, 0.f}; }
#pragma unroll
            for (int kk = 0; kk < 2; ++kk) {
                const bf16x8 bwa = *(const LAS bf16x8*)(lds + L_WA + eo * XS + (32 * kk + 8 * g4) * 2);
                const bf16x8 bwx = *(const LAS bf16x8*)(lds + L_WX + eo * XS + (32 * kk + 8 * g4) * 2);
#pragma unroll
                for (int s = 0; s < 2; ++s) {
                    const bf16x8 av = *(const LAS bf16x8*)(lds + L_XCB + (mt * 32 + 16 * s + e16) * XS + (32 * kk + 8 * g4) * 2);
                    ar[s] = __builtin_amdgcn_mfma_f32_16x16x32_bf16(av, bwa, ar[s], 0, 0, 0);
                    ai[s] = __builtin_amdgcn_mfma_f32_16x16x32_bf16(av, bwx, ai[s], 0, 0, 0);
                }
            }
#pragma unroll
            for (int s = 0; s < 2; ++s)
#pragma unroll
                for (int rg = 0; rg < 4; ++rg) {
                    const int tok = mt * 32 + 16 * s + 4 * g4 + rg;
                    const float er = fexp2(-1.4426950408889634f * (ar[s][rg] + gba)) + 1.0f, ei = fexp2(-1.4426950408889634f * (ai[s][rg] + gbx)) + 1.0f;
                    const float pr = frcp(er * ei);
                    const float rgt = ei * pr, igt = er * pr;
                    const float a = fexp2(rgt * gk1);
                    const float om = fmaxf(1.0f - a * a, 0.f);
                    const float u = __builtin_amdgcn_sqrtf(om) * igt * XCF[tok * FS + eo];
                    AV[tok * FS + eo] = a; UV[tok * FS + eo] = u;
                }
        }
        __syncthreads();
        float hl[8], ac[8];
        { float Hh = 0.f, Aa = 1.f;
#pragma unroll
          for (int k = 0; k < 8; ++k) { const float a = AV[(ss * 8 + k) * FS + sc], u = UV[(ss * 8 + k) * FS + sc]; Hh = a * Hh + u; Aa *= a; hl[k] = Hh; ac[k] = Aa; }
          SEGA[ss * 32 + sc] = Aa; SEGH[ss * 32 + sc] = Hh; }
        __syncthreads();
        { float cin = CARRY[(ti & 1) * 32 + sc];
#pragma unroll
          for (int s2 = 0; s2 < 15; ++s2) { const float sa = SEGA[s2 * 32 + sc], sh = SEGH[s2 * 32 + sc]; cin = (s2 < ss) ? sa * cin + sh : cin; }
#pragma unroll
          for (int k = 0; k < 8; ++k) { const float hv = hl[k] + ac[k] * cin; hl[k] = hv;
              ybase[(size_t)(t0 + ss * 8 + k) * YW] = (bf16_t)f2bf(bf2f(gv[k]) * hv); }
          if (ss == 15) CARRY[((ti + 1) & 1) * 32 + sc] = hl[7]; }
    }
    __syncthreads();
#undef RG2_LOADX
}
}
constexpr size_t MiB = 1u << 20;
constexpr size_t WS_CTL = 0, CTL_ZERO_BYTES = 64 * 1024, WS_ROWTOK = 256 * 1024, WS_ROWDST = 400 * 1024, WS_ROWW = 544 * 1024, WS_TILEE = 700 * 1024, WS_NTILES = 702 * 1024, WS_TOKPOS = 128 * 1024, WS_YPART = 325 * MiB;
constexpr size_t WS_MOD = 1 * MiB, WS_CS = 1 * MiB + 512 * 1024, WS_KMEAN = 5 * MiB + 512 * 1024, WS_TOPI = 5 * MiB + 640 * 1024, WS_TOPW = 5 * MiB + 768 * 1024;
constexpr size_t WS_L1W = 6 * MiB, WS_H = 28 * MiB, WS_YABC = 60 * MiB, WS_PROJ = 124 * MiB, WS_XA = 380 * MiB, WS_SPARE = 444 * MiB, WS_END = 488 * MiB;
constexpr size_t WS_HMID_MOE = 138 * MiB, OUT_W2 = 0, OUT_W13A = 44 * MiB, WS_W13B = 444 * MiB, WS_W13C = 6 * MiB, WS_W13D = 124 * MiB, W13_BYTES = 11 * MiB, W2_BYTES = 5 * MiB + 512 * 1024;
constexpr size_t LW_IN = 0, LW_BRA = 16 * MiB, LW_BRB = 18 * MiB, LW_BRC = 19 * MiB, LW_OUT = 20 * MiB, LW_W13 = 22 * MiB, LW_W2 = 33 * MiB;
constexpr int CW_TMO = 0, CW_QUEUE = 64  , CW_BAR = 4096;
constexpr int LDS_MISC = 131072 + 8192, LDS_TOTAL = 147456;


#define XB_TMO      128
#define XB_XCNT(j)  (256  + 64 * (j))
#define XB_XSUB(j)  (1280 + 64 * (j))
#define XB_XGEN(j)  (2304 + 64 * (j))
#define XB_TOP      3328
#define XB_TOPGEN   3392
#define XCD_BAR_WORDS 3456
#define XB_SPIN_CAP (1u << 18)

__device__ __forceinline__ unsigned xb_ld(unsigned* p)              { return __hip_atomic_load(p, __ATOMIC_RELAXED, __HIP_MEMORY_SCOPE_AGENT); }
__device__ __forceinline__ unsigned xb_add(unsigned* p, unsigned v) { return __hip_atomic_fetch_add(p, v, __ATOMIC_RELAXED, __HIP_MEMORY_SCOPE_AGENT); }
__device__ __forceinline__ unsigned xb_xcc_id() { return (unsigned)__builtin_amdgcn_s_getreg((3 << 11) | 20) & 0xFu; }
#define XB_SPIN(cond, bar) do { unsigned _sp = 0; while (cond) { __builtin_amdgcn_s_sleep(1); \
    if ((++_sp & 255u) == 0u) { if (xb_ld(&(bar)[XB_TMO])) break; if (_sp > XB_SPIN_CAP) { atomicAdd(&(bar)[XB_TMO], 1u); break; } } } } while (0)

struct XcdBarrier {
    unsigned* bar; unsigned x;
    volatile LAS unsigned* st;
};

__device__ __forceinline__ XcdBarrier xcd_barrier_post(unsigned* bar, volatile LAS unsigned* st) {
    XcdBarrier b; b.bar = bar; b.x = xb_xcc_id(); b.st = st;
    if (threadIdx.x == 0) (void)xb_add(&bar[XB_XCNT(b.x)], 1u);
    return b;
}
__device__ __forceinline__ void xcd_barrier_complete(unsigned* bar, unsigned x, unsigned& nloc, unsigned& nx) {
    const unsigned G = gridDim.x * gridDim.y * gridDim.z;
    unsigned sum, cnt, mine, sp = 0u;
    for (;;) {
        sum = 0u; cnt = 0u; mine = 0u;
#pragma unroll
        for (unsigned j = 0; j < 16; ++j) { const unsigned c = xb_ld(&bar[XB_XCNT(j)]); sum += c; cnt += (c > 0u) ? 1u : 0u; mine = (j == x) ? c : mine; }
        if (sum == G) break;
        __builtin_amdgcn_s_sleep(1);
        if ((++sp & 255u) == 0u) { if (xb_ld(&bar[XB_TMO])) break; if (sp > XB_SPIN_CAP) { atomicAdd(&bar[XB_TMO], 1u); break; } }
    }
    nloc = mine > 0u ? mine : 1u; nx = cnt > 0u ? cnt : 1u;
}

__device__ __forceinline__ void xcd_barrier(const XcdBarrier& b) {
    asm volatile("s_waitcnt vmcnt(0)" ::: "memory");
    __syncthreads();
    if (threadIdx.x == 0) {
        unsigned* bar = b.bar;
        __builtin_amdgcn_s_waitcnt(0);
        unsigned nloc = b.st[0], nx = b.st[1];
        if (nloc == 0u) { xcd_barrier_complete(bar, b.x, nloc, nx); b.st[0] = nloc; b.st[1] = nx; }
        const unsigned old = xb_add(&bar[XB_XSUB(b.x)], 1u);
        const unsigned gen = old / nloc;
        if (old + 1u == (gen + 1u) * nloc) {
            __builtin_amdgcn_fence(__ATOMIC_RELEASE, "agent");
            asm volatile("s_waitcnt vmcnt(0)" ::: "memory");
            const unsigned og = xb_add(&bar[XB_TOP], 1u);
            const unsigned tg = og / nx;
            if (og + 1u == (tg + 1u) * nx) xb_add(&bar[XB_TOPGEN], 1u);
            else XB_SPIN(xb_ld(&bar[XB_TOPGEN]) == tg, bar);
            __builtin_amdgcn_fence(__ATOMIC_ACQUIRE, "agent");
            xb_add(&bar[XB_XGEN(b.x)], 1u);
            asm volatile("s_waitcnt vmcnt(0)" ::: "memory");
        } else {
            XB_SPIN(xb_ld(&bar[XB_XGEN(b.x)]) == gen, bar);
            __builtin_amdgcn_fence(__ATOMIC_ACQUIRE, "agent");
            asm volatile("s_waitcnt vmcnt(0)" ::: "memory");
        }
    }
    __syncthreads();
}


#ifndef PHMASK
#define PHMASK 0xFFFFF
#endif
#define PH(k) if constexpr ((PHMASK >> (k)) & 1)
#define QOFF 0
__device__ __forceinline__ const float* ldptr(const LAS unsigned long long* PT, int i) {
    const unsigned long long v = PT[i];
    const unsigned lo = __builtin_amdgcn_readfirstlane((unsigned)v), hi = __builtin_amdgcn_readfirstlane((unsigned)(v >> 32));
    return (const float*)(const __attribute__((address_space(1))) float*)(((unsigned long long)hi << 32) | lo);
}
struct CvtD { unsigned long long src, dst; int K, N, ldk, coff, row_off, mode, nunits, pad; };
__device__ __forceinline__ void cvt_unit(const LAS CvtD* cd, int first, int u, LAS float* scr, int wid, int lane) {
    int d = first;
    while (u >= cd[d].nunits) { u -= cd[d].nunits; ++d; }
    const float* W = (const float*)(const __attribute__((address_space(1))) float*)cd[d].src; bf16_t* WT = (bf16_t*)(__attribute__((address_space(1))) bf16_t*)cd[d].dst;
    const int N = cd[d].N, ldk = cd[d].ldk, coff = cd[d].coff, row_off = cd[d].row_off, mode = cd[d].mode;
    LAS unsigned* T = (LAS unsigned*)scr;
    thin::TItem t0, t1;
    thin::titem_load(t0, W, N, 64 * u + wid, lane);
#pragma unroll 1
    for (int i = 0; i < 8; i += 2) { const int it = 64 * u + wid + 8 * i;
        thin::titem_load(t1, W, N, it + 8, lane);
        thin::titem_store(t0, N, WT, ldk, coff, row_off, mode, T, it, lane);
        if (i + 2 < 8) thin::titem_load(t0, W, N, it + 16, lane);
        thin::titem_store(t1, N, WT, ldk, coff, row_off, mode, T, it + 8, lane); }
}
__device__ __forceinline__ void cvt_find(const LAS CvtD* cd, int first, int it, int& d, int& loc) { d = first; while (it >= cd[d].nunits * 64) { it -= cd[d].nunits * 64; ++d; } loc = it; }
__device__ __forceinline__ void cvt_flat(const LAS CvtD* cd, int first, int total, LAS float* scr, int gw, int ngw, int lane) {
    LAS unsigned* T = (LAS unsigned*)scr;
    int it = gw; if (it >= total) return;
    int d, loc; cvt_find(cd, first, it, d, loc);
    thin::TItem cur; thin::titem_load(cur, (const float*)(const __attribute__((address_space(1))) float*)cd[d].src, cd[d].N, loc, lane);
#pragma unroll 1
    while (it < total) {
        const int nx = it + ngw; int d2 = d, loc2 = loc;
        thin::TItem nxt;
        if (nx < total) { cvt_find(cd, first, nx, d2, loc2); thin::titem_load(nxt, (const float*)(const __attribute__((address_space(1))) float*)cd[d2].src, cd[d2].N, loc2, lane); }
        thin::titem_store(cur, cd[d].N, (bf16_t*)(__attribute__((address_space(1))) bf16_t*)cd[d].dst, cd[d].ldk, cd[d].coff, cd[d].row_off, cd[d].mode, T, loc, lane);
        cur = nxt; it = nx; d = d2; loc = loc2;
    }
}
struct Args { const float* in[37]; float* out; unsigned char* ws; };

__device__ __forceinline__ float diff_lambda(const float* lq1, const float* lk1, const float* lq2, const float* lk2, float lam_init, int lane) {
    const float s1 = wave_sum(lq1[lane] * lk1[lane]), s2 = wave_sum(lq2[lane] * lk2[lane]); return expf(s1) - expf(s2) + lam_init; }

constexpr int NQ_RG = 256;
constexpr int NCVT0 = 77, NCVT1 = 198;
__global__ void __launch_bounds__(512, 2) mega_fwd(Args a) {
    extern __shared__ __attribute__((aligned(16))) unsigned char lds_raw[];
    LAS unsigned char* lds = (LAS unsigned char*)lds_raw;
    volatile LAS unsigned* MISC = (volatile LAS unsigned*)(lds + LDS_MISC);
    const int tid0 = threadIdx.x, wid0 = __builtin_amdgcn_readfirstlane(tid0 >> 6);
    const int G = gridDim.x, bid = blockIdx.x;
    if (tid0 < 64) MISC[tid0] = 0u;
    LAS unsigned long long* PT = (LAS unsigned long long*)(lds + LDS_MISC + 256);
    if (tid0 == 0) {
#pragma unroll
        for (int i = 0; i < 37; ++i) PT[i] = (unsigned long long)a.in[i];
    }
    LAS CvtD* CD = (LAS CvtD*)(lds + LDS_MISC + 1024);
    if (tid0 == 64) {
        const unsigned long long wsb = (unsigned long long)a.ws, ob = (unsigned long long)a.out;
#define CVT_PUT(i, SRC, DST, K_, N_, LDK, COFF, MODE) do { CD[i].src = (unsigned long long)(SRC); CD[i].dst = (DST); CD[i].K = (K_); CD[i].N = (N_); CD[i].ldk = (LDK); CD[i].coff = (COFF); CD[i].row_off = 0; CD[i].mode = (MODE); CD[i].nunits = ((K_) >> 6) * ((N_) >> 6) / 64; CD[i].pad = 0; } while (0)
        CVT_PUT(0, a.in[7] + (size_t)D * INC, wsb + WS_L1W + LW_IN, D, INC, D, 0, 3);
        CVT_PUT(1, a.in[25] + (size_t)D * D, wsb + WS_L1W + LW_BRA, D, D, 2048, 0, 0);
        CVT_PUT(2, a.in[26] + (size_t)512 * D, wsb + WS_L1W + LW_BRA, 512, D, 2048, 1024, 0);
        CVT_PUT(3, a.in[27] + (size_t)512 * D, wsb + WS_L1W + LW_BRA, 512, D, 2048, 1536, 0);
        CVT_PUT(4, a.in[28] + (size_t)D * D, wsb + WS_L1W + LW_OUT, D, D, D, 0, 0);
        CVT_PUT(5, a.in[29], ob + LW_W13, D, DFF, D, 0, 1);
        CVT_PUT(6, a.in[30], ob + LW_W13, D, DFF, D, 0, 2);
        CVT_PUT(7, a.in[31], ob + LW_W2, DFF, D, DFF, 0, 0);
#pragma unroll
        for (int e = 0; e < NE; ++e) CVT_PUT(8 + e, a.in[36] + (size_t)e * DFF * D, ob + OUT_W2 + e * W2_BYTES, DFF, D, DFF, 0, 0);
#pragma unroll
        for (int e = 0; e < 5; ++e) { const unsigned long long dst = (e == 0) ? ob + OUT_W13A : wsb + WS_W13B + (e - 1) * W13_BYTES;
            CVT_PUT(16 + 2 * e, a.in[34] + (size_t)e * D * DFF, dst, D, DFF, D, 0, 1); CVT_PUT(17 + 2 * e, a.in[35] + (size_t)e * D * DFF, dst, D, DFF, D, 0, 2); }
        CVT_PUT(26, a.in[7], ob + LW_IN, D, INC, D, 0, 3);
        CVT_PUT(27, a.in[25], ob + LW_BRA, D, D, 2048, 0, 0);
        CVT_PUT(28, a.in[26], ob + LW_BRA, 512, D, 2048, 1024, 0);
        CVT_PUT(29, a.in[27], ob + LW_BRA, 512, D, 2048, 1536, 0);
        CVT_PUT(30, a.in[28], ob + LW_OUT, D, D, D, 0, 0);
#pragma unroll
        for (int e = 5; e < NE; ++e) { const unsigned long long dst = (e < 7) ? wsb + WS_W13C + (e - 5) * W13_BYTES : wsb + WS_W13D;
            CVT_PUT(31 + 2 * (e - 5), a.in[34] + (size_t)e * D * DFF, dst, D, DFF, D, 0, 1); CVT_PUT(32 + 2 * (e - 5), a.in[35] + (size_t)e * D * DFF, dst, D, DFF, D, 0, 2); }
#undef CVT_PUT
    }
    __syncthreads();
    XcdBarrier bar = xcd_barrier_post((unsigned*)(a.ws + WS_CTL) + CW_BAR, MISC + 8);
#define F(i) ldptr(PT, (i))
#define PHASE_VARS(lv) \
    unsigned long long ws_u = (unsigned long long)a.ws, out_u = (unsigned long long)a.out; const int l = (lv); int wid = wid0; \
    asm volatile("" : "+s"(ws_u), "+s"(out_u), "+s"(wid)); \
    const int lane = lane_fresh(), tid = wid * 64 + lane; \
    unsigned char* ws = (unsigned char*)(__attribute__((address_space(1))) unsigned char*)ws_u; float* outp = (float*)(__attribute__((address_space(1))) float*)out_u; \
    const int gw = bid * 8 + wid, ngw = G * 8, gtid = bid * 512 + tid, ngt = G * 512; (void)gw; (void)ngw; (void)gtid; (void)ngt; (void)lane; (void)l; (void)tid; \
    char* outb = (char*)outp; (void)outb; \
    float* mod = (float*)(ws + WS_MOD); f32x2* cs = (f32x2*)(ws + WS_CS); float* kmean = (float*)(ws + WS_KMEAN); (void)mod; (void)cs; (void)kmean; \
    bf16_t* H = (bf16_t*)(ws + WS_H); bf16_t* YABC = (bf16_t*)(ws + WS_YABC); bf16_t* PROJ = (bf16_t*)(ws + WS_PROJ); bf16_t* GATES = (bf16_t*)(ws + WS_PROJ + (size_t)M * PP * 2); (void)GATES; float* XA = (float*)(ws + WS_XA); (void)H; (void)YABC; (void)PROJ; (void)XA; \
    const float* xin = (l == 0) ? F(0) : (const float*)XA; float* x1 = XA; const char* lwb = (l == 0) ? (const char*)outb : (const char*)ws + WS_L1W; \
    const float* modl = mod + (size_t)l * NB * 6 * D; (void)xin; (void)x1; (void)lwb; (void)modl;

    PH(0) { PHASE_VARS(0)
        LAS float* scr = (LAS float*)(lds + wid * 8192);
        cvt_flat(CD, 26, 2816, scr, gw, ngw, lane);
        __syncthreads();
        thin::mod_body(F(1), F(3), F(4), mod, bid, G, tid, (LAS float*)(lds + 65536));
        thin::rope_body((const int*)F(2), cs, gtid, ngt);
    }
    xcd_barrier(bar);

    {
        PH(1) { PHASE_VARS(0) thin::norm_body(xin, F(5) + l * D, modl + 0 * D, modl + 1 * D, H, gw, ngw, lane);
          for (int i = gtid; i < NB * 8 * 8 * 64; i += ngt) kmean[i] = 0.f; }
        xcd_barrier(bar);
        PH(2) { PHASE_VARS(0) pg8::DenseProb g{H, (const bf16_t*)(lwb + LW_IN), D, D, D, 0}; pg8::StaticOrder S; S.init(M, INC, G, bid);
          pg8::gemm_phase<pg8::DenseProb, epi::Proj, pg8::StaticOrder, true>(lds, g, S, epi::Proj{PROJ, F(8) + l * 3 * D, GATES, cs, F(16) + l * 64, F(17) + l * 64, F(23) + l * 64, F(24) + l * 64, kmean}, wid); }
        xcd_barrier(bar);
        {
#define POP_Q() do { __syncthreads(); if (tid == 0) MISC[16] = __hip_atomic_fetch_add((unsigned*)(ws + WS_CTL) + CW_QUEUE + 64 * (l + QOFF), 1u, __ATOMIC_RELAXED, __HIP_MEMORY_SCOPE_AGENT); __syncthreads(); q = (int)MISC[16]; } while (0)
#define POP_ISSUE() do { if (tid == 0) qn = __hip_atomic_fetch_add((unsigned*)(ws + WS_CTL) + CW_QUEUE + 64 * (l + QOFF), 1u, __ATOMIC_RELAXED, __HIP_MEMORY_SCOPE_AGENT); } while (0)
#define POP_TAKE() do { __syncthreads(); if (tid == 0) MISC[16] = qn; __syncthreads(); q = (int)MISC[16]; } while (0)
            int q; constexpr int NCVT = (0 == 0) ? NCVT0 : NCVT1;
            { PHASE_VARS(0) POP_Q(); }
            PH(5) { PHASE_VARS(0)
              const float lam_init = 0.8f - 0.6f * expf(-0.3f * (float)l);
              const float lam = diff_lambda(F(18) + l * 64, F(19) + l * 64, F(20) + l * 64, F(21) + l * 64, lam_init, lane);
              const float noff = attn::score_shift(F(16) + l * 64, F(17) + l * 64, lane);
#pragma unroll 1
              while (q < 256) { const int i = q; unsigned qn = 0u; POP_ISSUE();
                attn::diff_unit((i & 31) >> 2, i & 3, 7 - (i >> 5), PROJ, YABC, F(22) + l * 128, lam, 1.0f - lam_init, noff, (LAS char*)lds, wid);
                POP_TAKE(); } }
            PH(18) { PHASE_VARS(0)
#pragma unroll 1
              while (q < 256 + NCVT) { unsigned qn = 0u; POP_ISSUE(); __syncthreads(); cvt_unit(CD, l == 0 ? 0 : 8, q - 256, (LAS float*)(lds + wid * 8192), wid, lane);
                POP_TAKE(); } }
            PH(4) { PHASE_VARS(0)
#pragma unroll 1
              while (q < 256 + NCVT + NQ_RG) { const int i = q - 256 - NCVT; unsigned qn = 0u; POP_ISSUE();
                rg2::unit(i >> 5, (i >> 1) & 15, i & 1, PROJ, YABC, F(9) + l * 4 * D, F(10) + l * D, F(11) + (size_t)l * 16 * 4096, F(12) + l * D, F(13) + (size_t)l * 16 * 4096, F(14) + l * D, F(15) + l * D, (LAS char*)lds, wid);
                POP_TAKE(); } }
            PH(6) { PHASE_VARS(0)
              const float noff = attn::score_shift(F(23) + l * 64, F(24) + l * 64, lane);
#pragma unroll 1
              while (q < 256 + NCVT + NQ_RG + 512) { const int i = q - NQ_RG - 256 - NCVT; unsigned qn = 0u; POP_ISSUE();
                attn::moba_unit((i & 63) >> 3, i & 7, 7 - (i >> 6), PROJ, YABC, kmean, noff, (LAS char*)lds, wid);
                POP_TAKE(); } }
#undef POP_Q
#undef POP_ISSUE
#undef POP_TAKE
        }
        xcd_barrier(bar);
        PH(7) { PHASE_VARS(0) pg8::StaticOrder S; S.init(M, D, G, bid); pg8::DenseProb g{YABC, (const bf16_t*)(lwb + LW_BRA), 2048, YW, 2048, 0};
          pg8::gemm_phase<pg8::DenseProb, epi::BranchMerge, pg8::StaticOrder, true>(lds, g, S, epi::BranchMerge{GATES, H, 16, 24}, wid); }
        xcd_barrier(bar);
        PH(8) { PHASE_VARS(0) pg8::DenseProb g{H, (const bf16_t*)(lwb + LW_OUT), D, D, D, 0}; pg8::StaticOrder S; S.init(M, D, G, bid);
          pg8::gemm_phase<pg8::DenseProb, epi::Resid, pg8::StaticOrder, true>(lds, g, S, epi::Resid{xin, x1, modl + 2 * D}, wid); }
        xcd_barrier(bar);
        if (0 == 0) {
            PH(9) { PHASE_VARS(0) thin::norm_body(x1, F(6) + l * D, modl + 3 * D, modl + 4 * D, H, gw, ngw, lane); }
            xcd_barrier(bar);
            PH(10) { PHASE_VARS(0) pg8::DenseProb g{H, (const bf16_t*)(lwb + LW_W13), D, D, D, 0}; pg8::StaticOrder S; S.init(M, DFF2, G, bid);
              pg8::gemm_phase<pg8::DenseProb, epi::SwiGLU, pg8::StaticOrder, true>(lds, g, S, epi::SwiGLU{PROJ}, wid); }
            xcd_barrier(bar);
            PH(11) { PHASE_VARS(0) pg8::DenseProb g{PROJ, (const bf16_t*)(lwb + LW_W2), DFF, DFF, DFF, 0}; pg8::StaticOrder S; S.init(M, D, G, bid);
              pg8::gemm_phase<pg8::DenseProb, epi::Resid, pg8::StaticOrder, true>(lds, g, S, epi::Resid{x1, x1, modl + 5 * D}, wid); }
            xcd_barrier(bar);
        } else {
#define MOE_VARS \
            bf16_t* W2 = (bf16_t*)(outb + OUT_W2); bf16_t* h2 = H; bf16_t* hmid = (bf16_t*)(ws + WS_HMID_MOE); bf16_t* yslot = YABC; \
            int* topi = (int*)(ws + WS_TOPI); float* topw = (float*)(ws + WS_TOPW); int* rowtok = (int*)(ws + WS_ROWTOK); int* rowdst = (int*)(ws + WS_ROWDST); float* roww = (float*)(ws + WS_ROWW); int* tile_e = (int*)(ws + WS_TILEE); int* ntiles = (int*)(ws + WS_NTILES); int* tokpos = (int*)(ws + WS_TOKPOS); bf16_t* ypart = (bf16_t*)(ws + WS_YPART); (void)tokpos; (void)ypart; \
            (void)W2; (void)h2; (void)hmid; (void)yslot; (void)topi; (void)topw; (void)rowtok; (void)rowdst; (void)roww; (void)tile_e; (void)ntiles;
            PH(12) { PHASE_VARS(0) MOE_VARS thin::norm_router_body(x1, F(6) + l * D, modl + 3 * D, modl + 4 * D, h2, F(32), F(33), topi, topw, gw, ngw, lane); }
            xcd_barrier(bar);
            PH(14) { PHASE_VARS(0) MOE_VARS if (bid == 0) moe::assign(topi, topw, rowtok, rowdst, roww, tile_e, ntiles, tokpos, (LAS int*)lds, tid); }
            PH(13) if (bid != 0) { PHASE_VARS(0) MOE_VARS LAS float* scr = (LAS float*)(lds + wid * 8192); const int gw2 = (bid - 1) * 8 + wid, ngw2 = (G - 1) * 8;
              cvt_flat(CD, 31, 4224, scr, gw2, ngw2, lane); }

            xcd_barrier(bar);
            PH(15) { PHASE_VARS(0) MOE_VARS moe::Order S{tile_e, ntiles, DFF2 / 256, 0, 0, 0}; S.dev_init(G, bid);
              pg8::gemm_phase<moe::ProbUp, epi::SwiGLU, moe::Order, true>(lds, moe::ProbUp{h2, (const bf16_t*)(outb + OUT_W13A), (const bf16_t*)(ws + WS_W13B), (const bf16_t*)(ws + WS_W13C), (const bf16_t*)(ws + WS_W13D), rowtok, D, D, D, 0}, S, epi::SwiGLU{hmid}, wid); }
            xcd_barrier(bar);
            PH(16) { { PHASE_VARS(0) MOE_VARS moe::OrderCap S{tile_e, ntiles, D / 256, 0, 0, 0}; S.dev_init(G, bid);
              pg8::gemm_phase<moe::ProbDown, epi::MoeDown, moe::OrderCap, true>(lds, moe::ProbDown{hmid, W2, DFF, DFF, DFF, 0}, S, epi::MoeDown{rowdst, roww, yslot}, wid); }
              { PHASE_VARS(0) MOE_VARS moe::OrderTail S{tile_e, ntiles, 0, 0, 0, 0}; S.dev_init(G, (bid + 128) % G);
              pg8::gemm_phase<moe::ProbDownK, epi::MoeDownTail, moe::OrderTail, true>(lds, moe::ProbDownK{hmid, W2, moe::KSPLIT, DFF, DFF, 0}, S, epi::MoeDownTail{roww, ypart}, wid); } }
            xcd_barrier(bar);
            PH(17) { PHASE_VARS(0) MOE_VARS thin::moe_combine_body(x1, yslot, ypart, tokpos, modl + 5 * D, outp, gtid, ngt); }
#undef MOE_VARS
        }
    }
    {
        PH(1) { PHASE_VARS(1) thin::norm_body(xin, F(5) + l * D, modl + 0 * D, modl + 1 * D, H, gw, ngw, lane);
          for (int i = gtid; i < NB * 8 * 8 * 64; i += ngt) kmean[i] = 0.f; }
        xcd_barrier(bar);
        PH(2) { PHASE_VARS(1) pg8::DenseProb g{H, (const bf16_t*)(lwb + LW_IN), D, D, D, 0}; pg8::StaticOrder S; S.init(M, INC, G, bid);
          pg8::gemm_phase<pg8::DenseProb, epi::Proj, pg8::StaticOrder, true>(lds, g, S, epi::Proj{PROJ, F(8) + l * 3 * D, GATES, cs, F(16) + l * 64, F(17) + l * 64, F(23) + l * 64, F(24) + l * 64, kmean}, wid); }
        xcd_barrier(bar);
        {
#define POP_Q() do { __syncthreads(); if (tid == 0) MISC[16] = __hip_atomic_fetch_add((unsigned*)(ws + WS_CTL) + CW_QUEUE + 64 * (l + QOFF), 1u, __ATOMIC_RELAXED, __HIP_MEMORY_SCOPE_AGENT); __syncthreads(); q = (int)MISC[16]; } while (0)
#define POP_ISSUE() do { if (tid == 0) qn = __hip_atomic_fetch_add((unsigned*)(ws + WS_CTL) + CW_QUEUE + 64 * (l + QOFF), 1u, __ATOMIC_RELAXED, __HIP_MEMORY_SCOPE_AGENT); } while (0)
#define POP_TAKE() do { __syncthreads(); if (tid == 0) MISC[16] = qn; __syncthreads(); q = (int)MISC[16]; } while (0)
            int q; constexpr int NCVT = (1 == 0) ? NCVT0 : NCVT1;
            { PHASE_VARS(1) POP_Q(); }
            PH(5) { PHASE_VARS(1)
              const float lam_init = 0.8f - 0.6f * expf(-0.3f * (float)l);
              const float lam = diff_lambda(F(18) + l * 64, F(19) + l * 64, F(20) + l * 64, F(21) + l * 64, lam_init, lane);
              const float noff = attn::score_shift(F(16) + l * 64, F(17) + l * 64, lane);
#pragma unroll 1
              while (q < 256) { const int i = q; unsigned qn = 0u; POP_ISSUE();
                attn::diff_unit((i & 31) >> 2, i & 3, 7 - (i >> 5), PROJ, YABC, F(22) + l * 128, lam, 1.0f - lam_init, noff, (LAS char*)lds, wid);
                POP_TAKE(); } }
            PH(18) { PHASE_VARS(1)
#pragma unroll 1
              while (q < 256 + NCVT) { unsigned qn = 0u; POP_ISSUE(); __syncthreads(); cvt_unit(CD, l == 0 ? 0 : 8, q - 256, (LAS float*)(lds + wid * 8192), wid, lane);
                POP_TAKE(); } }
            PH(4) { PHASE_VARS(1)
#pragma unroll 1
              while (q < 256 + NCVT + NQ_RG) { const int i = q - 256 - NCVT; unsigned qn = 0u; POP_ISSUE();
                rg2::unit(i >> 5, (i >> 1) & 15, i & 1, PROJ, YABC, F(9) + l * 4 * D, F(10) + l * D, F(11) + (size_t)l * 16 * 4096, F(12) + l * D, F(13) + (size_t)l * 16 * 4096, F(14) + l * D, F(15) + l * D, (LAS char*)lds, wid);
                POP_TAKE(); } }
            PH(6) { PHASE_VARS(1)
              const float noff = attn::score_shift(F(23) + l * 64, F(24) + l * 64, lane);
#pragma unroll 1
              while (q < 256 + NCVT + NQ_RG + 512) { const int i = q - NQ_RG - 256 - NCVT; unsigned qn = 0u; POP_ISSUE();
                attn::moba_unit((i & 63) >> 3, i & 7, 7 - (i >> 6), PROJ, YABC, kmean, noff, (LAS char*)lds, wid);
                POP_TAKE(); } }
#undef POP_Q
#undef POP_ISSUE
#undef POP_TAKE
        }
        xcd_barrier(bar);
        PH(7) { PHASE_VARS(1) pg8::StaticOrder S; S.init(M, D, G, bid); pg8::DenseProb g{YABC, (const bf16_t*)(lwb + LW_BRA), 2048, YW, 2048, 0};
          pg8::gemm_phase<pg8::DenseProb, epi::BranchMerge, pg8::StaticOrder, true>(lds, g, S, epi::BranchMerge{GATES, H, 16, 24}, wid); }
        xcd_barrier(bar);
        PH(8) { PHASE_VARS(1) pg8::DenseProb g{H, (const bf16_t*)(lwb + LW_OUT), D, D, D, 0}; pg8::StaticOrder S; S.init(M, D, G, bid);
          pg8::gemm_phase<pg8::DenseProb, epi::Resid, pg8::StaticOrder, true>(lds, g, S, epi::Resid{xin, x1, modl + 2 * D}, wid); }
        xcd_barrier(bar);
        if (1 == 0) {
            PH(9) { PHASE_VARS(1) thin::norm_body(x1, F(6) + l * D, modl + 3 * D, modl + 4 * D, H, gw, ngw, lane); }
            xcd_barrier(bar);
            PH(10) { PHASE_VARS(1) pg8::DenseProb g{H, (const bf16_t*)(lwb + LW_W13), D, D, D, 0}; pg8::StaticOrder S; S.init(M, DFF2, G, bid);
              pg8::gemm_phase<pg8::DenseProb, epi::SwiGLU, pg8::StaticOrder, true>(lds, g, S, epi::SwiGLU{PROJ}, wid); }
            xcd_barrier(bar);
            PH(11) { PHASE_VARS(1) pg8::DenseProb g{PROJ, (const bf16_t*)(lwb + LW_W2), DFF, DFF, DFF, 0}; pg8::StaticOrder S; S.init(M, D, G, bid);
              pg8::gemm_phase<pg8::DenseProb, epi::Resid, pg8::StaticOrder, true>(lds, g, S, epi::Resid{x1, x1, modl + 5 * D}, wid); }
            xcd_barrier(bar);
        } else {
#define MOE_VARS \
            bf16_t* W2 = (bf16_t*)(outb + OUT_W2); bf16_t* h2 = H; bf16_t* hmid = (bf16_t*)(ws + WS_HMID_MOE); bf16_t* yslot = YABC; \
            int* topi = (int*)(ws + WS_TOPI); float* topw = (float*)(ws + WS_TOPW); int* rowtok = (int*)(ws + WS_ROWTOK); int* rowdst = (int*)(ws + WS_ROWDST); float* roww = (float*)(ws + WS_ROWW); int* tile_e = (int*)(ws + WS_TILEE); int* ntiles = (int*)(ws + WS_NTILES); int* tokpos = (int*)(ws + WS_TOKPOS); bf16_t* ypart = (bf16_t*)(ws + WS_YPART); (void)tokpos; (void)ypart; \
            (void)W2; (void)h2; (void)hmid; (void)yslot; (void)topi; (void)topw; (void)rowtok; (void)rowdst; (void)roww; (void)tile_e; (void)ntiles;
            PH(12) { PHASE_VARS(1) MOE_VARS thin::norm_router_body(x1, F(6) + l * D, modl + 3 * D, modl + 4 * D, h2, F(32), F(33), topi, topw, gw, ngw, lane); }
            xcd_barrier(bar);
            PH(14) { PHASE_VARS(1) MOE_VARS if (bid == 0) moe::assign(topi, topw, rowtok, rowdst, roww, tile_e, ntiles, tokpos, (LAS int*)lds, tid); }
            PH(13) if (bid != 0) { PHASE_VARS(1) MOE_VARS LAS float* scr = (LAS float*)(lds + wid * 8192); const int gw2 = (bid - 1) * 8 + wid, ngw2 = (G - 1) * 8;
              cvt_flat(CD, 31, 4224, scr, gw2, ngw2, lane); }

            xcd_barrier(bar);
            PH(15) { PHASE_VARS(1) MOE_VARS moe::Order S{tile_e, ntiles, DFF2 / 256, 0, 0, 0}; S.dev_init(G, bid);
              pg8::gemm_phase<moe::ProbUp, epi::SwiGLU, moe::Order, true>(lds, moe::ProbUp{h2, (const bf16_t*)(outb + OUT_W13A), (const bf16_t*)(ws + WS_W13B), (const bf16_t*)(ws + WS_W13C), (const bf16_t*)(ws + WS_W13D), rowtok, D, D, D, 0}, S, epi::SwiGLU{hmid}, wid); }
            xcd_barrier(bar);
            PH(16) { { PHASE_VARS(1) MOE_VARS moe::OrderCap S{tile_e, ntiles, D / 256, 0, 0, 0}; S.dev_init(G, bid);
              pg8::gemm_phase<moe::ProbDown, epi::MoeDown, moe::OrderCap, true>(lds, moe::ProbDown{hmid, W2, DFF, DFF, DFF, 0}, S, epi::MoeDown{rowdst, roww, yslot}, wid); }
              { PHASE_VARS(1) MOE_VARS moe::OrderTail S{tile_e, ntiles, 0, 0, 0, 0}; S.dev_init(G, (bid + 128) % G);
              pg8::gemm_phase<moe::ProbDownK, epi::MoeDownTail, moe::OrderTail, true>(lds, moe::ProbDownK{hmid, W2, moe::KSPLIT, DFF, DFF, 0}, S, epi::MoeDownTail{roww, ypart}, wid); } }
            xcd_barrier(bar);
            PH(17) { PHASE_VARS(1) MOE_VARS thin::moe_combine_body(x1, yslot, ypart, tokpos, modl + 5 * D, outp, gtid, ngt); }
#undef MOE_VARS
        }
    }
#undef F
#undef PHASE_VARS
}

extern "C" void kernel_launch(void* const* d_in, const int* in_sizes, int n_in, void* d_out, int out_size, void* d_ws, size_t ws_size, hipStream_t stream) {
    static int grid = 0;
    if (grid == 0) {
        if (n_in != 37 || ws_size < WS_END) { fprintf(stderr, "kernel_launch: unexpected n_in %d / ws_size %zu (need %zu)\n", n_in, ws_size, (size_t)WS_END); grid = -1; return; }
        int dev = 0, cus = 0, per_cu = 0;
        if (hipGetDevice(&dev) != hipSuccess || hipDeviceGetAttribute(&cus, hipDeviceAttributeMultiprocessorCount, dev) != hipSuccess) { grid = -1; return; }
        if (hipFuncSetAttribute((const void*)mega_fwd, hipFuncAttributeMaxDynamicSharedMemorySize, LDS_TOTAL) != hipSuccess) { fprintf(stderr, "kernel_launch: hipFuncSetAttribute failed\n"); grid = -1; return; }
        if (hipOccupancyMaxActiveBlocksPerMultiprocessor(&per_cu, (const void*)mega_fwd, 512, LDS_TOTAL) != hipSuccess || per_cu < 1) fprintf(stderr, "kernel_launch: occupancy query says %d\n", per_cu);
        (void)hipGetLastError();
        grid = cus;
    }
    if (grid < 0) return;
    (void)hipMemsetAsync((char*)d_ws + WS_CTL, 0, CTL_ZERO_BYTES, stream);
    Args a{};
    for (int i = 0; i < 37; ++i) a.in[i] = (const float*)d_in[i];
    a.out = (float*)d_out; a.ws = (unsigned char*)d_ws;
    hipLaunchKernelGGL(mega_fwd, dim3(grid), dim3(512), LDS_TOTAL, stream, a);
}
```
